# Optimizing an MI355X kernel written in HIP

```python
import jax, jax.numpy as jnp
from jax import lax
import numpy as np

D_MODEL = 1024
BATCH = 32
SEQ = 2048
DEPTH = 2

CHUNK = 64
HEAD_DIM = 64
ROPE_THETA = 10000.0
EPS = 1e-6
A_Q_HEADS = (D_MODEL // 2) // HEAD_DIM
A_KV_HEADS = A_Q_HEADS // 4
A_WINDOW = 128
A_PREV_CHUNKS = A_WINDOW // CHUNK
B_KEY_DIM = 128
B_VAL_DIM = 128
B_HEADS = (D_MODEL // 2) // B_VAL_DIM
B_BLOCK = 32
C_HEADS = D_MODEL // HEAD_DIM
C_PREV_CHUNKS = 8
REL_CLIP = 128
D_FF = 2816
CONV_WIDTH = 3
A_Q_DIM = A_Q_HEADS * HEAD_DIM
A_KV_DIM = A_KV_HEADS * HEAD_DIM
B_QK_DIM = B_HEADS * B_KEY_DIM
B_V_DIM = B_HEADS * B_VAL_DIM
EVEN_IN = A_Q_DIM + 2 * A_KV_DIM + 2 * B_QK_DIM + 2 * B_V_DIM
EVEN_MIX = A_Q_DIM + B_V_DIM
EVEN_SPLITS = (A_Q_DIM,
               A_Q_DIM + A_KV_DIM,
               A_Q_DIM + 2 * A_KV_DIM,
               A_Q_DIM + 2 * A_KV_DIM + B_QK_DIM,
               A_Q_DIM + 2 * A_KV_DIM + 2 * B_QK_DIM,
               A_Q_DIM + 2 * A_KV_DIM + 2 * B_QK_DIM + B_V_DIM)
C_DIM = C_HEADS * HEAD_DIM
ODD_IN = 3 * C_DIM
N_EVEN = (DEPTH + 1) // 2
N_ODD = DEPTH // 2

kernel_name = "chunk_causal_hybrid_swa_hgrn2_relpos_convffn"

F32 = jnp.float32


def rms_norm(x, w):
    xf = x.astype(F32)
    y = xf * lax.rsqrt(jnp.mean(xf * xf, axis=-1, keepdims=True) + EPS)
    return (y * w.astype(F32)).astype(x.dtype)


def rope(x):
    S, D = x.shape[1], x.shape[3]
    inv_freq = ROPE_THETA ** (-jnp.arange(0, D, 2, dtype=F32) / D)
    ang = jnp.arange(S, dtype=F32)[:, None] * inv_freq[None, :]
    cos = jnp.cos(ang)[None, :, None, :]
    sin = jnp.sin(ang)[None, :, None, :]
    xf = x.astype(F32)
    x1, x2 = xf[..., : D // 2], xf[..., D // 2:]
    return jnp.concatenate([x1 * cos - x2 * sin, x2 * cos + x1 * sin], axis=-1).astype(x.dtype)


def chunk_band_attention(q, k, v, n_prev, bias, sinks):
    B, S, Hq, D = q.shape
    Hkv = k.shape[2]
    G = Hq // Hkv
    n_chunks = S // CHUNK
    pad = n_prev * CHUNK
    band = pad + CHUNK
    scale = D ** -0.5
    k_pad = jnp.pad(k, ((0, 0), (pad, 0), (0, 0), (0, 0)))
    v_pad = jnp.pad(v, ((0, 0), (pad, 0), (0, 0), (0, 0)))
    qc = jnp.moveaxis(q.reshape(B, n_chunks, CHUNK, Hkv, G, D), 1, 0)
    key_idx = jnp.arange(band)

    def one_chunk(args):
        c, q_c = args
        start = c * CHUNK
        k_c = lax.dynamic_slice_in_dim(k_pad, start, band, axis=1)
        v_c = lax.dynamic_slice_in_dim(v_pad, start, band, axis=1)
        s = jnp.einsum('bqhgd,bjhd->bhgqj', q_c, k_c).astype(F32) * scale
        if bias is not None:
            s = s + bias.reshape(Hkv, G, CHUNK, band).astype(F32)
        valid = key_idx >= pad - start
        s = jnp.where(valid, s, -jnp.inf)
        if sinks is not None:
            sk = sinks.reshape(Hkv, G).astype(F32)[None, :, :, None, None]
            m = jnp.maximum(jnp.max(s, axis=-1, keepdims=True), sk)
            p = jnp.exp(s - m)
            p = p / (jnp.sum(p, axis=-1, keepdims=True) + jnp.exp(sk - m))
        else:
            p = jax.nn.softmax(s, axis=-1)
        o = jnp.einsum('bhgqj,bjhd->bqhgd', p.astype(v.dtype), v_c)
        return o.reshape(B, CHUNK, Hq, D)

    out = lax.map(one_chunk, (jnp.arange(n_chunks), qc))
    return jnp.moveaxis(out, 0, 1).reshape(B, S, Hq, D)


def hgrn2(q, f_logit, i, g, lb, norm_w):
    B, S, H, DK = q.shape
    DV = i.shape[-1]
    N = S // B_BLOCK
    lbh = lb.reshape(H, DK).astype(F32)
    f = lbh + (1.0 - lbh) * jax.nn.sigmoid(f_logit.astype(F32))
    log_f = jnp.log(f)
    k = 1.0 - f

    def blk(t):
        return t.reshape(B, N, B_BLOCK, H, t.shape[-1])

    qf, kf, vf, lf = blk(q.astype(F32)), blk(k), blk(i.astype(F32)), blk(log_f)
    cum = jnp.cumsum(lf, axis=2)
    last = cum[:, :, -1:]
    q_dec = qf * jnp.exp(cum)
    k_dec = kf * jnp.exp(-cum)
    k_end = kf * jnp.exp(last - cum)
    blk_decay = jnp.exp(last[:, :, 0])
    causal = jnp.tril(jnp.ones((B_BLOCK, B_BLOCK), dtype=bool))
    s = jnp.einsum('bnlhd,bnmhd->bnhlm', q_dec, k_dec)
    s = jnp.where(causal, s, 0.0)
    o_intra = jnp.einsum('bnhlm,bnmhe->bnlhe', s, vf)

    def step(state, xs):
        qd, ke, vv, dec = xs
        o = jnp.einsum('blhd,bhde->blhe', qd, state)
        state = dec[..., None] * state + jnp.einsum('blhd,blhe->bhde', ke, vv)
        return state, o

    state0 = jnp.zeros((B, H, DK, DV), F32)
    xs = (jnp.moveaxis(q_dec, 1, 0), jnp.moveaxis(k_end, 1, 0),
          jnp.moveaxis(vf, 1, 0), jnp.moveaxis(blk_decay, 1, 0))
    _, o_inter = lax.scan(step, state0, xs)
    o = (o_intra + jnp.moveaxis(o_inter, 0, 1)).reshape(B, S, H, DV)
    o = o * lax.rsqrt(jnp.mean(o * o, axis=-1, keepdims=True) + EPS) * norm_w.reshape(H, DV).astype(F32)
    return (o * jax.nn.silu(g.astype(F32))).astype(i.dtype)


def even_mixer(y, w_in, w_out, sinks, lb, gnorm_w):
    B, S, _ = y.shape
    proj = y @ w_in
    qa, ka, va, qb, fb, ib, gb = jnp.split(proj, EVEN_SPLITS, axis=-1)
    qa = rope(qa.reshape(B, S, A_Q_HEADS, HEAD_DIM))
    ka = rope(ka.reshape(B, S, A_KV_HEADS, HEAD_DIM))
    va = va.reshape(B, S, A_KV_HEADS, HEAD_DIM)
    oa = chunk_band_attention(qa, ka, va, A_PREV_CHUNKS, None, sinks)
    ob = hgrn2(qb.reshape(B, S, B_HEADS, B_KEY_DIM), fb.reshape(B, S, B_HEADS, B_KEY_DIM),
               ib.reshape(B, S, B_HEADS, B_VAL_DIM), gb.reshape(B, S, B_HEADS, B_VAL_DIM),
               lb, gnorm_w)
    o = jnp.concatenate([oa.reshape(B, S, A_Q_DIM), ob.reshape(B, S, B_V_DIM)], axis=-1)
    return o @ w_out


def odd_mixer(y, w_in, w_out, rel_table):
    B, S, _ = y.shape
    proj = y @ w_in
    q, k, v = jnp.split(proj, (C_DIM, 2 * C_DIM), axis=-1)
    q = q.reshape(B, S, C_HEADS, HEAD_DIM)
    k = k.reshape(B, S, C_HEADS, HEAD_DIM)
    v = v.reshape(B, S, C_HEADS, HEAD_DIM)
    pad = C_PREV_CHUNKS * CHUNK
    band = pad + CHUNK
    rel = jnp.arange(CHUNK)[:, None] + pad - jnp.arange(band)[None, :]
    idx = jnp.clip(rel, -REL_CLIP, REL_CLIP) + REL_CLIP
    bias = rel_table[:, idx]
    o = chunk_band_attention(q, k, v, C_PREV_CHUNKS, bias, None)
    return o.reshape(B, S, C_DIM) @ w_out


def conv_ffn(y, w_up, conv_w, conv_b, w_down):
    S = y.shape[1]
    up = y @ w_up
    u, v = jnp.split(up, 2, axis=-1)
    u_pad = jnp.pad(u, ((0, 0), (CONV_WIDTH - 1, 0), (0, 0)))
    c = conv_b
    for j in range(CONV_WIDTH):
        c = c + conv_w[j] * u_pad[:, j:j + S]
    return (jax.nn.gelu(c, approximate=False) * v) @ w_down


def setup_inputs(seed: int = 0) -> dict:
    key = jax.random.key(seed)
    ks = jax.random.split(key, 16)
    nrm = jax.random.normal
    x = nrm(ks[0], (BATCH, SEQ, D_MODEL), F32)
    even_w_in = nrm(ks[1], (N_EVEN, D_MODEL, EVEN_IN), F32) * D_MODEL ** -0.5
    even_w_out = nrm(ks[2], (N_EVEN, EVEN_MIX, D_MODEL), F32) * EVEN_MIX ** -0.5
    even_sinks = nrm(ks[3], (N_EVEN, A_Q_HEADS), F32) * 0.5
    hgrn_lb_logits = nrm(ks[4], (N_EVEN + 1, B_QK_DIM), F32) * 0.1
    hgrn_norm_w = 1.0 + 0.02 * nrm(ks[5], (N_EVEN, B_V_DIM), F32)
    odd_w_in = nrm(ks[6], (N_ODD, D_MODEL, ODD_IN), F32) * D_MODEL ** -0.5
    odd_w_out = nrm(ks[7], (N_ODD, C_DIM, D_MODEL), F32) * C_DIM ** -0.5
    odd_rel_bias = nrm(ks[8], (N_ODD, C_HEADS, 2 * REL_CLIP + 1), F32) * 0.1
    ffn_w_up = nrm(ks[9], (DEPTH, D_MODEL, 2 * D_FF), F32) * D_MODEL ** -0.5
    ffn_conv_w = nrm(ks[10], (DEPTH, CONV_WIDTH, D_FF), F32) * CONV_WIDTH ** -0.5
    ffn_conv_b = nrm(ks[11], (DEPTH, D_FF), F32) * 0.02
    ffn_w_down = nrm(ks[12], (DEPTH, D_FF, D_MODEL), F32) * D_FF ** -0.5
    norm_w = 1.0 + 0.02 * nrm(ks[13], (DEPTH, 4, D_MODEL), F32)
    return {"x": x, "even_w_in": even_w_in, "even_w_out": even_w_out, "even_sinks": even_sinks,
            "hgrn_lb_logits": hgrn_lb_logits, "hgrn_norm_w": hgrn_norm_w,
            "odd_w_in": odd_w_in, "odd_w_out": odd_w_out, "odd_rel_bias": odd_rel_bias,
            "ffn_w_up": ffn_w_up, "ffn_conv_w": ffn_conv_w, "ffn_conv_b": ffn_conv_b,
            "ffn_w_down": ffn_w_down, "norm_w": norm_w}


def reference(x, even_w_in, even_w_out, even_sinks, hgrn_lb_logits, hgrn_norm_w,
              odd_w_in, odd_w_out, odd_rel_bias, ffn_w_up, ffn_conv_w, ffn_conv_b,
              ffn_w_down, norm_w):
    lb_all = jnp.cumsum(jax.nn.softmax(hgrn_lb_logits.astype(F32), axis=0), axis=0)
    h = x
    for layer in range(DEPTH):
        nw = norm_w[layer]
        j = layer // 2
        y = rms_norm(h, nw[0])
        if layer % 2 == 0:
            y = even_mixer(y, even_w_in[j], even_w_out[j], even_sinks[j], lb_all[j], hgrn_norm_w[j])
        else:
            y = odd_mixer(y, odd_w_in[j], odd_w_out[j], odd_rel_bias[j])
        h = h + rms_norm(y, nw[1])
        y = conv_ffn(rms_norm(h, nw[2]), ffn_w_up[layer], ffn_conv_w[layer], ffn_conv_b[layer], ffn_w_down[layer])
        h = h + rms_norm(y, nw[3])
    return h
```

```cpp
#include <hip/hip_runtime.h>
#include <cstdio>
#include <cstdint>
#include <cmath>
namespace pg8 {
#define PG8_LAS __attribute__((address_space(3)))
typedef unsigned short bf16_t;
typedef short bf16x8 __attribute__((ext_vector_type(8)));
typedef float f32x4 __attribute__((ext_vector_type(4)));
typedef unsigned u32x4 __attribute__((ext_vector_type(4)));
constexpr int BM = 256, BK = 64, HALF = 128, HTB = HALF * BK * 2  , STAGE_BYTES = 8 * HTB, NXCD = 8, WGM = 8;

__host__ __device__ __forceinline__ int lds_byte(int r, int c) { const int st = (r >> 4) * 2 + (c >> 5), rr = r & 15, cc = c & 31, ob = rr * 64 + cc * 2; return st * 1024 + (ob ^ (((ob >> 9) & 1) << 5)); }
__host__ __device__ __forceinline__ void stage_rc(int b, int& R, int& C) { const int st = b / 1024, sb = b % 1024, swz = sb ^ (((sb >> 9) & 1) << 5); R = (st >> 1) * 16 + swz / 64; C = (st & 1) * 32 + (swz % 64) / 2; }
__host__ __device__ __forceinline__ int perm32(int rho) { const int n = rho >> 4, i = rho & 15; return 8 * (i >> 2) + 4 * n + (i & 3); }

struct Unit { int pm, pn; };
struct Gemm { const bf16_t* A; const bf16_t* Bt; int M, N, K; };

struct StaticOrder {
    int nM, nN, nwg, G, c;
    __host__ __device__ void init(int M, int N, int G_, int c_) { nM = M / BM; nN = N / BM; nwg = nM * nN; G = G_; c = c_; }
    __host__ __device__ bool next(int i, Unit& u) const {
        const long L = (long)i * G + c; if (L >= nwg) return false;
        int wgid = (int)L; { const int q = nwg / NXCD, r = nwg % NXCD, xcd = wgid % NXCD, off = wgid / NXCD; wgid = (xcd < r ? xcd * (q + 1) : r * (q + 1) + (xcd - r) * q) + off; }
        const int nig = WGM * nN, gid = wgid / nig, fm = gid * WGM, gsz = (nM - fm) < WGM ? (nM - fm) : WGM;
        u.pm = fm + ((wgid % nig) % gsz); u.pn = (wgid % nig) / gsz; return true;
    }
    __device__ __forceinline__ void a_ready(const Unit&) const {}
    __device__ __forceinline__ void done(const Unit&) const {}
};

__device__ __forceinline__ unsigned cvt_pk_bf16(float lo, float hi) { unsigned r; asm volatile("v_cvt_pk_bf16_f32 %0, %1, %2" : "=v"(r) : "v"(lo), "v"(hi)); return r; }
typedef float f32x2 __attribute__((ext_vector_type(2)));
__device__ __forceinline__ f32x2 gelu_pk(f32x2 v) {
    const f32x2 av = __builtin_elementwise_abs(v), d = av * 0.2316418882f + 1.0f;
    f32x2 t; t.x = __builtin_amdgcn_rcpf(d.x); t.y = __builtin_amdgcn_rcpf(d.y);
    f32x2 q = t * 0.5307027145f + (-0.7265760135f); q = q * t + 0.7107068705f; q = q * t + (-0.142248368f); q = q * t + 0.127414796f; q = q * t;
    const f32x2 s = (v * v) * (-0.72134752044f);
    f32x2 e; e.x = __builtin_amdgcn_exp2f(s.x); e.y = __builtin_amdgcn_exp2f(s.y);
    const f32x2 m = v * (q * e), r = v - m;
    f32x2 o; o.x = v.x < 0.f ? m.x : r.x; o.y = v.y < 0.f ? m.y : r.y; return o;
}

template <int ACT  > struct EpiBf16 {
    static constexpr bool PERM = true, AFTER_DRAIN = false; static_assert(ACT == 0 || ACT == 1, "EpiBf16: ACT is 0 (none) or 1 (gelu_pk)");
    bf16_t* O; int ldc; const float* bias; int split_cols; size_t split_stride; float scale0;
    __device__ __forceinline__ void operator()(const f32x4 (&acc)[2][2][4][2], const Unit& u, int wr, int wc, int fr, int fq) const {
        const int row0 = u.pm * BM + wr * 64 + fr; int colt = u.pn * BM; bf16_t* base = O;
        float sc = 1.f; if (split_cols) { const int t = colt / split_cols; base += (size_t)t * split_stride; colt -= t * split_cols; if (t == 0) sc = scale0; }
        const int col0 = colt + wc * 32 + 8 * fq, bcol0 = u.pn * BM + wc * 32 + 8 * fq;
        f32x4 bv[2][2];
#pragma unroll
        for (int bj = 0; bj < 2; ++bj)
#pragma unroll
            for (int n = 0; n < 2; ++n) bv[bj][n] = bias ? *(const f32x4*)(bias + bcol0 + bj * HALF + 4 * n) : (f32x4){0.f, 0.f, 0.f, 0.f};
#pragma unroll
        for (int ai = 0; ai < 2; ++ai)
#pragma unroll
            for (int m = 0; m < 4; ++m) { bf16_t* rowp = base + (size_t)(row0 + ai * HALF + m * 16) * ldc + col0;
#pragma unroll
                for (int bj = 0; bj < 2; ++bj) { f32x4 v0 = acc[ai][bj][m][0] + bv[bj][0], v1 = acc[ai][bj][m][1] + bv[bj][1];
                    if (ACT == 1) { f32x2 a = gelu_pk((f32x2){v0[0], v0[1]}), b = gelu_pk((f32x2){v0[2], v0[3]}), c = gelu_pk((f32x2){v1[0], v1[1]}), d = gelu_pk((f32x2){v1[2], v1[3]});
                        v0 = (f32x4){a.x, a.y, b.x, b.y}; v1 = (f32x4){c.x, c.y, d.x, d.y}; }
                    v0 = v0 * sc; v1 = v1 * sc; u32x4 w; w.x = cvt_pk_bf16(v0[0], v0[1]); w.y = cvt_pk_bf16(v0[2], v0[3]); w.z = cvt_pk_bf16(v1[0], v1[1]); w.w = cvt_pk_bf16(v1[2], v1[3]);
                    *(u32x4*)(rowp + bj * HALF) = w; } }
    }
};
struct EpiIn {
    static constexpr bool PERM = true, AFTER_DRAIN = false;
    bf16_t* O; int ldc; int rope_cols; int scale_cols; float scale; const float* tab;
    __device__ __forceinline__ void operator()(const f32x4 (&acc)[2][2][4][2], const Unit& u, int wr, int wc, int fr, int fq) const {
        const int row0 = u.pm * BM + wr * 64 + fr; const int colt = u.pn * BM;
        const int col0 = colt + wc * 32 + 8 * fq; const int i0 = 16 * (wc & 1) + 4 * fq;
#pragma unroll
        for (int ai = 0; ai < 2; ++ai)
#pragma unroll
            for (int m = 0; m < 4; ++m) { const int row = row0 + ai * HALF + m * 16; const int t = row & 2047; bf16_t* rowp = O + (size_t)row * ldc + col0;
#pragma unroll
                for (int bj = 0; bj < 2; ++bj) { f32x4 v0 = acc[ai][bj][m][0], v1 = acc[ai][bj][m][1]; const int cb = colt + bj * HALF;
                    if (cb < rope_cols) { const f32x4 c0 = *(const f32x4*)(tab + (size_t)(t * 32 + i0) * 2), c1 = *(const f32x4*)(tab + (size_t)(t * 32 + i0) * 2 + 4);
                        f32x4 r0, r1;
                        r0[0] = v0[0] * c0[0] - v0[1] * c0[1]; r0[1] = v0[1] * c0[0] + v0[0] * c0[1]; r0[2] = v0[2] * c0[2] - v0[3] * c0[3]; r0[3] = v0[3] * c0[2] + v0[2] * c0[3];
                        r1[0] = v1[0] * c1[0] - v1[1] * c1[1]; r1[1] = v1[1] * c1[0] + v1[0] * c1[1]; r1[2] = v1[2] * c1[2] - v1[3] * c1[3]; r1[3] = v1[3] * c1[2] + v1[2] * c1[3];
                        v0 = r0; v1 = r1; }
                    if (cb < scale_cols) { v0 = v0 * scale; v1 = v1 * scale; }
                    u32x4 w; w.x = cvt_pk_bf16(v0[0], v0[1]); w.y = cvt_pk_bf16(v0[2], v0[3]); w.z = cvt_pk_bf16(v1[0], v1[1]); w.w = cvt_pk_bf16(v1[2], v1[3]);
                    *(u32x4*)(rowp + bj * HALF) = w; } }
    }
};
struct EpiConvGate {
    static constexpr bool PERM = true, AFTER_DRAIN = false;
    bf16_t* H; bf16_t* UL; bf16_t* UF; bf16_t* VF; const float* cw; const float* cb; int ff;
    __device__ __forceinline__ void operator()(const f32x4 (&acc)[2][2][4][2], const Unit& u, int wr, int wc, int fr, int fq) const {
        const int j0 = u.pn * HALF + wc * 32 + 8 * fq; const int lane = (int)(threadIdx.x & 63);
        const int src1 = (lane & ~15) | ((fr + 15) & 15), src2 = (lane & ~15) | ((fr + 14) & 15);
        float k0[8], k1[8], k2[8], kb[8];
#pragma unroll
        for (int q = 0; q < 2; ++q) { const f32x4 a = *(const f32x4*)(cw + j0 + 4 * q), b = *(const f32x4*)(cw + ff + j0 + 4 * q), c = *(const f32x4*)(cw + 2 * ff + j0 + 4 * q), d = *(const f32x4*)(cb + j0 + 4 * q);
#pragma unroll
            for (int e = 0; e < 4; ++e) { k0[4 * q + e] = a[e]; k1[4 * q + e] = b[e]; k2[4 * q + e] = c[e]; kb[4 * q + e] = d[e]; } }
#pragma unroll
        for (int ai = 0; ai < 2; ++ai) {
            float pr1[8], pr2[8];
#pragma unroll
            for (int e = 0; e < 8; ++e) { pr1[e] = 0.f; pr2[e] = 0.f; }
#pragma unroll
            for (int m = 0; m < 4; ++m) { const int row = u.pm * BM + ai * HALF + wr * 64 + m * 16 + fr;
                float uu[8], vv[8], hh[8];
#pragma unroll
                for (int e = 0; e < 4; ++e) { uu[e] = acc[ai][0][m][0][e]; uu[4 + e] = acc[ai][0][m][1][e]; vv[e] = acc[ai][1][m][0][e]; vv[4 + e] = acc[ai][1][m][1][e]; }
#pragma unroll
                for (int e = 0; e < 8; ++e) { const float r1 = __shfl(uu[e], src1), r2 = __shfl(uu[e], src2);
                    const float p1 = fr >= 1 ? r1 : pr1[e], p2 = fr >= 2 ? r2 : pr2[e]; pr1[e] = r1; pr2[e] = r2;
                    hh[e] = kb[e] + k0[e] * p2 + k1[e] * p1 + k2[e] * uu[e]; }
#pragma unroll
                for (int e = 0; e < 8; e += 2) { const f32x2 g = gelu_pk((f32x2){hh[e], hh[e + 1]}); hh[e] = g.x * vv[e]; hh[e + 1] = g.y * vv[e + 1]; }
                u32x4 w; w.x = cvt_pk_bf16(hh[0], hh[1]); w.y = cvt_pk_bf16(hh[2], hh[3]); w.z = cvt_pk_bf16(hh[4], hh[5]); w.w = cvt_pk_bf16(hh[6], hh[7]);
                *(u32x4*)(H + (size_t)row * ff + j0) = w;
                if (m == 3 && fr >= 14) { u32x4 s; s.x = cvt_pk_bf16(uu[0], uu[1]); s.y = cvt_pk_bf16(uu[2], uu[3]); s.z = cvt_pk_bf16(uu[4], uu[5]); s.w = cvt_pk_bf16(uu[6], uu[7]);
                    *(u32x4*)(UL + ((size_t)(row >> 6) * 2 + (fr - 14)) * ff + j0) = s; }
                if (m == 0 && fr < 2) { u32x4 s; s.x = cvt_pk_bf16(uu[0], uu[1]); s.y = cvt_pk_bf16(uu[2], uu[3]); s.z = cvt_pk_bf16(uu[4], uu[5]); s.w = cvt_pk_bf16(uu[6], uu[7]);
                    *(u32x4*)(UF + ((size_t)(row >> 6) * 2 + fr) * ff + j0) = s;
                    u32x4 z; z.x = cvt_pk_bf16(vv[0], vv[1]); z.y = cvt_pk_bf16(vv[2], vv[3]); z.z = cvt_pk_bf16(vv[4], vv[5]); z.w = cvt_pk_bf16(vv[6], vv[7]);
                    *(u32x4*)(VF + ((size_t)(row >> 6) * 2 + fr) * ff + j0) = z; }
            }
        }
    }
};
template <class Epi, class Sched, bool ALIGN_EPI = false, bool SP2 = false>
__device__ __forceinline__ void gemm_phase(PG8_LAS unsigned char* lds, const Gemm g, const Sched& S, const Epi& E) {
    const int tid = threadIdx.x, wid = __builtin_amdgcn_readfirstlane(tid >> 6), lane = tid & 63, wr = wid >> 2, wc = wid & 3, fr = lane & 15, fq = lane >> 4;
    const int K = g.K, nt = K / BK;
    unsigned voffA[2], voffB[2];
#pragma unroll
    for (int i = 0; i < 2; ++i) { int R, C; stage_rc(tid * 16 + i * 8192, R, C); const int Rb = Epi::PERM ? ((R & ~31) + perm32(R & 31)) : R;
        voffA[i] = (unsigned)(R * K + C) * 2u; voffB[i] = (unsigned)(Rb * K + C) * 2u; }
    const size_t kstep = (size_t)(BK * 2);
    const size_t hstep = (size_t)HALF * K * 2;
    const size_t tstep = 2 * hstep;
    const unsigned ldsw = (unsigned)wid * 1024u;
    const int aoff = lds_byte(wr * 64 + fr, fq * 8), boff = lds_byte(wc * 32 + fr, fq * 8);
#define PG8_SA(b, h) (((b) * 2 + (h)) * HTB)
#define PG8_SB(b, h) ((4 + (b) * 2 + (h)) * HTB)
#define PG8_STAGE(bufoff, gbase, voff) do { _Pragma("unroll") for (int _i = 0; _i < 2; ++_i) \
        __builtin_amdgcn_global_load_lds((const unsigned*)((const char*)(gbase) + (voff)[_i]), (PG8_LAS unsigned*)(lds + (bufoff) + ldsw + _i * 8192), 16, 0, 0); } while (0)
#define PG8_LDA(dst, b, h) do { _Pragma("unroll") for (int m = 0; m < 4; ++m) _Pragma("unroll") for (int k = 0; k < 2; ++k) dst[m][k] = *(const PG8_LAS bf16x8*)(lds + PG8_SA(b, h) + aoff + m * 2048 + k * 1024); } while (0)
#define PG8_LDB(dst, b, h) do { _Pragma("unroll") for (int n = 0; n < 2; ++n) _Pragma("unroll") for (int k = 0; k < 2; ++k) dst[n][k] = *(const PG8_LAS bf16x8*)(lds + PG8_SB(b, h) + boff + n * 2048 + k * 1024); } while (0)
#define PG8_MMA(ai, bj, At, Bt) do { __builtin_amdgcn_s_setprio(1); _Pragma("unroll") for (int m = 0; m < 4; ++m) _Pragma("unroll") for (int n = 0; n < 2; ++n) _Pragma("unroll") for (int k = 0; k < 2; ++k) \
        acc[ai][bj][m][n] = __builtin_amdgcn_mfma_f32_16x16x32_bf16(Bt[n][k], At[m][k], acc[ai][bj][m][n], 0, 0, 0); __builtin_amdgcn_s_setprio(0); } while (0)
#define PG8_WAIT_V(n) asm volatile("s_waitcnt vmcnt(" #n ")" ::: "memory")
#define PG8_WAIT_L(n) asm volatile("s_waitcnt lgkmcnt(" #n ")" ::: "memory")
#define PG8_BAR __builtin_amdgcn_s_barrier()
#define PG8_SCHED __builtin_amdgcn_sched_barrier(0)
    Unit cur, nxt; int ui = 0;
    if (!S.next(0, cur)) return;
    f32x4 acc[2][2][4][2];
#pragma unroll
    for (int a = 0; a < 2; ++a)
#pragma unroll
        for (int b = 0; b < 2; ++b)
#pragma unroll
            for (int m = 0; m < 4; ++m)
#pragma unroll
                for (int n = 0; n < 2; ++n) acc[a][b][m][n] = (f32x4){0.f, 0.f, 0.f, 0.f};
    bf16x8 At[4][2], B0[2][2], B1[2][2];
    const char* cA = (const char*)g.A + (size_t)cur.pm * tstep; const char* cB = (const char*)g.Bt + (size_t)cur.pn * tstep;
    S.a_ready(cur);
    if constexpr (SP2) {
        PG8_STAGE(PG8_SB(0, 0), cB, voffB); PG8_STAGE(PG8_SB(0, 1), cB + hstep, voffB); PG8_STAGE(PG8_SA(0, 0), cA, voffA); PG8_STAGE(PG8_SA(0, 1), cA + hstep, voffA);
        if (wr == 1) PG8_BAR;
        PG8_WAIT_V(2); PG8_BAR;
        PG8_STAGE(PG8_SB(1, 0), cB + kstep, voffB); PG8_STAGE(PG8_SA(1, 0), cA + kstep, voffA); PG8_STAGE(PG8_SB(1, 1), cB + hstep + kstep, voffB);
        PG8_WAIT_V(6); PG8_BAR;
    } else {
        PG8_STAGE(PG8_SB(0, 0), cB, voffB); PG8_STAGE(PG8_SA(0, 0), cA, voffA); PG8_STAGE(PG8_SB(0, 1), cB + hstep, voffB); PG8_STAGE(PG8_SA(0, 1), cA + hstep, voffA);
        if (wr == 1) PG8_BAR;
        PG8_WAIT_V(4); PG8_BAR;
        PG8_STAGE(PG8_SB(1, 0), cB + kstep, voffB); PG8_STAGE(PG8_SA(1, 0), cA + kstep, voffA); PG8_STAGE(PG8_SB(1, 1), cB + hstep + kstep, voffB);
        PG8_WAIT_V(6); PG8_BAR;
    }
    for (;;) {
        const bool has_next = S.next(ui + 1, nxt);
        const char* nA = has_next ? (const char*)g.A + (size_t)nxt.pm * tstep : cA; const char* nB = has_next ? (const char*)g.Bt + (size_t)nxt.pn * tstep : cB;
        for (int t = 0; t < nt; t += 2) {
            const bool last = (t == nt - 2);
            const char* a1 = cA + (size_t)(t + 1) * kstep;
            const char* a2 = last ? nA : cA + (size_t)(t + 2) * kstep; const char* b2 = last ? nB : cB + (size_t)(t + 2) * kstep;
            const char* a3 = a2 + kstep; const char* b3 = b2 + kstep;
            if (last && has_next) S.a_ready(nxt);
            if constexpr (SP2) {
            PG8_LDB(B0, 0, 0); PG8_LDB(B1, 0, 1); PG8_SCHED; PG8_LDA(At, 0, 0); PG8_STAGE(PG8_SA(1, 1), a1 + hstep, voffA);
            PG8_WAIT_V(8); PG8_WAIT_L(0); PG8_BAR; PG8_MMA(0, 0, At, B0); PG8_MMA(0, 1, At, B1); PG8_BAR; PG8_SCHED;
            PG8_LDA(At, 0, 1); PG8_STAGE(PG8_SB(0, 0), b2, voffB); PG8_STAGE(PG8_SB(0, 1), b2 + hstep, voffB); PG8_STAGE(PG8_SA(0, 0), a2, voffA);
            PG8_WAIT_V(8); PG8_WAIT_L(0); PG8_BAR; PG8_MMA(1, 0, At, B0); PG8_MMA(1, 1, At, B1); PG8_BAR; PG8_SCHED;
            PG8_LDB(B0, 1, 0); PG8_LDB(B1, 1, 1); PG8_SCHED; PG8_LDA(At, 1, 0); PG8_STAGE(PG8_SA(0, 1), a2 + hstep, voffA);
            PG8_WAIT_V(8); PG8_WAIT_L(0); PG8_BAR; PG8_MMA(0, 0, At, B0); PG8_MMA(0, 1, At, B1); PG8_BAR; PG8_SCHED;
            PG8_LDA(At, 1, 1); PG8_STAGE(PG8_SB(1, 0), b3, voffB); PG8_STAGE(PG8_SB(1, 1), b3 + hstep, voffB); PG8_STAGE(PG8_SA(1, 0), a3, voffA);
            PG8_WAIT_V(8); PG8_WAIT_L(0); PG8_BAR; PG8_MMA(1, 0, At, B0); PG8_MMA(1, 1, At, B1); PG8_BAR; PG8_SCHED;
            } else {
            PG8_LDB(B0, 0, 0); PG8_SCHED; PG8_LDA(At, 0, 0); PG8_STAGE(PG8_SA(1, 1), a1 + hstep, voffA);
            PG8_WAIT_L(8); PG8_BAR; PG8_WAIT_L(0); PG8_MMA(0, 0, At, B0); PG8_BAR; PG8_SCHED;
            PG8_LDB(B1, 0, 1); PG8_STAGE(PG8_SB(0, 0), b2, voffB);
            PG8_BAR; PG8_WAIT_L(0); PG8_MMA(0, 1, At, B1); PG8_BAR;
            PG8_LDA(At, 0, 1); PG8_STAGE(PG8_SA(0, 0), a2, voffA);
            PG8_BAR; PG8_WAIT_L(0); PG8_MMA(1, 0, At, B0); PG8_BAR; PG8_SCHED;
            PG8_STAGE(PG8_SB(0, 1), b2 + hstep, voffB);
            PG8_WAIT_V(6); PG8_BAR; PG8_MMA(1, 1, At, B1); PG8_BAR;
            PG8_LDB(B0, 1, 0); PG8_SCHED; PG8_LDA(At, 1, 0); PG8_STAGE(PG8_SA(0, 1), a2 + hstep, voffA);
            PG8_WAIT_L(8); PG8_BAR; PG8_WAIT_L(0); PG8_MMA(0, 0, At, B0); PG8_BAR; PG8_SCHED;
            PG8_LDB(B1, 1, 1); PG8_STAGE(PG8_SB(1, 0), b3, voffB);
            PG8_BAR; PG8_WAIT_L(0); PG8_MMA(0, 1, At, B1); PG8_BAR;
            PG8_LDA(At, 1, 1); PG8_STAGE(PG8_SA(1, 0), a3, voffA);
            PG8_BAR; PG8_WAIT_L(0); PG8_MMA(1, 0, At, B0); PG8_BAR; PG8_SCHED;
            PG8_STAGE(PG8_SB(1, 1), b3 + hstep, voffB);
            PG8_WAIT_V(6); PG8_BAR; PG8_MMA(1, 1, At, B1); PG8_BAR;
            }
        }
        if constexpr (ALIGN_EPI) { if (wr == 0) PG8_BAR; }
        if constexpr (!Epi::AFTER_DRAIN) { E(acc, cur, wr, wc, fr, fq); S.done(cur); }
        if (!has_next) break;
#pragma unroll
        for (int a = 0; a < 2; ++a)
#pragma unroll
            for (int b = 0; b < 2; ++b)
#pragma unroll
                for (int m = 0; m < 4; ++m)
#pragma unroll
                    for (int n = 0; n < 2; ++n) acc[a][b][m][n] = (f32x4){0.f, 0.f, 0.f, 0.f};
        cur = nxt; cA = nA; cB = nB; ++ui;
        if constexpr (ALIGN_EPI) { if (wr == 1) PG8_BAR; }
    }
    PG8_WAIT_V(0);
    if constexpr (!ALIGN_EPI) { if (wr == 0) PG8_BAR; }
    PG8_BAR;
    if constexpr (Epi::AFTER_DRAIN) { E.fused(acc, cur, wr, wc, fr, fq, lds, wid, lane); S.done(cur); }
#undef PG8_SA
#undef PG8_SB
#undef PG8_STAGE
#undef PG8_LDA
#undef PG8_LDB
#undef PG8_MMA
#undef PG8_WAIT_V
#undef PG8_WAIT_L
#undef PG8_BAR
#undef PG8_SCHED
}
}
constexpr int NWAVES = 8;
constexpr int BATCH = 32, SEQ = 2048, D = 1024, M = BATCH * SEQ;
constexpr int EVEN_IN = 2816, ODD_IN = 3072, DFF = 2816, UPN = 2 * DFF;
constexpr int QB_OFF = 768, FB_OFF = 1280, IB_OFF = 1792, GB_OFF = 2304;
constexpr float EPS = 1e-6f;
constexpr float LOG2E = 1.4426950408889634f;
constexpr float C2 = 0.125f * LOG2E;

constexpr size_t MiB = 1u << 20;
constexpr size_t WS_CTL = 0, CTL_ZERO_BYTES = 64 * 1024;
constexpr size_t WS_TAB = 1 * MiB;
constexpr size_t WS_LB = WS_TAB + 768 * 1024;
constexpr size_t WS_WIN0 = 2 * MiB, WS_WOUT0 = 8 * MiB, WS_WIN1 = 10 * MiB, WS_WOUT1 = 16 * MiB, WS_WUP = 18 * MiB  , WS_WDN = 40 * MiB  ;
constexpr size_t WS_SIDE = 52 * MiB, SIDE_STRIDE = 12 * MiB;
constexpr size_t WS_XN = 96 * MiB;
constexpr size_t WS_PROJ = 224 * MiB;
constexpr size_t WS_O = 608 * MiB;
constexpr size_t WS_Y = 736 * MiB;
constexpr size_t WS_END = 864 * MiB;
constexpr int CW_BAR = 4096;

constexpr int RING_OFF = 0, RING_BYTES = 131072;
constexpr int LDSCTL_OFF = RING_BYTES, MISC_OFF = LDSCTL_OFF + 320;
constexpr int LDS_BYTES = 147456;

#define GAS __attribute__((address_space(1)))
#define LAS __attribute__((address_space(3)))
typedef unsigned short bf16;
typedef unsigned v4u __attribute__((ext_vector_type(4)));
typedef float f32x4 __attribute__((ext_vector_type(4)));
typedef short bf16x8 __attribute__((ext_vector_type(8)));
typedef GAS unsigned gu32;
typedef GAS unsigned long long gu64;
#define RLX_AGENT __ATOMIC_RELAXED, __HIP_MEMORY_SCOPE_AGENT
#define LDS_WAIT() asm volatile("s_waitcnt lgkmcnt(0)" ::: "memory")
#define VM_WAIT() asm volatile("s_waitcnt vmcnt(0)" ::: "memory")
__device__ __forceinline__ unsigned long long rt() { return __builtin_amdgcn_s_memrealtime(); }
__device__ __forceinline__ unsigned f2bf(float f) { unsigned u = __builtin_bit_cast(unsigned, f); return (u + 0x7fffu + ((u >> 16) & 1u)) >> 16; }
__device__ __forceinline__ unsigned pk2(float lo, float hi) { return f2bf(lo) | (f2bf(hi) << 16); }

#define XB_TMO      128
#define XB_XCNT(j)  (256  + 64 * (j))
#define XB_XSUB(j)  (1280 + 64 * (j))
#define XB_XGEN(j)  (2304 + 64 * (j))
#define XB_TOP      3328
#define XB_TOPGEN   3392
#define XCD_BAR_WORDS 3456
#define XB_SPIN_CAP (1u << 18)

__device__ __forceinline__ unsigned xb_ld(unsigned* p)              { return __hip_atomic_load(p, __ATOMIC_RELAXED, __HIP_MEMORY_SCOPE_AGENT); }
__device__ __forceinline__ unsigned xb_add(unsigned* p, unsigned v) { return __hip_atomic_fetch_add(p, v, __ATOMIC_RELAXED, __HIP_MEMORY_SCOPE_AGENT); }
__device__ __forceinline__ unsigned xb_xcc_id() { return (unsigned)__builtin_amdgcn_s_getreg((3 << 11) | 20) & 0xFu; }
#define XB_SPIN(cond, bar) do { unsigned _sp = 0; while (cond) { __builtin_amdgcn_s_sleep(1); \
    if ((++_sp & 255u) == 0u) { if (xb_ld(&(bar)[XB_TMO])) break; if (_sp > XB_SPIN_CAP) { atomicAdd(&(bar)[XB_TMO], 1u); break; } } } } while (0)

struct XcdBarrier {
    unsigned* bar; unsigned x;
    volatile LAS unsigned* st;
};

__device__ __forceinline__ XcdBarrier xcd_barrier_post(unsigned* bar, volatile LAS unsigned* st) {
    XcdBarrier b; b.bar = bar; b.x = xb_xcc_id(); b.st = st;
    if (threadIdx.x == 0) (void)xb_add(&bar[XB_XCNT(b.x)], 1u);
    return b;
}
__device__ __forceinline__ void xcd_barrier_complete(unsigned* bar, unsigned x, unsigned& nloc, unsigned& nx) {
    const unsigned G = gridDim.x * gridDim.y * gridDim.z;
    unsigned sum, cnt, mine, sp = 0u;
    for (;;) {
        sum = 0u; cnt = 0u; mine = 0u;
#pragma unroll
        for (unsigned j = 0; j < 16; ++j) { const unsigned c = xb_ld(&bar[XB_XCNT(j)]); sum += c; cnt += (c > 0u) ? 1u : 0u; mine = (j == x) ? c : mine; }
        if (sum == G) break;
        __builtin_amdgcn_s_sleep(1);
        if ((++sp & 255u) == 0u) { if (xb_ld(&bar[XB_TMO])) break; if (sp > XB_SPIN_CAP) { atomicAdd(&bar[XB_TMO], 1u); break; } }
    }
    nloc = mine > 0u ? mine : 1u; nx = cnt > 0u ? cnt : 1u;
}

__device__ __forceinline__ void xcd_barrier(const XcdBarrier& b) {
    asm volatile("s_waitcnt vmcnt(0)" ::: "memory");
    __syncthreads();
    if (threadIdx.x == 0) {
        unsigned* bar = b.bar;
        __builtin_amdgcn_s_waitcnt(0);
        unsigned nloc = b.st[0], nx = b.st[1];
        if (nloc == 0u) { xcd_barrier_complete(bar, b.x, nloc, nx); b.st[0] = nloc; b.st[1] = nx; }
        const unsigned old = xb_add(&bar[XB_XSUB(b.x)], 1u);
        const unsigned gen = old / nloc;
        if (old + 1u == (gen + 1u) * nloc) {
            __builtin_amdgcn_fence(__ATOMIC_RELEASE, "agent");
            asm volatile("s_waitcnt vmcnt(0)" ::: "memory");
            const unsigned og = xb_add(&bar[XB_TOP], 1u);
            const unsigned tg = og / nx;
            if (og + 1u == (tg + 1u) * nx) xb_add(&bar[XB_TOPGEN], 1u);
            else XB_SPIN(xb_ld(&bar[XB_TOPGEN]) == tg, bar);
            __builtin_amdgcn_fence(__ATOMIC_ACQUIRE, "agent");
            xb_add(&bar[XB_XGEN(b.x)], 1u);
            asm volatile("s_waitcnt vmcnt(0)" ::: "memory");
        } else {
            XB_SPIN(xb_ld(&bar[XB_XGEN(b.x)]) == gen, bar);
            __builtin_amdgcn_fence(__ATOMIC_ACQUIRE, "agent");
            asm volatile("s_waitcnt vmcnt(0)" ::: "memory");
        }
    }
    __syncthreads();
}
struct Frame {
    LAS unsigned char* lds;
    volatile LAS unsigned* MISC;
    gu32* ctl;
    int tid, lane, wave, G;
    unsigned char* ws;
    const float *x, *even_w_in, *even_w_out, *even_sinks, *lb_logits, *hgrn_norm_w, *odd_w_in, *odd_w_out, *odd_rel, *w_up, *conv_w, *conv_b, *w_down, *norm_w;
    float* out;
};
__device__ __forceinline__ float bf2f(bf16 b) { return __builtin_bit_cast(float, (unsigned)b << 16); }
__device__ __forceinline__ float wave_sum(float v) {
#pragma unroll
    for (int o = 1; o < 64; o <<= 1) v += __shfl_xor(v, o);
    return v;
}
__device__ __forceinline__ int colmap(int cmode, int n) {
    if (cmode == 1) { if (n >= 640) return n; const int p = n & 63; return (n - p) + (p >> 1) + 32 * (p & 1); }
    if (cmode == 2) { const int pn = n >> 8, r = n & 255; return r < 128 ? pn * 128 + r : DFF + pn * 128 + (r - 128); }
    return n;
}
__device__ __forceinline__ void transpose_item(const float* W, int K, int Nsrc, int Nout, bf16* WT, const float* kscale, int cmode, LAS float* scr, int item, int lane) {
    const int nblk = Nout / 32, kb = item / nblk, nb = item % nblk, k0 = 64 * kb, n0 = 32 * nb;
    const int nsrc = colmap(cmode, n0 + (lane & 31));
#pragma unroll 8
    for (int i = 0; i < 32; ++i) { const int kk = 2 * i + (lane >> 5); float w = W[(size_t)(k0 + kk) * Nsrc + nsrc]; if (kscale) w *= kscale[k0 + kk]; scr[kk * 33 + (lane & 31)] = w; }
    LDS_WAIT(); asm volatile("" ::: "memory");
    const int c = lane & 7;
#pragma unroll
    for (int j = 0; j < 4; ++j) { const int n = (lane >> 3) + 8 * j; const LAS float* s = scr + (8 * c) * 33 + n;
        v4u o; o.x = pk2(s[0 * 33], s[1 * 33]); o.y = pk2(s[2 * 33], s[3 * 33]); o.z = pk2(s[4 * 33], s[5 * 33]); o.w = pk2(s[6 * 33], s[7 * 33]);
        *(GAS v4u*)(WT + (size_t)(n0 + n) * K + k0 + 8 * c) = o; }
    LDS_WAIT(); asm volatile("" ::: "memory");
}
__device__ __forceinline__ void rms_row_to_bf16(int lane, const float* xrow, bf16* orow) {
    const GAS f32x4* xr = (const GAS f32x4*)xrow + lane;
    f32x4 v[4]; float s = 0.f;
#pragma unroll
    for (int j = 0; j < 4; ++j) { v[j] = xr[64 * j]; s += (v[j].x * v[j].x + v[j].y * v[j].y) + (v[j].z * v[j].z + v[j].w * v[j].w); }
    const float rstd = 1.f / sqrtf(wave_sum(s) * (1.f / D) + EPS);
    GAS unsigned long long* o8 = (GAS unsigned long long*)orow + lane;
#pragma unroll
    for (int j = 0; j < 4; ++j) o8[64 * j] = (unsigned long long)pk2(v[j].x * rstd, v[j].y * rstd) | ((unsigned long long)pk2(v[j].z * rstd, v[j].w * rstd) << 32);
}
__device__ __forceinline__ void p_prologue(Frame& F) {
    LAS float* scr = (LAS float*)(F.lds + RING_OFF + F.wave * 16384);
    const int gw = blockIdx.x * NWAVES + F.wave, NGW = F.G * NWAVES;
#pragma unroll 1
    for (int mat = 0; mat < 8; ++mat) {
        const float* W; int K, Nsrc, Nout, cmode = 0; const float* ks = nullptr; size_t dst;
        if (mat == 0)      { W = F.even_w_in;  K = D; Nsrc = EVEN_IN; Nout = EVEN_IN; cmode = 1; ks = F.norm_w + 0 * D; dst = WS_WIN0; }
        else if (mat == 1) { W = F.even_w_out; K = D; Nsrc = D; Nout = D; dst = WS_WOUT0; }
        else if (mat == 2) { W = F.odd_w_in;   K = D; Nsrc = ODD_IN; Nout = ODD_IN; ks = F.norm_w + 4 * D; dst = WS_WIN1; }
        else if (mat == 3) { W = F.odd_w_out;  K = D; Nsrc = D; Nout = D; dst = WS_WOUT1; }
        else if (mat < 6)  { const int l = mat - 4; W = F.w_up + (size_t)l * D * UPN; K = D; Nsrc = UPN; Nout = UPN; cmode = 2; ks = F.norm_w + (size_t)(l * 4 + 2) * D; dst = WS_WUP + (size_t)l * 11 * MiB; }
        else               { const int l = mat - 6; W = F.w_down + (size_t)l * DFF * D; K = DFF; Nsrc = D; Nout = D; dst = WS_WDN + (size_t)l * 5632 * 1024; }
        const int nitems = (K / 64) * (Nout / 32);
        for (int it = gw; it < nitems; it += NGW) transpose_item(W, K, Nsrc, Nout, (bf16*)(F.ws + dst), ks, cmode, scr, it, F.lane);
    }
    { float* tab = (float*)(F.ws + WS_TAB); const int gt = blockIdx.x * (NWAVES * 64) + F.tid, NT = F.G * NWAVES * 64;
      for (int e = gt; e < SEQ * 32; e += NT) { const int t = e >> 5, i = e & 31; const float inv = powf(10000.f, -(float)(2 * i) / 64.f); const float ang = (float)t * inv;
          tab[2 * e] = (float)cos((double)ang); tab[2 * e + 1] = (float)sin((double)ang); }
      float* lb = (float*)(F.ws + WS_LB);
      for (int e = gt; e < 512; e += NT) { const float a = F.lb_logits[e], b = F.lb_logits[512 + e]; const float mx = fmaxf(a, b); const float ea = expf(a - mx), eb = expf(b - mx); lb[e] = ea / (ea + eb); } }
    for (int m = gw; m < M; m += NGW) rms_row_to_bf16(F.lane, F.x + (size_t)m * D, (bf16*)(F.ws + WS_XN) + (size_t)m * D);
}
__device__ __forceinline__ void p_norm(Frame& F, const float* hin, const bf16* Y, const float* g, float* hout, bf16* xn) {
    const int gw = blockIdx.x * NWAVES + F.wave, NGW = F.G * NWAVES;
    f32x4 gv[4];
#pragma unroll
    for (int j = 0; j < 4; ++j) gv[j] = ((const GAS f32x4*)g)[F.lane + 64 * j];
    for (int m = gw; m < M; m += NGW) {
        const GAS f32x4* hr = (const GAS f32x4*)(hin + (size_t)m * D) + F.lane;
        const GAS unsigned long long* yr = (const GAS unsigned long long*)(Y + (size_t)m * D) + F.lane;
        f32x4 h[4], y[4]; float s = 0.f;
#pragma unroll
        for (int j = 0; j < 4; ++j) { h[j] = hr[64 * j]; const unsigned long long w = yr[64 * j];
            y[j].x = __builtin_bit_cast(float, (unsigned)(w & 0xffffu) << 16); y[j].y = __builtin_bit_cast(float, (unsigned)(w >> 16 & 0xffffu) << 16);
            y[j].z = __builtin_bit_cast(float, (unsigned)(w >> 32 & 0xffffu) << 16); y[j].w = __builtin_bit_cast(float, (unsigned)(w >> 48 & 0xffffu) << 16);
            s += (y[j].x * y[j].x + y[j].y * y[j].y) + (y[j].z * y[j].z + y[j].w * y[j].w); }
        const float r1 = 1.f / sqrtf(wave_sum(s) * (1.f / D) + EPS); float s2 = 0.f;
#pragma unroll
        for (int j = 0; j < 4; ++j) { h[j] = h[j] + y[j] * r1 * gv[j]; s2 += (h[j].x * h[j].x + h[j].y * h[j].y) + (h[j].z * h[j].z + h[j].w * h[j].w); }
        GAS f32x4* ho = (GAS f32x4*)(hout + (size_t)m * D) + F.lane;
#pragma unroll
        for (int j = 0; j < 4; ++j) ho[64 * j] = h[j];
        if (xn) { const float r2 = 1.f / sqrtf(wave_sum(s2) * (1.f / D) + EPS);
            GAS unsigned long long* o8 = (GAS unsigned long long*)(xn + (size_t)m * D) + F.lane;
#pragma unroll
            for (int j = 0; j < 4; ++j) o8[64 * j] = (unsigned long long)pk2(h[j].x * r2, h[j].y * r2) | ((unsigned long long)pk2(h[j].z * r2, h[j].w * r2) << 32); }
    }
}
__device__ __forceinline__ void p_fixup(Frame& F, bf16* H, const bf16* UL, const bf16* UF, const bf16* VF, const float* cw, const float* cb) {
    const int gt = blockIdx.x * (NWAVES * 64) + F.tid, NT = F.G * NWAVES * 64;
    constexpr int CH = DFF / 8, NIT = (M / 64) * 2 * CH;
    for (int it = gt; it < NIT; it += NT) {
        const int ch = it % CH, gr = it / CH, r = gr & 1, g = gr >> 1, j0 = ch * 8;
        const bool has_prev = (g & 31) != 0;
        const v4u z4 = {0u, 0u, 0u, 0u};
        const v4u u0 = *(const GAS v4u*)(UF + ((size_t)g * 2 + r) * DFF + j0);
        const v4u vv = *(const GAS v4u*)(VF + ((size_t)g * 2 + r) * DFF + j0);
        const v4u pl1 = has_prev ? *(const GAS v4u*)(UL + ((size_t)(g - 1) * 2 + 1) * DFF + j0) : z4;
        const v4u pl0 = has_prev ? *(const GAS v4u*)(UL + ((size_t)(g - 1) * 2 + 0) * DFF + j0) : z4;
        const v4u uf0 = *(const GAS v4u*)(UF + ((size_t)g * 2 + 0) * DFF + j0);
        const v4u um1 = r ? uf0 : pl1, um2 = r ? pl1 : pl0;
        float hh[8];
#pragma unroll
        for (int e = 0; e < 8; ++e) { const int sh = (e & 1) * 16; const unsigned wa = u0[e >> 1], wb = um1[e >> 1], wc_ = um2[e >> 1], wv = vv[e >> 1];
            const float a = bf2f((bf16)(wa >> sh)), b = bf2f((bf16)(wb >> sh)), c = bf2f((bf16)(wc_ >> sh)), v = bf2f((bf16)(wv >> sh));
            const float pre = cb[j0 + e] + cw[j0 + e] * c + cw[DFF + j0 + e] * b + cw[2 * DFF + j0 + e] * a;
            const pg8::f32x2 gg = pg8::gelu_pk((pg8::f32x2){pre, pre}); hh[e] = gg.x * v; }
        v4u o; o.x = pk2(hh[0], hh[1]); o.y = pk2(hh[2], hh[3]); o.z = pk2(hh[4], hh[5]); o.w = pk2(hh[6], hh[7]);
        *(GAS v4u*)(H + ((size_t)g * 64 + r) * DFF + j0) = o;
    }
}
__device__ __forceinline__ void p_attn_plain(Frame& F, const bf16* Q, int ldq, const bf16* Kp, int ldk, const bf16* Vp, int ldv, bf16* O, int ldo, int HQ, int GQ, int nprev, const float* sinks, const float* rel) {
    const int gt = blockIdx.x * (NWAVES * 64) + F.tid, NT = F.G * NWAVES * 64;
    const long total = (long)M * HQ;
    for (long idx = gt; idx < total; idx += NT) {
        const int hq = (int)(idx / M), row = (int)(idx % M), hk = hq / GQ;
        const int b = row / SEQ, t = row % SEQ, c = t >> 6, c0 = c - nprev < 0 ? 0 : c - nprev;
        float q[64], o[64];
        { const GAS v4u* qp = (const GAS v4u*)(Q + (size_t)row * ldq + hq * 64);
#pragma unroll
          for (int i = 0; i < 8; ++i) { const v4u w = qp[i];
#pragma unroll
              for (int e = 0; e < 4; ++e) { const unsigned ww = w[e]; q[8 * i + 2 * e] = bf2f((bf16)(ww & 0xffffu)); q[8 * i + 2 * e + 1] = bf2f((bf16)(ww >> 16)); } } }
#pragma unroll
        for (int d = 0; d < 64; ++d) o[d] = 0.f;
        float mrun = sinks ? sinks[hq] * LOG2E : -INFINITY, l = sinks ? 1.f : 0.f;
        const float* relh = rel ? rel + hq * 257 : nullptr;
        for (int kp = c0 * 64; kp < c * 64 + 64; ++kp) {
            const size_t krow = (size_t)b * SEQ + kp;
            const GAS v4u* kk = (const GAS v4u*)(Kp + krow * ldk + hk * 64);
            float s = 0.f;
#pragma unroll
            for (int i = 0; i < 8; ++i) { const v4u w = kk[i];
#pragma unroll
                for (int e = 0; e < 4; ++e) { const unsigned ww = w[e]; s += q[8 * i + 2 * e] * bf2f((bf16)(ww & 0xffffu)); s += q[8 * i + 2 * e + 1] * bf2f((bf16)(ww >> 16)); } }
            if (relh) { int r = t - kp; r = r < -128 ? -128 : (r > 128 ? 128 : r); s += relh[r + 128] * LOG2E; }
            const float mn = fmaxf(mrun, s), sc = exp2f(mrun - mn), p = exp2f(s - mn);
            l = l * sc + p; mrun = mn;
            const GAS v4u* vp = (const GAS v4u*)(Vp + krow * ldv + hk * 64);
#pragma unroll
            for (int i = 0; i < 8; ++i) { const v4u w = vp[i];
#pragma unroll
                for (int e = 0; e < 4; ++e) { const unsigned ww = w[e]; o[8 * i + 2 * e] = o[8 * i + 2 * e] * sc + p * bf2f((bf16)(ww & 0xffffu)); o[8 * i + 2 * e + 1] = o[8 * i + 2 * e + 1] * sc + p * bf2f((bf16)(ww >> 16)); } }
        }
        const float il = 1.f / l;
        GAS v4u* op = (GAS v4u*)(O + (size_t)row * ldo + hq * 64);
#pragma unroll
        for (int i = 0; i < 8; ++i) { v4u w; w.x = pk2(o[8 * i] * il, o[8 * i + 1] * il); w.y = pk2(o[8 * i + 2] * il, o[8 * i + 3] * il); w.z = pk2(o[8 * i + 4] * il, o[8 * i + 5] * il); w.w = pk2(o[8 * i + 6] * il, o[8 * i + 7] * il); op[i] = w; }
    }
}
__device__ __forceinline__ void p_hgrn_plain(Frame& F, const bf16* P, bf16* O, const float* lb, const float* gw_) {
    const int sb = F.tid >> 7, e = F.tid & 127;
    LAS float* base = (LAS float*)(F.lds + RING_OFF) + sb * 3328;
    LAS float* Fs = base; LAS float* Qs = base + 1024; LAS float* Os = base + 2048; LAS float* Rs = base + 3072;
    for (int u0 = blockIdx.x * 4; u0 < BATCH * 4; u0 += F.G * 4) {
        const int u = u0 + sb, b = u >> 2, h = u & 3;
        float S[128];
#pragma unroll
        for (int d = 0; d < 128; ++d) S[d] = 0.f;
        const float lbd = lb[h * 128 + e], gwe = gw_[h * 128 + e];
#pragma unroll 1
        for (int t0 = 0; t0 < SEQ; t0 += 8) {
#pragma unroll
            for (int s = 0; s < 8; ++s) { const size_t row = (size_t)b * SEQ + t0 + s; const float xf = bf2f(P[row * EVEN_IN + FB_OFF + h * 128 + e]);
                Fs[s * 128 + e] = lbd + (1.f - lbd) / (1.f + expf(-xf)); Qs[s * 128 + e] = bf2f(P[row * EVEN_IN + QB_OFF + h * 128 + e]); }
            __syncthreads();
#pragma unroll 1
            for (int s = 0; s < 8; ++s) { const size_t row = (size_t)b * SEQ + t0 + s; const float iv = bf2f(P[row * EVEN_IN + IB_OFF + h * 128 + e]); float acc = 0.f;
#pragma unroll
                for (int d = 0; d < 128; ++d) { const float f = Fs[s * 128 + d]; S[d] = f * S[d] + (1.f - f) * iv; acc += Qs[s * 128 + d] * S[d]; }
                const float ss = wave_sum(acc * acc); if (F.lane == 0) Rs[s * 2 + (F.wave & 1)] = ss; Os[s * 128 + e] = acc; }
            __syncthreads();
#pragma unroll
            for (int s = 0; s < 8; ++s) { const size_t row = (size_t)b * SEQ + t0 + s; const float tot = Rs[s * 2] + Rs[s * 2 + 1]; const float r = 1.f / sqrtf(tot * (1.f / 128.f) + EPS);
                const float g = bf2f(P[row * EVEN_IN + GB_OFF + h * 128 + e]); const float val = Os[s * 128 + e] * r * gwe * (g / (1.f + expf(-g)));
                O[row * D + 512 + h * 128 + e] = (bf16)f2bf(val); }
            __syncthreads();
        }
    }
}
constexpr int NPH = 17;
struct Args { const float* in[14]; float* out; unsigned char* ws; int ph_lo, ph_hi; };
__global__ void __launch_bounds__(NWAVES * 64, 2) mk_fwd(Args args) {
    extern __shared__ __attribute__((aligned(16))) unsigned char lds[];
    Frame F;
    F.lds = (LAS unsigned char*)lds;
    F.MISC = (volatile LAS unsigned*)(F.lds + MISC_OFF);
    F.tid = threadIdx.x; F.lane = F.tid & 63; F.wave = __builtin_amdgcn_readfirstlane(F.tid >> 6);
    F.G = gridDim.x;
    unsigned char* ws = args.ws; F.ws = ws;
    F.ctl = (gu32*)(ws + WS_CTL);
    F.x = args.in[0]; F.even_w_in = args.in[1]; F.even_w_out = args.in[2]; F.even_sinks = args.in[3]; F.lb_logits = args.in[4]; F.hgrn_norm_w = args.in[5];
    F.odd_w_in = args.in[6]; F.odd_w_out = args.in[7]; F.odd_rel = args.in[8]; F.w_up = args.in[9]; F.conv_w = args.in[10]; F.conv_b = args.in[11]; F.w_down = args.in[12]; F.norm_w = args.in[13];
    F.out = args.out;
    for (int u = F.tid; u < (LDS_BYTES - LDSCTL_OFF) / 4; u += NWAVES * 64) ((LAS unsigned*)(F.lds + LDSCTL_OFF))[u] = 0u;
    __syncthreads();
    const int lo = args.ph_lo, hi = args.ph_hi;
    XcdBarrier bar; bar.bar = (unsigned*)(F.ctl + CW_BAR); bar.x = 0; bar.st = nullptr;
    if (hi - lo > 1) bar = xcd_barrier_post((unsigned*)(F.ctl + CW_BAR), F.MISC + 8);
#define IN(k) (lo <= (k) && (k) < hi)
#define SEAM(k) do { if (IN(k) && IN((k) + 1)) xcd_barrier(bar); } while (0)
    bf16* const XN = (bf16*)(ws + WS_XN); bf16* const PROJ = (bf16*)(ws + WS_PROJ); bf16* const OB = (bf16*)(ws + WS_O); bf16* const YB = (bf16*)(ws + WS_Y);
    bf16* const UL = (bf16*)(ws + WS_SIDE); bf16* const UF = (bf16*)(ws + WS_SIDE + SIDE_STRIDE); bf16* const VF = (bf16*)(ws + WS_SIDE + 2 * SIDE_STRIDE);
    const float* const tab = (const float*)(ws + WS_TAB); const float* const lbv = (const float*)(ws + WS_LB);

    if (IN(0)) { p_prologue(F); } SEAM(0);
    if (IN(1)) { pg8::Gemm g{XN, (const bf16*)(ws + WS_WIN0), M, EVEN_IN, D}; pg8::StaticOrder S; S.init(M, EVEN_IN, F.G, (int)blockIdx.x);
        pg8::EpiIn E{PROJ, EVEN_IN, 640, 512, C2, tab};
        pg8::gemm_phase<pg8::EpiIn, pg8::StaticOrder, true, true>(F.lds + RING_OFF, g, S, E); } SEAM(1);
    if (IN(2)) { p_attn_plain(F, PROJ, EVEN_IN, PROJ + 512, EVEN_IN, PROJ + 640, EVEN_IN, OB, D, 8, 4, 2, F.even_sinks, nullptr);
        p_hgrn_plain(F, PROJ, OB, lbv, F.hgrn_norm_w); } SEAM(2);
    if (IN(3)) { pg8::Gemm g{OB, (const bf16*)(ws + WS_WOUT0), M, D, D}; pg8::StaticOrder S; S.init(M, D, F.G, (int)blockIdx.x);
        pg8::EpiBf16<0> E{YB, D, nullptr, 0, 0, 1.f};
        pg8::gemm_phase<pg8::EpiBf16<0>, pg8::StaticOrder, true, true>(F.lds + RING_OFF, g, S, E); } SEAM(3);
    if (IN(4)) { p_norm(F, F.x, YB, F.norm_w + 1 * D, F.out, XN); } SEAM(4);
    if (IN(5)) { pg8::Gemm g{XN, (const bf16*)(ws + WS_WUP), M, UPN, D}; pg8::StaticOrder S; S.init(M, UPN, F.G, (int)blockIdx.x);
        pg8::EpiConvGate E{PROJ, UL, UF, VF, F.conv_w, F.conv_b, DFF};
        pg8::gemm_phase<pg8::EpiConvGate, pg8::StaticOrder, true, true>(F.lds + RING_OFF, g, S, E); } SEAM(5);
    if (IN(6)) { p_fixup(F, PROJ, UL, UF, VF, F.conv_w, F.conv_b); } SEAM(6);
    if (IN(7)) { pg8::Gemm g{PROJ, (const bf16*)(ws + WS_WDN), M, D, DFF}; pg8::StaticOrder S; S.init(M, D, F.G, (int)blockIdx.x);
        pg8::EpiBf16<0> E{YB, D, nullptr, 0, 0, 1.f};
        pg8::gemm_phase<pg8::EpiBf16<0>, pg8::StaticOrder, true, true>(F.lds + RING_OFF, g, S, E); } SEAM(7);
    if (IN(8)) { p_norm(F, F.out, YB, F.norm_w + 3 * D, F.out, XN); } SEAM(8);
    if (IN(9)) { pg8::Gemm g{XN, (const bf16*)(ws + WS_WIN1), M, ODD_IN, D}; pg8::StaticOrder S; S.init(M, ODD_IN, F.G, (int)blockIdx.x);
        pg8::EpiIn E{PROJ, ODD_IN, 0, 1024, C2, tab};
        pg8::gemm_phase<pg8::EpiIn, pg8::StaticOrder, true, true>(F.lds + RING_OFF, g, S, E); } SEAM(9);
    if (IN(10)) { p_attn_plain(F, PROJ, ODD_IN, PROJ + 1024, ODD_IN, PROJ + 2048, ODD_IN, OB, D, 16, 1, 8, nullptr, F.odd_rel); } SEAM(10);
    if (IN(11)) { pg8::Gemm g{OB, (const bf16*)(ws + WS_WOUT1), M, D, D}; pg8::StaticOrder S; S.init(M, D, F.G, (int)blockIdx.x);
        pg8::EpiBf16<0> E{YB, D, nullptr, 0, 0, 1.f};
        pg8::gemm_phase<pg8::EpiBf16<0>, pg8::StaticOrder, true, true>(F.lds + RING_OFF, g, S, E); } SEAM(11);
    if (IN(12)) { p_norm(F, F.out, YB, F.norm_w + 5 * D, F.out, XN); } SEAM(12);
    if (IN(13)) { pg8::Gemm g{XN, (const bf16*)(ws + WS_WUP + 11 * MiB), M, UPN, D}; pg8::StaticOrder S; S.init(M, UPN, F.G, (int)blockIdx.x);
        pg8::EpiConvGate E{PROJ, UL, UF, VF, F.conv_w + 3 * DFF, F.conv_b + DFF, DFF};
        pg8::gemm_phase<pg8::EpiConvGate, pg8::StaticOrder, true, true>(F.lds + RING_OFF, g, S, E); } SEAM(13);
    if (IN(14)) { p_fixup(F, PROJ, UL, UF, VF, F.conv_w + 3 * DFF, F.conv_b + DFF); } SEAM(14);
    if (IN(15)) { pg8::Gemm g{PROJ, (const bf16*)(ws + WS_WDN + (size_t)5632 * 1024), M, D, DFF}; pg8::StaticOrder S; S.init(M, D, F.G, (int)blockIdx.x);
        pg8::EpiBf16<0> E{YB, D, nullptr, 0, 0, 1.f};
        pg8::gemm_phase<pg8::EpiBf16<0>, pg8::StaticOrder, true, true>(F.lds + RING_OFF, g, S, E); } SEAM(15);
    if (IN(16)) { p_norm(F, F.out, YB, F.norm_w + 7 * D, F.out, nullptr); }
#undef IN
#undef SEAM
}

#ifndef MK_ONE_LAUNCH
#define MK_ONE_LAUNCH 0
#endif
extern "C" void kernel_launch(void* const* d_in, const int* in_sizes, int n_in, void* d_out, int out_size, void* d_ws, size_t ws_size, hipStream_t stream) {
    static int grid = 0;
    if (grid == 0) {
        if (n_in != 14 || in_sizes[0] != M * D || out_size != M * D || ws_size < WS_END) { fprintf(stderr, "kernel_launch: unexpected shapes (n_in %d, in0 %d, out %d, ws %zu); nothing launched\n", n_in, n_in > 0 ? in_sizes[0] : -1, out_size, ws_size); grid = -1; return; }
        int dev = 0, cus = 0, per_cu = 0;
        if (hipGetDevice(&dev) != hipSuccess || hipDeviceGetAttribute(&cus, hipDeviceAttributeMultiprocessorCount, dev) != hipSuccess) { grid = -1; return; }
        if (hipFuncSetAttribute((const void*)mk_fwd, hipFuncAttributeMaxDynamicSharedMemorySize, LDS_BYTES) != hipSuccess) { fprintf(stderr, "kernel_launch: hipFuncSetAttribute failed\n"); grid = -1; return; }
        if (hipOccupancyMaxActiveBlocksPerMultiprocessor(&per_cu, (const void*)mk_fwd, NWAVES * 64, LDS_BYTES) != hipSuccess || per_cu < 1) { fprintf(stderr, "kernel_launch: occupancy query says %d\n", per_cu); }
        (void)hipGetLastError();
        grid = cus;
    }
    if (grid < 0) return;
    if (hipMemsetAsync((char*)d_ws + WS_CTL, 0, CTL_ZERO_BYTES, stream) != hipSuccess) return;
    Args a{};
    for (int i = 0; i < 14; ++i) a.in[i] = (const float*)d_in[i];
    a.out = (float*)d_out; a.ws = (unsigned char*)d_ws;
#if MK_ONE_LAUNCH
    a.ph_lo = 0; a.ph_hi = NPH;
    hipLaunchKernelGGL(mk_fwd, dim3(grid), dim3(NWAVES * 64), LDS_BYTES, stream, a);
#else
    for (int k = 0; k < NPH; ++k) { a.ph_lo = k; a.ph_hi = k + 1; hipLaunchKernelGGL(mk_fwd, dim3(grid), dim3(NWAVES * 64), LDS_BYTES, stream, a); }
#endif
}
```

```cpp
#include <hip/hip_runtime.h>
#include <cstdio>
#include <cstdint>
#include <cmath>
namespace pg8 {
#define PG8_LAS __attribute__((address_space(3)))
typedef unsigned short bf16_t;
typedef short bf16x8 __attribute__((ext_vector_type(8)));
typedef float f32x4 __attribute__((ext_vector_type(4)));
typedef unsigned u32x4 __attribute__((ext_vector_type(4)));
constexpr int BM = 256, BK = 64, HALF = 128, HTB = HALF * BK * 2  , STAGE_BYTES = 8 * HTB, NXCD = 8, WGM = 8;

__host__ __device__ __forceinline__ int lds_byte(int r, int c) { const int st = (r >> 4) * 2 + (c >> 5), rr = r & 15, cc = c & 31, ob = rr * 64 + cc * 2; return st * 1024 + (ob ^ (((ob >> 9) & 1) << 5)); }
__host__ __device__ __forceinline__ void stage_rc(int b, int& R, int& C) { const int st = b / 1024, sb = b % 1024, swz = sb ^ (((sb >> 9) & 1) << 5); R = (st >> 1) * 16 + swz / 64; C = (st & 1) * 32 + (swz % 64) / 2; }
__host__ __device__ __forceinline__ int perm32(int rho) { const int n = rho >> 4, i = rho & 15; return 8 * (i >> 2) + 4 * n + (i & 3); }

struct Unit { int pm, pn; };
struct Gemm { const bf16_t* A; const bf16_t* Bt; int M, N, K; };

struct StaticOrder {
    int nM, nN, nwg, G, c;
    __host__ __device__ void init(int M, int N, int G_, int c_) { nM = M / BM; nN = N / BM; nwg = nM * nN; G = G_; c = c_; }
    __host__ __device__ bool next(int i, Unit& u) const {
        const long L = (long)i * G + c; if (L >= nwg) return false;
        int wgid = (int)L; { const int q = nwg / NXCD, r = nwg % NXCD, xcd = wgid % NXCD, off = wgid / NXCD; wgid = (xcd < r ? xcd * (q + 1) : r * (q + 1) + (xcd - r) * q) + off; }
        const int nig = WGM * nN, gid = wgid / nig, fm = gid * WGM, gsz = (nM - fm) < WGM ? (nM - fm) : WGM;
        u.pm = fm + ((wgid % nig) % gsz); u.pn = (wgid % nig) / gsz; return true;
    }
    __device__ __forceinline__ void a_ready(const Unit&) const {}
    __device__ __forceinline__ void done(const Unit&) const {}
};

__device__ __forceinline__ unsigned cvt_pk_bf16(float lo, float hi) { unsigned r; asm volatile("v_cvt_pk_bf16_f32 %0, %1, %2" : "=v"(r) : "v"(lo), "v"(hi)); return r; }
typedef float f32x2 __attribute__((ext_vector_type(2)));
__device__ __forceinline__ f32x2 gelu_pk(f32x2 v) {
    const f32x2 av = __builtin_elementwise_abs(v), d = av * 0.2316418882f + 1.0f;
    f32x2 t; t.x = __builtin_amdgcn_rcpf(d.x); t.y = __builtin_amdgcn_rcpf(d.y);
    f32x2 q = t * 0.5307027145f + (-0.7265760135f); q = q * t + 0.7107068705f; q = q * t + (-0.142248368f); q = q * t + 0.127414796f; q = q * t;
    const f32x2 s = (v * v) * (-0.72134752044f);
    f32x2 e; e.x = __builtin_amdgcn_exp2f(s.x); e.y = __builtin_amdgcn_exp2f(s.y);
    const f32x2 m = v * (q * e), r = v - m;
    f32x2 o; o.x = v.x < 0.f ? m.x : r.x; o.y = v.y < 0.f ? m.y : r.y; return o;
}

template <int ACT  > struct EpiBf16 {
    static constexpr bool PERM = true, AFTER_DRAIN = false; static_assert(ACT == 0 || ACT == 1, "EpiBf16: ACT is 0 (none) or 1 (gelu_pk)");
    bf16_t* O; int ldc; const float* bias; int split_cols; size_t split_stride; float scale0;
    __device__ __forceinline__ void operator()(const f32x4 (&acc)[2][2][4][2], const Unit& u, int wr, int wc, int fr, int fq) const {
        const int row0 = u.pm * BM + wr * 64 + fr; int colt = u.pn * BM; bf16_t* base = O;
        float sc = 1.f; if (split_cols) { const int t = colt / split_cols; base += (size_t)t * split_stride; colt -= t * split_cols; if (t == 0) sc = scale0; }
        const int col0 = colt + wc * 32 + 8 * fq, bcol0 = u.pn * BM + wc * 32 + 8 * fq;
        f32x4 bv[2][2];
#pragma unroll
        for (int bj = 0; bj < 2; ++bj)
#pragma unroll
            for (int n = 0; n < 2; ++n) bv[bj][n] = bias ? *(const f32x4*)(bias + bcol0 + bj * HALF + 4 * n) : (f32x4){0.f, 0.f, 0.f, 0.f};
#pragma unroll
        for (int ai = 0; ai < 2; ++ai)
#pragma unroll
            for (int m = 0; m < 4; ++m) { bf16_t* rowp = base + (size_t)(row0 + ai * HALF + m * 16) * ldc + col0;
#pragma unroll
                for (int bj = 0; bj < 2; ++bj) { f32x4 v0 = acc[ai][bj][m][0] + bv[bj][0], v1 = acc[ai][bj][m][1] + bv[bj][1];
                    if (ACT == 1) { f32x2 a = gelu_pk((f32x2){v0[0], v0[1]}), b = gelu_pk((f32x2){v0[2], v0[3]}), c = gelu_pk((f32x2){v1[0], v1[1]}), d = gelu_pk((f32x2){v1[2], v1[3]});
                        v0 = (f32x4){a.x, a.y, b.x, b.y}; v1 = (f32x4){c.x, c.y, d.x, d.y}; }
                    v0 = v0 * sc; v1 = v1 * sc; u32x4 w; w.x = cvt_pk_bf16(v0[0], v0[1]); w.y = cvt_pk_bf16(v0[2], v0[3]); w.z = cvt_pk_bf16(v1[0], v1[1]); w.w = cvt_pk_bf16(v1[2], v1[3]);
                    *(u32x4*)(rowp + bj * HALF) = w; } }
    }
};
struct EpiIn {
    static constexpr bool PERM = true, AFTER_DRAIN = false;
    bf16_t* O; int ldc; int rope_cols; int scale_cols; float scale; const float* tab;
    __device__ __forceinline__ void operator()(const f32x4 (&acc)[2][2][4][2], const Unit& u, int wr, int wc, int fr, int fq) const {
        const int row0 = u.pm * BM + wr * 64 + fr; const int colt = u.pn * BM;
        const int col0 = colt + wc * 32 + 8 * fq; const int i0 = 16 * (wc & 1) + 4 * fq;
#pragma unroll
        for (int ai = 0; ai < 2; ++ai)
#pragma unroll
            for (int m = 0; m < 4; ++m) { const int row = row0 + ai * HALF + m * 16; const int t = row & 2047; bf16_t* rowp = O + (size_t)row * ldc + col0;
#pragma unroll
                for (int bj = 0; bj < 2; ++bj) { f32x4 v0 = acc[ai][bj][m][0], v1 = acc[ai][bj][m][1]; const int cb = colt + bj * HALF;
                    if (cb < rope_cols) { const f32x4 c0 = *(const f32x4*)(tab + (size_t)(t * 32 + i0) * 2), c1 = *(const f32x4*)(tab + (size_t)(t * 32 + i0) * 2 + 4);
                        f32x4 r0, r1;
                        r0[0] = v0[0] * c0[0] - v0[1] * c0[1]; r0[1] = v0[1] * c0[0] + v0[0] * c0[1]; r0[2] = v0[2] * c0[2] - v0[3] * c0[3]; r0[3] = v0[3] * c0[2] + v0[2] * c0[3];
                        r1[0] = v1[0] * c1[0] - v1[1] * c1[1]; r1[1] = v1[1] * c1[0] + v1[0] * c1[1]; r1[2] = v1[2] * c1[2] - v1[3] * c1[3]; r1[3] = v1[3] * c1[2] + v1[2] * c1[3];
                        v0 = r0; v1 = r1; }
                    if (cb < scale_cols) { v0 = v0 * scale; v1 = v1 * scale; }
                    u32x4 w; w.x = cvt_pk_bf16(v0[0], v0[1]); w.y = cvt_pk_bf16(v0[2], v0[3]); w.z = cvt_pk_bf16(v1[0], v1[1]); w.w = cvt_pk_bf16(v1[2], v1[3]);
                    *(u32x4*)(rowp + bj * HALF) = w; } }
    }
};
struct EpiConvGate {
    static constexpr bool PERM = true, AFTER_DRAIN = false;
    bf16_t* H; bf16_t* UL; bf16_t* UF; bf16_t* VF; const float* cw; const float* cb; int ff;
    __device__ __forceinline__ void operator()(const f32x4 (&acc)[2][2][4][2], const Unit& u, int wr, int wc, int fr, int fq) const {
        const int j0 = u.pn * HALF + wc * 32 + 8 * fq; const int lane = (int)(threadIdx.x & 63);
        const int src1 = (lane & ~15) | ((fr + 15) & 15), src2 = (lane & ~15) | ((fr + 14) & 15);
        float k0[8], k1[8], k2[8], kb[8];
#pragma unroll
        for (int q = 0; q < 2; ++q) { const f32x4 a = *(const f32x4*)(cw + j0 + 4 * q), b = *(const f32x4*)(cw + ff + j0 + 4 * q), c = *(const f32x4*)(cw + 2 * ff + j0 + 4 * q), d = *(const f32x4*)(cb + j0 + 4 * q);
#pragma unroll
            for (int e = 0; e < 4; ++e) { k0[4 * q + e] = a[e]; k1[4 * q + e] = b[e]; k2[4 * q + e] = c[e]; kb[4 * q + e] = d[e]; } }
#pragma unroll
        for (int ai = 0; ai < 2; ++ai) {
            float pr1[8], pr2[8];
#pragma unroll
            for (int e = 0; e < 8; ++e) { pr1[e] = 0.f; pr2[e] = 0.f; }
#pragma unroll
            for (int m = 0; m < 4; ++m) { const int row = u.pm * BM + ai * HALF + wr * 64 + m * 16 + fr;
                float uu[8], vv[8], hh[8];
#pragma unroll
                for (int e = 0; e < 4; ++e) { uu[e] = acc[ai][0][m][0][e]; uu[4 + e] = acc[ai][0][m][1][e]; vv[e] = acc[ai][1][m][0][e]; vv[4 + e] = acc[ai][1][m][1][e]; }
#pragma unroll
                for (int e = 0; e < 8; ++e) { const float r1 = __shfl(uu[e], src1), r2 = __shfl(uu[e], src2);
                    const float p1 = fr >= 1 ? r1 : pr1[e], p2 = fr >= 2 ? r2 : pr2[e]; pr1[e] = r1; pr2[e] = r2;
                    hh[e] = kb[e] + k0[e] * p2 + k1[e] * p1 + k2[e] * uu[e]; }
#pragma unroll
                for (int e = 0; e < 8; e += 2) { const f32x2 g = gelu_pk((f32x2){hh[e], hh[e + 1]}); hh[e] = g.x * vv[e]; hh[e + 1] = g.y * vv[e + 1]; }
                u32x4 w; w.x = cvt_pk_bf16(hh[0], hh[1]); w.y = cvt_pk_bf16(hh[2], hh[3]); w.z = cvt_pk_bf16(hh[4], hh[5]); w.w = cvt_pk_bf16(hh[6], hh[7]);
                *(u32x4*)(H + (size_t)row * ff + j0) = w;
                if (m == 3 && fr >= 14) { u32x4 s; s.x = cvt_pk_bf16(uu[0], uu[1]); s.y = cvt_pk_bf16(uu[2], uu[3]); s.z = cvt_pk_bf16(uu[4], uu[5]); s.w = cvt_pk_bf16(uu[6], uu[7]);
                    *(u32x4*)(UL + ((size_t)(row >> 6) * 2 + (fr - 14)) * ff + j0) = s; }
                if (m == 0 && fr < 2) { u32x4 s; s.x = cvt_pk_bf16(uu[0], uu[1]); s.y = cvt_pk_bf16(uu[2], uu[3]); s.z = cvt_pk_bf16(uu[4], uu[5]); s.w = cvt_pk_bf16(uu[6], uu[7]);
                    *(u32x4*)(UF + ((size_t)(row >> 6) * 2 + fr) * ff + j0) = s;
                    u32x4 z; z.x = cvt_pk_bf16(vv[0], vv[1]); z.y = cvt_pk_bf16(vv[2], vv[3]); z.z = cvt_pk_bf16(vv[4], vv[5]); z.w = cvt_pk_bf16(vv[6], vv[7]);
                    *(u32x4*)(VF + ((size_t)(row >> 6) * 2 + fr) * ff + j0) = z; }
            }
        }
    }
};
template <class Epi, class Sched, bool ALIGN_EPI = false, bool SP2 = false>
__device__ __forceinline__ void gemm_phase(PG8_LAS unsigned char* lds, const Gemm g, const Sched& S, const Epi& E) {
    const int tid = threadIdx.x, wid = __builtin_amdgcn_readfirstlane(tid >> 6), lane = tid & 63, wr = wid >> 2, wc = wid & 3, fr = lane & 15, fq = lane >> 4;
    const int K = g.K, nt = K / BK;
    unsigned voffA[2], voffB[2];
#pragma unroll
    for (int i = 0; i < 2; ++i) { int R, C; stage_rc(tid * 16 + i * 8192, R, C); const int Rb = Epi::PERM ? ((R & ~31) + perm32(R & 31)) : R;
        voffA[i] = (unsigned)(R * K + C) * 2u; voffB[i] = (unsigned)(Rb * K + C) * 2u; }
    const size_t kstep = (size_t)(BK * 2);
    const size_t hstep = (size_t)HALF * K * 2;
    const size_t tstep = 2 * hstep;
    const unsigned ldsw = (unsigned)wid * 1024u;
    const int aoff = lds_byte(wr * 64 + fr, fq * 8), boff = lds_byte(wc * 32 + fr, fq * 8);
#define PG8_SA(b, h) (((b) * 2 + (h)) * HTB)
#define PG8_SB(b, h) ((4 + (b) * 2 + (h)) * HTB)
#define PG8_STAGE(bufoff, gbase, voff) do { _Pragma("unroll") for (int _i = 0; _i < 2; ++_i) \
        __builtin_amdgcn_global_load_lds((const unsigned*)((const char*)(gbase) + (voff)[_i]), (PG8_LAS unsigned*)(lds + (bufoff) + ldsw + _i * 8192), 16, 0, 0); } while (0)
#define PG8_LDA(dst, b, h) do { _Pragma("unroll") for (int m = 0; m < 4; ++m) _Pragma("unroll") for (int k = 0; k < 2; ++k) dst[m][k] = *(const PG8_LAS bf16x8*)(lds + PG8_SA(b, h) + aoff + m * 2048 + k * 1024); } while (0)
#define PG8_LDB(dst, b, h) do { _Pragma("unroll") for (int n = 0; n < 2; ++n) _Pragma("unroll") for (int k = 0; k < 2; ++k) dst[n][k] = *(const PG8_LAS bf16x8*)(lds + PG8_SB(b, h) + boff + n * 2048 + k * 1024); } while (0)
#define PG8_MMA(ai, bj, At, Bt) do { __builtin_amdgcn_s_setprio(1); _Pragma("unroll") for (int m = 0; m < 4; ++m) _Pragma("unroll") for (int n = 0; n < 2; ++n) _Pragma("unroll") for (int k = 0; k < 2; ++k) \
        acc[ai][bj][m][n] = __builtin_amdgcn_mfma_f32_16x16x32_bf16(Bt[n][k], At[m][k], acc[ai][bj][m][n], 0, 0, 0); __builtin_amdgcn_s_setprio(0); } while (0)
#define PG8_WAIT_V(n) asm volatile("s_waitcnt vmcnt(" #n ")" ::: "memory")
#define PG8_WAIT_L(n) asm volatile("s_waitcnt lgkmcnt(" #n ")" ::: "memory")
#define PG8_BAR __builtin_amdgcn_s_barrier()
#define PG8_SCHED __builtin_amdgcn_sched_barrier(0)
    Unit cur, nxt; int ui = 0;
    if (!S.next(0, cur)) return;
    f32x4 acc[2][2][4][2];
#pragma unroll
    for (int a = 0; a < 2; ++a)
#pragma unroll
        for (int b = 0; b < 2; ++b)
#pragma unroll
            for (int m = 0; m < 4; ++m)
#pragma unroll
                for (int n = 0; n < 2; ++n) acc[a][b][m][n] = (f32x4){0.f, 0.f, 0.f, 0.f};
    bf16x8 At[4][2], B0[2][2], B1[2][2];
    const char* cA = (const char*)g.A + (size_t)cur.pm * tstep; const char* cB = (const char*)g.Bt + (size_t)cur.pn * tstep;
    S.a_ready(cur);
    if constexpr (SP2) {
        PG8_STAGE(PG8_SB(0, 0), cB, voffB); PG8_STAGE(PG8_SB(0, 1), cB + hstep, voffB); PG8_STAGE(PG8_SA(0, 0), cA, voffA); PG8_STAGE(PG8_SA(0, 1), cA + hstep, voffA);
        if (wr == 1) PG8_BAR;
        PG8_WAIT_V(2); PG8_BAR;
        PG8_STAGE(PG8_SB(1, 0), cB + kstep, voffB); PG8_STAGE(PG8_SA(1, 0), cA + kstep, voffA); PG8_STAGE(PG8_SB(1, 1), cB + hstep + kstep, voffB);
        PG8_WAIT_V(6); PG8_BAR;
    } else {
        PG8_STAGE(PG8_SB(0, 0), cB, voffB); PG8_STAGE(PG8_SA(0, 0), cA, voffA); PG8_STAGE(PG8_SB(0, 1), cB + hstep, voffB); PG8_STAGE(PG8_SA(0, 1), cA + hstep, voffA);
        if (wr == 1) PG8_BAR;
        PG8_WAIT_V(4); PG8_BAR;
        PG8_STAGE(PG8_SB(1, 0), cB + kstep, voffB); PG8_STAGE(PG8_SA(1, 0), cA + kstep, voffA); PG8_STAGE(PG8_SB(1, 1), cB + hstep + kstep, voffB);
        PG8_WAIT_V(6); PG8_BAR;
    }
    for (;;) {
        const bool has_next = S.next(ui + 1, nxt);
        const char* nA = has_next ? (const char*)g.A + (size_t)nxt.pm * tstep : cA; const char* nB = has_next ? (const char*)g.Bt + (size_t)nxt.pn * tstep : cB;
        for (int t = 0; t < nt; t += 2) {
            const bool last = (t == nt - 2);
            const char* a1 = cA + (size_t)(t + 1) * kstep;
            const char* a2 = last ? nA : cA + (size_t)(t + 2) * kstep; const char* b2 = last ? nB : cB + (size_t)(t + 2) * kstep;
            const char* a3 = a2 + kstep; const char* b3 = b2 + kstep;
            if (last && has_next) S.a_ready(nxt);
            if constexpr (SP2) {
            PG8_LDB(B0, 0, 0); PG8_LDB(B1, 0, 1); PG8_SCHED; PG8_LDA(At, 0, 0); PG8_STAGE(PG8_SA(1, 1), a1 + hstep, voffA);
            PG8_WAIT_V(8); PG8_WAIT_L(0); PG8_BAR; PG8_MMA(0, 0, At, B0); PG8_MMA(0, 1, At, B1); PG8_BAR; PG8_SCHED;
            PG8_LDA(At, 0, 1); PG8_STAGE(PG8_SB(0, 0), b2, voffB); PG8_STAGE(PG8_SB(0, 1), b2 + hstep, voffB); PG8_STAGE(PG8_SA(0, 0), a2, voffA);
            PG8_WAIT_V(8); PG8_WAIT_L(0); PG8_BAR; PG8_MMA(1, 0, At, B0); PG8_MMA(1, 1, At, B1); PG8_BAR; PG8_SCHED;
            PG8_LDB(B0, 1, 0); PG8_LDB(B1, 1, 1); PG8_SCHED; PG8_LDA(At, 1, 0); PG8_STAGE(PG8_SA(0, 1), a2 + hstep, voffA);
            PG8_WAIT_V(8); PG8_WAIT_L(0); PG8_BAR; PG8_MMA(0, 0, At, B0); PG8_MMA(0, 1, At, B1); PG8_BAR; PG8_SCHED;
            PG8_LDA(At, 1, 1); PG8_STAGE(PG8_SB(1, 0), b3, voffB); PG8_STAGE(PG8_SB(1, 1), b3 + hstep, voffB); PG8_STAGE(PG8_SA(1, 0), a3, voffA);
            PG8_WAIT_V(8); PG8_WAIT_L(0); PG8_BAR; PG8_MMA(1, 0, At, B0); PG8_MMA(1, 1, At, B1); PG8_BAR; PG8_SCHED;
            } else {
            PG8_LDB(B0, 0, 0); PG8_SCHED; PG8_LDA(At, 0, 0); PG8_STAGE(PG8_SA(1, 1), a1 + hstep, voffA);
            PG8_WAIT_L(8); PG8_BAR; PG8_WAIT_L(0); PG8_MMA(0, 0, At, B0); PG8_BAR; PG8_SCHED;
            PG8_LDB(B1, 0, 1); PG8_STAGE(PG8_SB(0, 0), b2, voffB);
            PG8_BAR; PG8_WAIT_L(0); PG8_MMA(0, 1, At, B1); PG8_BAR;
            PG8_LDA(At, 0, 1); PG8_STAGE(PG8_SA(0, 0), a2, voffA);
            PG8_BAR; PG8_WAIT_L(0); PG8_MMA(1, 0, At, B0); PG8_BAR; PG8_SCHED;
            PG8_STAGE(PG8_SB(0, 1), b2 + hstep, voffB);
            PG8_WAIT_V(6); PG8_BAR; PG8_MMA(1, 1, At, B1); PG8_BAR;
            PG8_LDB(B0, 1, 0); PG8_SCHED; PG8_LDA(At, 1, 0); PG8_STAGE(PG8_SA(0, 1), a2 + hstep, voffA);
            PG8_WAIT_L(8); PG8_BAR; PG8_WAIT_L(0); PG8_MMA(0, 0, At, B0); PG8_BAR; PG8_SCHED;
            PG8_LDB(B1, 1, 1); PG8_STAGE(PG8_SB(1, 0), b3, voffB);
            PG8_BAR; PG8_WAIT_L(0); PG8_MMA(0, 1, At, B1); PG8_BAR;
            PG8_LDA(At, 1, 1); PG8_STAGE(PG8_SA(1, 0), a3, voffA);
            PG8_BAR; PG8_WAIT_L(0); PG8_MMA(1, 0, At, B0); PG8_BAR; PG8_SCHED;
            PG8_STAGE(PG8_SB(1, 1), b3 + hstep, voffB);
            PG8_WAIT_V(6); PG8_BAR; PG8_MMA(1, 1, At, B1); PG8_BAR;
            }
        }
        if constexpr (ALIGN_EPI) { if (wr == 0) PG8_BAR; }
        if constexpr (!Epi::AFTER_DRAIN) { E(acc, cur, wr, wc, fr, fq); S.done(cur); }
        if (!has_next) break;
#pragma unroll
        for (int a = 0; a < 2; ++a)
#pragma unroll
            for (int b = 0; b < 2; ++b)
#pragma unroll
                for (int m = 0; m < 4; ++m)
#pragma unroll
                    for (int n = 0; n < 2; ++n) acc[a][b][m][n] = (f32x4){0.f, 0.f, 0.f, 0.f};
        cur = nxt; cA = nA; cB = nB; ++ui;
        if constexpr (ALIGN_EPI) { if (wr == 1) PG8_BAR; }
    }
    PG8_WAIT_V(0);
    if constexpr (!ALIGN_EPI) { if (wr == 0) PG8_BAR; }
    PG8_BAR;
    if constexpr (Epi::AFTER_DRAIN) { E.fused(acc, cur, wr, wc, fr, fq, lds, wid, lane); S.done(cur); }
#undef PG8_SA
#undef PG8_SB
#undef PG8_STAGE
#undef PG8_LDA
#undef PG8_LDB
#undef PG8_MMA
#undef PG8_WAIT_V
#undef PG8_WAIT_L
#undef PG8_BAR
#undef PG8_SCHED
}
}
constexpr int NWAVES = 8;
constexpr int BATCH = 32, SEQ = 2048, D = 1024, M = BATCH * SEQ;
constexpr int EVEN_IN = 2816, ODD_IN = 3072, DFF = 2816, UPN = 2 * DFF;
constexpr int QB_OFF = 768, FB_OFF = 1280, IB_OFF = 1792, GB_OFF = 2304;
constexpr float EPS = 1e-6f;
constexpr float LOG2E = 1.4426950408889634f;
constexpr float C2 = 0.125f * LOG2E;

constexpr size_t MiB = 1u << 20;
constexpr size_t WS_CTL = 0, CTL_ZERO_BYTES = 64 * 1024;
constexpr size_t WS_TAB = 1 * MiB;
constexpr size_t WS_LB = WS_TAB + 768 * 1024;
constexpr size_t WS_WIN0 = 2 * MiB, WS_WOUT0 = 8 * MiB, WS_WIN1 = 10 * MiB, WS_WOUT1 = 16 * MiB, WS_WUP = 18 * MiB  , WS_WDN = 40 * MiB  ;
constexpr size_t WS_SIDE = 52 * MiB, SIDE_STRIDE = 12 * MiB;
constexpr size_t WS_XN = 96 * MiB;
constexpr size_t WS_PROJ = 224 * MiB;
constexpr size_t WS_O = 608 * MiB;
constexpr size_t WS_Y = 736 * MiB;
constexpr size_t WS_END = 864 * MiB;
constexpr int CW_BAR = 4096;

constexpr int RING_OFF = 0, RING_BYTES = 131072;
constexpr int LDSCTL_OFF = RING_BYTES, MISC_OFF = LDSCTL_OFF + 320;
constexpr int LDS_BYTES = 147456;

#define GAS __attribute__((address_space(1)))
#define LAS __attribute__((address_space(3)))
typedef unsigned short bf16;
typedef unsigned v4u __attribute__((ext_vector_type(4)));
typedef float f32x4 __attribute__((ext_vector_type(4)));
typedef short bf16x8 __attribute__((ext_vector_type(8)));
typedef GAS unsigned gu32;
typedef GAS unsigned long long gu64;
#define RLX_AGENT __ATOMIC_RELAXED, __HIP_MEMORY_SCOPE_AGENT
#define LDS_WAIT() asm volatile("s_waitcnt lgkmcnt(0)" ::: "memory")
#define VM_WAIT() asm volatile("s_waitcnt vmcnt(0)" ::: "memory")
__device__ __forceinline__ unsigned long long rt() { return __builtin_amdgcn_s_memrealtime(); }
__device__ __forceinline__ unsigned f2bf(float f) { unsigned u = __builtin_bit_cast(unsigned, f); return (u + 0x7fffu + ((u >> 16) & 1u)) >> 16; }
__device__ __forceinline__ unsigned pk2(float lo, float hi) { return f2bf(lo) | (f2bf(hi) << 16); }

#define XB_TMO      128
#define XB_XCNT(j)  (256  + 64 * (j))
#define XB_XSUB(j)  (1280 + 64 * (j))
#define XB_XGEN(j)  (2304 + 64 * (j))
#define XB_TOP      3328
#define XB_TOPGEN   3392
#define XCD_BAR_WORDS 3456
#define XB_SPIN_CAP (1u << 18)

__device__ __forceinline__ unsigned xb_ld(unsigned* p)              { return __hip_atomic_load(p, __ATOMIC_RELAXED, __HIP_MEMORY_SCOPE_AGENT); }
__device__ __forceinline__ unsigned xb_add(unsigned* p, unsigned v) { return __hip_atomic_fetch_add(p, v, __ATOMIC_RELAXED, __HIP_MEMORY_SCOPE_AGENT); }
__device__ __forceinline__ unsigned xb_xcc_id() { return (unsigned)__builtin_amdgcn_s_getreg((3 << 11) | 20) & 0xFu; }
#define XB_SPIN(cond, bar) do { unsigned _sp = 0; while (cond) { __builtin_amdgcn_s_sleep(1); \
    if ((++_sp & 255u) == 0u) { if (xb_ld(&(bar)[XB_TMO])) break; if (_sp > XB_SPIN_CAP) { atomicAdd(&(bar)[XB_TMO], 1u); break; } } } } while (0)

struct XcdBarrier {
    unsigned* bar; unsigned x;
    volatile LAS unsigned* st;
};

__device__ __forceinline__ XcdBarrier xcd_barrier_post(unsigned* bar, volatile LAS unsigned* st) {
    XcdBarrier b; b.bar = bar; b.x = xb_xcc_id(); b.st = st;
    if (threadIdx.x == 0) (void)xb_add(&bar[XB_XCNT(b.x)], 1u);
    return b;
}
__device__ __forceinline__ void xcd_barrier_complete(unsigned* bar, unsigned x, unsigned& nloc, unsigned& nx) {
    const unsigned G = gridDim.x * gridDim.y * gridDim.z;
    unsigned sum, cnt, mine, sp = 0u;
    for (;;) {
        sum = 0u; cnt = 0u; mine = 0u;
#pragma unroll
        for (unsigned j = 0; j < 16; ++j) { const unsigned c = xb_ld(&bar[XB_XCNT(j)]); sum += c; cnt += (c > 0u) ? 1u : 0u; mine = (j == x) ? c : mine; }
        if (sum == G) break;
        __builtin_amdgcn_s_sleep(1);
        if ((++sp & 255u) == 0u) { if (xb_ld(&bar[XB_TMO])) break; if (sp > XB_SPIN_CAP) { atomicAdd(&bar[XB_TMO], 1u); break; } }
    }
    nloc = mine > 0u ? mine : 1u; nx = cnt > 0u ? cnt : 1u;
}

__device__ __forceinline__ void xcd_barrier(const XcdBarrier& b) {
    asm volatile("s_waitcnt vmcnt(0)" ::: "memory");
    __syncthreads();
    if (threadIdx.x == 0) {
        unsigned* bar = b.bar;
        __builtin_amdgcn_s_waitcnt(0);
        unsigned nloc = b.st[0], nx = b.st[1];
        if (nloc == 0u) { xcd_barrier_complete(bar, b.x, nloc, nx); b.st[0] = nloc; b.st[1] = nx; }
        const unsigned old = xb_add(&bar[XB_XSUB(b.x)], 1u);
        const unsigned gen = old / nloc;
        if (old + 1u == (gen + 1u) * nloc) {
            __builtin_amdgcn_fence(__ATOMIC_RELEASE, "agent");
            asm volatile("s_waitcnt vmcnt(0)" ::: "memory");
            const unsigned og = xb_add(&bar[XB_TOP], 1u);
            const unsigned tg = og / nx;
            if (og + 1u == (tg + 1u) * nx) xb_add(&bar[XB_TOPGEN], 1u);
            else XB_SPIN(xb_ld(&bar[XB_TOPGEN]) == tg, bar);
            __builtin_amdgcn_fence(__ATOMIC_ACQUIRE, "agent");
            xb_add(&bar[XB_XGEN(b.x)], 1u);
            asm volatile("s_waitcnt vmcnt(0)" ::: "memory");
        } else {
            XB_SPIN(xb_ld(&bar[XB_XGEN(b.x)]) == gen, bar);
            __builtin_amdgcn_fence(__ATOMIC_ACQUIRE, "agent");
            asm volatile("s_waitcnt vmcnt(0)" ::: "memory");
        }
    }
    __syncthreads();
}
struct Frame {
    LAS unsigned char* lds;
    volatile LAS unsigned* MISC;
    gu32* ctl;
    int tid, lane, wave, G;
    unsigned char* ws;
    const float *x, *even_w_in, *even_w_out, *even_sinks, *lb_logits, *hgrn_norm_w, *odd_w_in, *odd_w_out, *odd_rel, *w_up, *conv_w, *conv_b, *w_down, *norm_w;
    float* out;
};
__device__ __forceinline__ float bf2f(bf16 b) { return __builtin_bit_cast(float, (unsigned)b << 16); }
__device__ __forceinline__ float wave_sum(float v) {
#pragma unroll
    for (int o = 1; o < 64; o <<= 1) v += __shfl_xor(v, o);
    return v;
}
__device__ __forceinline__ int colmap(int cmode, int n) {
    if (cmode == 1) { if (n >= 640) return n; const int p = n & 63; return (n - p) + (p >> 1) + 32 * (p & 1); }
    if (cmode == 2) { const int pn = n >> 8, r = n & 255; return r < 128 ? pn * 128 + r : DFF + pn * 128 + (r - 128); }
    return n;
}
__device__ __forceinline__ void transpose_item(const float* W, int K, int Nsrc, int Nout, bf16* WT, const float* kscale, int cmode, LAS float* scr, int item, int lane) {
    const int nblk = Nout / 32, kb = item / nblk, nb = item % nblk, k0 = 64 * kb, n0 = 32 * nb;
    const int nsrc = colmap(cmode, n0 + (lane & 31));
#pragma unroll 8
    for (int i = 0; i < 32; ++i) { const int kk = 2 * i + (lane >> 5); float w = W[(size_t)(k0 + kk) * Nsrc + nsrc]; if (kscale) w *= kscale[k0 + kk]; scr[kk * 33 + (lane & 31)] = w; }
    LDS_WAIT(); asm volatile("" ::: "memory");
    const int c = lane & 7;
#pragma unroll
    for (int j = 0; j < 4; ++j) { const int n = (lane >> 3) + 8 * j; const LAS float* s = scr + (8 * c) * 33 + n;
        v4u o; o.x = pk2(s[0 * 33], s[1 * 33]); o.y = pk2(s[2 * 33], s[3 * 33]); o.z = pk2(s[4 * 33], s[5 * 33]); o.w = pk2(s[6 * 33], s[7 * 33]);
        *(GAS v4u*)(WT + (size_t)(n0 + n) * K + k0 + 8 * c) = o; }
    LDS_WAIT(); asm volatile("" ::: "memory");
}
__device__ __forceinline__ void rms_row_to_bf16(int lane, const float* xrow, bf16* orow) {
    const GAS f32x4* xr = (const GAS f32x4*)xrow + lane;
    f32x4 v[4]; float s = 0.f;
#pragma unroll
    for (int j = 0; j < 4; ++j) { v[j] = xr[64 * j]; s += (v[j].x * v[j].x + v[j].y * v[j].y) + (v[j].z * v[j].z + v[j].w * v[j].w); }
    const float rstd = 1.f / sqrtf(wave_sum(s) * (1.f / D) + EPS);
    GAS unsigned long long* o8 = (GAS unsigned long long*)orow + lane;
#pragma unroll
    for (int j = 0; j < 4; ++j) o8[64 * j] = (unsigned long long)pk2(v[j].x * rstd, v[j].y * rstd) | ((unsigned long long)pk2(v[j].z * rstd, v[j].w * rstd) << 32);
}
__device__ __forceinline__ void p_prologue(Frame& F) {
    LAS float* scr = (LAS float*)(F.lds + RING_OFF + F.wave * 16384);
    const int gw = blockIdx.x * NWAVES + F.wave, NGW = F.G * NWAVES;
#pragma unroll 1
    for (int mat = 0; mat < 8; ++mat) {
        const float* W; int K, Nsrc, Nout, cmode = 0; const float* ks = nullptr; size_t dst;
        if (mat == 0)      { W = F.even_w_in;  K = D; Nsrc = EVEN_IN; Nout = EVEN_IN; cmode = 1; ks = F.norm_w + 0 * D; dst = WS_WIN0; }
        else if (mat == 1) { W = F.even_w_out; K = D; Nsrc = D; Nout = D; dst = WS_WOUT0; }
        else if (mat == 2) { W = F.odd_w_in;   K = D; Nsrc = ODD_IN; Nout = ODD_IN; ks = F.norm_w + 4 * D; dst = WS_WIN1; }
        else if (mat == 3) { W = F.odd_w_out;  K = D; Nsrc = D; Nout = D; dst = WS_WOUT1; }
        else if (mat < 6)  { const int l = mat - 4; W = F.w_up + (size_t)l * D * UPN; K = D; Nsrc = UPN; Nout = UPN; cmode = 2; ks = F.norm_w + (size_t)(l * 4 + 2) * D; dst = WS_WUP + (size_t)l * 11 * MiB; }
        else               { const int l = mat - 6; W = F.w_down + (size_t)l * DFF * D; K = DFF; Nsrc = D; Nout = D; dst = WS_WDN + (size_t)l * 5632 * 1024; }
        const int nitems = (K / 64) * (Nout / 32);
        for (int it = gw; it < nitems; it += NGW) transpose_item(W, K, Nsrc, Nout, (bf16*)(F.ws + dst), ks, cmode, scr, it, F.lane);
    }
    { float* tab = (float*)(F.ws + WS_TAB); const int gt = blockIdx.x * (NWAVES * 64) + F.tid, NT = F.G * NWAVES * 64;
      for (int e = gt; e < SEQ * 32; e += NT) { const int t = e >> 5, i = e & 31; const float inv = powf(10000.f, -(float)(2 * i) / 64.f); const float ang = (float)t * inv;
          tab[2 * e] = (float)cos((double)ang); tab[2 * e + 1] = (float)sin((double)ang); }
      float* lb = (float*)(F.ws + WS_LB);
      for (int e = gt; e < 512; e += NT) { const float a = F.lb_logits[e], b = F.lb_logits[512 + e]; const float mx = fmaxf(a, b); const float ea = expf(a - mx), eb = expf(b - mx); lb[e] = ea / (ea + eb); } }
    for (int m = gw; m < M; m += NGW) rms_row_to_bf16(F.lane, F.x + (size_t)m * D, (bf16*)(F.ws + WS_XN) + (size_t)m * D);
}
__device__ __forceinline__ void p_norm(Frame& F, const float* hin, const bf16* Y, const float* g, float* hout, bf16* xn) {
    const int gw = blockIdx.x * NWAVES + F.wave, NGW = F.G * NWAVES;
    f32x4 gv[4];
#pragma unroll
    for (int j = 0; j < 4; ++j) gv[j] = ((const GAS f32x4*)g)[F.lane + 64 * j];
    for (int m = gw; m < M; m += NGW) {
        const GAS f32x4* hr = (const GAS f32x4*)(hin + (size_t)m * D) + F.lane;
        const GAS unsigned long long* yr = (const GAS unsigned long long*)(Y + (size_t)m * D) + F.lane;
        f32x4 h[4], y[4]; float s = 0.f;
#pragma unroll
        for (int j = 0; j < 4; ++j) { h[j] = hr[64 * j]; const unsigned long long w = yr[64 * j];
            y[j].x = __builtin_bit_cast(float, (unsigned)(w & 0xffffu) << 16); y[j].y = __builtin_bit_cast(float, (unsigned)(w >> 16 & 0xffffu) << 16);
            y[j].z = __builtin_bit_cast(float, (unsigned)(w >> 32 & 0xffffu) << 16); y[j].w = __builtin_bit_cast(float, (unsigned)(w >> 48 & 0xffffu) << 16);
            s += (y[j].x * y[j].x + y[j].y * y[j].y) + (y[j].z * y[j].z + y[j].w * y[j].w); }
        const float r1 = 1.f / sqrtf(wave_sum(s) * (1.f / D) + EPS); float s2 = 0.f;
#pragma unroll
        for (int j = 0; j < 4; ++j) { h[j] = h[j] + y[j] * r1 * gv[j]; s2 += (h[j].x * h[j].x + h[j].y * h[j].y) + (h[j].z * h[j].z + h[j].w * h[j].w); }
        GAS f32x4* ho = (GAS f32x4*)(hout + (size_t)m * D) + F.lane;
#pragma unroll
        for (int j = 0; j < 4; ++j) ho[64 * j] = h[j];
        if (xn) { const float r2 = 1.f / sqrtf(wave_sum(s2) * (1.f / D) + EPS);
            GAS unsigned long long* o8 = (GAS unsigned long long*)(xn + (size_t)m * D) + F.lane;
#pragma unroll
            for (int j = 0; j < 4; ++j) o8[64 * j] = (unsigned long long)pk2(h[j].x * r2, h[j].y * r2) | ((unsigned long long)pk2(h[j].z * r2, h[j].w * r2) << 32); }
    }
}
__device__ __forceinline__ void p_fixup(Frame& F, bf16* H, const bf16* UL, const bf16* UF, const bf16* VF, const float* cw, const float* cb) {
    const int gt = blockIdx.x * (NWAVES * 64) + F.tid, NT = F.G * NWAVES * 64;
    constexpr int CH = DFF / 8, NIT = (M / 64) * 2 * CH;
    for (int it = gt; it < NIT; it += NT) {
        const int ch = it % CH, gr = it / CH, r = gr & 1, g = gr >> 1, j0 = ch * 8;
        const bool has_prev = (g & 31) != 0;
        const v4u z4 = {0u, 0u, 0u, 0u};
        const v4u u0 = *(const GAS v4u*)(UF + ((size_t)g * 2 + r) * DFF + j0);
        const v4u vv = *(const GAS v4u*)(VF + ((size_t)g * 2 + r) * DFF + j0);
        const v4u pl1 = has_prev ? *(const GAS v4u*)(UL + ((size_t)(g - 1) * 2 + 1) * DFF + j0) : z4;
        const v4u pl0 = has_prev ? *(const GAS v4u*)(UL + ((size_t)(g - 1) * 2 + 0) * DFF + j0) : z4;
        const v4u uf0 = *(const GAS v4u*)(UF + ((size_t)g * 2 + 0) * DFF + j0);
        const v4u um1 = r ? uf0 : pl1, um2 = r ? pl1 : pl0;
        float hh[8];
#pragma unroll
        for (int e = 0; e < 8; ++e) { const int sh = (e & 1) * 16; const unsigned wa = u0[e >> 1], wb = um1[e >> 1], wc_ = um2[e >> 1], wv = vv[e >> 1];
            const float a = bf2f((bf16)(wa >> sh)), b = bf2f((bf16)(wb >> sh)), c = bf2f((bf16)(wc_ >> sh)), v = bf2f((bf16)(wv >> sh));
            const float pre = cb[j0 + e] + cw[j0 + e] * c + cw[DFF + j0 + e] * b + cw[2 * DFF + j0 + e] * a;
            const pg8::f32x2 gg = pg8::gelu_pk((pg8::f32x2){pre, pre}); hh[e] = gg.x * v; }
        v4u o; o.x = pk2(hh[0], hh[1]); o.y = pk2(hh[2], hh[3]); o.z = pk2(hh[4], hh[5]); o.w = pk2(hh[6], hh[7]);
        *(GAS v4u*)(H + ((size_t)g * 64 + r) * DFF + j0) = o;
    }
}
__device__ __forceinline__ void p_attn_plain(Frame& F, const bf16* Q, int ldq, const bf16* Kp, int ldk, const bf16* Vp, int ldv, bf16* O, int ldo, int HQ, int GQ, int nprev, const float* sinks, const float* rel) {
    const int gt = blockIdx.x * (NWAVES * 64) + F.tid, NT = F.G * NWAVES * 64;
    const long total = (long)M * HQ;
    for (long idx = gt; idx < total; idx += NT) {
        const int hq = (int)(idx / M), row = (int)(idx % M), hk = hq / GQ;
        const int b = row / SEQ, t = row % SEQ, c = t >> 6, c0 = c - nprev < 0 ? 0 : c - nprev;
        float q[64], o[64];
        { const GAS v4u* qp = (const GAS v4u*)(Q + (size_t)row * ldq + hq * 64);
#pragma unroll
          for (int i = 0; i < 8; ++i) { const v4u w = qp[i];
#pragma unroll
              for (int e = 0; e < 4; ++e) { const unsigned ww = w[e]; q[8 * i + 2 * e] = bf2f((bf16)(ww & 0xffffu)); q[8 * i + 2 * e + 1] = bf2f((bf16)(ww >> 16)); } } }
#pragma unroll
        for (int d = 0; d < 64; ++d) o[d] = 0.f;
        float mrun = sinks ? sinks[hq] * LOG2E : -INFINITY, l = sinks ? 1.f : 0.f;
        const float* relh = rel ? rel + hq * 257 : nullptr;
        for (int kp = c0 * 64; kp < c * 64 + 64; ++kp) {
            const size_t krow = (size_t)b * SEQ + kp;
            const GAS v4u* kk = (const GAS v4u*)(Kp + krow * ldk + hk * 64);
            float s = 0.f;
#pragma unroll
            for (int i = 0; i < 8; ++i) { const v4u w = kk[i];
#pragma unroll
                for (int e = 0; e < 4; ++e) { const unsigned ww = w[e]; s += q[8 * i + 2 * e] * bf2f((bf16)(ww & 0xffffu)); s += q[8 * i + 2 * e + 1] * bf2f((bf16)(ww >> 16)); } }
            if (relh) { int r = t - kp; r = r < -128 ? -128 : (r > 128 ? 128 : r); s += relh[r + 128] * LOG2E; }
            const float mn = fmaxf(mrun, s), sc = exp2f(mrun - mn), p = exp2f(s - mn);
            l = l * sc + p; mrun = mn;
            const GAS v4u* vp = (const GAS v4u*)(Vp + krow * ldv + hk * 64);
#pragma unroll
            for (int i = 0; i < 8; ++i) { const v4u w = vp[i];
#pragma unroll
                for (int e = 0; e < 4; ++e) { const unsigned ww = w[e]; o[8 * i + 2 * e] = o[8 * i + 2 * e] * sc + p * bf2f((bf16)(ww & 0xffffu)); o[8 * i + 2 * e + 1] = o[8 * i + 2 * e + 1] * sc + p * bf2f((bf16)(ww >> 16)); } }
        }
        const float il = 1.f / l;
        GAS v4u* op = (GAS v4u*)(O + (size_t)row * ldo + hq * 64);
#pragma unroll
        for (int i = 0; i < 8; ++i) { v4u w; w.x = pk2(o[8 * i] * il, o[8 * i + 1] * il); w.y = pk2(o[8 * i + 2] * il, o[8 * i + 3] * il); w.z = pk2(o[8 * i + 4] * il, o[8 * i + 5] * il); w.w = pk2(o[8 * i + 6] * il, o[8 * i + 7] * il); op[i] = w; }
    }
}
__device__ __forceinline__ void p_hgrn_plain(Frame& F, const bf16* P, bf16* O, const float* lb, const float* gw_) {
    const int sb = F.tid >> 7, e = F.tid & 127;
    LAS float* base = (LAS float*)(F.lds + RING_OFF) + sb * 3328;
    LAS float* Fs = base; LAS float* Qs = base + 1024; LAS float* Os = base + 2048; LAS float* Rs = base + 3072;
    for (int u0 = blockIdx.x * 4; u0 < BATCH * 4; u0 += F.G * 4) {
        const int u = u0 + sb, b = u >> 2, h = u & 3;
        float S[128];
#pragma unroll
        for (int d = 0; d < 128; ++d) S[d] = 0.f;
        const float lbd = lb[h * 128 + e], gwe = gw_[h * 128 + e];
#pragma unroll 1
        for (int t0 = 0; t0 < SEQ; t0 += 8) {
#pragma unroll
            for (int s = 0; s < 8; ++s) { const size_t row = (size_t)b * SEQ + t0 + s; const float xf = bf2f(P[row * EVEN_IN + FB_OFF + h * 128 + e]);
                Fs[s * 128 + e] = lbd + (1.f - lbd) / (1.f + expf(-xf)); Qs[s * 128 + e] = bf2f(P[row * EVEN_IN + QB_OFF + h * 128 + e]); }
            __syncthreads();
#pragma unroll 1
            for (int s = 0; s < 8; ++s) { const size_t row = (size_t)b * SEQ + t0 + s; const float iv = bf2f(P[row * EVEN_IN + IB_OFF + h * 128 + e]); float acc = 0.f;
#pragma unroll
                for (int d = 0; d < 128; ++d) { const float f = Fs[s * 128 + d]; S[d] = f * S[d] + (1.f - f) * iv; acc += Qs[s * 128 + d] * S[d]; }
                const float ss = wave_sum(acc * acc); if (F.lane == 0) Rs[s * 2 + (F.wave & 1)] = ss; Os[s * 128 + e] = acc; }
            __syncthreads();
#pragma unroll
            for (int s = 0; s < 8; ++s) { const size_t row = (size_t)b * SEQ + t0 + s; const float tot = Rs[s * 2] + Rs[s * 2 + 1]; const float r = 1.f / sqrtf(tot * (1.f / 128.f) + EPS);
                const float g = bf2f(P[row * EVEN_IN + GB_OFF + h * 128 + e]); const float val = Os[s * 128 + e] * r * gwe * (g / (1.f + expf(-g)));
                O[row * D + 512 + h * 128 + e] = (bf16)f2bf(val); }
            __syncthreads();
        }
    }
}
constexpr int NPH = 17;
struct Args { const float* in[14]; float* out; unsigned char* ws; int ph_lo, ph_hi; };
__global__ void __launch_bounds__(NWAVES * 64, 2) mk_fwd(Args args) {
    extern __shared__ __attribute__((aligned(16))) unsigned char lds[];
    Frame F;
    F.lds = (LAS unsigned char*)lds;
    F.MISC = (volatile LAS unsigned*)(F.lds + MISC_OFF);
    F.tid = threadIdx.x; F.lane = F.tid & 63; F.wave = __builtin_amdgcn_readfirstlane(F.tid >> 6);
    F.G = gridDim.x;
    unsigned char* ws = args.ws; F.ws = ws;
    F.ctl = (gu32*)(ws + WS_CTL);
    F.x = args.in[0]; F.even_w_in = args.in[1]; F.even_w_out = args.in[2]; F.even_sinks = args.in[3]; F.lb_logits = args.in[4]; F.hgrn_norm_w = args.in[5];
    F.odd_w_in = args.in[6]; F.odd_w_out = args.in[7]; F.odd_rel = args.in[8]; F.w_up = args.in[9]; F.conv_w = args.in[10]; F.conv_b = args.in[11]; F.w_down = args.in[12]; F.norm_w = args.in[13];
    F.out = args.out;
    for (int u = F.tid; u < (LDS_BYTES - LDSCTL_OFF) / 4; u += NWAVES * 64) ((LAS unsigned*)(F.lds + LDSCTL_OFF))[u] = 0u;
    __syncthreads();
    const int lo = args.ph_lo, hi = args.ph_hi;
    XcdBarrier bar; bar.bar = (unsigned*)(F.ctl + CW_BAR); bar.x = 0; bar.st = nullptr;
    if (hi - lo > 1) bar = xcd_barrier_post((unsigned*)(F.ctl + CW_BAR), F.MISC + 8);
#define IN(k) (lo <= (k) && (k) < hi)
#define SEAM(k) do { if (IN(k) && IN((k) + 1)) xcd_barrier(bar); } while (0)
    bf16* const XN = (bf16*)(ws + WS_XN); bf16* const PROJ = (bf16*)(ws + WS_PROJ); bf16* const OB = (bf16*)(ws + WS_O); bf16* const YB = (bf16*)(ws + WS_Y);
    bf16* const UL = (bf16*)(ws + WS_SIDE); bf16* const UF = (bf16*)(ws + WS_SIDE + SIDE_STRIDE); bf16* const VF = (bf16*)(ws + WS_SIDE + 2 * SIDE_STRIDE);
    const float* const tab = (const float*)(ws + WS_TAB); const float* const lbv = (const float*)(ws + WS_LB);

    if (IN(0)) { p_prologue(F); } SEAM(0);
    if (IN(1)) { pg8::Gemm g{XN, (const bf16*)(ws + WS_WIN0), M, EVEN_IN, D}; pg8::StaticOrder S; S.init(M, EVEN_IN, F.G, (int)blockIdx.x);
        pg8::EpiIn E{PROJ, EVEN_IN, 640, 512, C2, tab};
        pg8::gemm_phase<pg8::EpiIn, pg8::StaticOrder, true, true>(F.lds + RING_OFF, g, S, E); } SEAM(1);
    if (IN(2)) { p_attn_plain(F, PROJ, EVEN_IN, PROJ + 512, EVEN_IN, PROJ + 640, EVEN_IN, OB, D, 8, 4, 2, F.even_sinks, nullptr);
        p_hgrn_plain(F, PROJ, OB, lbv, F.hgrn_norm_w); } SEAM(2);
    if (IN(3)) { pg8::Gemm g{OB, (const bf16*)(ws + WS_WOUT0), M, D, D}; pg8::StaticOrder S; S.init(M, D, F.G, (int)blockIdx.x);
        pg8::EpiBf16<0> E{YB, D, nullptr, 0, 0, 1.f};
        pg8::gemm_phase<pg8::EpiBf16<0>, pg8::StaticOrder, true, true>(F.lds + RING_OFF, g, S, E); } SEAM(3);
    if (IN(4)) { p_norm(F, F.x, YB, F.norm_w + 1 * D, F.out, XN); } SEAM(4);
    if (IN(5)) { pg8::Gemm g{XN, (const bf16*)(ws + WS_WUP), M, UPN, D}; pg8::StaticOrder S; S.init(M, UPN, F.G, (int)blockIdx.x);
        pg8::EpiConvGate E{PROJ, UL, UF, VF, F.conv_w, F.conv_b, DFF};
        pg8::gemm_phase<pg8::EpiConvGate, pg8::StaticOrder, true, true>(F.lds + RING_OFF, g, S, E); } SEAM(5);
    if (IN(6)) { p_fixup(F, PROJ, UL, UF, VF, F.conv_w, F.conv_b); } SEAM(6);
    if (IN(7)) { pg8::Gemm g{PROJ, (const bf16*)(ws + WS_WDN), M, D, DFF}; pg8::StaticOrder S; S.init(M, D, F.G, (int)blockIdx.x);
        pg8::EpiBf16<0> E{YB, D, nullptr, 0, 0, 1.f};
        pg8::gemm_phase<pg8::EpiBf16<0>, pg8::StaticOrder, true, true>(F.lds + RING_OFF, g, S, E); } SEAM(7);
    if (IN(8)) { p_norm(F, F.out, YB, F.norm_w + 3 * D, F.out, XN); } SEAM(8);
    if (IN(9)) { pg8::Gemm g{XN, (const bf16*)(ws + WS_WIN1), M, ODD_IN, D}; pg8::StaticOrder S; S.init(M, ODD_IN, F.G, (int)blockIdx.x);
        pg8::EpiIn E{PROJ, ODD_IN, 0, 1024, C2, tab};
        pg8::gemm_phase<pg8::EpiIn, pg8::StaticOrder, true, true>(F.lds + RING_OFF, g, S, E); } SEAM(9);
    if (IN(10)) { p_attn_plain(F, PROJ, ODD_IN, PROJ + 1024, ODD_IN, PROJ + 2048, ODD_IN, OB, D, 16, 1, 8, nullptr, F.odd_rel); } SEAM(10);
    if (IN(11)) { pg8::Gemm g{OB, (const bf16*)(ws + WS_WOUT1), M, D, D}; pg8::StaticOrder S; S.init(M, D, F.G, (int)blockIdx.x);
        pg8::EpiBf16<0> E{YB, D, nullptr, 0, 0, 1.f};
        pg8::gemm_phase<pg8::EpiBf16<0>, pg8::StaticOrder, true, true>(F.lds + RING_OFF, g, S, E); } SEAM(11);
    if (IN(12)) { p_norm(F, F.out, YB, F.norm_w + 5 * D, F.out, XN); } SEAM(12);
    if (IN(13)) { pg8::Gemm g{XN, (const bf16*)(ws + WS_WUP + 11 * MiB), M, UPN, D}; pg8::StaticOrder S; S.init(M, UPN, F.G, (int)blockIdx.x);
        pg8::EpiConvGate E{PROJ, UL, UF, VF, F.conv_w + 3 * DFF, F.conv_b + DFF, DFF};
        pg8::gemm_phase<pg8::EpiConvGate, pg8::StaticOrder, true, true>(F.lds + RING_OFF, g, S, E); } SEAM(13);
    if (IN(14)) { p_fixup(F, PROJ, UL, UF, VF, F.conv_w + 3 * DFF, F.conv_b + DFF); } SEAM(14);
    if (IN(15)) { pg8::Gemm g{PROJ, (const bf16*)(ws + WS_WDN + (size_t)5632 * 1024), M, D, DFF}; pg8::StaticOrder S; S.init(M, D, F.G, (int)blockIdx.x);
        pg8::EpiBf16<0> E{YB, D, nullptr, 0, 0, 1.f};
        pg8::gemm_phase<pg8::EpiBf16<0>, pg8::StaticOrder, true, true>(F.lds + RING_OFF, g, S, E); } SEAM(15);
    if (IN(16)) { p_norm(F, F.out, YB, F.norm_w + 7 * D, F.out, nullptr); }
#undef IN
#undef SEAM
}

#ifndef MK_ONE_LAUNCH
#define MK_ONE_LAUNCH 1
#endif
extern "C" void kernel_launch(void* const* d_in, const int* in_sizes, int n_in, void* d_out, int out_size, void* d_ws, size_t ws_size, hipStream_t stream) {
    static int grid = 0;
    if (grid == 0) {
        if (n_in != 14 || in_sizes[0] != M * D || out_size != M * D || ws_size < WS_END) { fprintf(stderr, "kernel_launch: unexpected shapes (n_in %d, in0 %d, out %d, ws %zu); nothing launched\n", n_in, n_in > 0 ? in_sizes[0] : -1, out_size, ws_size); grid = -1; return; }
        int dev = 0, cus = 0, per_cu = 0;
        if (hipGetDevice(&dev) != hipSuccess || hipDeviceGetAttribute(&cus, hipDeviceAttributeMultiprocessorCount, dev) != hipSuccess) { grid = -1; return; }
        if (hipFuncSetAttribute((const void*)mk_fwd, hipFuncAttributeMaxDynamicSharedMemorySize, LDS_BYTES) != hipSuccess) { fprintf(stderr, "kernel_launch: hipFuncSetAttribute failed\n"); grid = -1; return; }
        if (hipOccupancyMaxActiveBlocksPerMultiprocessor(&per_cu, (const void*)mk_fwd, NWAVES * 64, LDS_BYTES) != hipSuccess || per_cu < 1) { fprintf(stderr, "kernel_launch: occupancy query says %d\n", per_cu); }
        (void)hipGetLastError();
        grid = cus;
    }
    if (grid < 0) return;
    if (hipMemsetAsync((char*)d_ws + WS_CTL, 0, CTL_ZERO_BYTES, stream) != hipSuccess) return;
    Args a{};
    for (int i = 0; i < 14; ++i) a.in[i] = (const float*)d_in[i];
    a.out = (float*)d_out; a.ws = (unsigned char*)d_ws;
#if MK_ONE_LAUNCH
    a.ph_lo = 0; a.ph_hi = NPH;
    hipLaunchKernelGGL(mk_fwd, dim3(grid), dim3(NWAVES * 64), LDS_BYTES, stream, a);
#else
    for (int k = 0; k < NPH; ++k) { a.ph_lo = k; a.ph_hi = k + 1; hipLaunchKernelGGL(mk_fwd, dim3(grid), dim3(NWAVES * 64), LDS_BYTES, stream, a); }
#endif
}
```

```cpp
#include <hip/hip_runtime.h>
#include <cstdio>
#include <cstdint>
#include <cmath>
namespace pg8 {
#define PG8_LAS __attribute__((address_space(3)))
typedef unsigned short bf16_t;
typedef short bf16x8 __attribute__((ext_vector_type(8)));
typedef float f32x4 __attribute__((ext_vector_type(4)));
typedef unsigned u32x4 __attribute__((ext_vector_type(4)));
constexpr int BM = 256, BK = 64, HALF = 128, HTB = HALF * BK * 2  , STAGE_BYTES = 8 * HTB, NXCD = 8, WGM = 8;

__host__ __device__ __forceinline__ int lds_byte(int r, int c) { const int st = (r >> 4) * 2 + (c >> 5), rr = r & 15, cc = c & 31, ob = rr * 64 + cc * 2; return st * 1024 + (ob ^ (((ob >> 9) & 1) << 5)); }
__host__ __device__ __forceinline__ void stage_rc(int b, int& R, int& C) { const int st = b / 1024, sb = b % 1024, swz = sb ^ (((sb >> 9) & 1) << 5); R = (st >> 1) * 16 + swz / 64; C = (st & 1) * 32 + (swz % 64) / 2; }
__host__ __device__ __forceinline__ int perm32(int rho) { const int n = rho >> 4, i = rho & 15; return 8 * (i >> 2) + 4 * n + (i & 3); }

struct Unit { int pm, pn; };
struct Gemm { const bf16_t* A; const bf16_t* Bt; int M, N, K; };

struct StaticOrder {
    int nM, nN, nwg, G, c;
    __host__ __device__ void init(int M, int N, int G_, int c_) { nM = M / BM; nN = N / BM; nwg = nM * nN; G = G_; c = c_; }
    __host__ __device__ bool next(int i, Unit& u) const {
        const long L = (long)i * G + c; if (L >= nwg) return false;
        int wgid = (int)L; { const int q = nwg / NXCD, r = nwg % NXCD, xcd = wgid % NXCD, off = wgid / NXCD; wgid = (xcd < r ? xcd * (q + 1) : r * (q + 1) + (xcd - r) * q) + off; }
        const int nig = WGM * nN, gid = wgid / nig, fm = gid * WGM, gsz = (nM - fm) < WGM ? (nM - fm) : WGM;
        u.pm = fm + ((wgid % nig) % gsz); u.pn = (wgid % nig) / gsz; return true;
    }
    __device__ __forceinline__ void a_ready(const Unit&) const {}
    __device__ __forceinline__ void done(const Unit&) const {}
};

__device__ __forceinline__ unsigned cvt_pk_bf16(float lo, float hi) { unsigned r; asm volatile("v_cvt_pk_bf16_f32 %0, %1, %2" : "=v"(r) : "v"(lo), "v"(hi)); return r; }
typedef float f32x2 __attribute__((ext_vector_type(2)));
__device__ __forceinline__ f32x2 gelu_pk(f32x2 v) {
    const f32x2 av = __builtin_elementwise_abs(v), d = av * 0.2316418882f + 1.0f;
    f32x2 t; t.x = __builtin_amdgcn_rcpf(d.x); t.y = __builtin_amdgcn_rcpf(d.y);
    f32x2 q = t * 0.5307027145f + (-0.7265760135f); q = q * t + 0.7107068705f; q = q * t + (-0.142248368f); q = q * t + 0.127414796f; q = q * t;
    const f32x2 s = (v * v) * (-0.72134752044f);
    f32x2 e; e.x = __builtin_amdgcn_exp2f(s.x); e.y = __builtin_amdgcn_exp2f(s.y);
    const f32x2 m = v * (q * e), r = v - m;
    f32x2 o; o.x = v.x < 0.f ? m.x : r.x; o.y = v.y < 0.f ? m.y : r.y; return o;
}

template <int ACT  > struct EpiBf16 {
    static constexpr bool PERM = true, AFTER_DRAIN = false; static_assert(ACT == 0 || ACT == 1, "EpiBf16: ACT is 0 (none) or 1 (gelu_pk)");
    bf16_t* O; int ldc; const float* bias; int split_cols; size_t split_stride; float scale0;
    __device__ __forceinline__ void operator()(const f32x4 (&acc)[2][2][4][2], const Unit& u, int wr, int wc, int fr, int fq) const {
        const int row0 = u.pm * BM + wr * 64 + fr; int colt = u.pn * BM; bf16_t* base = O;
        float sc = 1.f; if (split_cols) { const int t = colt / split_cols; base += (size_t)t * split_stride; colt -= t * split_cols; if (t == 0) sc = scale0; }
        const int col0 = colt + wc * 32 + 8 * fq, bcol0 = u.pn * BM + wc * 32 + 8 * fq;
        f32x4 bv[2][2];
#pragma unroll
        for (int bj = 0; bj < 2; ++bj)
#pragma unroll
            for (int n = 0; n < 2; ++n) bv[bj][n] = bias ? *(const f32x4*)(bias + bcol0 + bj * HALF + 4 * n) : (f32x4){0.f, 0.f, 0.f, 0.f};
#pragma unroll
        for (int ai = 0; ai < 2; ++ai)
#pragma unroll
            for (int m = 0; m < 4; ++m) { bf16_t* rowp = base + (size_t)(row0 + ai * HALF + m * 16) * ldc + col0;
#pragma unroll
                for (int bj = 0; bj < 2; ++bj) { f32x4 v0 = acc[ai][bj][m][0] + bv[bj][0], v1 = acc[ai][bj][m][1] + bv[bj][1];
                    if (ACT == 1) { f32x2 a = gelu_pk((f32x2){v0[0], v0[1]}), b = gelu_pk((f32x2){v0[2], v0[3]}), c = gelu_pk((f32x2){v1[0], v1[1]}), d = gelu_pk((f32x2){v1[2], v1[3]});
                        v0 = (f32x4){a.x, a.y, b.x, b.y}; v1 = (f32x4){c.x, c.y, d.x, d.y}; }
                    v0 = v0 * sc; v1 = v1 * sc; u32x4 w; w.x = cvt_pk_bf16(v0[0], v0[1]); w.y = cvt_pk_bf16(v0[2], v0[3]); w.z = cvt_pk_bf16(v1[0], v1[1]); w.w = cvt_pk_bf16(v1[2], v1[3]);
                    *(u32x4*)(rowp + bj * HALF) = w; } }
    }
};
struct EpiIn {
    static constexpr bool PERM = true, AFTER_DRAIN = false;
    bf16_t* O; int ldc; int rope_cols; int scale_cols; float scale; const float* tab;
    __device__ __forceinline__ void operator()(const f32x4 (&acc)[2][2][4][2], const Unit& u, int wr, int wc, int fr, int fq) const {
        const int row0 = u.pm * BM + wr * 64 + fr; const int colt = u.pn * BM;
        const int col0 = colt + wc * 32 + 8 * fq; const int i0 = 16 * (wc & 1) + 4 * fq;
#pragma unroll
        for (int ai = 0; ai < 2; ++ai)
#pragma unroll
            for (int m = 0; m < 4; ++m) { const int row = row0 + ai * HALF + m * 16; const int t = row & 2047; bf16_t* rowp = O + (size_t)row * ldc + col0;
#pragma unroll
                for (int bj = 0; bj < 2; ++bj) { f32x4 v0 = acc[ai][bj][m][0], v1 = acc[ai][bj][m][1]; const int cb = colt + bj * HALF;
                    if (cb < rope_cols) { const f32x4 c0 = *(const f32x4*)(tab + (size_t)(t * 32 + i0) * 2), c1 = *(const f32x4*)(tab + (size_t)(t * 32 + i0) * 2 + 4);
                        f32x4 r0, r1;
                        r0[0] = v0[0] * c0[0] - v0[1] * c0[1]; r0[1] = v0[1] * c0[0] + v0[0] * c0[1]; r0[2] = v0[2] * c0[2] - v0[3] * c0[3]; r0[3] = v0[3] * c0[2] + v0[2] * c0[3];
                        r1[0] = v1[0] * c1[0] - v1[1] * c1[1]; r1[1] = v1[1] * c1[0] + v1[0] * c1[1]; r1[2] = v1[2] * c1[2] - v1[3] * c1[3]; r1[3] = v1[3] * c1[2] + v1[2] * c1[3];
                        v0 = r0; v1 = r1; }
                    if (cb < scale_cols) { v0 = v0 * scale; v1 = v1 * scale; }
                    u32x4 w; w.x = cvt_pk_bf16(v0[0], v0[1]); w.y = cvt_pk_bf16(v0[2], v0[3]); w.z = cvt_pk_bf16(v1[0], v1[1]); w.w = cvt_pk_bf16(v1[2], v1[3]);
                    *(u32x4*)(rowp + bj * HALF) = w; } }
    }
};
struct EpiConvGate {
    static constexpr bool PERM = true, AFTER_DRAIN = false;
    bf16_t* H; bf16_t* UL; bf16_t* UF; bf16_t* VF; const float* cw; const float* cb; int ff;
    __device__ __forceinline__ void operator()(const f32x4 (&acc)[2][2][4][2], const Unit& u, int wr, int wc, int fr, int fq) const {
        const int j0 = u.pn * HALF + wc * 32 + 8 * fq; const int lane = (int)(threadIdx.x & 63);
        const int src1 = (lane & ~15) | ((fr + 15) & 15), src2 = (lane & ~15) | ((fr + 14) & 15);
        float k0[8], k1[8], k2[8], kb[8];
#pragma unroll
        for (int q = 0; q < 2; ++q) { const f32x4 a = *(const f32x4*)(cw + j0 + 4 * q), b = *(const f32x4*)(cw + ff + j0 + 4 * q), c = *(const f32x4*)(cw + 2 * ff + j0 + 4 * q), d = *(const f32x4*)(cb + j0 + 4 * q);
#pragma unroll
            for (int e = 0; e < 4; ++e) { k0[4 * q + e] = a[e]; k1[4 * q + e] = b[e]; k2[4 * q + e] = c[e]; kb[4 * q + e] = d[e]; } }
#pragma unroll
        for (int ai = 0; ai < 2; ++ai) {
            float pr1[8], pr2[8];
#pragma unroll
            for (int e = 0; e < 8; ++e) { pr1[e] = 0.f; pr2[e] = 0.f; }
#pragma unroll
            for (int m = 0; m < 4; ++m) { const int row = u.pm * BM + ai * HALF + wr * 64 + m * 16 + fr;
                float uu[8], vv[8], hh[8];
#pragma unroll
                for (int e = 0; e < 4; ++e) { uu[e] = acc[ai][0][m][0][e]; uu[4 + e] = acc[ai][0][m][1][e]; vv[e] = acc[ai][1][m][0][e]; vv[4 + e] = acc[ai][1][m][1][e]; }
#pragma unroll
                for (int e = 0; e < 8; ++e) { const float r1 = __shfl(uu[e], src1), r2 = __shfl(uu[e], src2);
                    const float p1 = fr >= 1 ? r1 : pr1[e], p2 = fr >= 2 ? r2 : pr2[e]; pr1[e] = r1; pr2[e] = r2;
                    hh[e] = kb[e] + k0[e] * p2 + k1[e] * p1 + k2[e] * uu[e]; }
#pragma unroll
                for (int e = 0; e < 8; e += 2) { const f32x2 g = gelu_pk((f32x2){hh[e], hh[e + 1]}); hh[e] = g.x * vv[e]; hh[e + 1] = g.y * vv[e + 1]; }
                u32x4 w; w.x = cvt_pk_bf16(hh[0], hh[1]); w.y = cvt_pk_bf16(hh[2], hh[3]); w.z = cvt_pk_bf16(hh[4], hh[5]); w.w = cvt_pk_bf16(hh[6], hh[7]);
                *(u32x4*)(H + (size_t)row * ff + j0) = w;
                if (m == 3 && fr >= 14) { u32x4 s; s.x = cvt_pk_bf16(uu[0], uu[1]); s.y = cvt_pk_bf16(uu[2], uu[3]); s.z = cvt_pk_bf16(uu[4], uu[5]); s.w = cvt_pk_bf16(uu[6], uu[7]);
                    *(u32x4*)(UL + ((size_t)(row >> 6) * 2 + (fr - 14)) * ff + j0) = s; }
                if (m == 0 && fr < 2) { u32x4 s; s.x = cvt_pk_bf16(uu[0], uu[1]); s.y = cvt_pk_bf16(uu[2], uu[3]); s.z = cvt_pk_bf16(uu[4], uu[5]); s.w = cvt_pk_bf16(uu[6], uu[7]);
                    *(u32x4*)(UF + ((size_t)(row >> 6) * 2 + fr) * ff + j0) = s;
                    u32x4 z; z.x = cvt_pk_bf16(vv[0], vv[1]); z.y = cvt_pk_bf16(vv[2], vv[3]); z.z = cvt_pk_bf16(vv[4], vv[5]); z.w = cvt_pk_bf16(vv[6], vv[7]);
                    *(u32x4*)(VF + ((size_t)(row >> 6) * 2 + fr) * ff + j0) = z; }
            }
        }
    }
};
template <class Epi, class Sched, bool ALIGN_EPI = false, bool SP2 = false>
__device__ __forceinline__ void gemm_phase(PG8_LAS unsigned char* lds, const Gemm g, const Sched& S, const Epi& E) {
    const int tid = threadIdx.x, wid = __builtin_amdgcn_readfirstlane(tid >> 6), lane = tid & 63, wr = wid >> 2, wc = wid & 3, fr = lane & 15, fq = lane >> 4;
    const int K = g.K, nt = K / BK;
    unsigned voffA[2], voffB[2];
#pragma unroll
    for (int i = 0; i < 2; ++i) { int R, C; stage_rc(tid * 16 + i * 8192, R, C); const int Rb = Epi::PERM ? ((R & ~31) + perm32(R & 31)) : R;
        voffA[i] = (unsigned)(R * K + C) * 2u; voffB[i] = (unsigned)(Rb * K + C) * 2u; }
    const size_t kstep = (size_t)(BK * 2);
    const size_t hstep = (size_t)HALF * K * 2;
    const size_t tstep = 2 * hstep;
    const unsigned ldsw = (unsigned)wid * 1024u;
    const int aoff = lds_byte(wr * 64 + fr, fq * 8), boff = lds_byte(wc * 32 + fr, fq * 8);
#define PG8_SA(b, h) (((b) * 2 + (h)) * HTB)
#define PG8_SB(b, h) ((4 + (b) * 2 + (h)) * HTB)
#define PG8_STAGE(bufoff, gbase, voff) do { _Pragma("unroll") for (int _i = 0; _i < 2; ++_i) \
        __builtin_amdgcn_global_load_lds((const unsigned*)((const char*)(gbase) + (voff)[_i]), (PG8_LAS unsigned*)(lds + (bufoff) + ldsw + _i * 8192), 16, 0, 0); } while (0)
#define PG8_LDA(dst, b, h) do { _Pragma("unroll") for (int m = 0; m < 4; ++m) _Pragma("unroll") for (int k = 0; k < 2; ++k) dst[m][k] = *(const PG8_LAS bf16x8*)(lds + PG8_SA(b, h) + aoff + m * 2048 + k * 1024); } while (0)
#define PG8_LDB(dst, b, h) do { _Pragma("unroll") for (int n = 0; n < 2; ++n) _Pragma("unroll") for (int k = 0; k < 2; ++k) dst[n][k] = *(const PG8_LAS bf16x8*)(lds + PG8_SB(b, h) + boff + n * 2048 + k * 1024); } while (0)
#define PG8_MMA(ai, bj, At, Bt) do { __builtin_amdgcn_s_setprio(1); _Pragma("unroll") for (int m = 0; m < 4; ++m) _Pragma("unroll") for (int n = 0; n < 2; ++n) _Pragma("unroll") for (int k = 0; k < 2; ++k) \
        acc[ai][bj][m][n] = __builtin_amdgcn_mfma_f32_16x16x32_bf16(Bt[n][k], At[m][k], acc[ai][bj][m][n], 0, 0, 0); __builtin_amdgcn_s_setprio(0); } while (0)
#define PG8_WAIT_V(n) asm volatile("s_waitcnt vmcnt(" #n ")" ::: "memory")
#define PG8_WAIT_L(n) asm volatile("s_waitcnt lgkmcnt(" #n ")" ::: "memory")
#define PG8_BAR __builtin_amdgcn_s_barrier()
#define PG8_SCHED __builtin_amdgcn_sched_barrier(0)
    Unit cur, nxt; int ui = 0;
    if (!S.next(0, cur)) return;
    f32x4 acc[2][2][4][2];
#pragma unroll
    for (int a = 0; a < 2; ++a)
#pragma unroll
        for (int b = 0; b < 2; ++b)
#pragma unroll
            for (int m = 0; m < 4; ++m)
#pragma unroll
                for (int n = 0; n < 2; ++n) acc[a][b][m][n] = (f32x4){0.f, 0.f, 0.f, 0.f};
    bf16x8 At[4][2], B0[2][2], B1[2][2];
    const char* cA = (const char*)g.A + (size_t)cur.pm * tstep; const char* cB = (const char*)g.Bt + (size_t)cur.pn * tstep;
    S.a_ready(cur);
    if constexpr (SP2) {
        PG8_STAGE(PG8_SB(0, 0), cB, voffB); PG8_STAGE(PG8_SB(0, 1), cB + hstep, voffB); PG8_STAGE(PG8_SA(0, 0), cA, voffA); PG8_STAGE(PG8_SA(0, 1), cA + hstep, voffA);
        if (wr == 1) PG8_BAR;
        PG8_WAIT_V(2); PG8_BAR;
        PG8_STAGE(PG8_SB(1, 0), cB + kstep, voffB); PG8_STAGE(PG8_SA(1, 0), cA + kstep, voffA); PG8_STAGE(PG8_SB(1, 1), cB + hstep + kstep, voffB);
        PG8_WAIT_V(6); PG8_BAR;
    } else {
        PG8_STAGE(PG8_SB(0, 0), cB, voffB); PG8_STAGE(PG8_SA(0, 0), cA, voffA); PG8_STAGE(PG8_SB(0, 1), cB + hstep, voffB); PG8_STAGE(PG8_SA(0, 1), cA + hstep, voffA);
        if (wr == 1) PG8_BAR;
        PG8_WAIT_V(4); PG8_BAR;
        PG8_STAGE(PG8_SB(1, 0), cB + kstep, voffB); PG8_STAGE(PG8_SA(1, 0), cA + kstep, voffA); PG8_STAGE(PG8_SB(1, 1), cB + hstep + kstep, voffB);
        PG8_WAIT_V(6); PG8_BAR;
    }
    for (;;) {
        const bool has_next = S.next(ui + 1, nxt);
        const char* nA = has_next ? (const char*)g.A + (size_t)nxt.pm * tstep : cA; const char* nB = has_next ? (const char*)g.Bt + (size_t)nxt.pn * tstep : cB;
        for (int t = 0; t < nt; t += 2) {
            const bool last = (t == nt - 2);
            const char* a1 = cA + (size_t)(t + 1) * kstep;
            const char* a2 = last ? nA : cA + (size_t)(t + 2) * kstep; const char* b2 = last ? nB : cB + (size_t)(t + 2) * kstep;
            const char* a3 = a2 + kstep; const char* b3 = b2 + kstep;
            if (last && has_next) S.a_ready(nxt);
            if constexpr (SP2) {
            PG8_LDB(B0, 0, 0); PG8_LDB(B1, 0, 1); PG8_SCHED; PG8_LDA(At, 0, 0); PG8_STAGE(PG8_SA(1, 1), a1 + hstep, voffA);
            PG8_WAIT_V(8); PG8_WAIT_L(0); PG8_BAR; PG8_MMA(0, 0, At, B0); PG8_MMA(0, 1, At, B1); PG8_BAR; PG8_SCHED;
            PG8_LDA(At, 0, 1); PG8_STAGE(PG8_SB(0, 0), b2, voffB); PG8_STAGE(PG8_SB(0, 1), b2 + hstep, voffB); PG8_STAGE(PG8_SA(0, 0), a2, voffA);
            PG8_WAIT_V(8); PG8_WAIT_L(0); PG8_BAR; PG8_MMA(1, 0, At, B0); PG8_MMA(1, 1, At, B1); PG8_BAR; PG8_SCHED;
            PG8_LDB(B0, 1, 0); PG8_LDB(B1, 1, 1); PG8_SCHED; PG8_LDA(At, 1, 0); PG8_STAGE(PG8_SA(0, 1), a2 + hstep, voffA);
            PG8_WAIT_V(8); PG8_WAIT_L(0); PG8_BAR; PG8_MMA(0, 0, At, B0); PG8_MMA(0, 1, At, B1); PG8_BAR; PG8_SCHED;
            PG8_LDA(At, 1, 1); PG8_STAGE(PG8_SB(1, 0), b3, voffB); PG8_STAGE(PG8_SB(1, 1), b3 + hstep, voffB); PG8_STAGE(PG8_SA(1, 0), a3, voffA);
            PG8_WAIT_V(8); PG8_WAIT_L(0); PG8_BAR; PG8_MMA(1, 0, At, B0); PG8_MMA(1, 1, At, B1); PG8_BAR; PG8_SCHED;
            } else {
            PG8_LDB(B0, 0, 0); PG8_SCHED; PG8_LDA(At, 0, 0); PG8_STAGE(PG8_SA(1, 1), a1 + hstep, voffA);
            PG8_WAIT_L(8); PG8_BAR; PG8_WAIT_L(0); PG8_MMA(0, 0, At, B0); PG8_BAR; PG8_SCHED;
            PG8_LDB(B1, 0, 1); PG8_STAGE(PG8_SB(0, 0), b2, voffB);
            PG8_BAR; PG8_WAIT_L(0); PG8_MMA(0, 1, At, B1); PG8_BAR;
            PG8_LDA(At, 0, 1); PG8_STAGE(PG8_SA(0, 0), a2, voffA);
            PG8_BAR; PG8_WAIT_L(0); PG8_MMA(1, 0, At, B0); PG8_BAR; PG8_SCHED;
            PG8_STAGE(PG8_SB(0, 1), b2 + hstep, voffB);
            PG8_WAIT_V(6); PG8_BAR; PG8_MMA(1, 1, At, B1); PG8_BAR;
            PG8_LDB(B0, 1, 0); PG8_SCHED; PG8_LDA(At, 1, 0); PG8_STAGE(PG8_SA(0, 1), a2 + hstep, voffA);
            PG8_WAIT_L(8); PG8_BAR; PG8_WAIT_L(0); PG8_MMA(0, 0, At, B0); PG8_BAR; PG8_SCHED;
            PG8_LDB(B1, 1, 1); PG8_STAGE(PG8_SB(1, 0), b3, voffB);
            PG8_BAR; PG8_WAIT_L(0); PG8_MMA(0, 1, At, B1); PG8_BAR;
            PG8_LDA(At, 1, 1); PG8_STAGE(PG8_SA(1, 0), a3, voffA);
            PG8_BAR; PG8_WAIT_L(0); PG8_MMA(1, 0, At, B0); PG8_BAR; PG8_SCHED;
            PG8_STAGE(PG8_SB(1, 1), b3 + hstep, voffB);
            PG8_WAIT_V(6); PG8_BAR; PG8_MMA(1, 1, At, B1); PG8_BAR;
            }
        }
        if constexpr (ALIGN_EPI) { if (wr == 0) PG8_BAR; }
        if constexpr (!Epi::AFTER_DRAIN) { E(acc, cur, wr, wc, fr, fq); S.done(cur); }
        if (!has_next) break;
#pragma unroll
        for (int a = 0; a < 2; ++a)
#pragma unroll
            for (int b = 0; b < 2; ++b)
#pragma unroll
                for (int m = 0; m < 4; ++m)
#pragma unroll
                    for (int n = 0; n < 2; ++n) acc[a][b][m][n] = (f32x4){0.f, 0.f, 0.f, 0.f};
        cur = nxt; cA = nA; cB = nB; ++ui;
        if constexpr (ALIGN_EPI) { if (wr == 1) PG8_BAR; }
    }
    PG8_WAIT_V(0);
    if constexpr (!ALIGN_EPI) { if (wr == 0) PG8_BAR; }
    PG8_BAR;
    if constexpr (Epi::AFTER_DRAIN) { E.fused(acc, cur, wr, wc, fr, fq, lds, wid, lane); S.done(cur); }
#undef PG8_SA
#undef PG8_SB
#undef PG8_STAGE
#undef PG8_LDA
#undef PG8_LDB
#undef PG8_MMA
#undef PG8_WAIT_V
#undef PG8_WAIT_L
#undef PG8_BAR
#undef PG8_SCHED
}
}
constexpr int NWAVES = 8;
constexpr int BATCH = 32, SEQ = 2048, D = 1024, M = BATCH * SEQ;
constexpr int EVEN_IN = 2816, ODD_IN = 3072, DFF = 2816, UPN = 2 * DFF;
constexpr int QB_OFF = 768, FB_OFF = 1280, IB_OFF = 1792, GB_OFF = 2304;
constexpr float EPS = 1e-6f;
constexpr float LOG2E = 1.4426950408889634f;
constexpr float C2 = 0.125f * LOG2E;

constexpr size_t MiB = 1u << 20;
constexpr size_t WS_CTL = 0, CTL_ZERO_BYTES = 64 * 1024;
constexpr size_t WS_TAB = 1 * MiB;
constexpr size_t WS_LB = WS_TAB + 768 * 1024;
constexpr size_t WS_WIN0 = 2 * MiB, WS_WOUT0 = 8 * MiB, WS_WIN1 = 10 * MiB, WS_WOUT1 = 16 * MiB, WS_WUP = 18 * MiB  , WS_WDN = 40 * MiB  ;
constexpr size_t WS_SIDE = 52 * MiB, SIDE_STRIDE = 12 * MiB;
constexpr size_t WS_XN = 96 * MiB;
constexpr size_t WS_PROJ = 224 * MiB;
constexpr size_t WS_O = 608 * MiB;
constexpr size_t WS_Y = 736 * MiB;
constexpr size_t WS_END = 864 * MiB;
constexpr int CW_BAR = 4096;

constexpr int RING_OFF = 0, RING_BYTES = 131072;
constexpr int LDSCTL_OFF = RING_BYTES, MISC_OFF = LDSCTL_OFF + 320;
constexpr int LDS_BYTES = 147456;

namespace attn2 {
using bf16x8 = __attribute__((ext_vector_type(8))) short;
using s16x4 = __attribute__((ext_vector_type(4))) short;
using f32x16 = __attribute__((ext_vector_type(16))) float;
using u32x4 = __attribute__((ext_vector_type(4))) unsigned;
typedef unsigned short bf16;
constexpr int NSLOT = 3, SLOTB = 8192;
constexpr int LDS_K = 0, LDS_V = NSLOT * SLOTB, LDS_WS = 2 * NSLOT * SLOTB, LDS_OST = LDS_WS + 8 * 64 * 4, LDS_TB = LDS_OST + 8 * 4096, LDS_BYTES = LDS_TB + 1088;
constexpr float THR = 8.f;
__device__ __forceinline__ int crow(int r, int hi) { return (r & 3) + 8 * (r >> 2) + 4 * hi; }
__device__ __forceinline__ void glds16(const void* gsrc, unsigned lds_dst) { unsigned keep;
    asm volatile("s_mov_b32 %0, m0\n\ts_mov_b32 m0, %2\n\ts_nop 0\n\tglobal_load_lds_dwordx4 %1, off\n\ts_mov_b32 m0, %0" : "=&s"(keep) : "v"(gsrc), "s"(lds_dst) : "memory"); }
typedef float f32x2_t __attribute__((ext_vector_type(2))); typedef __bf16 bf16x2_t __attribute__((ext_vector_type(2)));
__device__ __forceinline__ unsigned cvtpk_s(float lo, float hi) { f32x2_t v = {lo, hi}; bf16x2_t b = __builtin_convertvector(v, bf16x2_t); return __builtin_bit_cast(unsigned, b); }
__device__ __forceinline__ void qkt(f32x16& p0, f32x16& p1, const char* Kslot, const bf16x8* qr, const f32x16& cin, int r32, int hi) {
    const char* kb = Kslot + hi * 1024 + r32 * 16;
#pragma unroll
    for (int d0 = 0; d0 < 4; ++d0) {
        const bf16x8 b0 = *reinterpret_cast<const bf16x8*>(kb + d0 * 2048);
        const bf16x8 b1 = *reinterpret_cast<const bf16x8*>(kb + d0 * 2048 + 512);
        if (d0 == 0) { p0 = __builtin_amdgcn_mfma_f32_32x32x16_bf16(b0, qr[0], cin, 0, 0, 0); p1 = __builtin_amdgcn_mfma_f32_32x32x16_bf16(b1, qr[0], cin, 0, 0, 0); }
        else { p0 = __builtin_amdgcn_mfma_f32_32x32x16_bf16(b0, qr[d0], p0, 0, 0, 0); p1 = __builtin_amdgcn_mfma_f32_32x32x16_bf16(b1, qr[d0], p1, 0, 0, 0); } }
}
__device__ __forceinline__ void pv(f32x16* o, int vb, bf16x8 pa0, bf16x8 pa1, bf16x8 pa2, bf16x8 pa3) {
#pragma unroll
    for (int d0 = 0; d0 < 2; ++d0) { s16x4 lo[4], hi[4];
#pragma unroll
        for (int ks = 0; ks < 4; ++ks) {
            asm volatile("ds_read_b64_tr_b16 %0,%1 offset:%c2" : "=&v"(lo[ks]) : "v"(vb), "i"(d0 * 4096 + ks * 1024) : "memory");
            asm volatile("ds_read_b64_tr_b16 %0,%1 offset:%c2" : "=&v"(hi[ks]) : "v"(vb), "i"(d0 * 4096 + ks * 1024 + 512) : "memory"); }
        asm volatile("s_waitcnt lgkmcnt(0)" ::: "memory"); __builtin_amdgcn_sched_barrier(0);
#define ATT_PK(k) (bf16x8){lo[k][0], lo[k][1], lo[k][2], lo[k][3], hi[k][0], hi[k][1], hi[k][2], hi[k][3]}
        o[d0] = __builtin_amdgcn_mfma_f32_32x32x16_bf16(pa0, ATT_PK(0), o[d0], 0, 0, 0);
        o[d0] = __builtin_amdgcn_mfma_f32_32x32x16_bf16(pa1, ATT_PK(1), o[d0], 0, 0, 0);
        o[d0] = __builtin_amdgcn_mfma_f32_32x32x16_bf16(pa2, ATT_PK(2), o[d0], 0, 0, 0);
        o[d0] = __builtin_amdgcn_mfma_f32_32x32x16_bf16(pa3, ATT_PK(3), o[d0], 0, 0, 0);
#undef ATT_PK
    }
}
template <int LDQ, int LDKV, int LDO, bool BIAS, bool SINK>
__device__ __forceinline__ void band_unit(const bf16* Qw, const bf16* Kt, const bf16* Vt, bf16* Ow, int jlo, int jhi, int wlo, int whi, int qpos0, float sink2, char* shm) {
    const int tid = threadIdx.x, lane = tid & 63, r32 = lane & 31, hi = lane >> 5; const int wid = __builtin_amdgcn_readfirstlane(tid >> 6);
    const unsigned lds0 = (unsigned)(uintptr_t)shm;
    float* wsf = (float*)(shm + LDS_WS) + wid * 64;
    const float* tb = (const float*)(shm + LDS_TB);
    const bf16* ksrc = Kt + (long)lane * LDKV + wid * 8;
    const bf16* vsrc = Vt + (long)(16 * (wid & 3) + (lane >> 2)) * LDKV + (wid >> 2) * 32 + (lane & 3) * 8;
    const unsigned kdst = lds0 + LDS_K + wid * 1024, vdst = lds0 + LDS_V + wid * 1024;
#define ATT_DMA(t, slot) do { glds16(ksrc + (long)(t) * 64 * LDKV, (unsigned)__builtin_amdgcn_readfirstlane(kdst + (slot))); glds16(vsrc + (long)(t) * 64 * LDKV, (unsigned)__builtin_amdgcn_readfirstlane(vdst + (slot))); } while (0)
    const int vb0 = (int)(lds0 + LDS_V) + ((lane >> 4) & 1) * 32 + (lane & 3) * 8 + (4 * hi + ((lane & 15) >> 2)) * 64;
    bf16x8 qr[4];
#pragma unroll
    for (int d0 = 0; d0 < 4; ++d0) qr[d0] = *reinterpret_cast<const bf16x8*>(&Qw[(long)r32 * LDQ + d0 * 16 + hi * 8]);
    ATT_DMA(jlo, 0);
    if (jlo + 1 <= jhi) ATT_DMA(jlo + 1, SLOTB);
    float mhat = SINK ? sink2 : 0.f, l_reg = (SINK && hi == 0) ? 1.f : 0.f; bool first = !SINK;
    f32x16 o[2]; o[0] = f32x16{}; o[1] = f32x16{};
    f32x16 negm;
#pragma unroll
    for (int r = 0; r < 16; ++r) negm[r] = -mhat;
    int slot = 0;
    for (int j = jlo; j <= jhi; ++j) {
        if (j + 1 <= jhi) asm volatile("s_waitcnt vmcnt(2) lgkmcnt(0)\n\ts_barrier" ::: "memory"); else asm volatile("s_waitcnt vmcnt(0) lgkmcnt(0)\n\ts_barrier" ::: "memory");
        if (j + 2 <= jhi) { const int s2 = slot >= SLOTB ? slot - SLOTB : slot + 2 * SLOTB; ATT_DMA(j + 2, s2); }
        if (j >= wlo && j <= whi) {
            f32x16 p0, p1;
            qkt(p0, p1, shm + LDS_K + slot, qr, negm, r32, hi);
            if (BIAS) {
                const int dq = qpos0 + r32 - 64 * j;
                if ((qpos0 & ~63) - 64 * j >= 192) { const float c = tb[256];
#pragma unroll
                    for (int r = 0; r < 16; ++r) { p0[r] += c; p1[r] += c; } }
                else {
#pragma unroll
                    for (int r = 0; r < 16; ++r) { const int a = dq - crow(r, hi) + 128; const int i0 = a > 256 ? 256 : a, i1 = a - 32 > 256 ? 256 : a - 32; p0[r] += tb[i0]; p1[r] += tb[i1]; } }
            }
            float rm = fmaxf(p0[0], p1[0]);
#pragma unroll
            for (int r = 1; r < 16; ++r) rm = fmaxf(rm, fmaxf(p0[r], p1[r]));
            { auto rr = __builtin_amdgcn_permlane32_swap(__float_as_uint(rm), __float_as_uint(rm), false, false); rm = fmaxf(__uint_as_float(rr[0]), __uint_as_float(rr[1])); }
            bool resc = false;
            if (first) { const float dl = rm; mhat = dl;
#pragma unroll
                for (int r = 0; r < 16; ++r) { p0[r] -= dl; p1[r] -= dl; negm[r] = -mhat; }
                first = false; }
            else if (__any(rm > THR)) { const float dl = fmaxf(rm, 0.f); mhat += dl;
#pragma unroll
                for (int r = 0; r < 16; ++r) { p0[r] -= dl; p1[r] -= dl; negm[r] = -mhat; }
                const float f = __builtin_amdgcn_exp2f(-dl); l_reg *= f; if (hi == 0) wsf[r32] = f; resc = true; }
            float sacc = 0.f;
#pragma unroll
            for (int r = 0; r < 16; ++r) { p0[r] = __builtin_amdgcn_exp2f(p0[r]); p1[r] = __builtin_amdgcn_exp2f(p1[r]); sacc += p0[r] + p1[r]; }
            l_reg += sacc;
            u32x4 pw0, pw1, pw2, pw3;
            pw0 = (u32x4){cvtpk_s(p0[0], p0[1]), cvtpk_s(p0[2], p0[3]), cvtpk_s(p0[4], p0[5]), cvtpk_s(p0[6], p0[7])};
            pw1 = (u32x4){cvtpk_s(p0[8], p0[9]), cvtpk_s(p0[10], p0[11]), cvtpk_s(p0[12], p0[13]), cvtpk_s(p0[14], p0[15])};
            pw2 = (u32x4){cvtpk_s(p1[0], p1[1]), cvtpk_s(p1[2], p1[3]), cvtpk_s(p1[4], p1[5]), cvtpk_s(p1[6], p1[7])};
            pw3 = (u32x4){cvtpk_s(p1[8], p1[9]), cvtpk_s(p1[10], p1[11]), cvtpk_s(p1[12], p1[13]), cvtpk_s(p1[14], p1[15])};
            if (resc) { asm volatile("s_waitcnt lgkmcnt(0)" ::: "memory");
#pragma unroll
                for (int d_ = 0; d_ < 2; ++d_)
#pragma unroll
                    for (int r = 0; r < 16; ++r) o[d_][r] *= wsf[crow(r, hi)]; }
            pv(o, vb0 + slot, __builtin_bit_cast(bf16x8, pw0), __builtin_bit_cast(bf16x8, pw1), __builtin_bit_cast(bf16x8, pw2), __builtin_bit_cast(bf16x8, pw3));
        }
        slot = slot == 2 * SLOTB ? 0 : slot + SLOTB;
    }
    { auto rr = __builtin_amdgcn_permlane32_swap(__float_as_uint(l_reg), __float_as_uint(l_reg), false, false); l_reg = __uint_as_float(rr[0]) + __uint_as_float(rr[1]); }
    if (hi == 0) wsf[32 + r32] = l_reg; asm volatile("s_waitcnt lgkmcnt(0)" ::: "memory");
    float rli[16];
#pragma unroll
    for (int r = 0; r < 16; ++r) rli[r] = __builtin_amdgcn_rcpf(wsf[32 + crow(r, hi)]);
    { bf16* stg = (bf16*)(shm + LDS_OST) + wid * 2048;
#pragma unroll
      for (int r = 0; r < 16; ++r) { const int orow = crow(r, hi);
#pragma unroll
          for (int d0 = 0; d0 < 2; ++d0) { const float v = o[d0][r] * rli[r]; const unsigned u = __builtin_bit_cast(unsigned, v); stg[orow * 64 + d0 * 32 + r32] = (bf16)((u + 0x7fffu + ((u >> 16) & 1u)) >> 16); } }
      asm volatile("s_waitcnt lgkmcnt(0)" ::: "memory");
#pragma unroll
      for (int i = 0; i < 4; ++i) { const int row = i * 8 + (lane >> 3), ch = lane & 7; const u32x4 v = *(const u32x4*)(stg + row * 64 + ch * 8); *(u32x4*)(Ow + (long)row * LDO + ch * 8) = v; } }
    asm volatile("s_waitcnt lgkmcnt(0)\n\ts_barrier" ::: "memory");
#undef ATT_DMA
}
}
namespace hgrn2 {
using bf16x8 = __attribute__((ext_vector_type(8))) short;
using s16x4 = __attribute__((ext_vector_type(4))) short;
using f32x16 = __attribute__((ext_vector_type(16))) float;
using f32x4 = __attribute__((ext_vector_type(4))) float;
using u32x4 = __attribute__((ext_vector_type(4))) unsigned;
using u32x2 = __attribute__((ext_vector_type(2))) unsigned;
typedef unsigned short bf16;
#define HG_LAS __attribute__((address_space(3)))
constexpr int QS = 136, KS = 40, OS = 33;
constexpr int RAWF = 0, RAWQ = 8192, RAWV = 16384, OT = 0  , QD = 24576, KD = QD + 32 * QS * 2, KET = KD + 32 * QS * 2, VT = KET + 128 * KS * 2,
              DEC = VT + 128 * KS * 2, SSP = DEC + 512, GRP_BYTES = SSP + 512;
static_assert(4 * 32 * OS * 4 <= 24576 && 2 * GRP_BYTES <= 131072, "hgrn LDS map");
__device__ __forceinline__ int crow(int r, int hi) { return (r & 3) + 8 * (r >> 2) + 4 * hi; }
typedef float f32x2_t __attribute__((ext_vector_type(2))); typedef __bf16 bf16x2_t __attribute__((ext_vector_type(2)));
__device__ __forceinline__ unsigned cvtpk(float lo, float hi) { f32x2_t v = {lo, hi}; bf16x2_t b = __builtin_convertvector(v, bf16x2_t); return __builtin_bit_cast(unsigned, b); }
__device__ __forceinline__ float bf2f(unsigned short b) { return __builtin_bit_cast(float, (unsigned)b << 16); }
__device__ __forceinline__ bf16x8 packacc(const f32x16& x, int s) {
    u32x4 p; p[0] = cvtpk(x[8 * s], x[8 * s + 1]); p[1] = cvtpk(x[8 * s + 2], x[8 * s + 3]); p[2] = cvtpk(x[8 * s + 4], x[8 * s + 5]); p[3] = cvtpk(x[8 * s + 6], x[8 * s + 7]);
    return __builtin_bit_cast(bf16x8, p); }
__device__ __forceinline__ bf16x8 ldperm(const HG_LAS bf16* rowp, int k0, int hi) {
    const u32x2 a = *(const HG_LAS u32x2*)(rowp + k0 + 4 * hi), b = *(const HG_LAS u32x2*)(rowp + k0 + 8 + 4 * hi);
    u32x4 p; p[0] = a[0]; p[1] = a[1]; p[2] = b[0]; p[3] = b[1]; return __builtin_bit_cast(bf16x8, p); }
#define HG_MFMA(a, b, c) __builtin_amdgcn_mfma_f32_32x32x16_bf16((a), (b), (c), 0, 0, 0)

template <int LDP, int QOFF, int FOFF, int IOFF, int GOFF, int LDO, int OOFF, int SEQ_>
__device__ __forceinline__ void hgrn_pair(const bf16* P, bf16* O, const float* lb, const float* gw, int b, int h, HG_LAS unsigned char* g_lds, float eps) {
    const int tid = threadIdx.x, tid4 = tid & 255, lane = tid & 63, r32 = lane & 31, hi = lane >> 5; const int w4 = __builtin_amdgcn_readfirstlane((tid >> 6) & 3);
    HG_LAS bf16* rawf = (HG_LAS bf16*)(g_lds + RAWF); HG_LAS bf16* rawq = (HG_LAS bf16*)(g_lds + RAWQ); HG_LAS bf16* rawv = (HG_LAS bf16*)(g_lds + RAWV);
    HG_LAS bf16* qd = (HG_LAS bf16*)(g_lds + QD); HG_LAS bf16* kd = (HG_LAS bf16*)(g_lds + KD); HG_LAS bf16* ket = (HG_LAS bf16*)(g_lds + KET); HG_LAS bf16* vt = (HG_LAS bf16*)(g_lds + VT);
    HG_LAS float* dec = (HG_LAS float*)(g_lds + DEC); HG_LAS float* ssp = (HG_LAS float*)(g_lds + SSP); HG_LAS float* ot = (HG_LAS float*)(g_lds + OT) + w4 * 32 * OS;
    const int lrow = tid4 >> 3, lcol = 16 * (tid4 & 7);
    const int pd = tid4 >> 1, half = tid4 & 1;
    const float lbd = lb[h * 128 + pd];
    const int fl_ = lane & 31, eh = lane >> 5, ecol = 32 * w4 + 16 * eh;
    float gwv[16];
#pragma unroll
    for (int k = 0; k < 16; ++k) gwv[k] = gw[h * 128 + ecol + k];
    f32x16 S[4];
#pragma unroll
    for (int k = 0; k < 4; ++k) S[k] = f32x16{};
    const size_t seq0 = (size_t)b * SEQ_;
#pragma unroll 1
    for (int n = 0; n < SEQ_ / 32; ++n) {
        const size_t row0 = seq0 + (size_t)n * 32;
        { const bf16* src = P + (row0 + lrow) * LDP + h * 128 + lcol;
          const u32x4 f0 = *(const u32x4*)(src + FOFF), f1 = *(const u32x4*)(src + FOFF + 8), q0 = *(const u32x4*)(src + QOFF), q1 = *(const u32x4*)(src + QOFF + 8), v0 = *(const u32x4*)(src + IOFF), v1 = *(const u32x4*)(src + IOFF + 8);
          *(HG_LAS u32x4*)(rawf + lrow * 128 + lcol) = f0; *(HG_LAS u32x4*)(rawf + lrow * 128 + lcol + 8) = f1;
          *(HG_LAS u32x4*)(rawq + lrow * 128 + lcol) = q0; *(HG_LAS u32x4*)(rawq + lrow * 128 + lcol + 8) = q1;
          *(HG_LAS u32x4*)(rawv + lrow * 128 + lcol) = v0; *(HG_LAS u32x4*)(rawv + lrow * 128 + lcol + 8) = v1; }
        const bf16* gsrc = P + (row0 + fl_) * LDP + GOFF + h * 128 + ecol;
        const u32x4 g0 = *(const u32x4*)(gsrc), g1 = *(const u32x4*)(gsrc + 8);
        __syncthreads();
        { float fv[16], pv_[16]; float run = 1.f;
#pragma unroll
          for (int i = 0; i < 16; ++i) { const float x = bf2f(rawf[(16 * half + i) * 128 + pd]); const float f = lbd + (1.f - lbd) * __builtin_amdgcn_rcpf(1.f + __expf(-x)); run *= f; fv[i] = f; pv_[i] = run; }
          const float other = __shfl_xor(run, 1);
          const float pre = half ? other : 1.f, dtot = run * other;
          unsigned kew[8], vw[8];
#pragma unroll
          for (int i = 0; i < 16; i += 2) {
              const int l0 = 16 * half + i;
              const float p0 = pv_[i] * pre, p1 = pv_[i + 1] * pre;
              const float qa = bf2f(rawq[l0 * 128 + pd]) * p0, qb = bf2f(rawq[(l0 + 1) * 128 + pd]) * p1;
              const float ka = (1.f - fv[i]) * __builtin_amdgcn_rcpf(p0), kb = (1.f - fv[i + 1]) * __builtin_amdgcn_rcpf(p1);
              qd[l0 * QS + pd] = (bf16)(cvtpk(qa, qa) & 0xffffu); qd[(l0 + 1) * QS + pd] = (bf16)(cvtpk(qb, qb) & 0xffffu);
              kd[l0 * QS + pd] = (bf16)(cvtpk(ka, ka) & 0xffffu); kd[(l0 + 1) * QS + pd] = (bf16)(cvtpk(kb, kb) & 0xffffu);
              kew[i >> 1] = cvtpk(ka * dtot, kb * dtot);
              vw[i >> 1] = (unsigned)rawv[l0 * 128 + pd] | ((unsigned)rawv[(l0 + 1) * 128 + pd] << 16); }
          *(HG_LAS u32x4*)(ket + pd * KS + 16 * half) = (u32x4){kew[0], kew[1], kew[2], kew[3]}; *(HG_LAS u32x4*)(ket + pd * KS + 16 * half + 8) = (u32x4){kew[4], kew[5], kew[6], kew[7]};
          *(HG_LAS u32x4*)(vt + pd * KS + 16 * half) = (u32x4){vw[0], vw[1], vw[2], vw[3]}; *(HG_LAS u32x4*)(vt + pd * KS + 16 * half + 8) = (u32x4){vw[4], vw[5], vw[6], vw[7]};
          if (half == 0) dec[pd] = dtot; }
        __syncthreads();
        float ov[16];
        { f32x16 X = f32x16{};
#pragma unroll
          for (int s = 0; s < 8; ++s) { const bf16x8 a = *(const HG_LAS bf16x8*)(kd + r32 * QS + 16 * s + 8 * hi), bq = *(const HG_LAS bf16x8*)(qd + r32 * QS + 16 * s + 8 * hi); X = HG_MFMA(a, bq, X); }
#pragma unroll
          for (int r = 0; r < 16; ++r) X[r] = crow(r, hi) <= r32 ? X[r] : 0.f;
          const bf16x8 vf0 = ldperm(vt + (32 * w4 + r32) * KS, 0, hi), vf1 = ldperm(vt + (32 * w4 + r32) * KS, 16, hi);
          f32x16 Oa = f32x16{};
          Oa = HG_MFMA(packacc(X, 0), vf0, Oa); Oa = HG_MFMA(packacc(X, 1), vf1, Oa);
#pragma unroll
          for (int blk = 0; blk < 4; ++blk)
#pragma unroll
              for (int s = 0; s < 2; ++s) Oa = HG_MFMA(ldperm(qd + r32 * QS, 32 * blk + 16 * s, hi), packacc(S[blk], s), Oa);
#pragma unroll
          for (int blk = 0; blk < 4; ++blk) {
#pragma unroll
              for (int q4 = 0; q4 < 4; ++q4) { const f32x4 dv = *(const HG_LAS f32x4*)(dec + 32 * blk + 8 * q4 + 4 * hi);
#pragma unroll
                  for (int e = 0; e < 4; ++e) S[blk][4 * q4 + e] *= dv[e]; }
              S[blk] = HG_MFMA(ldperm(ket + (32 * blk + r32) * KS, 0, hi), vf0, S[blk]);
              S[blk] = HG_MFMA(ldperm(ket + (32 * blk + r32) * KS, 16, hi), vf1, S[blk]); }
#pragma unroll
          for (int r = 0; r < 16; ++r) ot[crow(r, hi) * OS + r32] = Oa[r];
          asm volatile("s_waitcnt lgkmcnt(0)" ::: "memory");
          float ss = 0.f;
#pragma unroll
          for (int k = 0; k < 16; ++k) { ov[k] = ot[fl_ * OS + 16 * eh + k]; ss += ov[k] * ov[k]; }
          ss += __shfl_xor(ss, 32);
          if (lane < 32) ssp[w4 * 32 + fl_] = ss; }
        __syncthreads();
        { const float tot = (ssp[fl_] + ssp[32 + fl_]) + (ssp[64 + fl_] + ssp[96 + fl_]); const float rstd = 1.f / sqrtf(tot * (1.f / 128.f) + eps);
          unsigned ow[8];
#pragma unroll
          for (int k = 0; k < 16; k += 2) { const unsigned gwd = k < 8 ? g0[k >> 1] : g1[(k - 8) >> 1];
              const float ga = bf2f((unsigned short)(gwd & 0xffffu)), gb = bf2f((unsigned short)(gwd >> 16));
              const float ra = ov[k] * rstd * gwv[k] * (ga / (1.f + __expf(-ga))), rb = ov[k + 1] * rstd * gwv[k + 1] * (gb / (1.f + __expf(-gb)));
              ow[k >> 1] = cvtpk(ra, rb); }
          bf16* dst = O + (row0 + fl_) * LDO + OOFF + h * 128 + ecol;
          *(u32x4*)(dst) = (u32x4){ow[0], ow[1], ow[2], ow[3]}; *(u32x4*)(dst + 8) = (u32x4){ow[4], ow[5], ow[6], ow[7]}; }
    }
    __syncthreads();
}
#undef HG_MFMA
}
#define GAS __attribute__((address_space(1)))
#define LAS __attribute__((address_space(3)))
typedef unsigned short bf16;
typedef unsigned v4u __attribute__((ext_vector_type(4)));
typedef float f32x4 __attribute__((ext_vector_type(4)));
typedef short bf16x8 __attribute__((ext_vector_type(8)));
typedef GAS unsigned gu32;
typedef GAS unsigned long long gu64;
#define RLX_AGENT __ATOMIC_RELAXED, __HIP_MEMORY_SCOPE_AGENT
#define LDS_WAIT() asm volatile("s_waitcnt lgkmcnt(0)" ::: "memory")
#define VM_WAIT() asm volatile("s_waitcnt vmcnt(0)" ::: "memory")
__device__ __forceinline__ unsigned long long rt() { return __builtin_amdgcn_s_memrealtime(); }
__device__ __forceinline__ unsigned f2bf(float f) { unsigned u = __builtin_bit_cast(unsigned, f); return (u + 0x7fffu + ((u >> 16) & 1u)) >> 16; }
__device__ __forceinline__ unsigned pk2(float lo, float hi) { return f2bf(lo) | (f2bf(hi) << 16); }

#define XB_TMO      128
#define XB_XCNT(j)  (256  + 64 * (j))
#define XB_XSUB(j)  (1280 + 64 * (j))
#define XB_XGEN(j)  (2304 + 64 * (j))
#define XB_TOP      3328
#define XB_TOPGEN   3392
#define XCD_BAR_WORDS 3456
#define XB_SPIN_CAP (1u << 18)

__device__ __forceinline__ unsigned xb_ld(unsigned* p)              { return __hip_atomic_load(p, __ATOMIC_RELAXED, __HIP_MEMORY_SCOPE_AGENT); }
__device__ __forceinline__ unsigned xb_add(unsigned* p, unsigned v) { return __hip_atomic_fetch_add(p, v, __ATOMIC_RELAXED, __HIP_MEMORY_SCOPE_AGENT); }
__device__ __forceinline__ unsigned xb_xcc_id() { return (unsigned)__builtin_amdgcn_s_getreg((3 << 11) | 20) & 0xFu; }
#define XB_SPIN(cond, bar) do { unsigned _sp = 0; while (cond) { __builtin_amdgcn_s_sleep(1); \
    if ((++_sp & 255u) == 0u) { if (xb_ld(&(bar)[XB_TMO])) break; if (_sp > XB_SPIN_CAP) { atomicAdd(&(bar)[XB_TMO], 1u); break; } } } } while (0)

struct XcdBarrier {
    unsigned* bar; unsigned x;
    volatile LAS unsigned* st;
};

__device__ __forceinline__ XcdBarrier xcd_barrier_post(unsigned* bar, volatile LAS unsigned* st) {
    XcdBarrier b; b.bar = bar; b.x = xb_xcc_id(); b.st = st;
    if (threadIdx.x == 0) (void)xb_add(&bar[XB_XCNT(b.x)], 1u);
    return b;
}
__device__ __forceinline__ void xcd_barrier_complete(unsigned* bar, unsigned x, unsigned& nloc, unsigned& nx) {
    const unsigned G = gridDim.x * gridDim.y * gridDim.z;
    unsigned sum, cnt, mine, sp = 0u;
    for (;;) {
        sum = 0u; cnt = 0u; mine = 0u;
#pragma unroll
        for (unsigned j = 0; j < 16; ++j) { const unsigned c = xb_ld(&bar[XB_XCNT(j)]); sum += c; cnt += (c > 0u) ? 1u : 0u; mine = (j == x) ? c : mine; }
        if (sum == G) break;
        __builtin_amdgcn_s_sleep(1);
        if ((++sp & 255u) == 0u) { if (xb_ld(&bar[XB_TMO])) break; if (sp > XB_SPIN_CAP) { atomicAdd(&bar[XB_TMO], 1u); break; } }
    }
    nloc = mine > 0u ? mine : 1u; nx = cnt > 0u ? cnt : 1u;
}

__device__ __forceinline__ void xcd_barrier(const XcdBarrier& b) {
    asm volatile("s_waitcnt vmcnt(0)" ::: "memory");
    __syncthreads();
    if (threadIdx.x == 0) {
        unsigned* bar = b.bar;
        __builtin_amdgcn_s_waitcnt(0);
        unsigned nloc = b.st[0], nx = b.st[1];
        if (nloc == 0u) { xcd_barrier_complete(bar, b.x, nloc, nx); b.st[0] = nloc; b.st[1] = nx; }
        const unsigned old = xb_add(&bar[XB_XSUB(b.x)], 1u);
        const unsigned gen = old / nloc;
        if (old + 1u == (gen + 1u) * nloc) {
            __builtin_amdgcn_fence(__ATOMIC_RELEASE, "agent");
            asm volatile("s_waitcnt vmcnt(0)" ::: "memory");
            const unsigned og = xb_add(&bar[XB_TOP], 1u);
            const unsigned tg = og / nx;
            if (og + 1u == (tg + 1u) * nx) xb_add(&bar[XB_TOPGEN], 1u);
            else XB_SPIN(xb_ld(&bar[XB_TOPGEN]) == tg, bar);
            __builtin_amdgcn_fence(__ATOMIC_ACQUIRE, "agent");
            xb_add(&bar[XB_XGEN(b.x)], 1u);
            asm volatile("s_waitcnt vmcnt(0)" ::: "memory");
        } else {
            XB_SPIN(xb_ld(&bar[XB_XGEN(b.x)]) == gen, bar);
            __builtin_amdgcn_fence(__ATOMIC_ACQUIRE, "agent");
            asm volatile("s_waitcnt vmcnt(0)" ::: "memory");
        }
    }
    __syncthreads();
}
struct Frame {
    LAS unsigned char* lds; char* ldsg;
    volatile LAS unsigned* MISC;
    gu32* ctl;
    int tid, lane, wave, G;
    unsigned char* ws;
    const float *x, *even_w_in, *even_w_out, *even_sinks, *lb_logits, *hgrn_norm_w, *odd_w_in, *odd_w_out, *odd_rel, *w_up, *conv_w, *conv_b, *w_down, *norm_w;
    float* out;
};
__device__ __forceinline__ float bf2f(bf16 b) { return __builtin_bit_cast(float, (unsigned)b << 16); }
__device__ __forceinline__ float wave_sum(float v) {
#pragma unroll
    for (int o = 1; o < 64; o <<= 1) v += __shfl_xor(v, o);
    return v;
}
__device__ __forceinline__ int colmap(int cmode, int n) {
    if (cmode == 1) { if (n >= 640) return n; const int p = n & 63; return (n - p) + (p >> 1) + 32 * (p & 1); }
    if (cmode == 2) { const int pn = n >> 8, r = n & 255; return r < 128 ? pn * 128 + r : DFF + pn * 128 + (r - 128); }
    return n;
}
__device__ __forceinline__ void transpose_item(const float* W, int K, int Nsrc, int Nout, bf16* WT, const float* kscale, int cmode, LAS float* scr, int item, int lane) {
    const int nblk = Nout / 32, kb = item / nblk, nb = item % nblk, k0 = 64 * kb, n0 = 32 * nb;
    const int nsrc = colmap(cmode, n0 + (lane & 31));
#pragma unroll 8
    for (int i = 0; i < 32; ++i) { const int kk = 2 * i + (lane >> 5); float w = W[(size_t)(k0 + kk) * Nsrc + nsrc]; if (kscale) w *= kscale[k0 + kk]; scr[kk * 33 + (lane & 31)] = w; }
    LDS_WAIT(); asm volatile("" ::: "memory");
    const int c = lane & 7;
#pragma unroll
    for (int j = 0; j < 4; ++j) { const int n = (lane >> 3) + 8 * j; const LAS float* s = scr + (8 * c) * 33 + n;
        v4u o; o.x = pk2(s[0 * 33], s[1 * 33]); o.y = pk2(s[2 * 33], s[3 * 33]); o.z = pk2(s[4 * 33], s[5 * 33]); o.w = pk2(s[6 * 33], s[7 * 33]);
        *(GAS v4u*)(WT + (size_t)(n0 + n) * K + k0 + 8 * c) = o; }
    LDS_WAIT(); asm volatile("" ::: "memory");
}
__device__ __forceinline__ void rms_row_to_bf16(int lane, const float* xrow, bf16* orow) {
    const GAS f32x4* xr = (const GAS f32x4*)xrow + lane;
    f32x4 v[4]; float s = 0.f;
#pragma unroll
    for (int j = 0; j < 4; ++j) { v[j] = xr[64 * j]; s += (v[j].x * v[j].x + v[j].y * v[j].y) + (v[j].z * v[j].z + v[j].w * v[j].w); }
    const float rstd = 1.f / sqrtf(wave_sum(s) * (1.f / D) + EPS);
    GAS unsigned long long* o8 = (GAS unsigned long long*)orow + lane;
#pragma unroll
    for (int j = 0; j < 4; ++j) o8[64 * j] = (unsigned long long)pk2(v[j].x * rstd, v[j].y * rstd) | ((unsigned long long)pk2(v[j].z * rstd, v[j].w * rstd) << 32);
}
__device__ __forceinline__ void p_prologue(Frame& F) {
    LAS float* scr = (LAS float*)(F.lds + RING_OFF + F.wave * 16384);
    const int gw = blockIdx.x * NWAVES + F.wave, NGW = F.G * NWAVES;
#pragma unroll 1
    for (int mat = 0; mat < 8; ++mat) {
        const float* W; int K, Nsrc, Nout, cmode = 0; const float* ks = nullptr; size_t dst;
        if (mat == 0)      { W = F.even_w_in;  K = D; Nsrc = EVEN_IN; Nout = EVEN_IN; cmode = 1; ks = F.norm_w + 0 * D; dst = WS_WIN0; }
        else if (mat == 1) { W = F.even_w_out; K = D; Nsrc = D; Nout = D; dst = WS_WOUT0; }
        else if (mat == 2) { W = F.odd_w_in;   K = D; Nsrc = ODD_IN; Nout = ODD_IN; ks = F.norm_w + 4 * D; dst = WS_WIN1; }
        else if (mat == 3) { W = F.odd_w_out;  K = D; Nsrc = D; Nout = D; dst = WS_WOUT1; }
        else if (mat < 6)  { const int l = mat - 4; W = F.w_up + (size_t)l * D * UPN; K = D; Nsrc = UPN; Nout = UPN; cmode = 2; ks = F.norm_w + (size_t)(l * 4 + 2) * D; dst = WS_WUP + (size_t)l * 11 * MiB; }
        else               { const int l = mat - 6; W = F.w_down + (size_t)l * DFF * D; K = DFF; Nsrc = D; Nout = D; dst = WS_WDN + (size_t)l * 5632 * 1024; }
        const int nitems = (K / 64) * (Nout / 32);
        for (int it = gw; it < nitems; it += NGW) transpose_item(W, K, Nsrc, Nout, (bf16*)(F.ws + dst), ks, cmode, scr, it, F.lane);
    }
    { float* tab = (float*)(F.ws + WS_TAB); const int gt = blockIdx.x * (NWAVES * 64) + F.tid, NT = F.G * NWAVES * 64;
      for (int e = gt; e < SEQ * 32; e += NT) { const int t = e >> 5, i = e & 31; const float inv = powf(10000.f, -(float)(2 * i) / 64.f); const float ang = (float)t * inv;
          tab[2 * e] = (float)cos((double)ang); tab[2 * e + 1] = (float)sin((double)ang); }
      float* lb = (float*)(F.ws + WS_LB);
      for (int e = gt; e < 512; e += NT) { const float a = F.lb_logits[e], b = F.lb_logits[512 + e]; const float mx = fmaxf(a, b); const float ea = expf(a - mx), eb = expf(b - mx); lb[e] = ea / (ea + eb); } }
    for (int m = gw; m < M; m += NGW) rms_row_to_bf16(F.lane, F.x + (size_t)m * D, (bf16*)(F.ws + WS_XN) + (size_t)m * D);
}
__device__ __forceinline__ void p_norm(Frame& F, const float* hin, const bf16* Y, const float* g, float* hout, bf16* xn) {
    const int gw = blockIdx.x * NWAVES + F.wave, NGW = F.G * NWAVES;
    f32x4 gv[4];
#pragma unroll
    for (int j = 0; j < 4; ++j) gv[j] = ((const GAS f32x4*)g)[F.lane + 64 * j];
    for (int m = gw; m < M; m += NGW) {
        const GAS f32x4* hr = (const GAS f32x4*)(hin + (size_t)m * D) + F.lane;
        const GAS unsigned long long* yr = (const GAS unsigned long long*)(Y + (size_t)m * D) + F.lane;
        f32x4 h[4], y[4]; float s = 0.f;
#pragma unroll
        for (int j = 0; j < 4; ++j) { h[j] = hr[64 * j]; const unsigned long long w = yr[64 * j];
            y[j].x = __builtin_bit_cast(float, (unsigned)(w & 0xffffu) << 16); y[j].y = __builtin_bit_cast(float, (unsigned)(w >> 16 & 0xffffu) << 16);
            y[j].z = __builtin_bit_cast(float, (unsigned)(w >> 32 & 0xffffu) << 16); y[j].w = __builtin_bit_cast(float, (unsigned)(w >> 48 & 0xffffu) << 16);
            s += (y[j].x * y[j].x + y[j].y * y[j].y) + (y[j].z * y[j].z + y[j].w * y[j].w); }
        const float r1 = 1.f / sqrtf(wave_sum(s) * (1.f / D) + EPS); float s2 = 0.f;
#pragma unroll
        for (int j = 0; j < 4; ++j) { h[j] = h[j] + y[j] * r1 * gv[j]; s2 += (h[j].x * h[j].x + h[j].y * h[j].y) + (h[j].z * h[j].z + h[j].w * h[j].w); }
        GAS f32x4* ho = (GAS f32x4*)(hout + (size_t)m * D) + F.lane;
#pragma unroll
        for (int j = 0; j < 4; ++j) ho[64 * j] = h[j];
        if (xn) { const float r2 = 1.f / sqrtf(wave_sum(s2) * (1.f / D) + EPS);
            GAS unsigned long long* o8 = (GAS unsigned long long*)(xn + (size_t)m * D) + F.lane;
#pragma unroll
            for (int j = 0; j < 4; ++j) o8[64 * j] = (unsigned long long)pk2(h[j].x * r2, h[j].y * r2) | ((unsigned long long)pk2(h[j].z * r2, h[j].w * r2) << 32); }
    }
}
__device__ __forceinline__ void p_fixup(Frame& F, bf16* H, const bf16* UL, const bf16* UF, const bf16* VF, const float* cw, const float* cb) {
    const int gt = blockIdx.x * (NWAVES * 64) + F.tid, NT = F.G * NWAVES * 64;
    constexpr int CH = DFF / 8, NIT = (M / 64) * 2 * CH;
    for (int it = gt; it < NIT; it += NT) {
        const int ch = it % CH, gr = it / CH, r = gr & 1, g = gr >> 1, j0 = ch * 8;
        const bool has_prev = (g & 31) != 0;
        const v4u z4 = {0u, 0u, 0u, 0u};
        const v4u u0 = *(const GAS v4u*)(UF + ((size_t)g * 2 + r) * DFF + j0);
        const v4u vv = *(const GAS v4u*)(VF + ((size_t)g * 2 + r) * DFF + j0);
        const v4u pl1 = has_prev ? *(const GAS v4u*)(UL + ((size_t)(g - 1) * 2 + 1) * DFF + j0) : z4;
        const v4u pl0 = has_prev ? *(const GAS v4u*)(UL + ((size_t)(g - 1) * 2 + 0) * DFF + j0) : z4;
        const v4u uf0 = *(const GAS v4u*)(UF + ((size_t)g * 2 + 0) * DFF + j0);
        const v4u um1 = r ? uf0 : pl1, um2 = r ? pl1 : pl0;
        float hh[8];
#pragma unroll
        for (int e = 0; e < 8; ++e) { const int sh = (e & 1) * 16; const unsigned wa = u0[e >> 1], wb = um1[e >> 1], wc_ = um2[e >> 1], wv = vv[e >> 1];
            const float a = bf2f((bf16)(wa >> sh)), b = bf2f((bf16)(wb >> sh)), c = bf2f((bf16)(wc_ >> sh)), v = bf2f((bf16)(wv >> sh));
            const float pre = cb[j0 + e] + cw[j0 + e] * c + cw[DFF + j0 + e] * b + cw[2 * DFF + j0 + e] * a;
            const pg8::f32x2 gg = pg8::gelu_pk((pg8::f32x2){pre, pre}); hh[e] = gg.x * v; }
        v4u o; o.x = pk2(hh[0], hh[1]); o.y = pk2(hh[2], hh[3]); o.z = pk2(hh[4], hh[5]); o.w = pk2(hh[6], hh[7]);
        *(GAS v4u*)(H + ((size_t)g * 64 + r) * DFF + j0) = o;
    }
}
__device__ __forceinline__ void p_attn_plain(Frame& F, const bf16* Q, int ldq, const bf16* Kp, int ldk, const bf16* Vp, int ldv, bf16* O, int ldo, int HQ, int GQ, int nprev, const float* sinks, const float* rel) {
    const int gt = blockIdx.x * (NWAVES * 64) + F.tid, NT = F.G * NWAVES * 64;
    const long total = (long)M * HQ;
    for (long idx = gt; idx < total; idx += NT) {
        const int hq = (int)(idx / M), row = (int)(idx % M), hk = hq / GQ;
        const int b = row / SEQ, t = row % SEQ, c = t >> 6, c0 = c - nprev < 0 ? 0 : c - nprev;
        float q[64], o[64];
        { const GAS v4u* qp = (const GAS v4u*)(Q + (size_t)row * ldq + hq * 64);
#pragma unroll
          for (int i = 0; i < 8; ++i) { const v4u w = qp[i];
#pragma unroll
              for (int e = 0; e < 4; ++e) { const unsigned ww = w[e]; q[8 * i + 2 * e] = bf2f((bf16)(ww & 0xffffu)); q[8 * i + 2 * e + 1] = bf2f((bf16)(ww >> 16)); } } }
#pragma unroll
        for (int d = 0; d < 64; ++d) o[d] = 0.f;
        float mrun = sinks ? sinks[hq] * LOG2E : -INFINITY, l = sinks ? 1.f : 0.f;
        const float* relh = rel ? rel + hq * 257 : nullptr;
        for (int kp = c0 * 64; kp < c * 64 + 64; ++kp) {
            const size_t krow = (size_t)b * SEQ + kp;
            const GAS v4u* kk = (const GAS v4u*)(Kp + krow * ldk + hk * 64);
            float s = 0.f;
#pragma unroll
            for (int i = 0; i < 8; ++i) { const v4u w = kk[i];
#pragma unroll
                for (int e = 0; e < 4; ++e) { const unsigned ww = w[e]; s += q[8 * i + 2 * e] * bf2f((bf16)(ww & 0xffffu)); s += q[8 * i + 2 * e + 1] * bf2f((bf16)(ww >> 16)); } }
            if (relh) { int r = t - kp; r = r < -128 ? -128 : (r > 128 ? 128 : r); s += relh[r + 128] * LOG2E; }
            const float mn = fmaxf(mrun, s), sc = exp2f(mrun - mn), p = exp2f(s - mn);
            l = l * sc + p; mrun = mn;
            const GAS v4u* vp = (const GAS v4u*)(Vp + krow * ldv + hk * 64);
#pragma unroll
            for (int i = 0; i < 8; ++i) { const v4u w = vp[i];
#pragma unroll
                for (int e = 0; e < 4; ++e) { const unsigned ww = w[e]; o[8 * i + 2 * e] = o[8 * i + 2 * e] * sc + p * bf2f((bf16)(ww & 0xffffu)); o[8 * i + 2 * e + 1] = o[8 * i + 2 * e + 1] * sc + p * bf2f((bf16)(ww >> 16)); } }
        }
        const float il = 1.f / l;
        GAS v4u* op = (GAS v4u*)(O + (size_t)row * ldo + hq * 64);
#pragma unroll
        for (int i = 0; i < 8; ++i) { v4u w; w.x = pk2(o[8 * i] * il, o[8 * i + 1] * il); w.y = pk2(o[8 * i + 2] * il, o[8 * i + 3] * il); w.z = pk2(o[8 * i + 4] * il, o[8 * i + 5] * il); w.w = pk2(o[8 * i + 6] * il, o[8 * i + 7] * il); op[i] = w; }
    }
}
__device__ __forceinline__ void p_hgrn_plain(Frame& F, const bf16* P, bf16* O, const float* lb, const float* gw_) {
    const int sb = F.tid >> 7, e = F.tid & 127;
    LAS float* base = (LAS float*)(F.lds + RING_OFF) + sb * 3328;
    LAS float* Fs = base; LAS float* Qs = base + 1024; LAS float* Os = base + 2048; LAS float* Rs = base + 3072;
    for (int u0 = blockIdx.x * 4; u0 < BATCH * 4; u0 += F.G * 4) {
        const int u = u0 + sb, b = u >> 2, h = u & 3;
        float S[128];
#pragma unroll
        for (int d = 0; d < 128; ++d) S[d] = 0.f;
        const float lbd = lb[h * 128 + e], gwe = gw_[h * 128 + e];
#pragma unroll 1
        for (int t0 = 0; t0 < SEQ; t0 += 8) {
#pragma unroll
            for (int s = 0; s < 8; ++s) { const size_t row = (size_t)b * SEQ + t0 + s; const float xf = bf2f(P[row * EVEN_IN + FB_OFF + h * 128 + e]);
                Fs[s * 128 + e] = lbd + (1.f - lbd) / (1.f + expf(-xf)); Qs[s * 128 + e] = bf2f(P[row * EVEN_IN + QB_OFF + h * 128 + e]); }
            __syncthreads();
#pragma unroll 1
            for (int s = 0; s < 8; ++s) { const size_t row = (size_t)b * SEQ + t0 + s; const float iv = bf2f(P[row * EVEN_IN + IB_OFF + h * 128 + e]); float acc = 0.f;
#pragma unroll
                for (int d = 0; d < 128; ++d) { const float f = Fs[s * 128 + d]; S[d] = f * S[d] + (1.f - f) * iv; acc += Qs[s * 128 + d] * S[d]; }
                const float ss = wave_sum(acc * acc); if (F.lane == 0) Rs[s * 2 + (F.wave & 1)] = ss; Os[s * 128 + e] = acc; }
            __syncthreads();
#pragma unroll
            for (int s = 0; s < 8; ++s) { const size_t row = (size_t)b * SEQ + t0 + s; const float tot = Rs[s * 2] + Rs[s * 2 + 1]; const float r = 1.f / sqrtf(tot * (1.f / 128.f) + EPS);
                const float g = bf2f(P[row * EVEN_IN + GB_OFF + h * 128 + e]); const float val = Os[s * 128 + e] * r * gwe * (g / (1.f + expf(-g)));
                O[row * D + 512 + h * 128 + e] = (bf16)f2bf(val); }
            __syncthreads();
        }
    }
}

__device__ __forceinline__ void p_attn1(Frame& F, const bf16* PROJ, bf16* OB) {
    LAS float* tbw = (LAS float*)(F.lds + RING_OFF + attn2::LDS_TB);
    for (int pair = blockIdx.x; pair < BATCH * 16; pair += F.G) {
        const int b = pair >> 4, h = pair & 15;
        if (F.tid < 257) tbw[F.tid] = F.odd_rel[h * 257 + F.tid] * LOG2E;
#pragma unroll 1
        for (int g4 = 0; g4 < 8; ++g4) {
            const int c0 = 4 * g4, jlo = c0 - 8 < 0 ? 0 : c0 - 8, jhi = c0 + 3, cw = c0 + (F.wave >> 1), wlo = cw - 8 < 0 ? 0 : cw - 8, qpos0 = 64 * cw + 32 * (F.wave & 1);
            const size_t row0 = (size_t)b * SEQ + qpos0, seq0 = (size_t)b * SEQ;
            attn2::band_unit<ODD_IN, ODD_IN, D, true, false>(PROJ + row0 * ODD_IN + h * 64, PROJ + seq0 * ODD_IN + 1024 + h * 64, PROJ + seq0 * ODD_IN + 2048 + h * 64,
                                                             OB + row0 * D + h * 64, jlo, jhi, wlo, cw, qpos0, 0.f, F.ldsg + RING_OFF);
        }
    }
}
__device__ __forceinline__ void p_attn0(Frame& F, const bf16* PROJ, bf16* OB, int first, int stride) {
#pragma unroll 1
    for (int u = first; u < BATCH * 2 * 32; u += stride) {
        const int c = u & 31, hk = (u >> 5) & 1, b = u >> 6, qh = 4 * hk + (F.wave >> 1), qpos0 = 64 * c + 32 * (F.wave & 1), jlo = c - 2 < 0 ? 0 : c - 2;
        const size_t row0 = (size_t)b * SEQ + qpos0, seq0 = (size_t)b * SEQ;
        attn2::band_unit<EVEN_IN, EVEN_IN, D, false, true>(PROJ + row0 * EVEN_IN + qh * 64, PROJ + seq0 * EVEN_IN + 512 + hk * 64, PROJ + seq0 * EVEN_IN + 640 + hk * 64,
                                                           OB + row0 * D + qh * 64, jlo, c, jlo, c, qpos0, F.even_sinks[qh] * LOG2E, F.ldsg + RING_OFF);
    }
}

__device__ __forceinline__ void p_hgrn(Frame& F, const bf16* PROJ, bf16* OB, const float* lb, int nhw) {
    const int grp = F.wave >> 2;
#pragma unroll 1
    for (int pp = blockIdx.x; pp < BATCH * 2; pp += nhw) { const int pair = 2 * pp + grp;
        hgrn2::hgrn_pair<EVEN_IN, QB_OFF, FB_OFF, IB_OFF, GB_OFF, D, 512, SEQ>(PROJ, OB, lb, F.hgrn_norm_w, pair >> 2, pair & 3, F.lds + RING_OFF + grp * hgrn2::GRP_BYTES, EPS); }
}
constexpr int NPH = 17;
struct Args { const float* in[14]; float* out; unsigned char* ws; int ph_lo, ph_hi; };
__global__ void __launch_bounds__(NWAVES * 64, 2) mk_fwd(Args args) {
    extern __shared__ __attribute__((aligned(16))) unsigned char lds[];
    Frame F;
    F.lds = (LAS unsigned char*)lds; F.ldsg = (char*)lds;
    F.MISC = (volatile LAS unsigned*)(F.lds + MISC_OFF);
    F.tid = threadIdx.x; F.lane = F.tid & 63; F.wave = __builtin_amdgcn_readfirstlane(F.tid >> 6);
    F.G = gridDim.x;
    unsigned char* ws = args.ws; F.ws = ws;
    F.ctl = (gu32*)(ws + WS_CTL);
    F.x = args.in[0]; F.even_w_in = args.in[1]; F.even_w_out = args.in[2]; F.even_sinks = args.in[3]; F.lb_logits = args.in[4]; F.hgrn_norm_w = args.in[5];
    F.odd_w_in = args.in[6]; F.odd_w_out = args.in[7]; F.odd_rel = args.in[8]; F.w_up = args.in[9]; F.conv_w = args.in[10]; F.conv_b = args.in[11]; F.w_down = args.in[12]; F.norm_w = args.in[13];
    F.out = args.out;
    for (int u = F.tid; u < (LDS_BYTES - LDSCTL_OFF) / 4; u += NWAVES * 64) ((LAS unsigned*)(F.lds + LDSCTL_OFF))[u] = 0u;
    __syncthreads();
    const int lo = args.ph_lo, hi = args.ph_hi;
    XcdBarrier bar; bar.bar = (unsigned*)(F.ctl + CW_BAR); bar.x = 0; bar.st = nullptr;
    if (hi - lo > 1) bar = xcd_barrier_post((unsigned*)(F.ctl + CW_BAR), F.MISC + 8);
#define IN(k) (lo <= (k) && (k) < hi)
#define SEAM(k) do { if (IN(k) && IN((k) + 1)) xcd_barrier(bar); } while (0)
    bf16* const XN = (bf16*)(ws + WS_XN); bf16* const PROJ = (bf16*)(ws + WS_PROJ); bf16* const OB = (bf16*)(ws + WS_O); bf16* const YB = (bf16*)(ws + WS_Y);
    bf16* const UL = (bf16*)(ws + WS_SIDE); bf16* const UF = (bf16*)(ws + WS_SIDE + SIDE_STRIDE); bf16* const VF = (bf16*)(ws + WS_SIDE + 2 * SIDE_STRIDE);
    const float* const tab = (const float*)(ws + WS_TAB); const float* const lbv = (const float*)(ws + WS_LB);

    if (IN(0)) { p_prologue(F); } SEAM(0);
    if (IN(1)) { pg8::Gemm g{XN, (const bf16*)(ws + WS_WIN0), M, EVEN_IN, D}; pg8::StaticOrder S; S.init(M, EVEN_IN, F.G, (int)blockIdx.x);
        pg8::EpiIn E{PROJ, EVEN_IN, 640, 512, C2, tab};
        pg8::gemm_phase<pg8::EpiIn, pg8::StaticOrder, true, true>(F.lds + RING_OFF, g, S, E); } SEAM(1);
    if (IN(2)) { const int nhw = F.G >= 128 ? 64 : 0;
        if (nhw == 0) { p_attn0(F, PROJ, OB, (int)blockIdx.x, F.G); __syncthreads(); p_hgrn(F, PROJ, OB, lbv, F.G < 64 ? F.G : 64); }
        else if ((int)blockIdx.x < nhw) p_hgrn(F, PROJ, OB, lbv, nhw);
        else p_attn0(F, PROJ, OB, (int)blockIdx.x - nhw, F.G - nhw); } SEAM(2);
    if (IN(3)) { pg8::Gemm g{OB, (const bf16*)(ws + WS_WOUT0), M, D, D}; pg8::StaticOrder S; S.init(M, D, F.G, (int)blockIdx.x);
        pg8::EpiBf16<0> E{YB, D, nullptr, 0, 0, 1.f};
        pg8::gemm_phase<pg8::EpiBf16<0>, pg8::StaticOrder, true, true>(F.lds + RING_OFF, g, S, E); } SEAM(3);
    if (IN(4)) { p_norm(F, F.x, YB, F.norm_w + 1 * D, F.out, XN); } SEAM(4);
    if (IN(5)) { pg8::Gemm g{XN, (const bf16*)(ws + WS_WUP), M, UPN, D}; pg8::StaticOrder S; S.init(M, UPN, F.G, (int)blockIdx.x);
        pg8::EpiConvGate E{PROJ, UL, UF, VF, F.conv_w, F.conv_b, DFF};
        pg8::gemm_phase<pg8::EpiConvGate, pg8::StaticOrder, true, true>(F.lds + RING_OFF, g, S, E); } SEAM(5);
    if (IN(6)) { p_fixup(F, PROJ, UL, UF, VF, F.conv_w, F.conv_b); } SEAM(6);
    if (IN(7)) { pg8::Gemm g{PROJ, (const bf16*)(ws + WS_WDN), M, D, DFF}; pg8::StaticOrder S; S.init(M, D, F.G, (int)blockIdx.x);
        pg8::EpiBf16<0> E{YB, D, nullptr, 0, 0, 1.f};
        pg8::gemm_phase<pg8::EpiBf16<0>, pg8::StaticOrder, true, true>(F.lds + RING_OFF, g, S, E); } SEAM(7);
    if (IN(8)) { p_norm(F, F.out, YB, F.norm_w + 3 * D, F.out, XN); } SEAM(8);
    if (IN(9)) { pg8::Gemm g{XN, (const bf16*)(ws + WS_WIN1), M, ODD_IN, D}; pg8::StaticOrder S; S.init(M, ODD_IN, F.G, (int)blockIdx.x);
        pg8::EpiIn E{PROJ, ODD_IN, 0, 1024, C2, tab};
        pg8::gemm_phase<pg8::EpiIn, pg8::StaticOrder, true, true>(F.lds + RING_OFF, g, S, E); } SEAM(9);
    if (IN(10)) { p_attn1(F, PROJ, OB); } SEAM(10);
    if (IN(11)) { pg8::Gemm g{OB, (const bf16*)(ws + WS_WOUT1), M, D, D}; pg8::StaticOrder S; S.init(M, D, F.G, (int)blockIdx.x);
        pg8::EpiBf16<0> E{YB, D, nullptr, 0, 0, 1.f};
        pg8::gemm_phase<pg8::EpiBf16<0>, pg8::StaticOrder, true, true>(F.lds + RING_OFF, g, S, E); } SEAM(11);
    if (IN(12)) { p_norm(F, F.out, YB, F.norm_w + 5 * D, F.out, XN); } SEAM(12);
    if (IN(13)) { pg8::Gemm g{XN, (const bf16*)(ws + WS_WUP + 11 * MiB), M, UPN, D}; pg8::StaticOrder S; S.init(M, UPN, F.G, (int)blockIdx.x);
        pg8::EpiConvGate E{PROJ, UL, UF, VF, F.conv_w + 3 * DFF, F.conv_b + DFF, DFF};
        pg8::gemm_phase<pg8::EpiConvGate, pg8::StaticOrder, true, true>(F.lds + RING_OFF, g, S, E); } SEAM(13);
    if (IN(14)) { p_fixup(F, PROJ, UL, UF, VF, F.conv_w + 3 * DFF, F.conv_b + DFF); } SEAM(14);
    if (IN(15)) { pg8::Gemm g{PROJ, (const bf16*)(ws + WS_WDN + (size_t)5632 * 1024), M, D, DFF}; pg8::StaticOrder S; S.init(M, D, F.G, (int)blockIdx.x);
        pg8::EpiBf16<0> E{YB, D, nullptr, 0, 0, 1.f};
        pg8::gemm_phase<pg8::EpiBf16<0>, pg8::StaticOrder, true, true>(F.lds + RING_OFF, g, S, E); } SEAM(15);
    if (IN(16)) { p_norm(F, F.out, YB, F.norm_w + 7 * D, F.out, nullptr); }
#undef IN
#undef SEAM
}

#ifndef MK_ONE_LAUNCH
#define MK_ONE_LAUNCH 1
#endif
extern "C" void kernel_launch(void* const* d_in, const int* in_sizes, int n_in, void* d_out, int out_size, void* d_ws, size_t ws_size, hipStream_t stream) {
    static int grid = 0;
    if (grid == 0) {
        if (n_in != 14 || in_sizes[0] != M * D || out_size != M * D || ws_size < WS_END) { fprintf(stderr, "kernel_launch: unexpected shapes (n_in %d, in0 %d, out %d, ws %zu); nothing launched\n", n_in, n_in > 0 ? in_sizes[0] : -1, out_size, ws_size); grid = -1; return; }
        int dev = 0, cus = 0, per_cu = 0;
        if (hipGetDevice(&dev) != hipSuccess || hipDeviceGetAttribute(&cus, hipDeviceAttributeMultiprocessorCount, dev) != hipSuccess) { grid = -1; return; }
        if (hipFuncSetAttribute((const void*)mk_fwd, hipFuncAttributeMaxDynamicSharedMemorySize, LDS_BYTES) != hipSuccess) { fprintf(stderr, "kernel_launch: hipFuncSetAttribute failed\n"); grid = -1; return; }
        if (hipOccupancyMaxActiveBlocksPerMultiprocessor(&per_cu, (const void*)mk_fwd, NWAVES * 64, LDS_BYTES) != hipSuccess || per_cu < 1) { fprintf(stderr, "kernel_launch: occupancy query says %d\n", per_cu); }
        (void)hipGetLastError();
        grid = cus;
    }
    if (grid < 0) return;
    if (hipMemsetAsync((char*)d_ws + WS_CTL, 0, CTL_ZERO_BYTES, stream) != hipSuccess) return;
    Args a{};
    for (int i = 0; i < 14; ++i) a.in[i] = (const float*)d_in[i];
    a.out = (float*)d_out; a.ws = (unsigned char*)d_ws;
#if MK_ONE_LAUNCH
    a.ph_lo = 0; a.ph_hi = NPH;
    hipLaunchKernelGGL(mk_fwd, dim3(grid), dim3(NWAVES * 64), LDS_BYTES, stream, a);
#else
    for (int k = 0; k < NPH; ++k) { a.ph_lo = k; a.ph_hi = k + 1; hipLaunchKernelGGL(mk_fwd, dim3(grid), dim3(NWAVES * 64), LDS_BYTES, stream, a); }
#endif
}
```

```cpp
#include <hip/hip_runtime.h>
#include <cstdio>
#include <cstdint>
#include <cmath>
namespace pg8 {
#define PG8_LAS __attribute__((address_space(3)))
typedef unsigned short bf16_t;
typedef short bf16x8 __attribute__((ext_vector_type(8)));
typedef float f32x4 __attribute__((ext_vector_type(4)));
typedef unsigned u32x4 __attribute__((ext_vector_type(4)));
constexpr int BM = 256, BK = 64, HALF = 128, HTB = HALF * BK * 2  , STAGE_BYTES = 8 * HTB, NXCD = 8, WGM = 8;

__host__ __device__ __forceinline__ int lds_byte(int r, int c) { const int st = (r >> 4) * 2 + (c >> 5), rr = r & 15, cc = c & 31, ob = rr * 64 + cc * 2; return st * 1024 + (ob ^ (((ob >> 9) & 1) << 5)); }
__host__ __device__ __forceinline__ void stage_rc(int b, int& R, int& C) { const int st = b / 1024, sb = b % 1024, swz = sb ^ (((sb >> 9) & 1) << 5); R = (st >> 1) * 16 + swz / 64; C = (st & 1) * 32 + (swz % 64) / 2; }
__host__ __device__ __forceinline__ int perm32(int rho) { const int n = rho >> 4, i = rho & 15; return 8 * (i >> 2) + 4 * n + (i & 3); }

struct Unit { int pm, pn; };
struct Gemm { const bf16_t* A; const bf16_t* Bt; int M, N, K; };

struct StaticOrder {
    int nM, nN, nwg, G, c;
    __host__ __device__ void init(int M, int N, int G_, int c_) { nM = M / BM; nN = N / BM; nwg = nM * nN; G = G_; c = c_; }
    __host__ __device__ bool next(int i, Unit& u) const {
        const long L = (long)i * G + c; if (L >= nwg) return false;
        int wgid = (int)L; { const int q = nwg / NXCD, r = nwg % NXCD, xcd = wgid % NXCD, off = wgid / NXCD; wgid = (xcd < r ? xcd * (q + 1) : r * (q + 1) + (xcd - r) * q) + off; }
        const int nig = WGM * nN, gid = wgid / nig, fm = gid * WGM, gsz = (nM - fm) < WGM ? (nM - fm) : WGM;
        u.pm = fm + ((wgid % nig) % gsz); u.pn = (wgid % nig) / gsz; return true;
    }
    __device__ __forceinline__ void a_ready(const Unit&) const {}
    __device__ __forceinline__ void done(const Unit&) const {}
};

__device__ __forceinline__ unsigned cvt_pk_bf16(float lo, float hi) { unsigned r; asm volatile("v_cvt_pk_bf16_f32 %0, %1, %2" : "=v"(r) : "v"(lo), "v"(hi)); return r; }
typedef float f32x2 __attribute__((ext_vector_type(2)));
__device__ __forceinline__ f32x2 gelu_pk(f32x2 v) {
    const f32x2 av = __builtin_elementwise_abs(v), d = av * 0.2316418882f + 1.0f;
    f32x2 t; t.x = __builtin_amdgcn_rcpf(d.x); t.y = __builtin_amdgcn_rcpf(d.y);
    f32x2 q = t * 0.5307027145f + (-0.7265760135f); q = q * t + 0.7107068705f; q = q * t + (-0.142248368f); q = q * t + 0.127414796f; q = q * t;
    const f32x2 s = (v * v) * (-0.72134752044f);
    f32x2 e; e.x = __builtin_amdgcn_exp2f(s.x); e.y = __builtin_amdgcn_exp2f(s.y);
    const f32x2 m = v * (q * e), r = v - m;
    f32x2 o; o.x = v.x < 0.f ? m.x : r.x; o.y = v.y < 0.f ? m.y : r.y; return o;
}

template <int ACT  > struct EpiBf16 {
    static constexpr bool PERM = true, AFTER_DRAIN = false; static_assert(ACT == 0 || ACT == 1, "EpiBf16: ACT is 0 (none) or 1 (gelu_pk)");
    bf16_t* O; int ldc; const float* bias; int split_cols; size_t split_stride; float scale0;
    __device__ __forceinline__ void operator()(const f32x4 (&acc)[2][2][4][2], const Unit& u, int wr, int wc, int fr, int fq) const {
        const int row0 = u.pm * BM + wr * 64 + fr; int colt = u.pn * BM; bf16_t* base = O;
        float sc = 1.f; if (split_cols) { const int t = colt / split_cols; base += (size_t)t * split_stride; colt -= t * split_cols; if (t == 0) sc = scale0; }
        const int col0 = colt + wc * 32 + 8 * fq, bcol0 = u.pn * BM + wc * 32 + 8 * fq;
        f32x4 bv[2][2];
#pragma unroll
        for (int bj = 0; bj < 2; ++bj)
#pragma unroll
            for (int n = 0; n < 2; ++n) bv[bj][n] = bias ? *(const f32x4*)(bias + bcol0 + bj * HALF + 4 * n) : (f32x4){0.f, 0.f, 0.f, 0.f};
#pragma unroll
        for (int ai = 0; ai < 2; ++ai)
#pragma unroll
            for (int m = 0; m < 4; ++m) { bf16_t* rowp = base + (size_t)(row0 + ai * HALF + m * 16) * ldc + col0;
#pragma unroll
                for (int bj = 0; bj < 2; ++bj) { f32x4 v0 = acc[ai][bj][m][0] + bv[bj][0], v1 = acc[ai][bj][m][1] + bv[bj][1];
                    if (ACT == 1) { f32x2 a = gelu_pk((f32x2){v0[0], v0[1]}), b = gelu_pk((f32x2){v0[2], v0[3]}), c = gelu_pk((f32x2){v1[0], v1[1]}), d = gelu_pk((f32x2){v1[2], v1[3]});
                        v0 = (f32x4){a.x, a.y, b.x, b.y}; v1 = (f32x4){c.x, c.y, d.x, d.y}; }
                    v0 = v0 * sc; v1 = v1 * sc; u32x4 w; w.x = cvt_pk_bf16(v0[0], v0[1]); w.y = cvt_pk_bf16(v0[2], v0[3]); w.z = cvt_pk_bf16(v1[0], v1[1]); w.w = cvt_pk_bf16(v1[2], v1[3]);
                    *(u32x4*)(rowp + bj * HALF) = w; } }
    }
};
template <int LDC, int ROPE_COLS, int SCALE_COLS, int GATE_LO, int GATE_HI, int SILU_LO, int SILU_HI> struct EpiIn {
    static constexpr bool PERM = true, AFTER_DRAIN = false;
    static constexpr int ldc = LDC, rope_cols = ROPE_COLS, scale_cols = SCALE_COLS, gate_lo = GATE_LO, gate_hi = GATE_HI;
    bf16_t* O; float scale; const float* tab; const float* lb;
    __device__ __forceinline__ void operator()(const f32x4 (&acc)[2][2][4][2], const Unit& u, int wr, int wc, int fr, int fq) const {
        const int row0 = u.pm * BM + wr * 64 + fr; const int colt = u.pn * BM;
        const int col0 = colt + wc * 32 + 8 * fq; const int i0 = 16 * (wc & 1) + 4 * fq;
#pragma unroll
        for (int ai = 0; ai < 2; ++ai)
#pragma unroll
            for (int m = 0; m < 4; ++m) { const int row = row0 + ai * HALF + m * 16; const int t = row & 2047; bf16_t* rowp = O + (size_t)row * ldc + col0;
#pragma unroll
                for (int bj = 0; bj < 2; ++bj) { f32x4 v0 = acc[ai][bj][m][0], v1 = acc[ai][bj][m][1]; const int cb = colt + bj * HALF;
                    if (cb < rope_cols) { const f32x4 c0 = *(const f32x4*)(tab + (size_t)(t * 32 + i0) * 2), c1 = *(const f32x4*)(tab + (size_t)(t * 32 + i0) * 2 + 4);
                        f32x4 r0, r1;
                        r0[0] = v0[0] * c0[0] - v0[1] * c0[1]; r0[1] = v0[1] * c0[0] + v0[0] * c0[1]; r0[2] = v0[2] * c0[2] - v0[3] * c0[3]; r0[3] = v0[3] * c0[2] + v0[2] * c0[3];
                        r1[0] = v1[0] * c1[0] - v1[1] * c1[1]; r1[1] = v1[1] * c1[0] + v1[0] * c1[1]; r1[2] = v1[2] * c1[2] - v1[3] * c1[3]; r1[3] = v1[3] * c1[2] + v1[2] * c1[3];
                        v0 = r0; v1 = r1; }
                    if (cb < scale_cols) { v0 = v0 * scale; v1 = v1 * scale; }
                    if (cb >= SILU_LO && cb < SILU_HI) {
#pragma unroll
                        for (int e_ = 0; e_ < 4; ++e_) { v0[e_] = v0[e_] * __builtin_amdgcn_rcpf(1.f + __expf(-v0[e_])); v1[e_] = v1[e_] * __builtin_amdgcn_rcpf(1.f + __expf(-v1[e_])); } }
                    if (cb >= gate_lo && cb < gate_hi) { const f32x4 l0 = *(const f32x4*)(lb + (col0 + bj * HALF - gate_lo)), l1 = *(const f32x4*)(lb + (col0 + bj * HALF - gate_lo) + 4);
                        f32x4 fa, fb;
#pragma unroll
                        for (int e_ = 0; e_ < 4; ++e_) { fa[e_] = __builtin_fminf((l0[e_] + (1.f - l0[e_]) * __builtin_amdgcn_rcpf(1.f + __expf(-v0[e_]))) * 65536.f + 0.5f, 65535.f);
                            fb[e_] = __builtin_fminf((l1[e_] + (1.f - l1[e_]) * __builtin_amdgcn_rcpf(1.f + __expf(-v1[e_]))) * 65536.f + 0.5f, 65535.f); }
                        u32x4 wq; wq.x = (unsigned)fa[0] | ((unsigned)fa[1] << 16); wq.y = (unsigned)fa[2] | ((unsigned)fa[3] << 16); wq.z = (unsigned)fb[0] | ((unsigned)fb[1] << 16); wq.w = (unsigned)fb[2] | ((unsigned)fb[3] << 16);
                        *(u32x4*)(rowp + bj * HALF) = wq; }
                    else {
                    u32x4 w; w.x = cvt_pk_bf16(v0[0], v0[1]); w.y = cvt_pk_bf16(v0[2], v0[3]); w.z = cvt_pk_bf16(v1[0], v1[1]); w.w = cvt_pk_bf16(v1[2], v1[3]);
                    *(u32x4*)(rowp + bj * HALF) = w; } } }
    }
};
struct EpiConvGate {
    static constexpr bool PERM = true, AFTER_DRAIN = false;
    bf16_t* H; bf16_t* UL; bf16_t* UF; bf16_t* VF; const float* cw; const float* cb; int ff;
    __device__ __forceinline__ void operator()(const f32x4 (&acc)[2][2][4][2], const Unit& u, int wr, int wc, int fr, int fq) const {
        const int j0 = u.pn * HALF + wc * 32 + 8 * fq; const int lane = (int)(threadIdx.x & 63);
        const int src1 = (lane & ~15) | ((fr + 15) & 15), src2 = (lane & ~15) | ((fr + 14) & 15);
        float k0[8], k1[8], k2[8], kb[8];
#pragma unroll
        for (int q = 0; q < 2; ++q) { const f32x4 a = *(const f32x4*)(cw + j0 + 4 * q), b = *(const f32x4*)(cw + ff + j0 + 4 * q), c = *(const f32x4*)(cw + 2 * ff + j0 + 4 * q), d = *(const f32x4*)(cb + j0 + 4 * q);
#pragma unroll
            for (int e = 0; e < 4; ++e) { k0[4 * q + e] = a[e]; k1[4 * q + e] = b[e]; k2[4 * q + e] = c[e]; kb[4 * q + e] = d[e]; } }
#pragma unroll
        for (int ai = 0; ai < 2; ++ai) {
            float pr1[8], pr2[8];
#pragma unroll
            for (int e = 0; e < 8; ++e) { pr1[e] = 0.f; pr2[e] = 0.f; }
#pragma unroll
            for (int m = 0; m < 4; ++m) { const int row = u.pm * BM + ai * HALF + wr * 64 + m * 16 + fr;
                float uu[8], vv[8], hh[8];
#pragma unroll
                for (int e = 0; e < 4; ++e) { uu[e] = acc[ai][0][m][0][e]; uu[4 + e] = acc[ai][0][m][1][e]; vv[e] = acc[ai][1][m][0][e]; vv[4 + e] = acc[ai][1][m][1][e]; }
#pragma unroll
                for (int e = 0; e < 8; ++e) { const float r1 = __shfl(uu[e], src1), r2 = __shfl(uu[e], src2);
                    const float p1 = fr >= 1 ? r1 : pr1[e], p2 = fr >= 2 ? r2 : pr2[e]; pr1[e] = r1; pr2[e] = r2;
                    hh[e] = kb[e] + k0[e] * p2 + k1[e] * p1 + k2[e] * uu[e]; }
#pragma unroll
                for (int e = 0; e < 8; e += 2) { const f32x2 g = gelu_pk((f32x2){hh[e], hh[e + 1]}); hh[e] = g.x * vv[e]; hh[e + 1] = g.y * vv[e + 1]; }
                u32x4 w; w.x = cvt_pk_bf16(hh[0], hh[1]); w.y = cvt_pk_bf16(hh[2], hh[3]); w.z = cvt_pk_bf16(hh[4], hh[5]); w.w = cvt_pk_bf16(hh[6], hh[7]);
                *(u32x4*)(H + (size_t)row * ff + j0) = w;
                if (m == 3 && fr >= 14) { u32x4 s; s.x = cvt_pk_bf16(uu[0], uu[1]); s.y = cvt_pk_bf16(uu[2], uu[3]); s.z = cvt_pk_bf16(uu[4], uu[5]); s.w = cvt_pk_bf16(uu[6], uu[7]);
                    *(u32x4*)(UL + ((size_t)(row >> 6) * 2 + (fr - 14)) * ff + j0) = s; }
                if (m == 0 && fr < 2) { u32x4 s; s.x = cvt_pk_bf16(uu[0], uu[1]); s.y = cvt_pk_bf16(uu[2], uu[3]); s.z = cvt_pk_bf16(uu[4], uu[5]); s.w = cvt_pk_bf16(uu[6], uu[7]);
                    *(u32x4*)(UF + ((size_t)(row >> 6) * 2 + fr) * ff + j0) = s;
                    u32x4 z; z.x = cvt_pk_bf16(vv[0], vv[1]); z.y = cvt_pk_bf16(vv[2], vv[3]); z.z = cvt_pk_bf16(vv[4], vv[5]); z.w = cvt_pk_bf16(vv[6], vv[7]);
                    *(u32x4*)(VF + ((size_t)(row >> 6) * 2 + fr) * ff + j0) = z; }
            }
        }
    }
};
template <class Epi, class Sched, bool ALIGN_EPI = false, bool SP2 = false>
__device__ __forceinline__ void gemm_phase(PG8_LAS unsigned char* lds, const Gemm g, const Sched& S, const Epi& E) {
    const int tid = threadIdx.x, wid = __builtin_amdgcn_readfirstlane(tid >> 6), lane = tid & 63, wr = wid >> 2, wc = wid & 3, fr = lane & 15, fq = lane >> 4;
    const int K = g.K, nt = K / BK;
    unsigned voffA[2], voffB[2];
#pragma unroll
    for (int i = 0; i < 2; ++i) { int R, C; stage_rc(tid * 16 + i * 8192, R, C); const int Rb = Epi::PERM ? ((R & ~31) + perm32(R & 31)) : R;
        voffA[i] = (unsigned)(R * K + C) * 2u; voffB[i] = (unsigned)(Rb * K + C) * 2u; }
    const size_t kstep = (size_t)(BK * 2);
    const size_t hstep = (size_t)HALF * K * 2;
    const size_t tstep = 2 * hstep;
    const unsigned ldsw = (unsigned)wid * 1024u;
    const int aoff = lds_byte(wr * 64 + fr, fq * 8), boff = lds_byte(wc * 32 + fr, fq * 8);
#define PG8_SA(b, h) (((b) * 2 + (h)) * HTB)
#define PG8_SB(b, h) ((4 + (b) * 2 + (h)) * HTB)
#define PG8_STAGE(bufoff, gbase, voff) do { _Pragma("unroll") for (int _i = 0; _i < 2; ++_i) \
        __builtin_amdgcn_global_load_lds((const unsigned*)((const char*)(gbase) + (voff)[_i]), (PG8_LAS unsigned*)(lds + (bufoff) + ldsw + _i * 8192), 16, 0, 0); } while (0)
#define PG8_LDA(dst, b, h) do { _Pragma("unroll") for (int m = 0; m < 4; ++m) _Pragma("unroll") for (int k = 0; k < 2; ++k) dst[m][k] = *(const PG8_LAS bf16x8*)(lds + PG8_SA(b, h) + aoff + m * 2048 + k * 1024); } while (0)
#define PG8_LDB(dst, b, h) do { _Pragma("unroll") for (int n = 0; n < 2; ++n) _Pragma("unroll") for (int k = 0; k < 2; ++k) dst[n][k] = *(const PG8_LAS bf16x8*)(lds + PG8_SB(b, h) + boff + n * 2048 + k * 1024); } while (0)
#define PG8_MMA(ai, bj, At, Bt) do { __builtin_amdgcn_s_setprio(1); _Pragma("unroll") for (int m = 0; m < 4; ++m) _Pragma("unroll") for (int n = 0; n < 2; ++n) _Pragma("unroll") for (int k = 0; k < 2; ++k) \
        acc[ai][bj][m][n] = __builtin_amdgcn_mfma_f32_16x16x32_bf16(Bt[n][k], At[m][k], acc[ai][bj][m][n], 0, 0, 0); __builtin_amdgcn_s_setprio(0); } while (0)
#define PG8_WAIT_V(n) asm volatile("s_waitcnt vmcnt(" #n ")" ::: "memory")
#define PG8_WAIT_L(n) asm volatile("s_waitcnt lgkmcnt(" #n ")" ::: "memory")
#define PG8_BAR __builtin_amdgcn_s_barrier()
#define PG8_SCHED __builtin_amdgcn_sched_barrier(0)
    Unit cur, nxt; int ui = 0;
    if (!S.next(0, cur)) return;
    f32x4 acc[2][2][4][2];
#pragma unroll
    for (int a = 0; a < 2; ++a)
#pragma unroll
        for (int b = 0; b < 2; ++b)
#pragma unroll
            for (int m = 0; m < 4; ++m)
#pragma unroll
                for (int n = 0; n < 2; ++n) acc[a][b][m][n] = (f32x4){0.f, 0.f, 0.f, 0.f};
    bf16x8 At[4][2], B0[2][2], B1[2][2];
    const char* cA = (const char*)g.A + (size_t)cur.pm * tstep; const char* cB = (const char*)g.Bt + (size_t)cur.pn * tstep;
    S.a_ready(cur);
    if constexpr (SP2) {
        PG8_STAGE(PG8_SB(0, 0), cB, voffB); PG8_STAGE(PG8_SB(0, 1), cB + hstep, voffB); PG8_STAGE(PG8_SA(0, 0), cA, voffA); PG8_STAGE(PG8_SA(0, 1), cA + hstep, voffA);
        if (wr == 1) PG8_BAR;
        PG8_WAIT_V(2); PG8_BAR;
        PG8_STAGE(PG8_SB(1, 0), cB + kstep, voffB); PG8_STAGE(PG8_SA(1, 0), cA + kstep, voffA); PG8_STAGE(PG8_SB(1, 1), cB + hstep + kstep, voffB);
        PG8_WAIT_V(6); PG8_BAR;
    } else {
        PG8_STAGE(PG8_SB(0, 0), cB, voffB); PG8_STAGE(PG8_SA(0, 0), cA, voffA); PG8_STAGE(PG8_SB(0, 1), cB + hstep, voffB); PG8_STAGE(PG8_SA(0, 1), cA + hstep, voffA);
        if (wr == 1) PG8_BAR;
        PG8_WAIT_V(4); PG8_BAR;
        PG8_STAGE(PG8_SB(1, 0), cB + kstep, voffB); PG8_STAGE(PG8_SA(1, 0), cA + kstep, voffA); PG8_STAGE(PG8_SB(1, 1), cB + hstep + kstep, voffB);
        PG8_WAIT_V(6); PG8_BAR;
    }
    for (;;) {
        const bool has_next = S.next(ui + 1, nxt);
        const char* nA = has_next ? (const char*)g.A + (size_t)nxt.pm * tstep : cA; const char* nB = has_next ? (const char*)g.Bt + (size_t)nxt.pn * tstep : cB;
        for (int t = 0; t < nt; t += 2) {
            const bool last = (t == nt - 2);
            const char* a1 = cA + (size_t)(t + 1) * kstep;
            const char* a2 = last ? nA : cA + (size_t)(t + 2) * kstep; const char* b2 = last ? nB : cB + (size_t)(t + 2) * kstep;
            const char* a3 = a2 + kstep; const char* b3 = b2 + kstep;
            if (last && has_next) S.a_ready(nxt);
            if constexpr (SP2) {
            PG8_LDB(B0, 0, 0); PG8_LDB(B1, 0, 1); PG8_SCHED; PG8_LDA(At, 0, 0); PG8_STAGE(PG8_SA(1, 1), a1 + hstep, voffA);
            PG8_WAIT_V(8); PG8_WAIT_L(0); PG8_BAR; PG8_MMA(0, 0, At, B0); PG8_MMA(0, 1, At, B1); PG8_BAR; PG8_SCHED;
            PG8_LDA(At, 0, 1); PG8_STAGE(PG8_SB(0, 0), b2, voffB); PG8_STAGE(PG8_SB(0, 1), b2 + hstep, voffB); PG8_STAGE(PG8_SA(0, 0), a2, voffA);
            PG8_WAIT_V(8); PG8_WAIT_L(0); PG8_BAR; PG8_MMA(1, 0, At, B0); PG8_MMA(1, 1, At, B1); PG8_BAR; PG8_SCHED;
            PG8_LDB(B0, 1, 0); PG8_LDB(B1, 1, 1); PG8_SCHED; PG8_LDA(At, 1, 0); PG8_STAGE(PG8_SA(0, 1), a2 + hstep, voffA);
            PG8_WAIT_V(8); PG8_WAIT_L(0); PG8_BAR; PG8_MMA(0, 0, At, B0); PG8_MMA(0, 1, At, B1); PG8_BAR; PG8_SCHED;
            PG8_LDA(At, 1, 1); PG8_STAGE(PG8_SB(1, 0), b3, voffB); PG8_STAGE(PG8_SB(1, 1), b3 + hstep, voffB); PG8_STAGE(PG8_SA(1, 0), a3, voffA);
            PG8_WAIT_V(8); PG8_WAIT_L(0); PG8_BAR; PG8_MMA(1, 0, At, B0); PG8_MMA(1, 1, At, B1); PG8_BAR; PG8_SCHED;
            } else {
            PG8_LDB(B0, 0, 0); PG8_SCHED; PG8_LDA(At, 0, 0); PG8_STAGE(PG8_SA(1, 1), a1 + hstep, voffA);
            PG8_WAIT_L(8); PG8_BAR; PG8_WAIT_L(0); PG8_MMA(0, 0, At, B0); PG8_BAR; PG8_SCHED;
            PG8_LDB(B1, 0, 1); PG8_STAGE(PG8_SB(0, 0), b2, voffB);
            PG8_BAR; PG8_WAIT_L(0); PG8_MMA(0, 1, At, B1); PG8_BAR;
            PG8_LDA(At, 0, 1); PG8_STAGE(PG8_SA(0, 0), a2, voffA);
            PG8_BAR; PG8_WAIT_L(0); PG8_MMA(1, 0, At, B0); PG8_BAR; PG8_SCHED;
            PG8_STAGE(PG8_SB(0, 1), b2 + hstep, voffB);
            PG8_WAIT_V(6); PG8_BAR; PG8_MMA(1, 1, At, B1); PG8_BAR;
            PG8_LDB(B0, 1, 0); PG8_SCHED; PG8_LDA(At, 1, 0); PG8_STAGE(PG8_SA(0, 1), a2 + hstep, voffA);
            PG8_WAIT_L(8); PG8_BAR; PG8_WAIT_L(0); PG8_MMA(0, 0, At, B0); PG8_BAR; PG8_SCHED;
            PG8_LDB(B1, 1, 1); PG8_STAGE(PG8_SB(1, 0), b3, voffB);
            PG8_BAR; PG8_WAIT_L(0); PG8_MMA(0, 1, At, B1); PG8_BAR;
            PG8_LDA(At, 1, 1); PG8_STAGE(PG8_SA(1, 0), a3, voffA);
            PG8_BAR; PG8_WAIT_L(0); PG8_MMA(1, 0, At, B0); PG8_BAR; PG8_SCHED;
            PG8_STAGE(PG8_SB(1, 1), b3 + hstep, voffB);
            PG8_WAIT_V(6); PG8_BAR; PG8_MMA(1, 1, At, B1); PG8_BAR;
            }
        }
        if constexpr (ALIGN_EPI) { if (wr == 0) PG8_BAR; }
        if constexpr (!Epi::AFTER_DRAIN) { E(acc, cur, wr, wc, fr, fq); S.done(cur); }
        if (!has_next) break;
#pragma unroll
        for (int a = 0; a < 2; ++a)
#pragma unroll
            for (int b = 0; b < 2; ++b)
#pragma unroll
                for (int m = 0; m < 4; ++m)
#pragma unroll
                    for (int n = 0; n < 2; ++n) acc[a][b][m][n] = (f32x4){0.f, 0.f, 0.f, 0.f};
        cur = nxt; cA = nA; cB = nB; ++ui;
        if constexpr (ALIGN_EPI) { if (wr == 1) PG8_BAR; }
    }
    PG8_WAIT_V(0);
    if constexpr (!ALIGN_EPI) { if (wr == 0) PG8_BAR; }
    PG8_BAR;
    if constexpr (Epi::AFTER_DRAIN) { E.fused(acc, cur, wr, wc, fr, fq, lds, wid, lane); S.done(cur); }
#undef PG8_SA
#undef PG8_SB
#undef PG8_STAGE
#undef PG8_LDA
#undef PG8_LDB
#undef PG8_MMA
#undef PG8_WAIT_V
#undef PG8_WAIT_L
#undef PG8_BAR
#undef PG8_SCHED
}
}
constexpr int NWAVES = 8;
constexpr int BATCH = 32, SEQ = 2048, D = 1024, M = BATCH * SEQ;
constexpr int EVEN_IN = 2816, ODD_IN = 3072, DFF = 2816, UPN = 2 * DFF;
constexpr int QB_OFF = 768, FB_OFF = 1280, IB_OFF = 1792, GB_OFF = 2304;
constexpr float EPS = 1e-6f;
constexpr float LOG2E = 1.4426950408889634f;
constexpr float C2 = 0.125f * LOG2E;

constexpr size_t MiB = 1u << 20;
constexpr size_t WS_CTL = 0, CTL_ZERO_BYTES = 64 * 1024;
constexpr size_t WS_TAB = 1 * MiB;
constexpr size_t WS_LB = WS_TAB + 768 * 1024;
constexpr size_t WS_WIN0 = 2 * MiB, WS_WOUT0 = 8 * MiB, WS_WIN1 = 10 * MiB, WS_WOUT1 = 16 * MiB, WS_WUP = 18 * MiB  , WS_WDN = 40 * MiB  ;
constexpr size_t WS_SIDE = 52 * MiB, SIDE_STRIDE = 12 * MiB;
constexpr size_t WS_SC = 90 * MiB;
constexpr size_t WS_XN = 96 * MiB;
constexpr size_t WS_PROJ = 224 * MiB;
constexpr size_t WS_O = 608 * MiB;
constexpr size_t WS_Y = 736 * MiB;
constexpr size_t WS_END = 864 * MiB;
constexpr int CW_BAR = 4096;

constexpr int RING_OFF = 0, RING_BYTES = 131072;
constexpr int LDSCTL_OFF = RING_BYTES, MISC_OFF = LDSCTL_OFF + 320;
constexpr int LDS_BYTES = 147456;

namespace attn2 {
using bf16x8 = __attribute__((ext_vector_type(8))) short;
using s16x4 = __attribute__((ext_vector_type(4))) short;
using f32x16 = __attribute__((ext_vector_type(16))) float;
using u32x4 = __attribute__((ext_vector_type(4))) unsigned;
typedef unsigned short bf16;
constexpr int NSLOT = 3, SLOTB = 8192;
constexpr int LDS_K = 0, LDS_V = NSLOT * SLOTB, LDS_WS = 2 * NSLOT * SLOTB, LDS_OST = LDS_WS + 8 * 64 * 4, LDS_TB = LDS_OST + 8 * 4096, LDS_BYTES = LDS_TB + 1088;
constexpr float THR = 8.f;
__device__ __forceinline__ int crow(int r, int hi) { return (r & 3) + 8 * (r >> 2) + 4 * hi; }
__device__ __forceinline__ void glds16(const void* gsrc, unsigned lds_dst) { unsigned keep;
    asm volatile("s_mov_b32 %0, m0\n\ts_mov_b32 m0, %2\n\ts_nop 0\n\tglobal_load_lds_dwordx4 %1, off\n\ts_mov_b32 m0, %0" : "=&s"(keep) : "v"(gsrc), "s"(lds_dst) : "memory"); }
typedef float f32x2_t __attribute__((ext_vector_type(2))); typedef __bf16 bf16x2_t __attribute__((ext_vector_type(2)));
__device__ __forceinline__ unsigned cvtpk_s(float lo, float hi) { f32x2_t v = {lo, hi}; bf16x2_t b = __builtin_convertvector(v, bf16x2_t); return __builtin_bit_cast(unsigned, b); }
__device__ __forceinline__ void qkt(f32x16& p0, f32x16& p1, const char* Kslot, const bf16x8* qr, const f32x16& cin, int r32, int hi) {
    const char* kb = Kslot + hi * 1024 + r32 * 16;
#pragma unroll
    for (int d0 = 0; d0 < 4; ++d0) {
        const bf16x8 b0 = *reinterpret_cast<const bf16x8*>(kb + d0 * 2048);
        const bf16x8 b1 = *reinterpret_cast<const bf16x8*>(kb + d0 * 2048 + 512);
        if (d0 == 0) { p0 = __builtin_amdgcn_mfma_f32_32x32x16_bf16(b0, qr[0], cin, 0, 0, 0); p1 = __builtin_amdgcn_mfma_f32_32x32x16_bf16(b1, qr[0], cin, 0, 0, 0); }
        else { p0 = __builtin_amdgcn_mfma_f32_32x32x16_bf16(b0, qr[d0], p0, 0, 0, 0); p1 = __builtin_amdgcn_mfma_f32_32x32x16_bf16(b1, qr[d0], p1, 0, 0, 0); } }
}
__device__ __forceinline__ void pv(f32x16* o, int vb, bf16x8 pa0, bf16x8 pa1, bf16x8 pa2, bf16x8 pa3) {
#pragma unroll
    for (int d0 = 0; d0 < 2; ++d0) { s16x4 lo[4], hi[4];
#pragma unroll
        for (int ks = 0; ks < 4; ++ks) {
            asm volatile("ds_read_b64_tr_b16 %0,%1 offset:%c2" : "=&v"(lo[ks]) : "v"(vb), "i"(d0 * 4096 + ks * 1024) : "memory");
            asm volatile("ds_read_b64_tr_b16 %0,%1 offset:%c2" : "=&v"(hi[ks]) : "v"(vb), "i"(d0 * 4096 + ks * 1024 + 512) : "memory"); }
        asm volatile("s_waitcnt lgkmcnt(0)" ::: "memory"); __builtin_amdgcn_sched_barrier(0);
#define ATT_PK(k) (bf16x8){lo[k][0], lo[k][1], lo[k][2], lo[k][3], hi[k][0], hi[k][1], hi[k][2], hi[k][3]}
        o[d0] = __builtin_amdgcn_mfma_f32_32x32x16_bf16(pa0, ATT_PK(0), o[d0], 0, 0, 0);
        o[d0] = __builtin_amdgcn_mfma_f32_32x32x16_bf16(pa1, ATT_PK(1), o[d0], 0, 0, 0);
        o[d0] = __builtin_amdgcn_mfma_f32_32x32x16_bf16(pa2, ATT_PK(2), o[d0], 0, 0, 0);
        o[d0] = __builtin_amdgcn_mfma_f32_32x32x16_bf16(pa3, ATT_PK(3), o[d0], 0, 0, 0);
#undef ATT_PK
    }
}
template <int LDQ, int LDKV, int LDO, bool BIAS, bool SINK>
__device__ __forceinline__ void band_unit(const bf16* Qw, const bf16* Kt, const bf16* Vt, bf16* Ow, int jlo, int jhi, int wlo, int whi, int qpos0, float sink2, char* shm) {
    const int tid = threadIdx.x, lane = tid & 63, r32 = lane & 31, hi = lane >> 5; const int wid = __builtin_amdgcn_readfirstlane(tid >> 6);
    const unsigned lds0 = (unsigned)(uintptr_t)shm;
    float* wsf = (float*)(shm + LDS_WS) + wid * 64;
    const float* tb = (const float*)(shm + LDS_TB);
    const bf16* ksrc = Kt + (long)lane * LDKV + wid * 8;
    const bf16* vsrc = Vt + (long)(16 * (wid & 3) + (lane >> 2)) * LDKV + (wid >> 2) * 32 + (lane & 3) * 8;
    const unsigned kdst = lds0 + LDS_K + wid * 1024, vdst = lds0 + LDS_V + wid * 1024;
#define ATT_DMAK(t, slot) glds16(ksrc + (long)(t) * 64 * LDKV, (unsigned)__builtin_amdgcn_readfirstlane(kdst + (slot)))
#define ATT_DMAV(t, slot) glds16(vsrc + (long)(t) * 64 * LDKV, (unsigned)__builtin_amdgcn_readfirstlane(vdst + (slot)))
#define ATT_SLOT(t) ((((t) - jlo) % 3) * SLOTB)
    const int vb0 = (int)(lds0 + LDS_V) + ((lane >> 4) & 1) * 32 + (lane & 3) * 8 + (4 * hi + ((lane & 15) >> 2)) * 64;
    bf16x8 qr[4];
#pragma unroll
    for (int d0 = 0; d0 < 4; ++d0) qr[d0] = *reinterpret_cast<const bf16x8*>(&Qw[(long)r32 * LDQ + d0 * 16 + hi * 8]);
    ATT_DMAK(jlo, 0);
    if (jlo + 1 <= jhi) ATT_DMAK(jlo + 1, SLOTB);
    ATT_DMAV(jlo, 0);
    if (jlo + 2 <= jhi) ATT_DMAK(jlo + 2, 2 * SLOTB);
    if (jlo + 1 <= jhi) ATT_DMAV(jlo + 1, SLOTB);
    float mhat = SINK ? sink2 : 0.f, l_reg = (SINK && hi == 0) ? 1.f : 0.f; bool first = !SINK;
    f32x16 o[2]; o[0] = f32x16{}; o[1] = f32x16{};
    f32x16 negm;
#pragma unroll
    for (int r = 0; r < 16; ++r) negm[r] = -mhat;
    asm volatile("s_waitcnt vmcnt(0) lgkmcnt(0)\n\ts_barrier" ::: "memory");
    asm volatile("" :: "v"(qr[0]), "v"(qr[1]), "v"(qr[2]), "v"(qr[3]));
    f32x16 pc0 = f32x16{}, pc1 = f32x16{}, pn0 = f32x16{}, pn1 = f32x16{};
    if (jlo >= wlo && jlo <= whi) qkt(pc0, pc1, shm + LDS_K, qr, negm, r32, hi);
    for (int j = jlo; j <= jhi; ++j) {
        if (j + 2 <= jhi) asm volatile("s_waitcnt vmcnt(2) lgkmcnt(0)\n\ts_barrier" ::: "memory");
        else if (j + 1 <= jhi) asm volatile("s_waitcnt vmcnt(1) lgkmcnt(0)\n\ts_barrier" ::: "memory");
        else asm volatile("s_waitcnt vmcnt(0) lgkmcnt(0)\n\ts_barrier" ::: "memory");
        if (j + 3 <= jhi) ATT_DMAK(j + 3, ATT_SLOT(j + 3));
        if (j + 2 <= jhi) ATT_DMAV(j + 2, ATT_SLOT(j + 2));
        const bool actn = (j + 1 <= jhi) && (j + 1 >= wlo) && (j + 1 <= whi);
        if (actn) qkt(pn0, pn1, shm + LDS_K + ATT_SLOT(j + 1), qr, negm, r32, hi);
        __builtin_amdgcn_sched_barrier(0);
        if (j >= wlo && j <= whi) {
            if (BIAS) {
                const int dq = qpos0 + r32 - 64 * j;
                if ((qpos0 & ~63) - 64 * j >= 192) { const float c = tb[256];
#pragma unroll
                    for (int r = 0; r < 16; ++r) { pc0[r] += c; pc1[r] += c; } }
                else {
#pragma unroll
                    for (int r = 0; r < 16; ++r) { const int a = dq - crow(r, hi) + 128; const int i0 = a > 256 ? 256 : a, i1 = a - 32 > 256 ? 256 : a - 32; pc0[r] += tb[i0]; pc1[r] += tb[i1]; } }
            }
            float ra = fmaxf(fmaxf(pc0[0], pc0[1]), pc1[0]), rb = fmaxf(fmaxf(pc0[2], pc0[3]), pc1[1]); ra = fmaxf(fmaxf(ra, pc1[2]), pc1[3]);
#pragma unroll
            for (int r = 4; r < 16; r += 4) { ra = fmaxf(fmaxf(ra, pc0[r]), pc0[r + 1]); rb = fmaxf(fmaxf(rb, pc0[r + 2]), pc0[r + 3]); ra = fmaxf(fmaxf(ra, pc1[r]), pc1[r + 1]); rb = fmaxf(fmaxf(rb, pc1[r + 2]), pc1[r + 3]); }
            float rm = fmaxf(ra, rb);
            { auto rr = __builtin_amdgcn_permlane32_swap(__float_as_uint(rm), __float_as_uint(rm), false, false); rm = fmaxf(__uint_as_float(rr[0]), __uint_as_float(rr[1])); }
            bool resc = false;
            if (first) { const float dl = rm; mhat = dl;
#pragma unroll
                for (int r = 0; r < 16; ++r) { pc0[r] -= dl; pc1[r] -= dl; pn0[r] -= dl; pn1[r] -= dl; negm[r] = -mhat; }
                first = false; }
            else if (__any(rm > THR)) { const float dl = fmaxf(rm, 0.f); mhat += dl;
#pragma unroll
                for (int r = 0; r < 16; ++r) { pc0[r] -= dl; pc1[r] -= dl; pn0[r] -= dl; pn1[r] -= dl; negm[r] = -mhat; }
                const float f = __builtin_amdgcn_exp2f(-dl); l_reg *= f; if (hi == 0) wsf[r32] = f; resc = true; }
            f32x2_t sacc = {0.f, 0.f};
#pragma unroll
            for (int r = 0; r < 16; ++r) { pc0[r] = __builtin_amdgcn_exp2f(pc0[r]); pc1[r] = __builtin_amdgcn_exp2f(pc1[r]); }
#pragma unroll
            for (int r = 0; r < 16; r += 2) { sacc += (f32x2_t){pc0[r], pc0[r + 1]}; sacc += (f32x2_t){pc1[r], pc1[r + 1]}; }
            l_reg += sacc[0] + sacc[1];
            u32x4 pw0, pw1, pw2, pw3;
            pw0 = (u32x4){cvtpk_s(pc0[0], pc0[1]), cvtpk_s(pc0[2], pc0[3]), cvtpk_s(pc0[4], pc0[5]), cvtpk_s(pc0[6], pc0[7])};
            pw1 = (u32x4){cvtpk_s(pc0[8], pc0[9]), cvtpk_s(pc0[10], pc0[11]), cvtpk_s(pc0[12], pc0[13]), cvtpk_s(pc0[14], pc0[15])};
            pw2 = (u32x4){cvtpk_s(pc1[0], pc1[1]), cvtpk_s(pc1[2], pc1[3]), cvtpk_s(pc1[4], pc1[5]), cvtpk_s(pc1[6], pc1[7])};
            pw3 = (u32x4){cvtpk_s(pc1[8], pc1[9]), cvtpk_s(pc1[10], pc1[11]), cvtpk_s(pc1[12], pc1[13]), cvtpk_s(pc1[14], pc1[15])};
            if (resc) { asm volatile("s_waitcnt lgkmcnt(0)" ::: "memory");
#pragma unroll
                for (int d_ = 0; d_ < 2; ++d_)
#pragma unroll
                    for (int r = 0; r < 16; ++r) o[d_][r] *= wsf[crow(r, hi)]; }
            pv(o, vb0 + ATT_SLOT(j), __builtin_bit_cast(bf16x8, pw0), __builtin_bit_cast(bf16x8, pw1), __builtin_bit_cast(bf16x8, pw2), __builtin_bit_cast(bf16x8, pw3));
        }
        pc0 = pn0; pc1 = pn1;
    }
    { auto rr = __builtin_amdgcn_permlane32_swap(__float_as_uint(l_reg), __float_as_uint(l_reg), false, false); l_reg = __uint_as_float(rr[0]) + __uint_as_float(rr[1]); }
    if (hi == 0) wsf[32 + r32] = l_reg; asm volatile("s_waitcnt lgkmcnt(0)" ::: "memory");
    float rli[16];
#pragma unroll
    for (int r = 0; r < 16; ++r) rli[r] = __builtin_amdgcn_rcpf(wsf[32 + crow(r, hi)]);
    { bf16* stg = (bf16*)(shm + LDS_OST) + wid * 2048;
#pragma unroll
      for (int r = 0; r < 16; ++r) { const int orow = crow(r, hi);
#pragma unroll
          for (int d0 = 0; d0 < 2; ++d0) { const float v = o[d0][r] * rli[r]; const unsigned u = __builtin_bit_cast(unsigned, v); stg[orow * 64 + d0 * 32 + r32] = (bf16)((u + 0x7fffu + ((u >> 16) & 1u)) >> 16); } }
      asm volatile("s_waitcnt lgkmcnt(0)" ::: "memory");
#pragma unroll
      for (int i = 0; i < 4; ++i) { const int row = i * 8 + (lane >> 3), ch = lane & 7; const u32x4 v = *(const u32x4*)(stg + row * 64 + ch * 8); *(u32x4*)(Ow + (long)row * LDO + ch * 8) = v; } }
    asm volatile("s_waitcnt lgkmcnt(0)\n\ts_barrier" ::: "memory");
#undef ATT_DMAK
#undef ATT_DMAV
#undef ATT_SLOT
}
}
namespace hgrn2 {
using bf16x8 = __attribute__((ext_vector_type(8))) short;
using f32x16 = __attribute__((ext_vector_type(16))) float;
using f32x4 = __attribute__((ext_vector_type(4))) float;
using u32x4 = __attribute__((ext_vector_type(4))) unsigned;
using u32x2 = __attribute__((ext_vector_type(2))) unsigned;
typedef unsigned short bf16;
#define HG_LAS __attribute__((address_space(3)))
constexpr int QS = 136, KS = 40, OS = 33;
constexpr int QD = 0, KD = QD + 32 * QS * 2, KET = KD + 32 * QS * 2, VT = KET + 128 * KS * 2, DEC = VT + 128 * KS * 2, PBSZ = DEC + 512;
constexpr int OT = 2 * PBSZ, SSP = OT + 4 * 32 * OS * 4, WG_BYTES = SSP + 2 * 512;
static_assert(WG_BYTES <= 131072 && PBSZ % 16 == 0 && OT % 16 == 0, "hgrn LDS map");
__device__ __forceinline__ int crow(int r, int hi) { return (r & 3) + 8 * (r >> 2) + 4 * hi; }
typedef float f32x2_t __attribute__((ext_vector_type(2))); typedef __bf16 bf16x2_t __attribute__((ext_vector_type(2)));
__device__ __forceinline__ unsigned cvtpk(float lo, float hi) { f32x2_t v = {lo, hi}; bf16x2_t b = __builtin_convertvector(v, bf16x2_t); return __builtin_bit_cast(unsigned, b); }
__device__ __forceinline__ float bf2f(unsigned short b) { return __builtin_bit_cast(float, (unsigned)b << 16); }
__device__ __forceinline__ bf16x8 packacc(const f32x16& x, int s) {
    u32x4 p; p[0] = cvtpk(x[8 * s], x[8 * s + 1]); p[1] = cvtpk(x[8 * s + 2], x[8 * s + 3]); p[2] = cvtpk(x[8 * s + 4], x[8 * s + 5]); p[3] = cvtpk(x[8 * s + 6], x[8 * s + 7]);
    return __builtin_bit_cast(bf16x8, p); }
__device__ __forceinline__ bf16x8 ldperm(const HG_LAS bf16* rowp, int k0, int hi) {
    const u32x2 a = *(const HG_LAS u32x2*)(rowp + k0 + 4 * hi), b = *(const HG_LAS u32x2*)(rowp + k0 + 8 + 4 * hi);
    u32x4 p; p[0] = a[0]; p[1] = a[1]; p[2] = b[0]; p[3] = b[1]; return __builtin_bit_cast(bf16x8, p); }
#define HG_MFMA(a, b, c) __builtin_amdgcn_mfma_f32_32x32x16_bf16((a), (b), (c), 0, 0, 0)

template <int LDP, int QOFF, int FOFF, int IOFF, int GOFF, int LDO, int OOFF, int SEQ_>
__device__ __forceinline__ void hgrn_pair(const bf16* P, bf16* O, const float* lb, const float* gw, int b, int h, HG_LAS unsigned char* lds, float eps) {
    constexpr int NB = SEQ_ / 32;
    const int tid = threadIdx.x, tid4 = tid & 255, lane = tid & 63, r32 = lane & 31, hi = lane >> 5; const int wave = __builtin_amdgcn_readfirstlane(tid >> 6); const int w4 = wave & 3;
    const size_t seq0 = (size_t)b * SEQ_;
    if (wave >= 4) {
        const int pd = tid4 >> 1, half = tid4 & 1;
        const bf16* src0 = P + (seq0 + 16 * half) * LDP + h * 128 + pd;
        unsigned short af[16], aq[16], av[16], bf_[16], bq[16], bv[16];
#define HG_LOAD(F_, Q_, V_, n) do { const bf16* s_ = src0 + (size_t)(n) * 32 * LDP; _Pragma("unroll") for (int i = 0; i < 16; ++i) { F_[i] = s_[(size_t)i * LDP + FOFF]; Q_[i] = s_[(size_t)i * LDP + QOFF]; V_[i] = s_[(size_t)i * LDP + IOFF]; } } while (0)
#define HG_PREP(F_, Q_, V_, pbo) do { \
        HG_LAS bf16* qd = (HG_LAS bf16*)(lds + (pbo) + QD); HG_LAS bf16* kd = (HG_LAS bf16*)(lds + (pbo) + KD); HG_LAS bf16* ket = (HG_LAS bf16*)(lds + (pbo) + KET); HG_LAS bf16* vt = (HG_LAS bf16*)(lds + (pbo) + VT); \
        HG_LAS float* dec = (HG_LAS float*)(lds + (pbo) + DEC); \
        float fv[16], pv_[16]; float run = 1.f; \
        _Pragma("unroll") for (int i = 0; i < 16; ++i) { const float f = (float)(unsigned)F_[i] * (1.f / 65536.f); run *= f; fv[i] = f; pv_[i] = run; } \
        const float other = __shfl_xor(run, 1); const float pre = half ? other : 1.f, dtot = run * other; \
        unsigned kew[8], vw[8]; \
        _Pragma("unroll") for (int i = 0; i < 16; i += 2) { const int l0 = 16 * half + i; \
            const float p0 = pv_[i] * pre, p1 = pv_[i + 1] * pre; \
            const float qa = bf2f(Q_[i]) * p0, qb = bf2f(Q_[i + 1]) * p1; \
            const float ka = (1.f - fv[i]) * __builtin_amdgcn_rcpf(p0), kb = (1.f - fv[i + 1]) * __builtin_amdgcn_rcpf(p1); \
            qd[l0 * QS + pd] = (bf16)(cvtpk(qa, qa) & 0xffffu); qd[(l0 + 1) * QS + pd] = (bf16)(cvtpk(qb, qb) & 0xffffu); \
            kd[l0 * QS + pd] = (bf16)(cvtpk(ka, ka) & 0xffffu); kd[(l0 + 1) * QS + pd] = (bf16)(cvtpk(kb, kb) & 0xffffu); \
            kew[i >> 1] = cvtpk(ka * dtot, kb * dtot); vw[i >> 1] = (unsigned)V_[i] | ((unsigned)V_[i + 1] << 16); } \
        *(HG_LAS u32x4*)(ket + pd * KS + 16 * half) = (u32x4){kew[0], kew[1], kew[2], kew[3]}; *(HG_LAS u32x4*)(ket + pd * KS + 16 * half + 8) = (u32x4){kew[4], kew[5], kew[6], kew[7]}; \
        *(HG_LAS u32x4*)(vt + pd * KS + 16 * half) = (u32x4){vw[0], vw[1], vw[2], vw[3]}; *(HG_LAS u32x4*)(vt + pd * KS + 16 * half + 8) = (u32x4){vw[4], vw[5], vw[6], vw[7]}; \
        if (half == 0) dec[pd] = dtot; } while (0)
        HG_LOAD(af, aq, av, 0);
#pragma unroll 1
        for (int n = 0; n < NB + 2; n += 2) {
            if (n + 1 < NB) HG_LOAD(bf_, bq, bv, n + 1);
            if (n < NB) HG_PREP(af, aq, av, 0);
            __syncthreads();
            if (n + 2 < NB) HG_LOAD(af, aq, av, n + 2);
            if (n + 1 < NB) HG_PREP(bf_, bq, bv, PBSZ);
            __syncthreads();
        }
#undef HG_LOAD
#undef HG_PREP
    } else {
        HG_LAS float* ot = (HG_LAS float*)(lds + OT) + w4 * 32 * OS;
        const int fl_ = lane & 31, eh = lane >> 5, ecol = 32 * w4 + 16 * eh;
        float gwv[16];
#pragma unroll
        for (int k = 0; k < 16; ++k) gwv[k] = gw[h * 128 + ecol + k];
        f32x16 S[4];
#pragma unroll
        for (int k = 0; k < 4; ++k) S[k] = f32x16{};
        float ov[16]; u32x4 g0 = {0u, 0u, 0u, 0u}, g1 = {0u, 0u, 0u, 0u};
#pragma unroll
        for (int k = 0; k < 16; ++k) ov[k] = 0.f;
#define HG_MMA(nb, pbo, sso) do { \
        const HG_LAS bf16* qd = (const HG_LAS bf16*)(lds + (pbo) + QD); const HG_LAS bf16* kd = (const HG_LAS bf16*)(lds + (pbo) + KD); const HG_LAS bf16* ket = (const HG_LAS bf16*)(lds + (pbo) + KET); \
        const HG_LAS bf16* vt = (const HG_LAS bf16*)(lds + (pbo) + VT); const HG_LAS float* dec = (const HG_LAS float*)(lds + (pbo) + DEC); HG_LAS float* ssp = (HG_LAS float*)(lds + SSP + (sso)); \
        { const bf16* gsrc = P + (seq0 + (size_t)(nb) * 32 + fl_) * LDP + GOFF + h * 128 + ecol; g0 = *(const u32x4*)(gsrc); g1 = *(const u32x4*)(gsrc + 8); } \
        f32x16 X = f32x16{}; \
        _Pragma("unroll") for (int s = 0; s < 8; ++s) { const bf16x8 a = *(const HG_LAS bf16x8*)(kd + r32 * QS + 16 * s + 8 * hi), bq_ = *(const HG_LAS bf16x8*)(qd + r32 * QS + 16 * s + 8 * hi); X = HG_MFMA(a, bq_, X); } \
        _Pragma("unroll") for (int r = 0; r < 16; ++r) X[r] = crow(r, hi) <= r32 ? X[r] : 0.f; \
        const bf16x8 vf0 = ldperm(vt + (32 * w4 + r32) * KS, 0, hi), vf1 = ldperm(vt + (32 * w4 + r32) * KS, 16, hi); \
        f32x16 Oa = f32x16{}; \
        Oa = HG_MFMA(packacc(X, 0), vf0, Oa); Oa = HG_MFMA(packacc(X, 1), vf1, Oa); \
        _Pragma("unroll") for (int blk = 0; blk < 4; ++blk) _Pragma("unroll") for (int s = 0; s < 2; ++s) Oa = HG_MFMA(ldperm(qd + r32 * QS, 32 * blk + 16 * s, hi), packacc(S[blk], s), Oa); \
        _Pragma("unroll") for (int blk = 0; blk < 4; ++blk) { \
            _Pragma("unroll") for (int q4 = 0; q4 < 4; ++q4) { const f32x4 dv = *(const HG_LAS f32x4*)(dec + 32 * blk + 8 * q4 + 4 * hi); \
                _Pragma("unroll") for (int e = 0; e < 4; ++e) S[blk][4 * q4 + e] *= dv[e]; } \
            S[blk] = HG_MFMA(ldperm(ket + (32 * blk + r32) * KS, 0, hi), vf0, S[blk]); \
            S[blk] = HG_MFMA(ldperm(ket + (32 * blk + r32) * KS, 16, hi), vf1, S[blk]); } \
        _Pragma("unroll") for (int r = 0; r < 16; ++r) ot[crow(r, hi) * OS + r32] = Oa[r]; \
        asm volatile("s_waitcnt lgkmcnt(0)" ::: "memory"); \
        float ss = 0.f; \
        _Pragma("unroll") for (int k = 0; k < 16; ++k) { ov[k] = ot[fl_ * OS + 16 * eh + k]; ss += ov[k] * ov[k]; } \
        ss += __shfl_xor(ss, 32); \
        if (lane < 32) ssp[w4 * 32 + fl_] = ss; } while (0)
#define HG_FIN(nb, sso) do { \
        const HG_LAS float* ssp = (const HG_LAS float*)(lds + SSP + (sso)); \
        const float tot = (ssp[fl_] + ssp[32 + fl_]) + (ssp[64 + fl_] + ssp[96 + fl_]); const float rstd = 1.f / sqrtf(tot * (1.f / 128.f) + eps); \
        unsigned ow[8]; \
        _Pragma("unroll") for (int k = 0; k < 16; k += 2) { const unsigned gwd = k < 8 ? g0[k >> 1] : g1[(k - 8) >> 1]; \
            const float ga = bf2f((unsigned short)(gwd & 0xffffu)), gb = bf2f((unsigned short)(gwd >> 16)); \
            const float ra = ov[k] * rstd * gwv[k] * ga, rb = ov[k + 1] * rstd * gwv[k + 1] * gb;     \
            ow[k >> 1] = cvtpk(ra, rb); } \
        bf16* dst = O + (seq0 + (size_t)(nb) * 32 + fl_) * LDO + OOFF + h * 128 + ecol; \
        *(u32x4*)(dst) = (u32x4){ow[0], ow[1], ow[2], ow[3]}; *(u32x4*)(dst + 8) = (u32x4){ow[4], ow[5], ow[6], ow[7]}; } while (0)
#pragma unroll 1
        for (int n = 0; n < NB + 2; n += 2) {
            if (n >= 2) HG_FIN(n - 2, 0);
            if (n >= 1 && n <= NB) HG_MMA(n - 1, PBSZ, 512);
            __syncthreads();
            if (n >= 1 && n <= NB) HG_FIN(n - 1, 512);
            if (n < NB) HG_MMA(n, 0, 0);
            __syncthreads();
        }
#undef HG_MMA
#undef HG_FIN
    }
    __syncthreads();
}
#undef HG_MFMA
}
#define GAS __attribute__((address_space(1)))
#define LAS __attribute__((address_space(3)))
typedef unsigned short bf16;
typedef unsigned v4u __attribute__((ext_vector_type(4)));
typedef float f32x4 __attribute__((ext_vector_type(4)));
typedef short bf16x8 __attribute__((ext_vector_type(8)));
typedef GAS unsigned gu32;
typedef GAS unsigned long long gu64;
#define RLX_AGENT __ATOMIC_RELAXED, __HIP_MEMORY_SCOPE_AGENT
#define LDS_WAIT() asm volatile("s_waitcnt lgkmcnt(0)" ::: "memory")
#define VM_WAIT() asm volatile("s_waitcnt vmcnt(0)" ::: "memory")
__device__ __forceinline__ unsigned long long rt() { return __builtin_amdgcn_s_memrealtime(); }
__device__ __forceinline__ unsigned f2bf(float f) { unsigned u = __builtin_bit_cast(unsigned, f); return (u + 0x7fffu + ((u >> 16) & 1u)) >> 16; }
__device__ __forceinline__ unsigned pk2(float lo, float hi) { return f2bf(lo) | (f2bf(hi) << 16); }

#define XB_TMO      128
#define XB_XCNT(j)  (256  + 64 * (j))
#define XB_XSUB(j)  (1280 + 64 * (j))
#define XB_XGEN(j)  (2304 + 64 * (j))
#define XB_TOP      3328
#define XB_TOPGEN   3392
#define XCD_BAR_WORDS 3456
#define XB_SPIN_CAP (1u << 18)

__device__ __forceinline__ unsigned xb_ld(unsigned* p)              { return __hip_atomic_load(p, __ATOMIC_RELAXED, __HIP_MEMORY_SCOPE_AGENT); }
__device__ __forceinline__ unsigned xb_add(unsigned* p, unsigned v) { return __hip_atomic_fetch_add(p, v, __ATOMIC_RELAXED, __HIP_MEMORY_SCOPE_AGENT); }
__device__ __forceinline__ unsigned xb_xcc_id() { return (unsigned)__builtin_amdgcn_s_getreg((3 << 11) | 20) & 0xFu; }
#define XB_SPIN(cond, bar) do { unsigned _sp = 0; while (cond) { __builtin_amdgcn_s_sleep(1); \
    if ((++_sp & 255u) == 0u) { if (xb_ld(&(bar)[XB_TMO])) break; if (_sp > XB_SPIN_CAP) { atomicAdd(&(bar)[XB_TMO], 1u); break; } } } } while (0)

struct XcdBarrier {
    unsigned* bar; unsigned x;
    volatile LAS unsigned* st;
};

__device__ __forceinline__ XcdBarrier xcd_barrier_post(unsigned* bar, volatile LAS unsigned* st) {
    XcdBarrier b; b.bar = bar; b.x = xb_xcc_id(); b.st = st;
    if (threadIdx.x == 0) (void)xb_add(&bar[XB_XCNT(b.x)], 1u);
    return b;
}
__device__ __forceinline__ void xcd_barrier_complete(unsigned* bar, unsigned x, unsigned& nloc, unsigned& nx) {
    const unsigned G = gridDim.x * gridDim.y * gridDim.z;
    unsigned sum, cnt, mine, sp = 0u;
    for (;;) {
        sum = 0u; cnt = 0u; mine = 0u;
#pragma unroll
        for (unsigned j = 0; j < 16; ++j) { const unsigned c = xb_ld(&bar[XB_XCNT(j)]); sum += c; cnt += (c > 0u) ? 1u : 0u; mine = (j == x) ? c : mine; }
        if (sum == G) break;
        __builtin_amdgcn_s_sleep(1);
        if ((++sp & 255u) == 0u) { if (xb_ld(&bar[XB_TMO])) break; if (sp > XB_SPIN_CAP) { atomicAdd(&bar[XB_TMO], 1u); break; } }
    }
    nloc = mine > 0u ? mine : 1u; nx = cnt > 0u ? cnt : 1u;
}

__device__ __forceinline__ void xcd_barrier(const XcdBarrier& b) {
    asm volatile("s_waitcnt vmcnt(0)" ::: "memory");
    __syncthreads();
    if (threadIdx.x == 0) {
        unsigned* bar = b.bar;
        __builtin_amdgcn_s_waitcnt(0);
        unsigned nloc = b.st[0], nx = b.st[1];
        if (nloc == 0u) { xcd_barrier_complete(bar, b.x, nloc, nx); b.st[0] = nloc; b.st[1] = nx; }
        const unsigned old = xb_add(&bar[XB_XSUB(b.x)], 1u);
        const unsigned gen = old / nloc;
        if (old + 1u == (gen + 1u) * nloc) {
            __builtin_amdgcn_fence(__ATOMIC_RELEASE, "agent");
            asm volatile("s_waitcnt vmcnt(0)" ::: "memory");
            const unsigned og = xb_add(&bar[XB_TOP], 1u);
            const unsigned tg = og / nx;
            if (og + 1u == (tg + 1u) * nx) xb_add(&bar[XB_TOPGEN], 1u);
            else XB_SPIN(xb_ld(&bar[XB_TOPGEN]) == tg, bar);
            __builtin_amdgcn_fence(__ATOMIC_ACQUIRE, "agent");
            xb_add(&bar[XB_XGEN(b.x)], 1u);
            asm volatile("s_waitcnt vmcnt(0)" ::: "memory");
        } else {
            XB_SPIN(xb_ld(&bar[XB_XGEN(b.x)]) == gen, bar);
            __builtin_amdgcn_fence(__ATOMIC_ACQUIRE, "agent");
            asm volatile("s_waitcnt vmcnt(0)" ::: "memory");
        }
    }
    __syncthreads();
}
struct Frame {
    LAS unsigned char* lds; char* ldsg;
    volatile LAS unsigned* MISC;
    gu32* ctl;
    int tid, lane, wave, G;
    unsigned char* ws;
    const float *x, *even_w_in, *even_w_out, *even_sinks, *lb_logits, *hgrn_norm_w, *odd_w_in, *odd_w_out, *odd_rel, *w_up, *conv_w, *conv_b, *w_down, *norm_w;
    float* out;
};
__device__ __forceinline__ float bf2f(bf16 b) { return __builtin_bit_cast(float, (unsigned)b << 16); }
__device__ __forceinline__ float wave_sum(float v) {
#pragma unroll
    for (int o = 1; o < 64; o <<= 1) v += __shfl_xor(v, o);
    return v;
}
__device__ __forceinline__ int colmap(int cmode, int n) {
    if (cmode == 1) { if (n >= 640) return n; const int p = n & 63; return (n - p) + (p >> 1) + 32 * (p & 1); }
    if (cmode == 2) { const int pn = n >> 8, r = n & 255; return r < 128 ? pn * 128 + r : DFF + pn * 128 + (r - 128); }
    return n;
}
__device__ __forceinline__ void transpose_item(const float* W, int K, int Nsrc, int Nout, bf16* WT, const float* kscale, int cmode, LAS float* scr, int item, int lane) {
    const int nblk = Nout / 32, kb = item / nblk, nb = item % nblk, k0 = 64 * kb, n0 = 32 * nb;
    const int nsrc = colmap(cmode, n0 + (lane & 31));
#pragma unroll 8
    for (int i = 0; i < 32; ++i) { const int kk = 2 * i + (lane >> 5); float w = W[(size_t)(k0 + kk) * Nsrc + nsrc]; if (kscale) w *= kscale[k0 + kk]; scr[kk * 33 + (lane & 31)] = w; }
    LDS_WAIT(); asm volatile("" ::: "memory");
    const int c = lane & 7;
#pragma unroll
    for (int j = 0; j < 4; ++j) { const int n = (lane >> 3) + 8 * j; const LAS float* s = scr + (8 * c) * 33 + n;
        v4u o; o.x = pk2(s[0 * 33], s[1 * 33]); o.y = pk2(s[2 * 33], s[3 * 33]); o.z = pk2(s[4 * 33], s[5 * 33]); o.w = pk2(s[6 * 33], s[7 * 33]);
        *(GAS v4u*)(WT + (size_t)(n0 + n) * K + k0 + 8 * c) = o; }
    LDS_WAIT(); asm volatile("" ::: "memory");
}
__device__ __forceinline__ void rms_row_to_bf16(int lane, const float* xrow, bf16* orow, float* scp) {
    const GAS f32x4* xr = (const GAS f32x4*)xrow + lane;
    f32x4 v[4]; float s = 0.f;
#pragma unroll
    for (int j = 0; j < 4; ++j) { v[j] = xr[64 * j]; s += (v[j].x * v[j].x + v[j].y * v[j].y) + (v[j].z * v[j].z + v[j].w * v[j].w); }
    const float rms = sqrtf(wave_sum(s) * (1.f / D) + EPS), rstd = 1.f / rms;
    if (lane == 0) *scp = rms;
    GAS unsigned long long* o8 = (GAS unsigned long long*)orow + lane;
#pragma unroll
    for (int j = 0; j < 4; ++j) o8[64 * j] = (unsigned long long)pk2(v[j].x * rstd, v[j].y * rstd) | ((unsigned long long)pk2(v[j].z * rstd, v[j].w * rstd) << 32);
}
__device__ __forceinline__ void p_prologue(Frame& F) {
    LAS float* scr = (LAS float*)(F.lds + RING_OFF + F.wave * 16384);
    const int gw = blockIdx.x * NWAVES + F.wave, NGW = F.G * NWAVES;
#pragma unroll 1
    for (int mat = 0; mat < 8; ++mat) {
        const float* W; int K, Nsrc, Nout, cmode = 0; const float* ks = nullptr; size_t dst;
        if (mat == 0)      { W = F.even_w_in;  K = D; Nsrc = EVEN_IN; Nout = EVEN_IN; cmode = 1; ks = F.norm_w + 0 * D; dst = WS_WIN0; }
        else if (mat == 1) { W = F.even_w_out; K = D; Nsrc = D; Nout = D; dst = WS_WOUT0; }
        else if (mat == 2) { W = F.odd_w_in;   K = D; Nsrc = ODD_IN; Nout = ODD_IN; ks = F.norm_w + 4 * D; dst = WS_WIN1; }
        else if (mat == 3) { W = F.odd_w_out;  K = D; Nsrc = D; Nout = D; dst = WS_WOUT1; }
        else if (mat < 6)  { const int l = mat - 4; W = F.w_up + (size_t)l * D * UPN; K = D; Nsrc = UPN; Nout = UPN; cmode = 2; ks = F.norm_w + (size_t)(l * 4 + 2) * D; dst = WS_WUP + (size_t)l * 11 * MiB; }
        else               { const int l = mat - 6; W = F.w_down + (size_t)l * DFF * D; K = DFF; Nsrc = D; Nout = D; dst = WS_WDN + (size_t)l * 5632 * 1024; }
        const int nitems = (K / 64) * (Nout / 32);
        for (int it = gw; it < nitems; it += NGW) transpose_item(W, K, Nsrc, Nout, (bf16*)(F.ws + dst), ks, cmode, scr, it, F.lane);
    }
    { float* tab = (float*)(F.ws + WS_TAB); const int gt = blockIdx.x * (NWAVES * 64) + F.tid, NT = F.G * NWAVES * 64;
      for (int e = gt; e < SEQ * 32; e += NT) { const int t = e >> 5, i = e & 31; const float inv = powf(10000.f, -(float)(2 * i) / 64.f); const float ang = (float)t * inv;
          tab[2 * e] = (float)cos((double)ang); tab[2 * e + 1] = (float)sin((double)ang); }
      float* lb = (float*)(F.ws + WS_LB);
      for (int e = gt; e < 512; e += NT) { const float a = F.lb_logits[e], b = F.lb_logits[512 + e]; const float mx = fmaxf(a, b); const float ea = expf(a - mx), eb = expf(b - mx); lb[e] = ea / (ea + eb); } }
    for (int m0 = gw; m0 < M; m0 += 2 * NGW) {
        const int m1 = m0 + NGW < M ? m0 + NGW : m0;
        const GAS f32x4* xa = (const GAS f32x4*)(F.x + (size_t)m0 * D) + F.lane; const GAS f32x4* xb = (const GAS f32x4*)(F.x + (size_t)m1 * D) + F.lane;
        f32x4 va[4], vb[4]; float sa = 0.f, sb = 0.f;
#pragma unroll
        for (int j = 0; j < 4; ++j) { va[j] = xa[64 * j]; vb[j] = xb[64 * j]; }
#pragma unroll
        for (int j = 0; j < 4; ++j) { sa += (va[j].x * va[j].x + va[j].y * va[j].y) + (va[j].z * va[j].z + va[j].w * va[j].w); sb += (vb[j].x * vb[j].x + vb[j].y * vb[j].y) + (vb[j].z * vb[j].z + vb[j].w * vb[j].w); }
        const float rmsa = sqrtf(wave_sum(sa) * (1.f / D) + EPS), rmsb = sqrtf(wave_sum(sb) * (1.f / D) + EPS), ra = 1.f / rmsa, rb = 1.f / rmsb;
        float* scp = (float*)(F.ws + WS_SC);
        GAS unsigned long long* oa = (GAS unsigned long long*)((bf16*)(F.ws + WS_XN) + (size_t)m0 * D) + F.lane; GAS unsigned long long* ob = (GAS unsigned long long*)((bf16*)(F.ws + WS_XN) + (size_t)m1 * D) + F.lane;
        if (F.lane == 0) { scp[m0] = rmsa; if (m1 != m0) scp[m1] = rmsb; }
#pragma unroll
        for (int j = 0; j < 4; ++j) oa[64 * j] = (unsigned long long)pk2(va[j].x * ra, va[j].y * ra) | ((unsigned long long)pk2(va[j].z * ra, va[j].w * ra) << 32);
        if (m1 != m0) {
#pragma unroll
            for (int j = 0; j < 4; ++j) ob[64 * j] = (unsigned long long)pk2(vb[j].x * rb, vb[j].y * rb) | ((unsigned long long)pk2(vb[j].z * rb, vb[j].w * rb) << 32); }
    }
}
__device__ __forceinline__ void p_norm(Frame& F, bf16* XNp, float* sc, const bf16* Y, const float* g, float* outf) {
    const int gw = blockIdx.x * NWAVES + F.wave, NGW = F.G * NWAVES;
    f32x4 gv[4];
#pragma unroll
    for (int j = 0; j < 4; ++j) gv[j] = ((const GAS f32x4*)g)[F.lane + 64 * j];
    constexpr int R = 2;
    for (int m0 = gw; m0 < M; m0 += R * NGW) {
        unsigned long long wx[R][4], wy[R][4]; float scm[R];
#pragma unroll
        for (int r = 0; r < R; ++r) { const int m = m0 + r * NGW; const int mm = m < M ? m : m0;
            const GAS unsigned long long* xr = (const GAS unsigned long long*)(XNp + (size_t)mm * D) + F.lane;
            const GAS unsigned long long* yr = (const GAS unsigned long long*)(Y + (size_t)mm * D) + F.lane;
            scm[r] = sc[mm];
#pragma unroll
            for (int j = 0; j < 4; ++j) { wx[r][j] = xr[64 * j]; wy[r][j] = yr[64 * j]; } }
#pragma unroll
        for (int r = 0; r < R; ++r) { const int m = m0 + r * NGW; if (m >= M) break;
            f32x4 h[4], y[4]; float s = 0.f;
#pragma unroll
            for (int j = 0; j < 4; ++j) { const unsigned long long a = wx[r][j], w = wy[r][j];
                h[j].x = __builtin_bit_cast(float, (unsigned)(a & 0xffffu) << 16); h[j].y = __builtin_bit_cast(float, (unsigned)(a >> 16 & 0xffffu) << 16);
                h[j].z = __builtin_bit_cast(float, (unsigned)(a >> 32 & 0xffffu) << 16); h[j].w = __builtin_bit_cast(float, (unsigned)(a >> 48 & 0xffffu) << 16);
                y[j].x = __builtin_bit_cast(float, (unsigned)(w & 0xffffu) << 16); y[j].y = __builtin_bit_cast(float, (unsigned)(w >> 16 & 0xffffu) << 16);
                y[j].z = __builtin_bit_cast(float, (unsigned)(w >> 32 & 0xffffu) << 16); y[j].w = __builtin_bit_cast(float, (unsigned)(w >> 48 & 0xffffu) << 16);
                s += (y[j].x * y[j].x + y[j].y * y[j].y) + (y[j].z * y[j].z + y[j].w * y[j].w); }
            const float r1 = 1.f / sqrtf(wave_sum(s) * (1.f / D) + EPS); float s2 = 0.f;
#pragma unroll
            for (int j = 0; j < 4; ++j) { h[j] = h[j] * scm[r] + y[j] * r1 * gv[j]; s2 += (h[j].x * h[j].x + h[j].y * h[j].y) + (h[j].z * h[j].z + h[j].w * h[j].w); }
            if (outf) { GAS f32x4* ho = (GAS f32x4*)(outf + (size_t)m * D) + F.lane;
#pragma unroll
                for (int j = 0; j < 4; ++j) ho[64 * j] = h[j]; }
            else { const float rms = sqrtf(wave_sum(s2) * (1.f / D) + EPS), r2 = 1.f / rms;
                if (F.lane == 0) sc[m] = rms;
                GAS unsigned long long* xo = (GAS unsigned long long*)(XNp + (size_t)m * D) + F.lane;
#pragma unroll
                for (int j = 0; j < 4; ++j) xo[64 * j] = (unsigned long long)pk2(h[j].x * r2, h[j].y * r2) | ((unsigned long long)pk2(h[j].z * r2, h[j].w * r2) << 32); }
        }
    }
}
__device__ __forceinline__ void p_fixup(Frame& F, bf16* H, const bf16* UL, const bf16* UF, const bf16* VF, const float* cw, const float* cb) {
    const int gt = blockIdx.x * (NWAVES * 64) + F.tid, NT = F.G * NWAVES * 64;
    constexpr int CH = DFF / 8, NIT = (M / 64) * 2 * CH;
    for (int it = gt; it < NIT; it += NT) {
        const int ch = it % CH, gr = it / CH, r = gr & 1, g = gr >> 1, j0 = ch * 8;
        const bool has_prev = (g & 31) != 0;
        const v4u z4 = {0u, 0u, 0u, 0u};
        const v4u u0 = *(const GAS v4u*)(UF + ((size_t)g * 2 + r) * DFF + j0);
        const v4u vv = *(const GAS v4u*)(VF + ((size_t)g * 2 + r) * DFF + j0);
        const v4u pl1 = has_prev ? *(const GAS v4u*)(UL + ((size_t)(g - 1) * 2 + 1) * DFF + j0) : z4;
        const v4u pl0 = has_prev ? *(const GAS v4u*)(UL + ((size_t)(g - 1) * 2 + 0) * DFF + j0) : z4;
        const v4u uf0 = *(const GAS v4u*)(UF + ((size_t)g * 2 + 0) * DFF + j0);
        const v4u um1 = r ? uf0 : pl1, um2 = r ? pl1 : pl0;
        float hh[8];
        const f32x4 kb0 = *(const GAS f32x4*)(cb + j0), kb1 = *(const GAS f32x4*)(cb + j0 + 4), k00 = *(const GAS f32x4*)(cw + j0), k01 = *(const GAS f32x4*)(cw + j0 + 4),
                    k10 = *(const GAS f32x4*)(cw + DFF + j0), k11 = *(const GAS f32x4*)(cw + DFF + j0 + 4), k20 = *(const GAS f32x4*)(cw + 2 * DFF + j0), k21 = *(const GAS f32x4*)(cw + 2 * DFF + j0 + 4);
#pragma unroll
        for (int e = 0; e < 8; ++e) { const int sh = (e & 1) * 16; const unsigned wa = u0[e >> 1], wb = um1[e >> 1], wc_ = um2[e >> 1], wv = vv[e >> 1];
            const float a = bf2f((bf16)(wa >> sh)), b = bf2f((bf16)(wb >> sh)), c = bf2f((bf16)(wc_ >> sh)), v = bf2f((bf16)(wv >> sh));
            const float pre = (e < 4 ? kb0[e & 3] : kb1[e & 3]) + (e < 4 ? k00[e & 3] : k01[e & 3]) * c + (e < 4 ? k10[e & 3] : k11[e & 3]) * b + (e < 4 ? k20[e & 3] : k21[e & 3]) * a;
            const pg8::f32x2 gg = pg8::gelu_pk((pg8::f32x2){pre, pre}); hh[e] = gg.x * v; }
        v4u o; o.x = pk2(hh[0], hh[1]); o.y = pk2(hh[2], hh[3]); o.z = pk2(hh[4], hh[5]); o.w = pk2(hh[6], hh[7]);
        *(GAS v4u*)(H + ((size_t)g * 64 + r) * DFF + j0) = o;
    }
}
__device__ __forceinline__ void p_attn_plain(Frame& F, const bf16* Q, int ldq, const bf16* Kp, int ldk, const bf16* Vp, int ldv, bf16* O, int ldo, int HQ, int GQ, int nprev, const float* sinks, const float* rel) {
    const int gt = blockIdx.x * (NWAVES * 64) + F.tid, NT = F.G * NWAVES * 64;
    const long total = (long)M * HQ;
    for (long idx = gt; idx < total; idx += NT) {
        const int hq = (int)(idx / M), row = (int)(idx % M), hk = hq / GQ;
        const int b = row / SEQ, t = row % SEQ, c = t >> 6, c0 = c - nprev < 0 ? 0 : c - nprev;
        float q[64], o[64];
        { const GAS v4u* qp = (const GAS v4u*)(Q + (size_t)row * ldq + hq * 64);
#pragma unroll
          for (int i = 0; i < 8; ++i) { const v4u w = qp[i];
#pragma unroll
              for (int e = 0; e < 4; ++e) { const unsigned ww = w[e]; q[8 * i + 2 * e] = bf2f((bf16)(ww & 0xffffu)); q[8 * i + 2 * e + 1] = bf2f((bf16)(ww >> 16)); } } }
#pragma unroll
        for (int d = 0; d < 64; ++d) o[d] = 0.f;
        float mrun = sinks ? sinks[hq] * LOG2E : -INFINITY, l = sinks ? 1.f : 0.f;
        const float* relh = rel ? rel + hq * 257 : nullptr;
        for (int kp = c0 * 64; kp < c * 64 + 64; ++kp) {
            const size_t krow = (size_t)b * SEQ + kp;
            const GAS v4u* kk = (const GAS v4u*)(Kp + krow * ldk + hk * 64);
            float s = 0.f;
#pragma unroll
            for (int i = 0; i < 8; ++i) { const v4u w = kk[i];
#pragma unroll
                for (int e = 0; e < 4; ++e) { const unsigned ww = w[e]; s += q[8 * i + 2 * e] * bf2f((bf16)(ww & 0xffffu)); s += q[8 * i + 2 * e + 1] * bf2f((bf16)(ww >> 16)); } }
            if (relh) { int r = t - kp; r = r < -128 ? -128 : (r > 128 ? 128 : r); s += relh[r + 128] * LOG2E; }
            const float mn = fmaxf(mrun, s), sc = exp2f(mrun - mn), p = exp2f(s - mn);
            l = l * sc + p; mrun = mn;
            const GAS v4u* vp = (const GAS v4u*)(Vp + krow * ldv + hk * 64);
#pragma unroll
            for (int i = 0; i < 8; ++i) { const v4u w = vp[i];
#pragma unroll
                for (int e = 0; e < 4; ++e) { const unsigned ww = w[e]; o[8 * i + 2 * e] = o[8 * i + 2 * e] * sc + p * bf2f((bf16)(ww & 0xffffu)); o[8 * i + 2 * e + 1] = o[8 * i + 2 * e + 1] * sc + p * bf2f((bf16)(ww >> 16)); } }
        }
        const float il = 1.f / l;
        GAS v4u* op = (GAS v4u*)(O + (size_t)row * ldo + hq * 64);
#pragma unroll
        for (int i = 0; i < 8; ++i) { v4u w; w.x = pk2(o[8 * i] * il, o[8 * i + 1] * il); w.y = pk2(o[8 * i + 2] * il, o[8 * i + 3] * il); w.z = pk2(o[8 * i + 4] * il, o[8 * i + 5] * il); w.w = pk2(o[8 * i + 6] * il, o[8 * i + 7] * il); op[i] = w; }
    }
}
__device__ __forceinline__ void p_hgrn_plain(Frame& F, const bf16* P, bf16* O, const float* lb, const float* gw_) {
    const int sb = F.tid >> 7, e = F.tid & 127;
    LAS float* base = (LAS float*)(F.lds + RING_OFF) + sb * 3328;
    LAS float* Fs = base; LAS float* Qs = base + 1024; LAS float* Os = base + 2048; LAS float* Rs = base + 3072;
    for (int u0 = blockIdx.x * 4; u0 < BATCH * 4; u0 += F.G * 4) {
        const int u = u0 + sb, b = u >> 2, h = u & 3;
        float S[128];
#pragma unroll
        for (int d = 0; d < 128; ++d) S[d] = 0.f;
        const float lbd = lb[h * 128 + e], gwe = gw_[h * 128 + e];
#pragma unroll 1
        for (int t0 = 0; t0 < SEQ; t0 += 8) {
#pragma unroll
            for (int s = 0; s < 8; ++s) { const size_t row = (size_t)b * SEQ + t0 + s; const float xf = bf2f(P[row * EVEN_IN + FB_OFF + h * 128 + e]);
                Fs[s * 128 + e] = lbd + (1.f - lbd) / (1.f + expf(-xf)); Qs[s * 128 + e] = bf2f(P[row * EVEN_IN + QB_OFF + h * 128 + e]); }
            __syncthreads();
#pragma unroll 1
            for (int s = 0; s < 8; ++s) { const size_t row = (size_t)b * SEQ + t0 + s; const float iv = bf2f(P[row * EVEN_IN + IB_OFF + h * 128 + e]); float acc = 0.f;
#pragma unroll
                for (int d = 0; d < 128; ++d) { const float f = Fs[s * 128 + d]; S[d] = f * S[d] + (1.f - f) * iv; acc += Qs[s * 128 + d] * S[d]; }
                const float ss = wave_sum(acc * acc); if (F.lane == 0) Rs[s * 2 + (F.wave & 1)] = ss; Os[s * 128 + e] = acc; }
            __syncthreads();
#pragma unroll
            for (int s = 0; s < 8; ++s) { const size_t row = (size_t)b * SEQ + t0 + s; const float tot = Rs[s * 2] + Rs[s * 2 + 1]; const float r = 1.f / sqrtf(tot * (1.f / 128.f) + EPS);
                const float g = bf2f(P[row * EVEN_IN + GB_OFF + h * 128 + e]); const float val = Os[s * 128 + e] * r * gwe * (g / (1.f + expf(-g)));
                O[row * D + 512 + h * 128 + e] = (bf16)f2bf(val); }
            __syncthreads();
        }
    }
}

__device__ __forceinline__ void p_attn1(Frame& F, const bf16* PROJ, bf16* OB) {
    LAS float* tbw = (LAS float*)(F.lds + RING_OFF + attn2::LDS_TB);
    for (int pair = blockIdx.x; pair < BATCH * 16; pair += F.G) {
        const int b = pair >> 4, h = pair & 15;
        if (F.tid < 257) tbw[F.tid] = F.odd_rel[h * 257 + F.tid] * LOG2E;
#pragma unroll 1
        for (int g4 = 0; g4 < 8; ++g4) {
            const int c0 = 4 * g4, jlo = c0 - 8 < 0 ? 0 : c0 - 8, jhi = c0 + 3, cw = c0 + (F.wave >> 1), wlo = cw - 8 < 0 ? 0 : cw - 8, qpos0 = 64 * cw + 32 * (F.wave & 1);
            const size_t row0 = (size_t)b * SEQ + qpos0, seq0 = (size_t)b * SEQ;
            attn2::band_unit<ODD_IN, ODD_IN, D, true, false>(PROJ + row0 * ODD_IN + h * 64, PROJ + seq0 * ODD_IN + 1024 + h * 64, PROJ + seq0 * ODD_IN + 2048 + h * 64,
                                                             OB + row0 * D + h * 64, jlo, jhi, wlo, cw, qpos0, 0.f, F.ldsg + RING_OFF);
        }
    }
}
__device__ __forceinline__ void p_attn0(Frame& F, const bf16* PROJ, bf16* OB, int first, int stride) {
#pragma unroll 1
    for (int u = first; u < BATCH * 2 * 32; u += stride) {
        const int c = u & 31, hk = (u >> 5) & 1, b = u >> 6, qh = 4 * hk + (F.wave >> 1), qpos0 = 64 * c + 32 * (F.wave & 1), jlo = c - 2 < 0 ? 0 : c - 2;
        const size_t row0 = (size_t)b * SEQ + qpos0, seq0 = (size_t)b * SEQ;
        attn2::band_unit<EVEN_IN, EVEN_IN, D, false, true>(PROJ + row0 * EVEN_IN + qh * 64, PROJ + seq0 * EVEN_IN + 512 + hk * 64, PROJ + seq0 * EVEN_IN + 640 + hk * 64,
                                                           OB + row0 * D + qh * 64, jlo, c, jlo, c, qpos0, F.even_sinks[qh] * LOG2E, F.ldsg + RING_OFF);
    }
}

__device__ __forceinline__ void p_hgrn(Frame& F, const bf16* PROJ, bf16* OB, const float* lb, int nhw) {
#pragma unroll 1
    for (int pair = blockIdx.x; pair < BATCH * 4; pair += nhw)
        hgrn2::hgrn_pair<EVEN_IN, QB_OFF, FB_OFF, IB_OFF, GB_OFF, D, 512, SEQ>(PROJ, OB, lb, F.hgrn_norm_w, pair >> 2, pair & 3, F.lds + RING_OFF, EPS);
}
constexpr int NPH = 17;
#ifndef MK_REP2_ROLE
#define MK_REP2_ROLE 0
#endif
#ifndef MK_REPEAT
#define MK_REPEAT -1
#endif
struct Args { const float* in[14]; float* out; unsigned char* ws; int ph_lo, ph_hi; };
__global__ void __launch_bounds__(NWAVES * 64, 2) mk_fwd(Args args) {
    extern __shared__ __attribute__((aligned(16))) unsigned char lds[];
    Frame F;
    F.lds = (LAS unsigned char*)lds; F.ldsg = (char*)lds;
    F.MISC = (volatile LAS unsigned*)(F.lds + MISC_OFF);
    F.tid = threadIdx.x; F.lane = F.tid & 63; F.wave = __builtin_amdgcn_readfirstlane(F.tid >> 6);
    F.G = gridDim.x;
    unsigned char* ws = args.ws; F.ws = ws;
    F.ctl = (gu32*)(ws + WS_CTL);
    F.x = args.in[0]; F.even_w_in = args.in[1]; F.even_w_out = args.in[2]; F.even_sinks = args.in[3]; F.lb_logits = args.in[4]; F.hgrn_norm_w = args.in[5];
    F.odd_w_in = args.in[6]; F.odd_w_out = args.in[7]; F.odd_rel = args.in[8]; F.w_up = args.in[9]; F.conv_w = args.in[10]; F.conv_b = args.in[11]; F.w_down = args.in[12]; F.norm_w = args.in[13];
    F.out = args.out;
    for (int u = F.tid; u < (LDS_BYTES - LDSCTL_OFF) / 4; u += NWAVES * 64) ((LAS unsigned*)(F.lds + LDSCTL_OFF))[u] = 0u;
    __syncthreads();
    const int lo = args.ph_lo, hi = args.ph_hi;
    XcdBarrier bar; bar.bar = (unsigned*)(F.ctl + CW_BAR); bar.x = 0; bar.st = nullptr;
    if (hi - lo > 1) {
        bar.x = xb_xcc_id(); bar.st = F.MISC + 8;
        if (F.tid == 0) F.MISC[10] = xb_add(&bar.bar[XB_XCNT(bar.x)], 1u);
    }
#ifdef MK_XCD_PROBE
    unsigned xcd_probe_us = 0u;
#endif
    int vcu = (int)blockIdx.x;
#define IN(k) (lo <= (k) && (k) < hi)
#define SEAM(k) do { if (IN(k) && IN((k) + 1)) xcd_barrier(bar); } while (0)
    bf16* const XN = (bf16*)(ws + WS_XN); bf16* const PROJ = (bf16*)(ws + WS_PROJ); bf16* const OB = (bf16*)(ws + WS_O); bf16* const YB = (bf16*)(ws + WS_Y);
    bf16* const UL = (bf16*)(ws + WS_SIDE); bf16* const UF = (bf16*)(ws + WS_SIDE + SIDE_STRIDE); bf16* const VF = (bf16*)(ws + WS_SIDE + 2 * SIDE_STRIDE);
    float* const SCB = (float*)(ws + WS_SC); const float* const tab = (const float*)(ws + WS_TAB); const float* const lbv = (const float*)(ws + WS_LB);

    if (IN(0)) { p_prologue(F); }
    if (MK_REPEAT == 0 && IN(0)) { p_prologue(F); } SEAM(0);
    if (hi - lo > 1 && lo == 0) {
        if (F.tid == 0) { unsigned dense = 0u, nx = 0u; bool ok = (F.G % 8) == 0;
            for (unsigned j = 0; j < 16; ++j) { const unsigned cnt = xb_ld(&bar.bar[XB_XCNT(j)]); if (cnt) { ++nx; if (cnt != (unsigned)F.G / 8u) ok = false; } if (j < bar.x && cnt) ++dense; }
            const unsigned rank = F.MISC[10];
            F.MISC[11] = (ok && nx == 8u && rank < (unsigned)F.G / 8u) ? (8u * rank + dense) : 0xffffffffu; }
        __syncthreads();
        const unsigned v = F.MISC[11]; if (v != 0xffffffffu) vcu = (int)v;
#ifdef MK_XCD_PROBE
        xcd_probe_us = (v == 0xffffffffu ? 300u : 0u) + ((v != 0xffffffffu && (v & 7u) != (blockIdx.x & 7u)) ? 600u : 0u);
#endif
    }

    if (IN(1)) { pg8::Gemm g{XN, (const bf16*)(ws + WS_WIN0), M, EVEN_IN, D}; pg8::StaticOrder S; S.init(M, EVEN_IN, F.G, vcu);
        typedef pg8::EpiIn<EVEN_IN, 640, 512, FB_OFF, FB_OFF + 512, GB_OFF, GB_OFF + 512> EpiIn0; EpiIn0 E{PROJ, C2, tab, lbv};
        pg8::gemm_phase<EpiIn0, pg8::StaticOrder, true, true>(F.lds + RING_OFF, g, S, E); }
    if (MK_REPEAT == 1 && IN(1)) { pg8::Gemm g{XN, (const bf16*)(ws + WS_WIN0), M, EVEN_IN, D}; pg8::StaticOrder S; S.init(M, EVEN_IN, F.G, vcu);
        typedef pg8::EpiIn<EVEN_IN, 640, 512, FB_OFF, FB_OFF + 512, GB_OFF, GB_OFF + 512> EpiIn0; EpiIn0 E{PROJ, C2, tab, lbv};
        pg8::gemm_phase<EpiIn0, pg8::StaticOrder, true, true>(F.lds + RING_OFF, g, S, E); } SEAM(1);
    if (IN(2)) { const int nhw = F.G >= 192 ? 128 : 0;
        if (nhw == 0) { p_attn0(F, PROJ, OB, (int)blockIdx.x, F.G); __syncthreads(); p_hgrn(F, PROJ, OB, lbv, F.G); }
        else if ((int)blockIdx.x < nhw) p_hgrn(F, PROJ, OB, lbv, nhw);
        else p_attn0(F, PROJ, OB, (int)blockIdx.x - nhw, F.G - nhw); }
    if (MK_REPEAT == 2 && IN(2)) { const int nhw = F.G >= 192 ? 128 : 0;
        if (nhw == 0) { p_attn0(F, PROJ, OB, (int)blockIdx.x, F.G); __syncthreads(); p_hgrn(F, PROJ, OB, lbv, F.G); }
        else if ((int)blockIdx.x < nhw) { if (MK_REP2_ROLE != 2) p_hgrn(F, PROJ, OB, lbv, nhw); }
        else { if (MK_REP2_ROLE != 1) p_attn0(F, PROJ, OB, (int)blockIdx.x - nhw, F.G - nhw); } } SEAM(2);
    if (IN(3)) { pg8::Gemm g{OB, (const bf16*)(ws + WS_WOUT0), M, D, D}; pg8::StaticOrder S; S.init(M, D, F.G, vcu);
        pg8::EpiBf16<0> E{YB, D, nullptr, 0, 0, 1.f};
        pg8::gemm_phase<pg8::EpiBf16<0>, pg8::StaticOrder, true, true>(F.lds + RING_OFF, g, S, E); }
    if (MK_REPEAT == 3 && IN(3)) { pg8::Gemm g{OB, (const bf16*)(ws + WS_WOUT0), M, D, D}; pg8::StaticOrder S; S.init(M, D, F.G, vcu);
        pg8::EpiBf16<0> E{YB, D, nullptr, 0, 0, 1.f};
        pg8::gemm_phase<pg8::EpiBf16<0>, pg8::StaticOrder, true, true>(F.lds + RING_OFF, g, S, E); } SEAM(3);
    if (IN(4)) { p_norm(F, XN, SCB, YB, F.norm_w + 1 * D, nullptr); }
    if (MK_REPEAT == 4 && IN(4)) { p_norm(F, XN, SCB, YB, F.norm_w + 1 * D, nullptr); } SEAM(4);
#ifdef MK_CLOCK_PROBE
    long long cp_c0 = 0, cp_c1 = 0; unsigned long long cp_t0 = 0, cp_t1 = 0;
    if (IN(5)) { cp_c0 = clock64(); cp_t0 = __builtin_amdgcn_s_memrealtime(); }
#endif
    if (IN(5)) { pg8::Gemm g{XN, (const bf16*)(ws + WS_WUP), M, UPN, D}; pg8::StaticOrder S; S.init(M, UPN, F.G, vcu);
        pg8::EpiConvGate E{PROJ, UL, UF, VF, F.conv_w, F.conv_b, DFF};
        pg8::gemm_phase<pg8::EpiConvGate, pg8::StaticOrder, true, true>(F.lds + RING_OFF, g, S, E); }
    if (MK_REPEAT == 5 && IN(5)) { pg8::Gemm g{XN, (const bf16*)(ws + WS_WUP), M, UPN, D}; pg8::StaticOrder S; S.init(M, UPN, F.G, vcu);
        pg8::EpiConvGate E{PROJ, UL, UF, VF, F.conv_w, F.conv_b, DFF};
        pg8::gemm_phase<pg8::EpiConvGate, pg8::StaticOrder, true, true>(F.lds + RING_OFF, g, S, E); } SEAM(5);
#ifdef MK_CLOCK_PROBE
    if (IN(5)) { cp_c1 = clock64(); cp_t1 = __builtin_amdgcn_s_memrealtime(); }
#endif
    if (IN(6)) { p_fixup(F, PROJ, UL, UF, VF, F.conv_w, F.conv_b); }
    if (MK_REPEAT == 6 && IN(6)) { p_fixup(F, PROJ, UL, UF, VF, F.conv_w, F.conv_b); } SEAM(6);
    if (IN(7)) { pg8::Gemm g{PROJ, (const bf16*)(ws + WS_WDN), M, D, DFF}; pg8::StaticOrder S; S.init(M, D, F.G, vcu);
        pg8::EpiBf16<0> E{YB, D, nullptr, 0, 0, 1.f};
        pg8::gemm_phase<pg8::EpiBf16<0>, pg8::StaticOrder, true, true>(F.lds + RING_OFF, g, S, E); }
    if (MK_REPEAT == 7 && IN(7)) { pg8::Gemm g{PROJ, (const bf16*)(ws + WS_WDN), M, D, DFF}; pg8::StaticOrder S; S.init(M, D, F.G, vcu);
        pg8::EpiBf16<0> E{YB, D, nullptr, 0, 0, 1.f};
        pg8::gemm_phase<pg8::EpiBf16<0>, pg8::StaticOrder, true, true>(F.lds + RING_OFF, g, S, E); } SEAM(7);
    if (IN(8)) { p_norm(F, XN, SCB, YB, F.norm_w + 3 * D, nullptr); }
    if (MK_REPEAT == 8 && IN(8)) { p_norm(F, XN, SCB, YB, F.norm_w + 3 * D, nullptr); } SEAM(8);
    if (IN(9)) { pg8::Gemm g{XN, (const bf16*)(ws + WS_WIN1), M, ODD_IN, D}; pg8::StaticOrder S; S.init(M, ODD_IN, F.G, vcu);
        typedef pg8::EpiIn<ODD_IN, 0, 1024, 0, 0, 0, 0> EpiIn1; EpiIn1 E{PROJ, C2, tab, lbv};
        pg8::gemm_phase<EpiIn1, pg8::StaticOrder, true, true>(F.lds + RING_OFF, g, S, E); }
    if (MK_REPEAT == 9 && IN(9)) { pg8::Gemm g{XN, (const bf16*)(ws + WS_WIN1), M, ODD_IN, D}; pg8::StaticOrder S; S.init(M, ODD_IN, F.G, vcu);
        typedef pg8::EpiIn<ODD_IN, 0, 1024, 0, 0, 0, 0> EpiIn1; EpiIn1 E{PROJ, C2, tab, lbv};
        pg8::gemm_phase<EpiIn1, pg8::StaticOrder, true, true>(F.lds + RING_OFF, g, S, E); } SEAM(9);
    if (IN(10)) { p_attn1(F, PROJ, OB); }
    if (MK_REPEAT == 10 && IN(10)) { p_attn1(F, PROJ, OB); } SEAM(10);
    if (IN(11)) { pg8::Gemm g{OB, (const bf16*)(ws + WS_WOUT1), M, D, D}; pg8::StaticOrder S; S.init(M, D, F.G, vcu);
        pg8::EpiBf16<0> E{YB, D, nullptr, 0, 0, 1.f};
        pg8::gemm_phase<pg8::EpiBf16<0>, pg8::StaticOrder, true, true>(F.lds + RING_OFF, g, S, E); }
    if (MK_REPEAT == 11 && IN(11)) { pg8::Gemm g{OB, (const bf16*)(ws + WS_WOUT1), M, D, D}; pg8::StaticOrder S; S.init(M, D, F.G, vcu);
        pg8::EpiBf16<0> E{YB, D, nullptr, 0, 0, 1.f};
        pg8::gemm_phase<pg8::EpiBf16<0>, pg8::StaticOrder, true, true>(F.lds + RING_OFF, g, S, E); } SEAM(11);
    if (IN(12)) { p_norm(F, XN, SCB, YB, F.norm_w + 5 * D, nullptr); }
    if (MK_REPEAT == 12 && IN(12)) { p_norm(F, XN, SCB, YB, F.norm_w + 5 * D, nullptr); } SEAM(12);
    if (IN(13)) { pg8::Gemm g{XN, (const bf16*)(ws + WS_WUP + 11 * MiB), M, UPN, D}; pg8::StaticOrder S; S.init(M, UPN, F.G, vcu);
        pg8::EpiConvGate E{PROJ, UL, UF, VF, F.conv_w + 3 * DFF, F.conv_b + DFF, DFF};
        pg8::gemm_phase<pg8::EpiConvGate, pg8::StaticOrder, true, true>(F.lds + RING_OFF, g, S, E); }
    if (MK_REPEAT == 13 && IN(13)) { pg8::Gemm g{XN, (const bf16*)(ws + WS_WUP + 11 * MiB), M, UPN, D}; pg8::StaticOrder S; S.init(M, UPN, F.G, vcu);
        pg8::EpiConvGate E{PROJ, UL, UF, VF, F.conv_w + 3 * DFF, F.conv_b + DFF, DFF};
        pg8::gemm_phase<pg8::EpiConvGate, pg8::StaticOrder, true, true>(F.lds + RING_OFF, g, S, E); } SEAM(13);
    if (IN(14)) { p_fixup(F, PROJ, UL, UF, VF, F.conv_w + 3 * DFF, F.conv_b + DFF); }
    if (MK_REPEAT == 14 && IN(14)) { p_fixup(F, PROJ, UL, UF, VF, F.conv_w + 3 * DFF, F.conv_b + DFF); } SEAM(14);
    if (IN(15)) { pg8::Gemm g{PROJ, (const bf16*)(ws + WS_WDN + (size_t)5632 * 1024), M, D, DFF}; pg8::StaticOrder S; S.init(M, D, F.G, vcu);
        pg8::EpiBf16<0> E{YB, D, nullptr, 0, 0, 1.f};
        pg8::gemm_phase<pg8::EpiBf16<0>, pg8::StaticOrder, true, true>(F.lds + RING_OFF, g, S, E); }
    if (MK_REPEAT == 15 && IN(15)) { pg8::Gemm g{PROJ, (const bf16*)(ws + WS_WDN + (size_t)5632 * 1024), M, D, DFF}; pg8::StaticOrder S; S.init(M, D, F.G, vcu);
        pg8::EpiBf16<0> E{YB, D, nullptr, 0, 0, 1.f};
        pg8::gemm_phase<pg8::EpiBf16<0>, pg8::StaticOrder, true, true>(F.lds + RING_OFF, g, S, E); } SEAM(15);
    if (IN(16)) { p_norm(F, XN, SCB, YB, F.norm_w + 7 * D, F.out); }
#ifdef MK_XCD_PROBE
    if (F.tid == 0 && xcd_probe_us) { const unsigned long long tend = __builtin_amdgcn_s_memrealtime() + 100ull * xcd_probe_us; while (__builtin_amdgcn_s_memrealtime() < tend) __builtin_amdgcn_s_sleep(8); }
#endif
#ifdef MK_CLOCK_PROBE
    if (blockIdx.x == 0 && F.tid == 0 && hi == NPH) {
        const unsigned long long dt = cp_t1 - cp_t0; const unsigned long long mhz = dt ? (unsigned long long)(cp_c1 - cp_c0) * 100ull / dt : 0ull;
        const unsigned long long tend = __builtin_amdgcn_s_memrealtime() + mhz * 100ull;
        while (__builtin_amdgcn_s_memrealtime() < tend) __builtin_amdgcn_s_sleep(8); }
#endif
#undef IN
#undef SEAM
}

#ifndef MK_ONE_LAUNCH
#define MK_ONE_LAUNCH 1
#endif
extern "C" void kernel_launch(void* const* d_in, const int* in_sizes, int n_in, void* d_out, int out_size, void* d_ws, size_t ws_size, hipStream_t stream) {
    static int grid = 0;
    if (grid == 0) {
        if (n_in != 14 || in_sizes[0] != M * D || out_size != M * D || ws_size < WS_END) { fprintf(stderr, "kernel_launch: unexpected shapes (n_in %d, in0 %d, out %d, ws %zu); nothing launched\n", n_in, n_in > 0 ? in_sizes[0] : -1, out_size, ws_size); grid = -1; return; }
        int dev = 0, cus = 0, per_cu = 0;
        if (hipGetDevice(&dev) != hipSuccess || hipDeviceGetAttribute(&cus, hipDeviceAttributeMultiprocessorCount, dev) != hipSuccess) { grid = -1; return; }
        if (hipFuncSetAttribute((const void*)mk_fwd, hipFuncAttributeMaxDynamicSharedMemorySize, LDS_BYTES) != hipSuccess) { fprintf(stderr, "kernel_launch: hipFuncSetAttribute failed\n"); grid = -1; return; }
        if (hipOccupancyMaxActiveBlocksPerMultiprocessor(&per_cu, (const void*)mk_fwd, NWAVES * 64, LDS_BYTES) != hipSuccess || per_cu < 1) { fprintf(stderr, "kernel_launch: occupancy query says %d\n", per_cu); }
        (void)hipGetLastError();
        grid = cus;
    }
    if (grid < 0) return;
    if (hipMemsetAsync((char*)d_ws + WS_CTL, 0, CTL_ZERO_BYTES, stream) != hipSuccess) return;
    Args a{};
    for (int i = 0; i < 14; ++i) a.in[i] = (const float*)d_in[i];
    a.out = (float*)d_out; a.ws = (unsigned char*)d_ws;
#if MK_ONE_LAUNCH
    a.ph_lo = 0; a.ph_hi = NPH;
    hipLaunchKernelGGL(mk_fwd, dim3(grid), dim3(NWAVES * 64), LDS_BYTES, stream, a);
#else
    for (int k = 0; k < NPH; ++k) { a.ph_lo = k; a.ph_hi = k + 1; hipLaunchKernelGGL(mk_fwd, dim3(grid), dim3(NWAVES * 64), LDS_BYTES, stream, a); }
#endif
}
```

```cpp
#include <hip/hip_runtime.h>
#include <cstdio>
#include <cstdint>
#include <cmath>
namespace pg8 {
#define PG8_LAS __attribute__((address_space(3)))
typedef unsigned short bf16_t;
typedef short bf16x8 __attribute__((ext_vector_type(8)));
typedef float f32x4 __attribute__((ext_vector_type(4)));
typedef unsigned u32x4 __attribute__((ext_vector_type(4)));
constexpr int BM = 256, BK = 64, HALF = 128, HTB = HALF * BK * 2  , STAGE_BYTES = 8 * HTB, NXCD = 8, WGM = 8;

__host__ __device__ __forceinline__ int lds_byte(int r, int c) { const int st = (r >> 4) * 2 + (c >> 5), rr = r & 15, cc = c & 31, ob = rr * 64 + cc * 2; return st * 1024 + (ob ^ (((ob >> 9) & 1) << 5)); }
__host__ __device__ __forceinline__ void stage_rc(int b, int& R, int& C) { const int st = b / 1024, sb = b % 1024, swz = sb ^ (((sb >> 9) & 1) << 5); R = (st >> 1) * 16 + swz / 64; C = (st & 1) * 32 + (swz % 64) / 2; }
__host__ __device__ __forceinline__ int perm32(int rho) { const int n = rho >> 4, i = rho & 15; return 8 * (i >> 2) + 4 * n + (i & 3); }

struct Unit { int pm, pn; };
struct Gemm { const bf16_t* A; const bf16_t* Bt; int M, N, K; };

struct StaticOrder {
    int nM, nN, nwg, G, c;
    __host__ __device__ void init(int M, int N, int G_, int c_) { nM = M / BM; nN = N / BM; nwg = nM * nN; G = G_; c = c_; }
    __host__ __device__ bool next(int i, Unit& u) const {
        const long L = (long)i * G + c; if (L >= nwg) return false;
        int wgid = (int)L; { const int q = nwg / NXCD, r = nwg % NXCD, xcd = wgid % NXCD, off = wgid / NXCD; wgid = (xcd < r ? xcd * (q + 1) : r * (q + 1) + (xcd - r) * q) + off; }
        const int nig = WGM * nN, gid = wgid / nig, fm = gid * WGM, gsz = (nM - fm) < WGM ? (nM - fm) : WGM;
        u.pm = fm + ((wgid % nig) % gsz); u.pn = (wgid % nig) / gsz; return true;
    }
    __device__ __forceinline__ void a_ready(const Unit&) const {}
    __device__ __forceinline__ void done(const Unit&) const {}
};

__device__ __forceinline__ unsigned cvt_pk_bf16(float lo, float hi) { unsigned r; asm volatile("v_cvt_pk_bf16_f32 %0, %1, %2" : "=v"(r) : "v"(lo), "v"(hi)); return r; }
typedef float f32x2 __attribute__((ext_vector_type(2)));
__device__ __forceinline__ f32x2 gelu_pk(f32x2 v) {
    const f32x2 av = __builtin_elementwise_abs(v), d = av * 0.2316418882f + 1.0f;
    f32x2 t; t.x = __builtin_amdgcn_rcpf(d.x); t.y = __builtin_amdgcn_rcpf(d.y);
    f32x2 q = t * 0.5307027145f + (-0.7265760135f); q = q * t + 0.7107068705f; q = q * t + (-0.142248368f); q = q * t + 0.127414796f; q = q * t;
    const f32x2 s = (v * v) * (-0.72134752044f);
    f32x2 e; e.x = __builtin_amdgcn_exp2f(s.x); e.y = __builtin_amdgcn_exp2f(s.y);
    const f32x2 m = v * (q * e), r = v - m;
    f32x2 o; o.x = v.x < 0.f ? m.x : r.x; o.y = v.y < 0.f ? m.y : r.y; return o;
}

template <int ACT  > struct EpiBf16 {
    static constexpr bool PERM = true, AFTER_DRAIN = false; static_assert(ACT == 0 || ACT == 1, "EpiBf16: ACT is 0 (none) or 1 (gelu_pk)");
    bf16_t* O; int ldc; const float* bias; int split_cols; size_t split_stride; float scale0;
    __device__ __forceinline__ void operator()(const f32x4 (&acc)[2][2][4][2], const Unit& u, int wr, int wc, int fr, int fq) const {
        const int row0 = u.pm * BM + wr * 64 + fr; int colt = u.pn * BM; bf16_t* base = O;
        float sc = 1.f; if (split_cols) { const int t = colt / split_cols; base += (size_t)t * split_stride; colt -= t * split_cols; if (t == 0) sc = scale0; }
        const int col0 = colt + wc * 32 + 8 * fq, bcol0 = u.pn * BM + wc * 32 + 8 * fq;
        f32x4 bv[2][2];
#pragma unroll
        for (int bj = 0; bj < 2; ++bj)
#pragma unroll
            for (int n = 0; n < 2; ++n) bv[bj][n] = bias ? *(const f32x4*)(bias + bcol0 + bj * HALF + 4 * n) : (f32x4){0.f, 0.f, 0.f, 0.f};
#pragma unroll
        for (int ai = 0; ai < 2; ++ai)
#pragma unroll
            for (int m = 0; m < 4; ++m) { bf16_t* rowp = base + (size_t)(row0 + ai * HALF + m * 16) * ldc + col0;
#pragma unroll
                for (int bj = 0; bj < 2; ++bj) { f32x4 v0 = acc[ai][bj][m][0] + bv[bj][0], v1 = acc[ai][bj][m][1] + bv[bj][1];
                    if (ACT == 1) { f32x2 a = gelu_pk((f32x2){v0[0], v0[1]}), b = gelu_pk((f32x2){v0[2], v0[3]}), c = gelu_pk((f32x2){v1[0], v1[1]}), d = gelu_pk((f32x2){v1[2], v1[3]});
                        v0 = (f32x4){a.x, a.y, b.x, b.y}; v1 = (f32x4){c.x, c.y, d.x, d.y}; }
                    v0 = v0 * sc; v1 = v1 * sc; u32x4 w; w.x = cvt_pk_bf16(v0[0], v0[1]); w.y = cvt_pk_bf16(v0[2], v0[3]); w.z = cvt_pk_bf16(v1[0], v1[1]); w.w = cvt_pk_bf16(v1[2], v1[3]);
                    *(u32x4*)(rowp + bj * HALF) = w; } }
    }
};
template <int LDC, int ROPE_COLS, int SCALE_COLS, int GATE_LO, int GATE_HI, int SILU_LO, int SILU_HI> struct EpiIn {
    static constexpr bool PERM = true, AFTER_DRAIN = false;
    static constexpr int ldc = LDC, rope_cols = ROPE_COLS, scale_cols = SCALE_COLS, gate_lo = GATE_LO, gate_hi = GATE_HI;
    bf16_t* O; float scale; const float* tab; const float* lb;
    __device__ __forceinline__ void operator()(const f32x4 (&acc)[2][2][4][2], const Unit& u, int wr, int wc, int fr, int fq) const {
        const int row0 = u.pm * BM + wr * 64 + fr; const int colt = u.pn * BM;
        const int col0 = colt + wc * 32 + 8 * fq; const int i0 = 16 * (wc & 1) + 4 * fq;
#pragma unroll
        for (int ai = 0; ai < 2; ++ai)
#pragma unroll
            for (int m = 0; m < 4; ++m) { const int row = row0 + ai * HALF + m * 16; const int t = row & 2047; bf16_t* rowp = O + (size_t)row * ldc + col0;
#pragma unroll
                for (int bj = 0; bj < 2; ++bj) { f32x4 v0 = acc[ai][bj][m][0], v1 = acc[ai][bj][m][1]; const int cb = colt + bj * HALF;
                    if (cb < rope_cols) { const f32x4 c0 = *(const f32x4*)(tab + (size_t)(t * 32 + i0) * 2), c1 = *(const f32x4*)(tab + (size_t)(t * 32 + i0) * 2 + 4);
                        f32x4 r0, r1;
                        r0[0] = v0[0] * c0[0] - v0[1] * c0[1]; r0[1] = v0[1] * c0[0] + v0[0] * c0[1]; r0[2] = v0[2] * c0[2] - v0[3] * c0[3]; r0[3] = v0[3] * c0[2] + v0[2] * c0[3];
                        r1[0] = v1[0] * c1[0] - v1[1] * c1[1]; r1[1] = v1[1] * c1[0] + v1[0] * c1[1]; r1[2] = v1[2] * c1[2] - v1[3] * c1[3]; r1[3] = v1[3] * c1[2] + v1[2] * c1[3];
                        v0 = r0; v1 = r1; }
                    if (cb < scale_cols) { v0 = v0 * scale; v1 = v1 * scale; }
                    if (cb >= SILU_LO && cb < SILU_HI) {
#pragma unroll
                        for (int e_ = 0; e_ < 4; ++e_) { v0[e_] = v0[e_] * __builtin_amdgcn_rcpf(1.f + __expf(-v0[e_])); v1[e_] = v1[e_] * __builtin_amdgcn_rcpf(1.f + __expf(-v1[e_])); } }
                    if (cb >= gate_lo && cb < gate_hi) { const f32x4 l0 = *(const f32x4*)(lb + (col0 + bj * HALF - gate_lo)), l1 = *(const f32x4*)(lb + (col0 + bj * HALF - gate_lo) + 4);
                        f32x4 fa, fb;
#pragma unroll
                        for (int e_ = 0; e_ < 4; ++e_) { fa[e_] = __builtin_fminf((l0[e_] + (1.f - l0[e_]) * __builtin_amdgcn_rcpf(1.f + __expf(-v0[e_]))) * 65536.f + 0.5f, 65535.f);
                            fb[e_] = __builtin_fminf((l1[e_] + (1.f - l1[e_]) * __builtin_amdgcn_rcpf(1.f + __expf(-v1[e_]))) * 65536.f + 0.5f, 65535.f); }
                        u32x4 wq; wq.x = (unsigned)fa[0] | ((unsigned)fa[1] << 16); wq.y = (unsigned)fa[2] | ((unsigned)fa[3] << 16); wq.z = (unsigned)fb[0] | ((unsigned)fb[1] << 16); wq.w = (unsigned)fb[2] | ((unsigned)fb[3] << 16);
                        *(u32x4*)(rowp + bj * HALF) = wq; }
                    else {
                    u32x4 w; w.x = cvt_pk_bf16(v0[0], v0[1]); w.y = cvt_pk_bf16(v0[2], v0[3]); w.z = cvt_pk_bf16(v1[0], v1[1]); w.w = cvt_pk_bf16(v1[2], v1[3]);
                    *(u32x4*)(rowp + bj * HALF) = w; } } }
    }
};
struct EpiConvGate {
    static constexpr bool PERM = true, AFTER_DRAIN = false;
    bf16_t* H; bf16_t* UL; bf16_t* UF; bf16_t* VF; const float* cw; const float* cb; int ff;
    __device__ __forceinline__ void operator()(const f32x4 (&acc)[2][2][4][2], const Unit& u, int wr, int wc, int fr, int fq) const {
        const int j0 = u.pn * HALF + wc * 32 + 8 * fq; const int lane = (int)(threadIdx.x & 63);
        const int src1 = (lane & ~15) | ((fr + 15) & 15), src2 = (lane & ~15) | ((fr + 14) & 15);
        float k0[8], k1[8], k2[8], kb[8];
#pragma unroll
        for (int q = 0; q < 2; ++q) { const f32x4 a = *(const f32x4*)(cw + j0 + 4 * q), b = *(const f32x4*)(cw + ff + j0 + 4 * q), c = *(const f32x4*)(cw + 2 * ff + j0 + 4 * q), d = *(const f32x4*)(cb + j0 + 4 * q);
#pragma unroll
            for (int e = 0; e < 4; ++e) { k0[4 * q + e] = a[e]; k1[4 * q + e] = b[e]; k2[4 * q + e] = c[e]; kb[4 * q + e] = d[e]; } }
#pragma unroll
        for (int ai = 0; ai < 2; ++ai) {
            float pr1[8], pr2[8];
#pragma unroll
            for (int e = 0; e < 8; ++e) { pr1[e] = 0.f; pr2[e] = 0.f; }
#pragma unroll
            for (int m = 0; m < 4; ++m) { const int row = u.pm * BM + ai * HALF + wr * 64 + m * 16 + fr;
                float uu[8], vv[8], hh[8];
#pragma unroll
                for (int e = 0; e < 4; ++e) { uu[e] = acc[ai][0][m][0][e]; uu[4 + e] = acc[ai][0][m][1][e]; vv[e] = acc[ai][1][m][0][e]; vv[4 + e] = acc[ai][1][m][1][e]; }
#pragma unroll
                for (int e = 0; e < 8; ++e) { const float r1 = __shfl(uu[e], src1), r2 = __shfl(uu[e], src2);
                    const float p1 = fr >= 1 ? r1 : pr1[e], p2 = fr >= 2 ? r2 : pr2[e]; pr1[e] = r1; pr2[e] = r2;
                    hh[e] = kb[e] + k0[e] * p2 + k1[e] * p1 + k2[e] * uu[e]; }
#pragma unroll
                for (int e = 0; e < 8; e += 2) { const f32x2 g = gelu_pk((f32x2){hh[e], hh[e + 1]}); hh[e] = g.x * vv[e]; hh[e + 1] = g.y * vv[e + 1]; }
                u32x4 w; w.x = cvt_pk_bf16(hh[0], hh[1]); w.y = cvt_pk_bf16(hh[2], hh[3]); w.z = cvt_pk_bf16(hh[4], hh[5]); w.w = cvt_pk_bf16(hh[6], hh[7]);
                *(u32x4*)(H + (size_t)row * ff + j0) = w;
                if (m == 3 && fr >= 14) { u32x4 s; s.x = cvt_pk_bf16(uu[0], uu[1]); s.y = cvt_pk_bf16(uu[2], uu[3]); s.z = cvt_pk_bf16(uu[4], uu[5]); s.w = cvt_pk_bf16(uu[6], uu[7]);
                    *(u32x4*)(UL + ((size_t)(row >> 6) * 2 + (fr - 14)) * ff + j0) = s; }
                if (m == 0 && fr < 2) { u32x4 s; s.x = cvt_pk_bf16(uu[0], uu[1]); s.y = cvt_pk_bf16(uu[2], uu[3]); s.z = cvt_pk_bf16(uu[4], uu[5]); s.w = cvt_pk_bf16(uu[6], uu[7]);
                    *(u32x4*)(UF + ((size_t)(row >> 6) * 2 + fr) * ff + j0) = s;
                    u32x4 z; z.x = cvt_pk_bf16(vv[0], vv[1]); z.y = cvt_pk_bf16(vv[2], vv[3]); z.z = cvt_pk_bf16(vv[4], vv[5]); z.w = cvt_pk_bf16(vv[6], vv[7]);
                    *(u32x4*)(VF + ((size_t)(row >> 6) * 2 + fr) * ff + j0) = z; }
            }
        }
    }
};
template <class Epi, class Sched, bool ALIGN_EPI = false, bool SP2 = false>
__device__ __forceinline__ void gemm_phase(PG8_LAS unsigned char* lds, const Gemm g, const Sched& S, const Epi& E) {
    const int tid = threadIdx.x, wid = __builtin_amdgcn_readfirstlane(tid >> 6), lane = tid & 63, wr = wid >> 2, wc = wid & 3, fr = lane & 15, fq = lane >> 4;
    const int K = g.K, nt = K / BK;
    unsigned voffA[2], voffB[2];
#pragma unroll
    for (int i = 0; i < 2; ++i) { int R, C; stage_rc(tid * 16 + i * 8192, R, C); const int Rb = Epi::PERM ? ((R & ~31) + perm32(R & 31)) : R;
        voffA[i] = (unsigned)(R * K + C) * 2u; voffB[i] = (unsigned)(Rb * K + C) * 2u; }
    const size_t kstep = (size_t)(BK * 2);
    const size_t hstep = (size_t)HALF * K * 2;
    const size_t tstep = 2 * hstep;
    const unsigned ldsw = (unsigned)wid * 1024u;
    const int aoff = lds_byte(wr * 64 + fr, fq * 8), boff = lds_byte(wc * 32 + fr, fq * 8);
#define PG8_SA(b, h) (((b) * 2 + (h)) * HTB)
#define PG8_SB(b, h) ((4 + (b) * 2 + (h)) * HTB)
#define PG8_STAGE(bufoff, gbase, voff) do { _Pragma("unroll") for (int _i = 0; _i < 2; ++_i) \
        __builtin_amdgcn_global_load_lds((const unsigned*)((const char*)(gbase) + (voff)[_i]), (PG8_LAS unsigned*)(lds + (bufoff) + ldsw + _i * 8192), 16, 0, 0); } while (0)
#define PG8_LDA(dst, b, h) do { _Pragma("unroll") for (int m = 0; m < 4; ++m) _Pragma("unroll") for (int k = 0; k < 2; ++k) dst[m][k] = *(const PG8_LAS bf16x8*)(lds + PG8_SA(b, h) + aoff + m * 2048 + k * 1024); } while (0)
#define PG8_LDB(dst, b, h) do { _Pragma("unroll") for (int n = 0; n < 2; ++n) _Pragma("unroll") for (int k = 0; k < 2; ++k) dst[n][k] = *(const PG8_LAS bf16x8*)(lds + PG8_SB(b, h) + boff + n * 2048 + k * 1024); } while (0)
#define PG8_MMA(ai, bj, At, Bt) do { __builtin_amdgcn_s_setprio(1); _Pragma("unroll") for (int m = 0; m < 4; ++m) _Pragma("unroll") for (int n = 0; n < 2; ++n) _Pragma("unroll") for (int k = 0; k < 2; ++k) \
        acc[ai][bj][m][n] = __builtin_amdgcn_mfma_f32_16x16x32_bf16(Bt[n][k], At[m][k], acc[ai][bj][m][n], 0, 0, 0); __builtin_amdgcn_s_setprio(0); } while (0)
#define PG8_WAIT_V(n) asm volatile("s_waitcnt vmcnt(" #n ")" ::: "memory")
#define PG8_WAIT_L(n) asm volatile("s_waitcnt lgkmcnt(" #n ")" ::: "memory")
#define PG8_BAR __builtin_amdgcn_s_barrier()
#define PG8_SCHED __builtin_amdgcn_sched_barrier(0)
    Unit cur, nxt; int ui = 0;
    if (!S.next(0, cur)) return;
    f32x4 acc[2][2][4][2];
#pragma unroll
    for (int a = 0; a < 2; ++a)
#pragma unroll
        for (int b = 0; b < 2; ++b)
#pragma unroll
            for (int m = 0; m < 4; ++m)
#pragma unroll
                for (int n = 0; n < 2; ++n) acc[a][b][m][n] = (f32x4){0.f, 0.f, 0.f, 0.f};
    bf16x8 At[4][2], B0[2][2], B1[2][2];
    const char* cA = (const char*)g.A + (size_t)cur.pm * tstep; const char* cB = (const char*)g.Bt + (size_t)cur.pn * tstep;
    S.a_ready(cur);
    if constexpr (SP2) {
        PG8_STAGE(PG8_SB(0, 0), cB, voffB); PG8_STAGE(PG8_SB(0, 1), cB + hstep, voffB); PG8_STAGE(PG8_SA(0, 0), cA, voffA); PG8_STAGE(PG8_SA(0, 1), cA + hstep, voffA);
        if (wr == 1) PG8_BAR;
        PG8_WAIT_V(2); PG8_BAR;
        PG8_STAGE(PG8_SB(1, 0), cB + kstep, voffB); PG8_STAGE(PG8_SA(1, 0), cA + kstep, voffA); PG8_STAGE(PG8_SB(1, 1), cB + hstep + kstep, voffB);
        PG8_WAIT_V(6); PG8_BAR;
    } else {
        PG8_STAGE(PG8_SB(0, 0), cB, voffB); PG8_STAGE(PG8_SA(0, 0), cA, voffA); PG8_STAGE(PG8_SB(0, 1), cB + hstep, voffB); PG8_STAGE(PG8_SA(0, 1), cA + hstep, voffA);
        if (wr == 1) PG8_BAR;
        PG8_WAIT_V(4); PG8_BAR;
        PG8_STAGE(PG8_SB(1, 0), cB + kstep, voffB); PG8_STAGE(PG8_SA(1, 0), cA + kstep, voffA); PG8_STAGE(PG8_SB(1, 1), cB + hstep + kstep, voffB);
        PG8_WAIT_V(6); PG8_BAR;
    }
    for (;;) {
        const bool has_next = S.next(ui + 1, nxt);
        const char* nA = has_next ? (const char*)g.A + (size_t)nxt.pm * tstep : cA; const char* nB = has_next ? (const char*)g.Bt + (size_t)nxt.pn * tstep : cB;
        for (int t = 0; t < nt; t += 2) {
            const bool last = (t == nt - 2);
            const char* a1 = cA + (size_t)(t + 1) * kstep;
            const char* a2 = last ? nA : cA + (size_t)(t + 2) * kstep; const char* b2 = last ? nB : cB + (size_t)(t + 2) * kstep;
            const char* a3 = a2 + kstep; const char* b3 = b2 + kstep;
            if (last && has_next) S.a_ready(nxt);
            if constexpr (SP2) {
            PG8_LDB(B0, 0, 0); PG8_LDB(B1, 0, 1); PG8_SCHED; PG8_LDA(At, 0, 0); PG8_STAGE(PG8_SA(1, 1), a1 + hstep, voffA);
            PG8_WAIT_V(8); PG8_WAIT_L(0); PG8_BAR; PG8_MMA(0, 0, At, B0); PG8_MMA(0, 1, At, B1); PG8_BAR; PG8_SCHED;
            PG8_LDA(At, 0, 1); PG8_STAGE(PG8_SB(0, 0), b2, voffB); PG8_STAGE(PG8_SB(0, 1), b2 + hstep, voffB); PG8_STAGE(PG8_SA(0, 0), a2, voffA);
            PG8_WAIT_V(8); PG8_WAIT_L(0); PG8_BAR; PG8_MMA(1, 0, At, B0); PG8_MMA(1, 1, At, B1); PG8_BAR; PG8_SCHED;
            PG8_LDB(B0, 1, 0); PG8_LDB(B1, 1, 1); PG8_SCHED; PG8_LDA(At, 1, 0); PG8_STAGE(PG8_SA(0, 1), a2 + hstep, voffA);
            PG8_WAIT_V(8); PG8_WAIT_L(0); PG8_BAR; PG8_MMA(0, 0, At, B0); PG8_MMA(0, 1, At, B1); PG8_BAR; PG8_SCHED;
            PG8_LDA(At, 1, 1); PG8_STAGE(PG8_SB(1, 0), b3, voffB); PG8_STAGE(PG8_SB(1, 1), b3 + hstep, voffB); PG8_STAGE(PG8_SA(1, 0), a3, voffA);
            PG8_WAIT_V(8); PG8_WAIT_L(0); PG8_BAR; PG8_MMA(1, 0, At, B0); PG8_MMA(1, 1, At, B1); PG8_BAR; PG8_SCHED;
            } else {
            PG8_LDB(B0, 0, 0); PG8_SCHED; PG8_LDA(At, 0, 0); PG8_STAGE(PG8_SA(1, 1), a1 + hstep, voffA);
            PG8_WAIT_L(8); PG8_BAR; PG8_WAIT_L(0); PG8_MMA(0, 0, At, B0); PG8_BAR; PG8_SCHED;
            PG8_LDB(B1, 0, 1); PG8_STAGE(PG8_SB(0, 0), b2, voffB);
            PG8_BAR; PG8_WAIT_L(0); PG8_MMA(0, 1, At, B1); PG8_BAR;
            PG8_LDA(At, 0, 1); PG8_STAGE(PG8_SA(0, 0), a2, voffA);
            PG8_BAR; PG8_WAIT_L(0); PG8_MMA(1, 0, At, B0); PG8_BAR; PG8_SCHED;
            PG8_STAGE(PG8_SB(0, 1), b2 + hstep, voffB);
            PG8_WAIT_V(6); PG8_BAR; PG8_MMA(1, 1, At, B1); PG8_BAR;
            PG8_LDB(B0, 1, 0); PG8_SCHED; PG8_LDA(At, 1, 0); PG8_STAGE(PG8_SA(0, 1), a2 + hstep, voffA);
            PG8_WAIT_L(8); PG8_BAR; PG8_WAIT_L(0); PG8_MMA(0, 0, At, B0); PG8_BAR; PG8_SCHED;
            PG8_LDB(B1, 1, 1); PG8_STAGE(PG8_SB(1, 0), b3, voffB);
            PG8_BAR; PG8_WAIT_L(0); PG8_MMA(0, 1, At, B1); PG8_BAR;
            PG8_LDA(At, 1, 1); PG8_STAGE(PG8_SA(1, 0), a3, voffA);
            PG8_BAR; PG8_WAIT_L(0); PG8_MMA(1, 0, At, B0); PG8_BAR; PG8_SCHED;
            PG8_STAGE(PG8_SB(1, 1), b3 + hstep, voffB);
            PG8_WAIT_V(6); PG8_BAR; PG8_MMA(1, 1, At, B1); PG8_BAR;
            }
        }
        if constexpr (ALIGN_EPI) { if (wr == 0) PG8_BAR; }
        if constexpr (!Epi::AFTER_DRAIN) { E(acc, cur, wr, wc, fr, fq); S.done(cur); }
        if (!has_next) break;
#pragma unroll
        for (int a = 0; a < 2; ++a)
#pragma unroll
            for (int b = 0; b < 2; ++b)
#pragma unroll
                for (int m = 0; m < 4; ++m)
#pragma unroll
                    for (int n = 0; n < 2; ++n) acc[a][b][m][n] = (f32x4){0.f, 0.f, 0.f, 0.f};
        cur = nxt; cA = nA; cB = nB; ++ui;
        if constexpr (ALIGN_EPI) { if (wr == 1) PG8_BAR; }
    }
    PG8_WAIT_V(0);
    if constexpr (!ALIGN_EPI) { if (wr == 0) PG8_BAR; }
    PG8_BAR;
    if constexpr (Epi::AFTER_DRAIN) { E.fused(acc, cur, wr, wc, fr, fq, lds, wid, lane); S.done(cur); }
#undef PG8_SA
#undef PG8_SB
#undef PG8_STAGE
#undef PG8_LDA
#undef PG8_LDB
#undef PG8_MMA
#undef PG8_WAIT_V
#undef PG8_WAIT_L
#undef PG8_BAR
#undef PG8_SCHED
}
}
constexpr int NWAVES = 8;
constexpr int BATCH = 32, SEQ = 2048, D = 1024, M = BATCH * SEQ;
constexpr int EVEN_IN = 2816, ODD_IN = 3072, DFF = 2816, UPN = 2 * DFF;
constexpr int QB_OFF = 768, FB_OFF = 1280, IB_OFF = 1792, GB_OFF = 2304;
constexpr float EPS = 1e-6f;
constexpr float LOG2E = 1.4426950408889634f;
constexpr float C2 = 0.125f * LOG2E;

constexpr size_t MiB = 1u << 20;
constexpr size_t WS_CTL = 0, CTL_ZERO_BYTES = 64 * 1024;
constexpr size_t WS_TAB = 1 * MiB;
constexpr size_t WS_LB = WS_TAB + 768 * 1024;
constexpr size_t WS_WIN0 = 2 * MiB, WS_WOUT0 = 8 * MiB, WS_WIN1 = 10 * MiB, WS_WOUT1 = 16 * MiB, WS_WUP = 18 * MiB  , WS_WDN = 40 * MiB  ;
constexpr size_t WS_SIDE = 52 * MiB, SIDE_STRIDE = 12 * MiB;
constexpr size_t WS_SC = 90 * MiB;
constexpr size_t WS_XN = 96 * MiB;
constexpr size_t WS_PROJ = 224 * MiB;
constexpr size_t WS_O = 608 * MiB;
constexpr size_t WS_Y = 736 * MiB;
constexpr size_t WS_END = 864 * MiB;
constexpr int CW_BAR = 4096;

constexpr int RING_OFF = 0, RING_BYTES = 131072;
constexpr int LDSCTL_OFF = RING_BYTES, MISC_OFF = LDSCTL_OFF + 320;
constexpr int LDS_BYTES = 147456;

namespace attn2 {
using bf16x8 = __attribute__((ext_vector_type(8))) short;
using s16x4 = __attribute__((ext_vector_type(4))) short;
using f32x16 = __attribute__((ext_vector_type(16))) float;
using u32x4 = __attribute__((ext_vector_type(4))) unsigned;
typedef unsigned short bf16;
constexpr int NSLOT = 3, SLOTB = 8192;
constexpr int LDS_K = 0, LDS_V = NSLOT * SLOTB, LDS_WS = 2 * NSLOT * SLOTB, LDS_OST = LDS_WS + 8 * 64 * 4, LDS_TB = LDS_OST + 8 * 4096, LDS_BYTES = LDS_TB + 1088;
constexpr float THR = 8.f;
__device__ __forceinline__ int crow(int r, int hi) { return (r & 3) + 8 * (r >> 2) + 4 * hi; }
__device__ __forceinline__ void glds16(const void* gsrc, unsigned lds_dst) { unsigned keep;
    asm volatile("s_mov_b32 %0, m0\n\ts_mov_b32 m0, %2\n\ts_nop 0\n\tglobal_load_lds_dwordx4 %1, off\n\ts_mov_b32 m0, %0" : "=&s"(keep) : "v"(gsrc), "s"(lds_dst) : "memory"); }
typedef float f32x2_t __attribute__((ext_vector_type(2))); typedef __bf16 bf16x2_t __attribute__((ext_vector_type(2)));
__device__ __forceinline__ unsigned cvtpk_s(float lo, float hi) { f32x2_t v = {lo, hi}; bf16x2_t b = __builtin_convertvector(v, bf16x2_t); return __builtin_bit_cast(unsigned, b); }
__device__ __forceinline__ void qkt(f32x16& p0, f32x16& p1, const char* Kslot, const bf16x8* qr, const f32x16& cin, int r32, int hi) {
    const char* kb = Kslot + hi * 1024 + r32 * 16;
#pragma unroll
    for (int d0 = 0; d0 < 4; ++d0) {
        const bf16x8 b0 = *reinterpret_cast<const bf16x8*>(kb + d0 * 2048);
        const bf16x8 b1 = *reinterpret_cast<const bf16x8*>(kb + d0 * 2048 + 512);
        if (d0 == 0) { p0 = __builtin_amdgcn_mfma_f32_32x32x16_bf16(b0, qr[0], cin, 0, 0, 0); p1 = __builtin_amdgcn_mfma_f32_32x32x16_bf16(b1, qr[0], cin, 0, 0, 0); }
        else { p0 = __builtin_amdgcn_mfma_f32_32x32x16_bf16(b0, qr[d0], p0, 0, 0, 0); p1 = __builtin_amdgcn_mfma_f32_32x32x16_bf16(b1, qr[d0], p1, 0, 0, 0); } }
}
__device__ __forceinline__ void pv(f32x16* o, int vb, bf16x8 pa0, bf16x8 pa1, bf16x8 pa2, bf16x8 pa3) {
#pragma unroll
    for (int d0 = 0; d0 < 2; ++d0) { s16x4 lo[4], hi[4];
#pragma unroll
        for (int ks = 0; ks < 4; ++ks) {
            asm volatile("ds_read_b64_tr_b16 %0,%1 offset:%c2" : "=&v"(lo[ks]) : "v"(vb), "i"(d0 * 4096 + ks * 1024) : "memory");
            asm volatile("ds_read_b64_tr_b16 %0,%1 offset:%c2" : "=&v"(hi[ks]) : "v"(vb), "i"(d0 * 4096 + ks * 1024 + 512) : "memory"); }
        asm volatile("s_waitcnt lgkmcnt(0)" ::: "memory"); __builtin_amdgcn_sched_barrier(0);
#define ATT_PK(k) (bf16x8){lo[k][0], lo[k][1], lo[k][2], lo[k][3], hi[k][0], hi[k][1], hi[k][2], hi[k][3]}
        o[d0] = __builtin_amdgcn_mfma_f32_32x32x16_bf16(pa0, ATT_PK(0), o[d0], 0, 0, 0);
        o[d0] = __builtin_amdgcn_mfma_f32_32x32x16_bf16(pa1, ATT_PK(1), o[d0], 0, 0, 0);
        o[d0] = __builtin_amdgcn_mfma_f32_32x32x16_bf16(pa2, ATT_PK(2), o[d0], 0, 0, 0);
        o[d0] = __builtin_amdgcn_mfma_f32_32x32x16_bf16(pa3, ATT_PK(3), o[d0], 0, 0, 0);
#undef ATT_PK
    }
}
template <int LDQ, int LDKV, int LDO, bool BIAS, bool SINK>
__device__ __forceinline__ void band_unit(const bf16* Qw, const bf16* Kt, const bf16* Vt, bf16* Ow, int jlo, int jhi, int wlo, int whi, int qpos0, float sink2, char* shm) {
    const int tid = threadIdx.x, lane = tid & 63, r32 = lane & 31, hi = lane >> 5; const int wid = __builtin_amdgcn_readfirstlane(tid >> 6);
    const unsigned lds0 = (unsigned)(uintptr_t)shm;
    float* wsf = (float*)(shm + LDS_WS) + wid * 64;
    const float* tb = (const float*)(shm + LDS_TB);
    const bf16* ksrc = Kt + (long)lane * LDKV + wid * 8;
    const bf16* vsrc = Vt + (long)(16 * (wid & 3) + (lane >> 2)) * LDKV + (wid >> 2) * 32 + (lane & 3) * 8;
    const unsigned kdst = lds0 + LDS_K + wid * 1024, vdst = lds0 + LDS_V + wid * 1024;
#define ATT_DMAK(t, slot) glds16(ksrc + (long)(t) * 64 * LDKV, (unsigned)__builtin_amdgcn_readfirstlane(kdst + (slot)))
#define ATT_DMAV(t, slot) glds16(vsrc + (long)(t) * 64 * LDKV, (unsigned)__builtin_amdgcn_readfirstlane(vdst + (slot)))
#define ATT_SLOT(t) ((((t) - jlo) % 3) * SLOTB)
    const int vb0 = (int)(lds0 + LDS_V) + ((lane >> 4) & 1) * 32 + (lane & 3) * 8 + (4 * hi + ((lane & 15) >> 2)) * 64;
    bf16x8 qr[4];
#pragma unroll
    for (int d0 = 0; d0 < 4; ++d0) qr[d0] = *reinterpret_cast<const bf16x8*>(&Qw[(long)r32 * LDQ + d0 * 16 + hi * 8]);
    ATT_DMAK(jlo, 0);
    if (jlo + 1 <= jhi) ATT_DMAK(jlo + 1, SLOTB);
    ATT_DMAV(jlo, 0);
    if (jlo + 2 <= jhi) ATT_DMAK(jlo + 2, 2 * SLOTB);
    if (jlo + 1 <= jhi) ATT_DMAV(jlo + 1, SLOTB);
    float mhat = SINK ? sink2 : 0.f, l_reg = (SINK && hi == 0) ? 1.f : 0.f; bool first = !SINK;
    f32x16 o[2]; o[0] = f32x16{}; o[1] = f32x16{};
    f32x16 negm;
#pragma unroll
    for (int r = 0; r < 16; ++r) negm[r] = -mhat;
    asm volatile("s_waitcnt vmcnt(0) lgkmcnt(0)\n\ts_barrier" ::: "memory");
    asm volatile("" :: "v"(qr[0]), "v"(qr[1]), "v"(qr[2]), "v"(qr[3]));
    f32x16 pc0 = f32x16{}, pc1 = f32x16{}, pn0 = f32x16{}, pn1 = f32x16{};
    if (jlo >= wlo && jlo <= whi) qkt(pc0, pc1, shm + LDS_K, qr, negm, r32, hi);
    for (int j = jlo; j <= jhi; ++j) {
        if (j + 2 <= jhi) asm volatile("s_waitcnt vmcnt(2) lgkmcnt(0)\n\ts_barrier" ::: "memory");
        else if (j + 1 <= jhi) asm volatile("s_waitcnt vmcnt(1) lgkmcnt(0)\n\ts_barrier" ::: "memory");
        else asm volatile("s_waitcnt vmcnt(0) lgkmcnt(0)\n\ts_barrier" ::: "memory");
        if (j + 3 <= jhi) ATT_DMAK(j + 3, ATT_SLOT(j + 3));
        if (j + 2 <= jhi) ATT_DMAV(j + 2, ATT_SLOT(j + 2));
        const bool actn = (j + 1 <= jhi) && (j + 1 >= wlo) && (j + 1 <= whi);
        if (actn) qkt(pn0, pn1, shm + LDS_K + ATT_SLOT(j + 1), qr, negm, r32, hi);
        __builtin_amdgcn_sched_barrier(0);
        if (j >= wlo && j <= whi) {
            if (BIAS) {
                const int dq = qpos0 + r32 - 64 * j;
                if ((qpos0 & ~63) - 64 * j >= 192) { const float c = tb[256];
#pragma unroll
                    for (int r = 0; r < 16; ++r) { pc0[r] += c; pc1[r] += c; } }
                else {
#pragma unroll
                    for (int r = 0; r < 16; ++r) { const int a = dq - crow(r, hi) + 128; const int i0 = a > 256 ? 256 : a, i1 = a - 32 > 256 ? 256 : a - 32; pc0[r] += tb[i0]; pc1[r] += tb[i1]; } }
            }
            float ra = fmaxf(fmaxf(pc0[0], pc0[1]), pc1[0]), rb = fmaxf(fmaxf(pc0[2], pc0[3]), pc1[1]); ra = fmaxf(fmaxf(ra, pc1[2]), pc1[3]);
#pragma unroll
            for (int r = 4; r < 16; r += 4) { ra = fmaxf(fmaxf(ra, pc0[r]), pc0[r + 1]); rb = fmaxf(fmaxf(rb, pc0[r + 2]), pc0[r + 3]); ra = fmaxf(fmaxf(ra, pc1[r]), pc1[r + 1]); rb = fmaxf(fmaxf(rb, pc1[r + 2]), pc1[r + 3]); }
            float rm = fmaxf(ra, rb);
            { auto rr = __builtin_amdgcn_permlane32_swap(__float_as_uint(rm), __float_as_uint(rm), false, false); rm = fmaxf(__uint_as_float(rr[0]), __uint_as_float(rr[1])); }
            bool resc = false;
            if (first) { const float dl = rm; mhat = dl;
#pragma unroll
                for (int r = 0; r < 16; ++r) { pc0[r] -= dl; pc1[r] -= dl; pn0[r] -= dl; pn1[r] -= dl; negm[r] = -mhat; }
                first = false; }
            else if (__any(rm > THR)) { const float dl = fmaxf(rm, 0.f); mhat += dl;
#pragma unroll
                for (int r = 0; r < 16; ++r) { pc0[r] -= dl; pc1[r] -= dl; pn0[r] -= dl; pn1[r] -= dl; negm[r] = -mhat; }
                const float f = __builtin_amdgcn_exp2f(-dl); l_reg *= f; if (hi == 0) wsf[r32] = f; resc = true; }
            f32x2_t sacc = {0.f, 0.f};
#pragma unroll
            for (int r = 0; r < 16; ++r) { pc0[r] = __builtin_amdgcn_exp2f(pc0[r]); pc1[r] = __builtin_amdgcn_exp2f(pc1[r]); }
#pragma unroll
            for (int r = 0; r < 16; r += 2) { sacc += (f32x2_t){pc0[r], pc0[r + 1]}; sacc += (f32x2_t){pc1[r], pc1[r + 1]}; }
            l_reg += sacc[0] + sacc[1];
            u32x4 pw0, pw1, pw2, pw3;
            pw0 = (u32x4){cvtpk_s(pc0[0], pc0[1]), cvtpk_s(pc0[2], pc0[3]), cvtpk_s(pc0[4], pc0[5]), cvtpk_s(pc0[6], pc0[7])};
            pw1 = (u32x4){cvtpk_s(pc0[8], pc0[9]), cvtpk_s(pc0[10], pc0[11]), cvtpk_s(pc0[12], pc0[13]), cvtpk_s(pc0[14], pc0[15])};
            pw2 = (u32x4){cvtpk_s(pc1[0], pc1[1]), cvtpk_s(pc1[2], pc1[3]), cvtpk_s(pc1[4], pc1[5]), cvtpk_s(pc1[6], pc1[7])};
            pw3 = (u32x4){cvtpk_s(pc1[8], pc1[9]), cvtpk_s(pc1[10], pc1[11]), cvtpk_s(pc1[12], pc1[13]), cvtpk_s(pc1[14], pc1[15])};
            if (resc) { asm volatile("s_waitcnt lgkmcnt(0)" ::: "memory");
#pragma unroll
                for (int d_ = 0; d_ < 2; ++d_)
#pragma unroll
                    for (int r = 0; r < 16; ++r) o[d_][r] *= wsf[crow(r, hi)]; }
            pv(o, vb0 + ATT_SLOT(j), __builtin_bit_cast(bf16x8, pw0), __builtin_bit_cast(bf16x8, pw1), __builtin_bit_cast(bf16x8, pw2), __builtin_bit_cast(bf16x8, pw3));
        }
        pc0 = pn0; pc1 = pn1;
    }
    { auto rr = __builtin_amdgcn_permlane32_swap(__float_as_uint(l_reg), __float_as_uint(l_reg), false, false); l_reg = __uint_as_float(rr[0]) + __uint_as_float(rr[1]); }
    if (hi == 0) wsf[32 + r32] = l_reg; asm volatile("s_waitcnt lgkmcnt(0)" ::: "memory");
    float rli[16];
#pragma unroll
    for (int r = 0; r < 16; ++r) rli[r] = __builtin_amdgcn_rcpf(wsf[32 + crow(r, hi)]);
    { bf16* stg = (bf16*)(shm + LDS_OST) + wid * 2048;
#pragma unroll
      for (int r = 0; r < 16; ++r) { const int orow = crow(r, hi);
#pragma unroll
          for (int d0 = 0; d0 < 2; ++d0) { const float v = o[d0][r] * rli[r]; const unsigned u = __builtin_bit_cast(unsigned, v); stg[orow * 64 + d0 * 32 + r32] = (bf16)((u + 0x7fffu + ((u >> 16) & 1u)) >> 16); } }
      asm volatile("s_waitcnt lgkmcnt(0)" ::: "memory");
#pragma unroll
      for (int i = 0; i < 4; ++i) { const int row = i * 8 + (lane >> 3), ch = lane & 7; const u32x4 v = *(const u32x4*)(stg + row * 64 + ch * 8); *(u32x4*)(Ow + (long)row * LDO + ch * 8) = v; } }
    asm volatile("s_waitcnt lgkmcnt(0)\n\ts_barrier" ::: "memory");
#undef ATT_DMAK
#undef ATT_DMAV
#undef ATT_SLOT
}
}
namespace attn3 {
typedef unsigned short bf16;
using bf16x8=__attribute__((ext_vector_type(8)))short;
using s16x4=__attribute__((ext_vector_type(4)))short;
using f32x16=__attribute__((ext_vector_type(16)))float;
using u32x4=__attribute__((ext_vector_type(4)))unsigned;
constexpr int NW=8,QBLK=32,KVBLK=64;
__device__ __forceinline__ int crow(int r,int hi){return (r&3)+8*(r>>2)+4*hi;}
#define SBAR() __builtin_amdgcn_sched_barrier(0)
constexpr int NSLOT=3, SLOTB=8192;
constexpr int LDS_K=0, LDS_V=NSLOT*SLOTB, LDS_WS=2*NSLOT*SLOTB, LDS_OST=LDS_WS+NW*64*4, LDS_TB=LDS_OST+NW*4096,LDS_BYTES=LDS_TB+1280;
constexpr float MASKV=-4096.f;
__device__ __forceinline__ void glds16(const void*gbase,unsigned voff,unsigned lds_dst){unsigned keep;
  asm volatile("s_mov_b32 %0, m0\n\ts_mov_b32 m0, %3\n\ts_nop 0\n\tglobal_load_lds_dwordx4 %1, %2\n\ts_mov_b32 m0, %0":"=&s"(keep):"v"(voff),"s"(gbase),"s"(lds_dst):"memory");}
__device__ __forceinline__ float max3f(float a,float b,float c){float r;asm("v_max3_f32 %0, %1, %2, %3":"=v"(r):"v"(a),"v"(b),"v"(c));return r;}
__device__ __forceinline__ float max2f(float a,float b){float r;asm("v_max_f32_e32 %0, %1, %2":"=v"(r):"v"(a),"v"(b));return r;}
__device__ __forceinline__ float fadd_s(float a,float b){float r;asm("v_add_f32_e32 %0, %1, %2":"=v"(r):"v"(a),"v"(b));return r;}
__device__ __forceinline__ float fsub_s(float a,float b){float r;asm("v_sub_f32_e32 %0, %1, %2":"=v"(r):"v"(a),"v"(b));return r;}
typedef float f32x2_t __attribute__((ext_vector_type(2))); typedef __bf16 bf16x2_t __attribute__((ext_vector_type(2)));
__device__ __forceinline__ unsigned cvtpk_s(float lo,float hi){f32x2_t v={lo,hi};bf16x2_t b=__builtin_convertvector(v,bf16x2_t);return __builtin_bit_cast(unsigned,b);}
#define WAIT_BAR(N) asm volatile("s_waitcnt vmcnt(" #N ") lgkmcnt(0)\n\ts_barrier":::"memory")

__device__ __forceinline__ void qkt(f32x16&p0,f32x16&p1,const char*Kslot,const bf16x8*qr,int r32,int hi){ const f32x16 zz=f32x16{};
  const char*kb=Kslot+hi*1024+r32*16;
  #pragma unroll
  for(int d0=0;d0<4;++d0){
    const bf16x8 b0=*reinterpret_cast<const bf16x8*>(kb+d0*2048);
    const bf16x8 b1=*reinterpret_cast<const bf16x8*>(kb+d0*2048+512);
    if(d0==0){p0=__builtin_amdgcn_mfma_f32_32x32x16_bf16(b0,qr[0],zz,0,0,0);p1=__builtin_amdgcn_mfma_f32_32x32x16_bf16(b1,qr[0],zz,0,0,0);}
    else{p0=__builtin_amdgcn_mfma_f32_32x32x16_bf16(b0,qr[d0],p0,0,0,0);p1=__builtin_amdgcn_mfma_f32_32x32x16_bf16(b1,qr[d0],p1,0,0,0);}}
}
typedef __attribute__((address_space(3))) const char* lds_cptr;
typedef short v4i16_t __attribute__((ext_vector_type(4)));
__device__ __forceinline__ void kload8(bf16x8*kf,lds_cptr kp){
  kf[0]=*(const __attribute__((address_space(3))) bf16x8*)(kp);      kf[1]=*(const __attribute__((address_space(3))) bf16x8*)(kp+512);
  kf[2]=*(const __attribute__((address_space(3))) bf16x8*)(kp+2048); kf[3]=*(const __attribute__((address_space(3))) bf16x8*)(kp+2560);
  kf[4]=*(const __attribute__((address_space(3))) bf16x8*)(kp+4096); kf[5]=*(const __attribute__((address_space(3))) bf16x8*)(kp+4608);
  kf[6]=*(const __attribute__((address_space(3))) bf16x8*)(kp+6144); kf[7]=*(const __attribute__((address_space(3))) bf16x8*)(kp+6656);
}
__device__ __forceinline__ void kload2(bf16x8*kf,lds_cptr kp,int j){ kf[2*j]=*(const __attribute__((address_space(3))) bf16x8*)(kp+j*2048); kf[2*j+1]=*(const __attribute__((address_space(3))) bf16x8*)(kp+j*2048+512); }
__device__ __forceinline__ s16x4 vtr(lds_cptr p){ return __builtin_bit_cast(s16x4,__builtin_amdgcn_ds_read_tr16_b64_v4i16((__attribute__((address_space(3))) v4i16_t*)p)); }
__device__ __forceinline__ float rowmax(const f32x16&p0,const f32x16&p1){
  float a=max3f(p0[0],p0[1],p1[0]),b=max3f(p0[2],p0[3],p1[1]);a=max3f(a,p1[2],p1[3]);
  #pragma unroll
  for(int r=4;r<16;r+=4){a=max3f(a,p0[r],p0[r+1]);b=max3f(b,p0[r+2],p0[r+3]);a=max3f(a,p1[r],p1[r+1]);b=max3f(b,p1[r+2],p1[r+3]);}
  const float m=max2f(a,b);
  auto rr=__builtin_amdgcn_permlane32_swap(__float_as_uint(m),__float_as_uint(m),false,false);
  return max2f(__uint_as_float(rr[0]),__uint_as_float(rr[1]));
}
__device__ __forceinline__ void pv(f32x16*o,int vb,bf16x8 pa0,bf16x8 pa1,bf16x8 pa2,bf16x8 pa3){
  #pragma unroll
  for(int d0=0;d0<2;++d0){s16x4 lo[4],hi[4];
    #pragma unroll
    for(int ks=0;ks<4;++ks){
      asm volatile("ds_read_b64_tr_b16 %0,%1 offset:%c2":"=&v"(lo[ks]):"v"(vb),"i"(d0*4096+ks*1024):"memory");
      asm volatile("ds_read_b64_tr_b16 %0,%1 offset:%c2":"=&v"(hi[ks]):"v"(vb),"i"(d0*4096+ks*1024+512):"memory");}
    asm volatile("s_waitcnt lgkmcnt(0)":::"memory");SBAR();
    #define PK(k) (bf16x8){lo[k][0],lo[k][1],lo[k][2],lo[k][3],hi[k][0],hi[k][1],hi[k][2],hi[k][3]}
    o[d0]=__builtin_amdgcn_mfma_f32_32x32x16_bf16(pa0,PK(0),o[d0],0,0,0);
    o[d0]=__builtin_amdgcn_mfma_f32_32x32x16_bf16(pa1,PK(1),o[d0],0,0,0);
    o[d0]=__builtin_amdgcn_mfma_f32_32x32x16_bf16(pa2,PK(2),o[d0],0,0,0);
    o[d0]=__builtin_amdgcn_mfma_f32_32x32x16_bf16(pa3,PK(3),o[d0],0,0,0);
    #undef PK
  }
}

#ifndef ATTN_STORE16
#define ATTN_STORE16(p,v) (*(u32x4*)(p)=(v))
#endif
template<int DM,int LDO,int THRL> __device__ __forceinline__ void attn_unit(const bf16*Qw,const bf16*__restrict__ Kh,const bf16*__restrict__ Vh,bf16*Ow,int NT,int wt0,int wt1,int qi0,char*shm){
  const int tid=threadIdx.x,lane=tid&63,r32=lane&31,hi=lane>>5; const int wid=__builtin_amdgcn_readfirstlane(tid>>6);
  const unsigned lds0=(unsigned)(uintptr_t)shm;
  float*wsf=(float*)(shm+LDS_WS)+wid*64;
  const unsigned koff=(unsigned)(lane*DM+wid*8)*2u, voff=(unsigned)((16*(wid&3)+(lane>>2))*DM+(wid>>2)*32+(lane&3)*8)*2u;
  const unsigned kdst=lds0+LDS_K+wid*1024, vdst=lds0+LDS_V+wid*1024;
  #define DMA_K(t,slot) glds16(Kh+(long)(t)*KVBLK*DM,koff,(unsigned)__builtin_amdgcn_readfirstlane(kdst+(slot)))
  #define DMA_V(t,slot) glds16(Vh+(long)(t)*KVBLK*DM,voff,(unsigned)__builtin_amdgcn_readfirstlane(vdst+(slot)))
  const char*Kbase=shm+LDS_K; bf16x8 kf[8];
  const lds_cptr shm3=(lds_cptr)shm; const lds_cptr kp0=shm3+LDS_K+hi*1024+r32*16; const lds_cptr vp0=shm3+LDS_V+((lane>>4)&1)*32+(lane&3)*8+(4*hi+((lane&15)>>2))*64;
  DMA_K(0,0);DMA_V(0,0);DMA_K(1,SLOTB);
  bf16x8 qr[4];
  #pragma unroll
  for(int d0=0;d0<4;++d0)qr[d0]=*reinterpret_cast<const bf16x8*>(&Qw[(long)r32*DM+d0*16+hi*8]);
  float mhat=0.f,l_reg=0.f;f32x16 o[2];o[0]=f32x16{};o[1]=f32x16{};const f32x16 zz=f32x16{};
  const __attribute__((address_space(3))) float*tbr=(const __attribute__((address_space(3))) float*)((lds_cptr)shm+LDS_TB); const float cfar=__uint_as_float(__builtin_amdgcn_readfirstlane(__float_as_uint(tbr[0])));
  #define CMASK(P0,P1,t) do{ const int dc_=wt1-(t); \
    if(dc_<0||(t)<wt0){ const float mv_=MASKV-mhat; _Pragma("unroll") for(int r=0;r<16;++r){P0[r]=mv_;P1[r]=mv_;} } \
    else if(dc_>=3){ const float c_=cfar-mhat; _Pragma("unroll") for(int r=0;r<16;++r){P0[r]+=c_;P1[r]+=c_;} } \
    else{ const __attribute__((address_space(3))) float*tp_=tbr+(191-64*dc_-qi0-(int)(threadIdx.x&31u)+4*(int)((threadIdx.x>>5)&1u)); \
      _Pragma("unroll") for(int r=0;r<16;++r){ P0[r]+=tp_[(r&3)+8*(r>>2)]-mhat; P1[r]+=tp_[(r&3)+8*(r>>2)+32]-mhat; } } }while(0)
  bool resc=false;
  #define START(P0,P1) do{ const float rm=rowmax(P0,P1); resc=false; \
    { const float dl=rm; mhat=fadd_s(mhat,dl); \
      _Pragma("unroll") for(int r=0;r<16;++r){P0[r]=fsub_s(P0[r],dl);P1[r]=fsub_s(P1[r],dl);} \
      } \
    _Pragma("unroll") for(int r=0;r<16;++r)P0[r]=__builtin_amdgcn_exp2f(P0[r]); }while(0)
  #define RESC() do{ if(resc){ asm volatile("s_waitcnt lgkmcnt(0)":::"memory"); \
      _Pragma("unroll") for(int d_=0;d_<2;++d_) _Pragma("unroll") for(int r=0;r<16;++r)o[d_][r]*=wsf[crow(r,hi)]; } }while(0)
  f32x16 pA0,pA1,pB0,pB1;
  int sl_prev=0,sl_cur=0,sl_next=SLOTB;
  #define ROT() do{sl_prev=sl_cur;sl_cur=sl_next;sl_next=(sl_next==(NSLOT-1)*SLOTB)?0:sl_next+SLOTB;}while(0)
  DMA_K(2,2*SLOTB);
  WAIT_BAR(3);
  qkt(pA0,pA1,Kbase,qr,r32,hi);asm volatile("s_nop 15\n\ts_nop 7":"+v"(pA0),"+v"(pA1));CMASK(pA0,pA1,0);
  START(pA0,pA1);
  _Pragma("unroll") for(int r=0;r<16;++r)pA1[r]=__builtin_amdgcn_exp2f(pA1[r]);
  WAIT_BAR(0);
  DMA_K(3,0);DMA_V(1,SLOTB);
  ROT();
  kload8(kf,kp0+sl_cur);
  WAIT_BAR(2);
  s16x4 vlo[8],vhi[8]; u32x4 pw0,pw1,pw2,pw3;
  #define PKW(P,B) cvtpk_s(P[B],P[B+1])
  #define PAF(k) __builtin_bit_cast(bf16x8,pw##k)
  #define VFR(i) (bf16x8){vlo[i][0],vlo[i][1],vlo[i][2],vlo[i][3],vhi[i][0],vhi[i][1],vhi[i][2],vhi[i][3]}
  #define PIN(x) asm volatile("":"+v"(x))
  #define MX3(a,b,c) __builtin_fmaxf(__builtin_fmaxf((a),(b)),(c))
  #define GAPA(MF,A0,A1,A2,A3,W0,W1,PW) do{ MF; sacc+=A0; sacc+=A1; sacc+=A2; sacc+=A3; PIN(sacc); W0; W1; PIN(PW); SBAR(); }while(0)
  #define EX(v) __builtin_amdgcn_exp2f(v)
  #define GAPB(MF,X,B) do{ MF; X[B]=EX(X[B]); X[B+1]=EX(X[B+1]); X[B+2]=EX(X[B+2]); X[B+3]=EX(X[B+3]); PIN(X); SBAR(); }while(0)
  #define VRD(i) do{ vlo[i]=vtr(vp_+(((i)>>2)*4096+((i)&3)*1024)); vhi[i]=vtr(vp_+(((i)>>2)*4096+((i)&3)*1024+512)); }while(0)
  #define KRD(G,j) do{ if(G){ kload2(kf,kp0+sl_next,j); SBAR(); } }while(0)
  #define STEP(C0,C1,P0,P1,t,GK,GV,GL) do{ SBAR(); \
    const lds_cptr vp_=vp0+sl_prev; \
    VRD(0); SBAR(); float sacc=(P0[0]+P0[1]); \
    GAPA(C0=__builtin_amdgcn_mfma_f32_32x32x16_bf16(kf[0],qr[0],zz,0,0,0), P0[2],P0[3],P0[4],P0[5],     pw0[0]=PKW(P0,0), pw0[1]=PKW(P0,2), pw0); \
    VRD(4); SBAR(); GAPA(C1=__builtin_amdgcn_mfma_f32_32x32x16_bf16(kf[1],qr[0],zz,0,0,0), P0[6],P0[7],P0[8],P0[9],     pw0[2]=PKW(P0,4), pw0[3]=PKW(P0,6), pw0); \
    VRD(1); SBAR(); GAPA(C0=__builtin_amdgcn_mfma_f32_32x32x16_bf16(kf[2],qr[1],C0,0,0,0),   P0[10],P0[11],P0[12],P0[13], pw1[0]=PKW(P0,8), pw1[1]=PKW(P0,10), pw1); \
    VRD(5); SBAR(); GAPA(C1=__builtin_amdgcn_mfma_f32_32x32x16_bf16(kf[3],qr[1],C1,0,0,0),   P0[14],P0[15],P1[0],P1[1],   pw1[2]=PKW(P0,12),pw1[3]=PKW(P0,14), pw1); \
    VRD(2); SBAR(); GAPA(C0=__builtin_amdgcn_mfma_f32_32x32x16_bf16(kf[4],qr[2],C0,0,0,0),   P1[2],P1[3],P1[4],P1[5],     pw2[0]=PKW(P1,0), pw2[1]=PKW(P1,2), pw2); \
    VRD(6); SBAR(); GAPA(C1=__builtin_amdgcn_mfma_f32_32x32x16_bf16(kf[5],qr[2],C1,0,0,0),   P1[6],P1[7],P1[8],P1[9],     pw2[2]=PKW(P1,4), pw2[3]=PKW(P1,6), pw2); \
    VRD(3); SBAR(); GAPA(C0=__builtin_amdgcn_mfma_f32_32x32x16_bf16(kf[6],qr[3],C0,0,0,0),   P1[10],P1[11],P1[12],P1[13], pw3[0]=PKW(P1,8), pw3[1]=PKW(P1,10), pw3); \
    VRD(7); SBAR(); GAPA(C1=__builtin_amdgcn_mfma_f32_32x32x16_bf16(kf[7],qr[3],C1,0,0,0),   P1[14],P1[15],0.f,0.f,       pw3[2]=PKW(P1,12),pw3[3]=PKW(P1,14), pw3); \
    l_reg+=sacc; \
    if(GK){DMA_K((t)+3,sl_cur);} if(GV){DMA_V((t)+1,sl_next);} \
    CMASK(C0,C1,t); \
    { float a=MX3(C0[0],C0[1],C1[0]),b=MX3(C0[2],C0[3],C1[1]); a=MX3(a,C1[2],C1[3]); \
      _Pragma("unroll") for(int r=4;r<16;r+=4){a=MX3(a,C0[r],C0[r+1]);b=MX3(b,C0[r+2],C0[r+3]);a=MX3(a,C1[r],C1[r+1]);b=MX3(b,C1[r+2],C1[r+3]);} \
      float rm=__builtin_fmaxf(a,b); { auto rr=__builtin_amdgcn_permlane32_swap(__float_as_uint(rm),__float_as_uint(rm),false,false); rm=__builtin_fmaxf(__uint_as_float(rr[0]),__uint_as_float(rr[1])); } \
      resc=false; \
      if(__builtin_expect(__any(rm>(float)THRL),0)){ const float dl=__builtin_fmaxf(rm,0.f); mhat+=dl; \
        _Pragma("unroll") for(int r=0;r<16;++r){C0[r]-=dl;C1[r]-=dl;} \
        const float f=__builtin_amdgcn_exp2f(-dl); l_reg*=f; if(hi==0)wsf[r32]=f; resc=true; } } \
    SBAR(); \
    GAPB(o[0]=__builtin_amdgcn_mfma_f32_32x32x16_bf16(PAF(0),VFR(0),o[0],0,0,0), C0,0); \
    GAPB(o[1]=__builtin_amdgcn_mfma_f32_32x32x16_bf16(PAF(0),VFR(4),o[1],0,0,0), C0,4); \
    KRD(GL,0); GAPB(o[0]=__builtin_amdgcn_mfma_f32_32x32x16_bf16(PAF(1),VFR(1),o[0],0,0,0), C0,8); \
    KRD(GL,1); GAPB(o[1]=__builtin_amdgcn_mfma_f32_32x32x16_bf16(PAF(1),VFR(5),o[1],0,0,0), C0,12); \
    KRD(GL,2); GAPB(o[0]=__builtin_amdgcn_mfma_f32_32x32x16_bf16(PAF(2),VFR(2),o[0],0,0,0), C1,0); \
    KRD(GL,3); GAPB(o[1]=__builtin_amdgcn_mfma_f32_32x32x16_bf16(PAF(2),VFR(6),o[1],0,0,0), C1,4); \
    GAPB(o[0]=__builtin_amdgcn_mfma_f32_32x32x16_bf16(PAF(3),VFR(3),o[0],0,0,0), C1,8); \
    GAPB(o[1]=__builtin_amdgcn_mfma_f32_32x32x16_bf16(PAF(3),VFR(7),o[1],0,0,0), C1,12); \
    }while(0)
  int t=1;
  for(;t+5<NT;t+=2){
    STEP(pB0,pB1,pA0,pA1,t,true,true,true);     WAIT_BAR(2); RESC(); ROT();
    STEP(pA0,pA1,pB0,pB1,t+1,true,true,true);   WAIT_BAR(2); RESC(); ROT();
  }
  #define ENDW(tt) do{ if((tt)+3<NT){WAIT_BAR(2);} else if((tt)+2<NT){WAIT_BAR(1);} else {WAIT_BAR(0);} }while(0)
  for(;t+1<NT;t+=2){
    STEP(pB0,pB1,pA0,pA1,t,(t+3<NT),(t+1<NT),(t+1<NT));       ENDW(t);   RESC(); ROT();
    STEP(pA0,pA1,pB0,pB1,t+1,(t+4<NT),(t+2<NT),(t+2<NT));     ENDW(t+1); RESC(); ROT();
  }
  STEP(pB0,pB1,pA0,pA1,NT-1,false,false,false); RESC();
  { float sacc=pB0[0]+pB0[1]; _Pragma("unroll") for(int r=2;r<16;++r)sacc+=pB0[r]; _Pragma("unroll") for(int r=0;r<16;++r)sacc+=pB1[r]; l_reg+=sacc;
    pw0=(u32x4){PKW(pB0,0),PKW(pB0,2),PKW(pB0,4),PKW(pB0,6)};pw1=(u32x4){PKW(pB0,8),PKW(pB0,10),PKW(pB0,12),PKW(pB0,14)};pw2=(u32x4){PKW(pB1,0),PKW(pB1,2),PKW(pB1,4),PKW(pB1,6)};pw3=(u32x4){PKW(pB1,8),PKW(pB1,10),PKW(pB1,12),PKW(pB1,14)};
    SBAR(); pv(o,(int)(unsigned)(uintptr_t)(vp0+sl_cur),PAF(0),PAF(1),PAF(2),PAF(3)); }
  #undef PKW
  #undef PAF
  #undef VFR
  #undef PIN
  #undef MX3
  #undef GAPA
  #undef GAPB
  #undef EX
  #undef VRD
  #undef KRD
  #undef STEP
  #undef ENDW
  {auto rr=__builtin_amdgcn_permlane32_swap(__float_as_uint(l_reg),__float_as_uint(l_reg),false,false);l_reg=__uint_as_float(rr[0])+__uint_as_float(rr[1]);}
  if(hi==0)wsf[32+r32]=l_reg;asm volatile("s_waitcnt lgkmcnt(0)":::"memory");
  float rli[16];
  #pragma unroll
  for(int r=0;r<16;++r)rli[r]=__builtin_amdgcn_rcpf(wsf[32+crow(r,hi)]);
  { bf16*stg=(bf16*)(shm+LDS_OST)+wid*2048;
    #pragma unroll
    for(int r=0;r<16;++r){const int orow=crow(r,hi);
      #pragma unroll
      for(int d0=0;d0<2;++d0){ const float v_=o[d0][r]*rli[r]; const unsigned u_=__builtin_bit_cast(unsigned,v_); stg[orow*64+d0*32+r32]=(bf16)((u_+0x7fffu+((u_>>16)&1u))>>16); } }
    asm volatile("s_waitcnt lgkmcnt(0)":::"memory");
    #pragma unroll
    for(int i=0;i<4;++i){const int row=i*8+(lane>>3),ch=lane&7; const u32x4 v=*(const u32x4*)(stg+row*64+ch*8); *(u32x4*)(Ow+(long)row*LDO+ch*8)=v;} }
  asm volatile("s_waitcnt lgkmcnt(0)\n\ts_barrier":::"memory");
  #undef DMA_K
  #undef DMA_V
  #undef CMASK
  #undef START
  #undef RESC
  #undef ROT
}
#undef SBAR
#undef WAIT_BAR
}
namespace hgrn2 {
using bf16x8 = __attribute__((ext_vector_type(8))) short;
using f32x16 = __attribute__((ext_vector_type(16))) float;
using f32x4 = __attribute__((ext_vector_type(4))) float;
using u32x4 = __attribute__((ext_vector_type(4))) unsigned;
using u32x2 = __attribute__((ext_vector_type(2))) unsigned;
typedef unsigned short bf16;
#define HG_LAS __attribute__((address_space(3)))
constexpr int QS = 136, KS = 40, OS = 33;
constexpr int QD = 0, KD = QD + 32 * QS * 2, KET = KD + 32 * QS * 2, VT = KET + 128 * KS * 2, DEC = VT + 128 * KS * 2, PBSZ = DEC + 512;
constexpr int OT = 2 * PBSZ, SSP = OT + 4 * 32 * OS * 4, WG_BYTES = SSP + 2 * 512;
static_assert(WG_BYTES <= 131072 && PBSZ % 16 == 0 && OT % 16 == 0, "hgrn LDS map");
__device__ __forceinline__ int crow(int r, int hi) { return (r & 3) + 8 * (r >> 2) + 4 * hi; }
typedef float f32x2_t __attribute__((ext_vector_type(2))); typedef __bf16 bf16x2_t __attribute__((ext_vector_type(2)));
__device__ __forceinline__ unsigned cvtpk(float lo, float hi) { f32x2_t v = {lo, hi}; bf16x2_t b = __builtin_convertvector(v, bf16x2_t); return __builtin_bit_cast(unsigned, b); }
__device__ __forceinline__ float bf2f(unsigned short b) { return __builtin_bit_cast(float, (unsigned)b << 16); }
__device__ __forceinline__ bf16x8 packacc(const f32x16& x, int s) {
    u32x4 p; p[0] = cvtpk(x[8 * s], x[8 * s + 1]); p[1] = cvtpk(x[8 * s + 2], x[8 * s + 3]); p[2] = cvtpk(x[8 * s + 4], x[8 * s + 5]); p[3] = cvtpk(x[8 * s + 6], x[8 * s + 7]);
    return __builtin_bit_cast(bf16x8, p); }
__device__ __forceinline__ bf16x8 ldperm(const HG_LAS bf16* rowp, int k0, int hi) {
    const u32x2 a = *(const HG_LAS u32x2*)(rowp + k0 + 4 * hi), b = *(const HG_LAS u32x2*)(rowp + k0 + 8 + 4 * hi);
    u32x4 p; p[0] = a[0]; p[1] = a[1]; p[2] = b[0]; p[3] = b[1]; return __builtin_bit_cast(bf16x8, p); }
#define HG_MFMA(a, b, c) __builtin_amdgcn_mfma_f32_32x32x16_bf16((a), (b), (c), 0, 0, 0)

template <int LDP, int QOFF, int FOFF, int IOFF, int GOFF, int LDO, int OOFF, int SEQ_>
__device__ __forceinline__ void hgrn_pair(const bf16* P, bf16* O, const float* lb, const float* gw, int b, int h, HG_LAS unsigned char* lds, float eps) {
    constexpr int NB = SEQ_ / 32;
    const int tid = threadIdx.x, tid4 = tid & 255, lane = tid & 63, r32 = lane & 31, hi = lane >> 5; const int wave = __builtin_amdgcn_readfirstlane(tid >> 6); const int w4 = wave & 3;
    const size_t seq0 = (size_t)b * SEQ_;
    if (wave >= 4) {
        const int pd = tid4 >> 1, half = tid4 & 1;
        const bf16* src0 = P + (seq0 + 16 * half) * LDP + h * 128 + pd;
        unsigned short af[16], aq[16], av[16], bf_[16], bq[16], bv[16];
#define HG_LOAD(F_, Q_, V_, n) do { const bf16* s_ = src0 + (size_t)(n) * 32 * LDP; _Pragma("unroll") for (int i = 0; i < 16; ++i) { F_[i] = s_[(size_t)i * LDP + FOFF]; Q_[i] = s_[(size_t)i * LDP + QOFF]; V_[i] = s_[(size_t)i * LDP + IOFF]; } } while (0)
#define HG_PREP(F_, Q_, V_, pbo) do { \
        HG_LAS bf16* qd = (HG_LAS bf16*)(lds + (pbo) + QD); HG_LAS bf16* kd = (HG_LAS bf16*)(lds + (pbo) + KD); HG_LAS bf16* ket = (HG_LAS bf16*)(lds + (pbo) + KET); HG_LAS bf16* vt = (HG_LAS bf16*)(lds + (pbo) + VT); \
        HG_LAS float* dec = (HG_LAS float*)(lds + (pbo) + DEC); \
        float fv[16], pv_[16]; float run = 1.f; \
        _Pragma("unroll") for (int i = 0; i < 16; ++i) { const float f = (float)(unsigned)F_[i] * (1.f / 65536.f); run *= f; fv[i] = f; pv_[i] = run; } \
        const float other = __shfl_xor(run, 1); const float pre = half ? other : 1.f, dtot = run * other; \
        unsigned kew[8], vw[8]; \
        _Pragma("unroll") for (int i = 0; i < 16; i += 2) { const int l0 = 16 * half + i; \
            const float p0 = pv_[i] * pre, p1 = pv_[i + 1] * pre; \
            const float qa = bf2f(Q_[i]) * p0, qb = bf2f(Q_[i + 1]) * p1; \
            const float ka = (1.f - fv[i]) * __builtin_amdgcn_rcpf(p0), kb = (1.f - fv[i + 1]) * __builtin_amdgcn_rcpf(p1); \
            qd[l0 * QS + pd] = (bf16)(cvtpk(qa, qa) & 0xffffu); qd[(l0 + 1) * QS + pd] = (bf16)(cvtpk(qb, qb) & 0xffffu); \
            kd[l0 * QS + pd] = (bf16)(cvtpk(ka, ka) & 0xffffu); kd[(l0 + 1) * QS + pd] = (bf16)(cvtpk(kb, kb) & 0xffffu); \
            kew[i >> 1] = cvtpk(ka * dtot, kb * dtot); vw[i >> 1] = (unsigned)V_[i] | ((unsigned)V_[i + 1] << 16); } \
        *(HG_LAS u32x4*)(ket + pd * KS + 16 * half) = (u32x4){kew[0], kew[1], kew[2], kew[3]}; *(HG_LAS u32x4*)(ket + pd * KS + 16 * half + 8) = (u32x4){kew[4], kew[5], kew[6], kew[7]}; \
        *(HG_LAS u32x4*)(vt + pd * KS + 16 * half) = (u32x4){vw[0], vw[1], vw[2], vw[3]}; *(HG_LAS u32x4*)(vt + pd * KS + 16 * half + 8) = (u32x4){vw[4], vw[5], vw[6], vw[7]}; \
        if (half == 0) dec[pd] = dtot; } while (0)
        HG_LOAD(af, aq, av, 0);
#pragma unroll 1
        for (int n = 0; n < NB + 2; n += 2) {
            if (n + 1 < NB) HG_LOAD(bf_, bq, bv, n + 1);
            if (n < NB) HG_PREP(af, aq, av, 0);
            __syncthreads();
            if (n + 2 < NB) HG_LOAD(af, aq, av, n + 2);
            if (n + 1 < NB) HG_PREP(bf_, bq, bv, PBSZ);
            __syncthreads();
        }
#undef HG_LOAD
#undef HG_PREP
    } else {
        HG_LAS float* ot = (HG_LAS float*)(lds + OT) + w4 * 32 * OS;
        const int fl_ = lane & 31, eh = lane >> 5, ecol = 32 * w4 + 16 * eh;
        float gwv[16];
#pragma unroll
        for (int k = 0; k < 16; ++k) gwv[k] = gw[h * 128 + ecol + k];
        f32x16 S[4];
#pragma unroll
        for (int k = 0; k < 4; ++k) S[k] = f32x16{};
        float ov[16]; u32x4 g0 = {0u, 0u, 0u, 0u}, g1 = {0u, 0u, 0u, 0u};
#pragma unroll
        for (int k = 0; k < 16; ++k) ov[k] = 0.f;
#define HG_MMA(nb, pbo, sso) do { \
        const HG_LAS bf16* qd = (const HG_LAS bf16*)(lds + (pbo) + QD); const HG_LAS bf16* kd = (const HG_LAS bf16*)(lds + (pbo) + KD); const HG_LAS bf16* ket = (const HG_LAS bf16*)(lds + (pbo) + KET); \
        const HG_LAS bf16* vt = (const HG_LAS bf16*)(lds + (pbo) + VT); const HG_LAS float* dec = (const HG_LAS float*)(lds + (pbo) + DEC); HG_LAS float* ssp = (HG_LAS float*)(lds + SSP + (sso)); \
        { const bf16* gsrc = P + (seq0 + (size_t)(nb) * 32 + fl_) * LDP + GOFF + h * 128 + ecol; g0 = *(const u32x4*)(gsrc); g1 = *(const u32x4*)(gsrc + 8); } \
        f32x16 X = f32x16{}; \
        _Pragma("unroll") for (int s = 0; s < 8; ++s) { const bf16x8 a = *(const HG_LAS bf16x8*)(kd + r32 * QS + 16 * s + 8 * hi), bq_ = *(const HG_LAS bf16x8*)(qd + r32 * QS + 16 * s + 8 * hi); X = HG_MFMA(a, bq_, X); } \
        _Pragma("unroll") for (int r = 0; r < 16; ++r) X[r] = crow(r, hi) <= r32 ? X[r] : 0.f; \
        const bf16x8 vf0 = ldperm(vt + (32 * w4 + r32) * KS, 0, hi), vf1 = ldperm(vt + (32 * w4 + r32) * KS, 16, hi); \
        f32x16 Oa = f32x16{}; \
        Oa = HG_MFMA(packacc(X, 0), vf0, Oa); Oa = HG_MFMA(packacc(X, 1), vf1, Oa); \
        _Pragma("unroll") for (int blk = 0; blk < 4; ++blk) _Pragma("unroll") for (int s = 0; s < 2; ++s) Oa = HG_MFMA(ldperm(qd + r32 * QS, 32 * blk + 16 * s, hi), packacc(S[blk], s), Oa); \
        _Pragma("unroll") for (int blk = 0; blk < 4; ++blk) { \
            _Pragma("unroll") for (int q4 = 0; q4 < 4; ++q4) { const f32x4 dv = *(const HG_LAS f32x4*)(dec + 32 * blk + 8 * q4 + 4 * hi); \
                _Pragma("unroll") for (int e = 0; e < 4; ++e) S[blk][4 * q4 + e] *= dv[e]; } \
            S[blk] = HG_MFMA(ldperm(ket + (32 * blk + r32) * KS, 0, hi), vf0, S[blk]); \
            S[blk] = HG_MFMA(ldperm(ket + (32 * blk + r32) * KS, 16, hi), vf1, S[blk]); } \
        _Pragma("unroll") for (int r = 0; r < 16; ++r) ot[crow(r, hi) * OS + r32] = Oa[r]; \
        asm volatile("s_waitcnt lgkmcnt(0)" ::: "memory"); \
        float ss = 0.f; \
        _Pragma("unroll") for (int k = 0; k < 16; ++k) { ov[k] = ot[fl_ * OS + 16 * eh + k]; ss += ov[k] * ov[k]; } \
        ss += __shfl_xor(ss, 32); \
        if (lane < 32) ssp[w4 * 32 + fl_] = ss; } while (0)
#define HG_FIN(nb, sso) do { \
        const HG_LAS float* ssp = (const HG_LAS float*)(lds + SSP + (sso)); \
        const float tot = (ssp[fl_] + ssp[32 + fl_]) + (ssp[64 + fl_] + ssp[96 + fl_]); const float rstd = 1.f / sqrtf(tot * (1.f / 128.f) + eps); \
        unsigned ow[8]; \
        _Pragma("unroll") for (int k = 0; k < 16; k += 2) { const unsigned gwd = k < 8 ? g0[k >> 1] : g1[(k - 8) >> 1]; \
            const float ga = bf2f((unsigned short)(gwd & 0xffffu)), gb = bf2f((unsigned short)(gwd >> 16)); \
            const float ra = ov[k] * rstd * gwv[k] * ga, rb = ov[k + 1] * rstd * gwv[k + 1] * gb;     \
            ow[k >> 1] = cvtpk(ra, rb); } \
        bf16* dst = O + (seq0 + (size_t)(nb) * 32 + fl_) * LDO + OOFF + h * 128 + ecol; \
        *(u32x4*)(dst) = (u32x4){ow[0], ow[1], ow[2], ow[3]}; *(u32x4*)(dst + 8) = (u32x4){ow[4], ow[5], ow[6], ow[7]}; } while (0)
#pragma unroll 1
        for (int n = 0; n < NB + 2; n += 2) {
            if (n >= 2) HG_FIN(n - 2, 0);
            if (n >= 1 && n <= NB) HG_MMA(n - 1, PBSZ, 512);
            __syncthreads();
            if (n >= 1 && n <= NB) HG_FIN(n - 1, 512);
            if (n < NB) HG_MMA(n, 0, 0);
            __syncthreads();
        }
#undef HG_MMA
#undef HG_FIN
    }
    __syncthreads();
}
#undef HG_MFMA
}
#define GAS __attribute__((address_space(1)))
#define LAS __attribute__((address_space(3)))
typedef unsigned short bf16;
typedef unsigned v4u __attribute__((ext_vector_type(4)));
typedef float f32x4 __attribute__((ext_vector_type(4)));
typedef short bf16x8 __attribute__((ext_vector_type(8)));
typedef GAS unsigned gu32;
typedef GAS unsigned long long gu64;
#define RLX_AGENT __ATOMIC_RELAXED, __HIP_MEMORY_SCOPE_AGENT
#define LDS_WAIT() asm volatile("s_waitcnt lgkmcnt(0)" ::: "memory")
#define VM_WAIT() asm volatile("s_waitcnt vmcnt(0)" ::: "memory")
__device__ __forceinline__ unsigned long long rt() { return __builtin_amdgcn_s_memrealtime(); }
__device__ __forceinline__ unsigned f2bf(float f) { unsigned u = __builtin_bit_cast(unsigned, f); return (u + 0x7fffu + ((u >> 16) & 1u)) >> 16; }
__device__ __forceinline__ unsigned pk2(float lo, float hi) { return f2bf(lo) | (f2bf(hi) << 16); }

#define XB_TMO      128
#define XB_XCNT(j)  (256  + 64 * (j))
#define XB_XSUB(j)  (1280 + 64 * (j))
#define XB_XGEN(j)  (2304 + 64 * (j))
#define XB_TOP      3328
#define XB_TOPGEN   3392
#define XCD_BAR_WORDS 3456
#define XB_SPIN_CAP (1u << 18)

__device__ __forceinline__ unsigned xb_ld(unsigned* p)              { return __hip_atomic_load(p, __ATOMIC_RELAXED, __HIP_MEMORY_SCOPE_AGENT); }
__device__ __forceinline__ unsigned xb_add(unsigned* p, unsigned v) { return __hip_atomic_fetch_add(p, v, __ATOMIC_RELAXED, __HIP_MEMORY_SCOPE_AGENT); }
__device__ __forceinline__ unsigned xb_xcc_id() { return (unsigned)__builtin_amdgcn_s_getreg((3 << 11) | 20) & 0xFu; }
#define XB_SPIN(cond, bar) do { unsigned _sp = 0; while (cond) { __builtin_amdgcn_s_sleep(1); \
    if ((++_sp & 255u) == 0u) { if (xb_ld(&(bar)[XB_TMO])) break; if (_sp > XB_SPIN_CAP) { atomicAdd(&(bar)[XB_TMO], 1u); break; } } } } while (0)

struct XcdBarrier {
    unsigned* bar; unsigned x;
    volatile LAS unsigned* st;
};

__device__ __forceinline__ XcdBarrier xcd_barrier_post(unsigned* bar, volatile LAS unsigned* st) {
    XcdBarrier b; b.bar = bar; b.x = xb_xcc_id(); b.st = st;
    if (threadIdx.x == 0) (void)xb_add(&bar[XB_XCNT(b.x)], 1u);
    return b;
}
__device__ __forceinline__ void xcd_barrier_complete(unsigned* bar, unsigned x, unsigned& nloc, unsigned& nx) {
    const unsigned G = gridDim.x * gridDim.y * gridDim.z;
    unsigned sum, cnt, mine, sp = 0u;
    for (;;) {
        sum = 0u; cnt = 0u; mine = 0u;
#pragma unroll
        for (unsigned j = 0; j < 16; ++j) { const unsigned c = xb_ld(&bar[XB_XCNT(j)]); sum += c; cnt += (c > 0u) ? 1u : 0u; mine = (j == x) ? c : mine; }
        if (sum == G) break;
        __builtin_amdgcn_s_sleep(1);
        if ((++sp & 255u) == 0u) { if (xb_ld(&bar[XB_TMO])) break; if (sp > XB_SPIN_CAP) { atomicAdd(&bar[XB_TMO], 1u); break; } }
    }
    nloc = mine > 0u ? mine : 1u; nx = cnt > 0u ? cnt : 1u;
}

__device__ __forceinline__ void xcd_barrier(const XcdBarrier& b) {
    asm volatile("s_waitcnt vmcnt(0)" ::: "memory");
    __syncthreads();
    if (threadIdx.x == 0) {
        unsigned* bar = b.bar;
        __builtin_amdgcn_s_waitcnt(0);
        unsigned nloc = b.st[0], nx = b.st[1];
        if (nloc == 0u) { xcd_barrier_complete(bar, b.x, nloc, nx); b.st[0] = nloc; b.st[1] = nx; }
        const unsigned old = xb_add(&bar[XB_XSUB(b.x)], 1u);
        const unsigned gen = old / nloc;
        if (old + 1u == (gen + 1u) * nloc) {
            __builtin_amdgcn_fence(__ATOMIC_RELEASE, "agent");
            asm volatile("s_waitcnt vmcnt(0)" ::: "memory");
            const unsigned og = xb_add(&bar[XB_TOP], 1u);
            const unsigned tg = og / nx;
            if (og + 1u == (tg + 1u) * nx) xb_add(&bar[XB_TOPGEN], 1u);
            else XB_SPIN(xb_ld(&bar[XB_TOPGEN]) == tg, bar);
            __builtin_amdgcn_fence(__ATOMIC_ACQUIRE, "agent");
            xb_add(&bar[XB_XGEN(b.x)], 1u);
            asm volatile("s_waitcnt vmcnt(0)" ::: "memory");
        } else {
            XB_SPIN(xb_ld(&bar[XB_XGEN(b.x)]) == gen, bar);
            __builtin_amdgcn_fence(__ATOMIC_ACQUIRE, "agent");
            asm volatile("s_waitcnt vmcnt(0)" ::: "memory");
        }
    }
    __syncthreads();
}
struct Frame {
    LAS unsigned char* lds; char* ldsg;
    volatile LAS unsigned* MISC;
    gu32* ctl;
    int tid, lane, wave, G;
    unsigned char* ws;
    const float *x, *even_w_in, *even_w_out, *even_sinks, *lb_logits, *hgrn_norm_w, *odd_w_in, *odd_w_out, *odd_rel, *w_up, *conv_w, *conv_b, *w_down, *norm_w;
    float* out;
};
__device__ __forceinline__ float bf2f(bf16 b) { return __builtin_bit_cast(float, (unsigned)b << 16); }
__device__ __forceinline__ float wave_sum(float v) {
#pragma unroll
    for (int o = 1; o < 64; o <<= 1) v += __shfl_xor(v, o);
    return v;
}
__device__ __forceinline__ int colmap(int cmode, int n) {
    if (cmode == 1) { if (n >= 640) return n; const int p = n & 63; return (n - p) + (p >> 1) + 32 * (p & 1); }
    if (cmode == 2) { const int pn = n >> 8, r = n & 255; return r < 128 ? pn * 128 + r : DFF + pn * 128 + (r - 128); }
    return n;
}
__device__ __forceinline__ void transpose_item(const float* W, int K, int Nsrc, int Nout, bf16* WT, const float* kscale, int cmode, LAS float* scr, int item, int lane) {
    const int nblk = Nout / 32, kb = item / nblk, nb = item % nblk, k0 = 64 * kb, n0 = 32 * nb;
    const int nsrc = colmap(cmode, n0 + (lane & 31));
#pragma unroll 8
    for (int i = 0; i < 32; ++i) { const int kk = 2 * i + (lane >> 5); float w = W[(size_t)(k0 + kk) * Nsrc + nsrc]; if (kscale) w *= kscale[k0 + kk]; scr[kk * 33 + (lane & 31)] = w; }
    LDS_WAIT(); asm volatile("" ::: "memory");
    const int c = lane & 7;
#pragma unroll
    for (int j = 0; j < 4; ++j) { const int n = (lane >> 3) + 8 * j; const LAS float* s = scr + (8 * c) * 33 + n;
        v4u o; o.x = pk2(s[0 * 33], s[1 * 33]); o.y = pk2(s[2 * 33], s[3 * 33]); o.z = pk2(s[4 * 33], s[5 * 33]); o.w = pk2(s[6 * 33], s[7 * 33]);
        *(GAS v4u*)(WT + (size_t)(n0 + n) * K + k0 + 8 * c) = o; }
    LDS_WAIT(); asm volatile("" ::: "memory");
}
__device__ __forceinline__ void rms_row_to_bf16(int lane, const float* xrow, bf16* orow, float* scp) {
    const GAS f32x4* xr = (const GAS f32x4*)xrow + lane;
    f32x4 v[4]; float s = 0.f;
#pragma unroll
    for (int j = 0; j < 4; ++j) { v[j] = xr[64 * j]; s += (v[j].x * v[j].x + v[j].y * v[j].y) + (v[j].z * v[j].z + v[j].w * v[j].w); }
    const float rms = sqrtf(wave_sum(s) * (1.f / D) + EPS), rstd = 1.f / rms;
    if (lane == 0) *scp = rms;
    GAS unsigned long long* o8 = (GAS unsigned long long*)orow + lane;
#pragma unroll
    for (int j = 0; j < 4; ++j) o8[64 * j] = (unsigned long long)pk2(v[j].x * rstd, v[j].y * rstd) | ((unsigned long long)pk2(v[j].z * rstd, v[j].w * rstd) << 32);
}
__device__ __forceinline__ void p_prologue(Frame& F) {
    LAS float* scr = (LAS float*)(F.lds + RING_OFF + F.wave * 16384);
    const int gw = blockIdx.x * NWAVES + F.wave, NGW = F.G * NWAVES;
#pragma unroll 1
    for (int mat = 0; mat < 8; ++mat) {
        const float* W; int K, Nsrc, Nout, cmode = 0; const float* ks = nullptr; size_t dst;
        if (mat == 0)      { W = F.even_w_in;  K = D; Nsrc = EVEN_IN; Nout = EVEN_IN; cmode = 1; ks = F.norm_w + 0 * D; dst = WS_WIN0; }
        else if (mat == 1) { W = F.even_w_out; K = D; Nsrc = D; Nout = D; dst = WS_WOUT0; }
        else if (mat == 2) { W = F.odd_w_in;   K = D; Nsrc = ODD_IN; Nout = ODD_IN; ks = F.norm_w + 4 * D; dst = WS_WIN1; }
        else if (mat == 3) { W = F.odd_w_out;  K = D; Nsrc = D; Nout = D; dst = WS_WOUT1; }
        else if (mat < 6)  { const int l = mat - 4; W = F.w_up + (size_t)l * D * UPN; K = D; Nsrc = UPN; Nout = UPN; cmode = 2; ks = F.norm_w + (size_t)(l * 4 + 2) * D; dst = WS_WUP + (size_t)l * 11 * MiB; }
        else               { const int l = mat - 6; W = F.w_down + (size_t)l * DFF * D; K = DFF; Nsrc = D; Nout = D; dst = WS_WDN + (size_t)l * 5632 * 1024; }
        const int nitems = (K / 64) * (Nout / 32);
        for (int it = gw; it < nitems; it += NGW) transpose_item(W, K, Nsrc, Nout, (bf16*)(F.ws + dst), ks, cmode, scr, it, F.lane);
    }
    { float* tab = (float*)(F.ws + WS_TAB); const int gt = blockIdx.x * (NWAVES * 64) + F.tid, NT = F.G * NWAVES * 64;
      for (int e = gt; e < SEQ * 32; e += NT) { const int t = e >> 5, i = e & 31; const float inv = powf(10000.f, -(float)(2 * i) / 64.f); const float ang = (float)t * inv;
          tab[2 * e] = (float)cos((double)ang); tab[2 * e + 1] = (float)sin((double)ang); }
      float* lb = (float*)(F.ws + WS_LB);
      for (int e = gt; e < 512; e += NT) { const float a = F.lb_logits[e], b = F.lb_logits[512 + e]; const float mx = fmaxf(a, b); const float ea = expf(a - mx), eb = expf(b - mx); lb[e] = ea / (ea + eb); } }
    for (int m0 = gw; m0 < M; m0 += 2 * NGW) {
        const int m1 = m0 + NGW < M ? m0 + NGW : m0;
        const GAS f32x4* xa = (const GAS f32x4*)(F.x + (size_t)m0 * D) + F.lane; const GAS f32x4* xb = (const GAS f32x4*)(F.x + (size_t)m1 * D) + F.lane;
        f32x4 va[4], vb[4]; float sa = 0.f, sb = 0.f;
#pragma unroll
        for (int j = 0; j < 4; ++j) { va[j] = xa[64 * j]; vb[j] = xb[64 * j]; }
#pragma unroll
        for (int j = 0; j < 4; ++j) { sa += (va[j].x * va[j].x + va[j].y * va[j].y) + (va[j].z * va[j].z + va[j].w * va[j].w); sb += (vb[j].x * vb[j].x + vb[j].y * vb[j].y) + (vb[j].z * vb[j].z + vb[j].w * vb[j].w); }
        const float rmsa = sqrtf(wave_sum(sa) * (1.f / D) + EPS), rmsb = sqrtf(wave_sum(sb) * (1.f / D) + EPS), ra = 1.f / rmsa, rb = 1.f / rmsb;
        float* scp = (float*)(F.ws + WS_SC);
        GAS unsigned long long* oa = (GAS unsigned long long*)((bf16*)(F.ws + WS_XN) + (size_t)m0 * D) + F.lane; GAS unsigned long long* ob = (GAS unsigned long long*)((bf16*)(F.ws + WS_XN) + (size_t)m1 * D) + F.lane;
        if (F.lane == 0) { scp[m0] = rmsa; if (m1 != m0) scp[m1] = rmsb; }
#pragma unroll
        for (int j = 0; j < 4; ++j) oa[64 * j] = (unsigned long long)pk2(va[j].x * ra, va[j].y * ra) | ((unsigned long long)pk2(va[j].z * ra, va[j].w * ra) << 32);
        if (m1 != m0) {
#pragma unroll
            for (int j = 0; j < 4; ++j) ob[64 * j] = (unsigned long long)pk2(vb[j].x * rb, vb[j].y * rb) | ((unsigned long long)pk2(vb[j].z * rb, vb[j].w * rb) << 32); }
    }
}
__device__ __forceinline__ void p_norm(Frame& F, bf16* XNp, float* sc, const bf16* Y, const float* g, float* outf) {
    const int gw = blockIdx.x * NWAVES + F.wave, NGW = F.G * NWAVES;
    f32x4 gv[4];
#pragma unroll
    for (int j = 0; j < 4; ++j) gv[j] = ((const GAS f32x4*)g)[F.lane + 64 * j];
    constexpr int R = 2;
    for (int m0 = gw; m0 < M; m0 += R * NGW) {
        unsigned long long wx[R][4], wy[R][4]; float scm[R];
#pragma unroll
        for (int r = 0; r < R; ++r) { const int m = m0 + r * NGW; const int mm = m < M ? m : m0;
            const GAS unsigned long long* xr = (const GAS unsigned long long*)(XNp + (size_t)mm * D) + F.lane;
            const GAS unsigned long long* yr = (const GAS unsigned long long*)(Y + (size_t)mm * D) + F.lane;
            scm[r] = sc[mm];
#pragma unroll
            for (int j = 0; j < 4; ++j) { wx[r][j] = xr[64 * j]; wy[r][j] = yr[64 * j]; } }
#pragma unroll
        for (int r = 0; r < R; ++r) { const int m = m0 + r * NGW; if (m >= M) break;
            f32x4 h[4], y[4]; float s = 0.f;
#pragma unroll
            for (int j = 0; j < 4; ++j) { const unsigned long long a = wx[r][j], w = wy[r][j];
                h[j].x = __builtin_bit_cast(float, (unsigned)(a & 0xffffu) << 16); h[j].y = __builtin_bit_cast(float, (unsigned)(a >> 16 & 0xffffu) << 16);
                h[j].z = __builtin_bit_cast(float, (unsigned)(a >> 32 & 0xffffu) << 16); h[j].w = __builtin_bit_cast(float, (unsigned)(a >> 48 & 0xffffu) << 16);
                y[j].x = __builtin_bit_cast(float, (unsigned)(w & 0xffffu) << 16); y[j].y = __builtin_bit_cast(float, (unsigned)(w >> 16 & 0xffffu) << 16);
                y[j].z = __builtin_bit_cast(float, (unsigned)(w >> 32 & 0xffffu) << 16); y[j].w = __builtin_bit_cast(float, (unsigned)(w >> 48 & 0xffffu) << 16);
                s += (y[j].x * y[j].x + y[j].y * y[j].y) + (y[j].z * y[j].z + y[j].w * y[j].w); }
            const float r1 = 1.f / sqrtf(wave_sum(s) * (1.f / D) + EPS); float s2 = 0.f;
#pragma unroll
            for (int j = 0; j < 4; ++j) { h[j] = h[j] * scm[r] + y[j] * r1 * gv[j]; s2 += (h[j].x * h[j].x + h[j].y * h[j].y) + (h[j].z * h[j].z + h[j].w * h[j].w); }
            if (outf) { GAS f32x4* ho = (GAS f32x4*)(outf + (size_t)m * D) + F.lane;
#pragma unroll
                for (int j = 0; j < 4; ++j) ho[64 * j] = h[j]; }
            else { const float rms = sqrtf(wave_sum(s2) * (1.f / D) + EPS), r2 = 1.f / rms;
                if (F.lane == 0) sc[m] = rms;
                GAS unsigned long long* xo = (GAS unsigned long long*)(XNp + (size_t)m * D) + F.lane;
#pragma unroll
                for (int j = 0; j < 4; ++j) xo[64 * j] = (unsigned long long)pk2(h[j].x * r2, h[j].y * r2) | ((unsigned long long)pk2(h[j].z * r2, h[j].w * r2) << 32); }
        }
    }
}
__device__ __forceinline__ void p_fixup(Frame& F, bf16* H, const bf16* UL, const bf16* UF, const bf16* VF, const float* cw, const float* cb) {
    const int gt = blockIdx.x * (NWAVES * 64) + F.tid, NT = F.G * NWAVES * 64;
    constexpr int CH = DFF / 8, NIT = (M / 64) * 2 * CH;
    for (int it = gt; it < NIT; it += NT) {
        const int ch = it % CH, gr = it / CH, r = gr & 1, g = gr >> 1, j0 = ch * 8;
        const bool has_prev = (g & 31) != 0;
        const v4u z4 = {0u, 0u, 0u, 0u};
        const v4u u0 = *(const GAS v4u*)(UF + ((size_t)g * 2 + r) * DFF + j0);
        const v4u vv = *(const GAS v4u*)(VF + ((size_t)g * 2 + r) * DFF + j0);
        const v4u pl1 = has_prev ? *(const GAS v4u*)(UL + ((size_t)(g - 1) * 2 + 1) * DFF + j0) : z4;
        const v4u pl0 = has_prev ? *(const GAS v4u*)(UL + ((size_t)(g - 1) * 2 + 0) * DFF + j0) : z4;
        const v4u uf0 = *(const GAS v4u*)(UF + ((size_t)g * 2 + 0) * DFF + j0);
        const v4u um1 = r ? uf0 : pl1, um2 = r ? pl1 : pl0;
        float hh[8];
        const f32x4 kb0 = *(const GAS f32x4*)(cb + j0), kb1 = *(const GAS f32x4*)(cb + j0 + 4), k00 = *(const GAS f32x4*)(cw + j0), k01 = *(const GAS f32x4*)(cw + j0 + 4),
                    k10 = *(const GAS f32x4*)(cw + DFF + j0), k11 = *(const GAS f32x4*)(cw + DFF + j0 + 4), k20 = *(const GAS f32x4*)(cw + 2 * DFF + j0), k21 = *(const GAS f32x4*)(cw + 2 * DFF + j0 + 4);
#pragma unroll
        for (int e = 0; e < 8; ++e) { const int sh = (e & 1) * 16; const unsigned wa = u0[e >> 1], wb = um1[e >> 1], wc_ = um2[e >> 1], wv = vv[e >> 1];
            const float a = bf2f((bf16)(wa >> sh)), b = bf2f((bf16)(wb >> sh)), c = bf2f((bf16)(wc_ >> sh)), v = bf2f((bf16)(wv >> sh));
            const float pre = (e < 4 ? kb0[e & 3] : kb1[e & 3]) + (e < 4 ? k00[e & 3] : k01[e & 3]) * c + (e < 4 ? k10[e & 3] : k11[e & 3]) * b + (e < 4 ? k20[e & 3] : k21[e & 3]) * a;
            const pg8::f32x2 gg = pg8::gelu_pk((pg8::f32x2){pre, pre}); hh[e] = gg.x * v; }
        v4u o; o.x = pk2(hh[0], hh[1]); o.y = pk2(hh[2], hh[3]); o.z = pk2(hh[4], hh[5]); o.w = pk2(hh[6], hh[7]);
        *(GAS v4u*)(H + ((size_t)g * 64 + r) * DFF + j0) = o;
    }
}
__device__ __forceinline__ void p_attn_plain(Frame& F, const bf16* Q, int ldq, const bf16* Kp, int ldk, const bf16* Vp, int ldv, bf16* O, int ldo, int HQ, int GQ, int nprev, const float* sinks, const float* rel) {
    const int gt = blockIdx.x * (NWAVES * 64) + F.tid, NT = F.G * NWAVES * 64;
    const long total = (long)M * HQ;
    for (long idx = gt; idx < total; idx += NT) {
        const int hq = (int)(idx / M), row = (int)(idx % M), hk = hq / GQ;
        const int b = row / SEQ, t = row % SEQ, c = t >> 6, c0 = c - nprev < 0 ? 0 : c - nprev;
        float q[64], o[64];
        { const GAS v4u* qp = (const GAS v4u*)(Q + (size_t)row * ldq + hq * 64);
#pragma unroll
          for (int i = 0; i < 8; ++i) { const v4u w = qp[i];
#pragma unroll
              for (int e = 0; e < 4; ++e) { const unsigned ww = w[e]; q[8 * i + 2 * e] = bf2f((bf16)(ww & 0xffffu)); q[8 * i + 2 * e + 1] = bf2f((bf16)(ww >> 16)); } } }
#pragma unroll
        for (int d = 0; d < 64; ++d) o[d] = 0.f;
        float mrun = sinks ? sinks[hq] * LOG2E : -INFINITY, l = sinks ? 1.f : 0.f;
        const float* relh = rel ? rel + hq * 257 : nullptr;
        for (int kp = c0 * 64; kp < c * 64 + 64; ++kp) {
            const size_t krow = (size_t)b * SEQ + kp;
            const GAS v4u* kk = (const GAS v4u*)(Kp + krow * ldk + hk * 64);
            float s = 0.f;
#pragma unroll
            for (int i = 0; i < 8; ++i) { const v4u w = kk[i];
#pragma unroll
                for (int e = 0; e < 4; ++e) { const unsigned ww = w[e]; s += q[8 * i + 2 * e] * bf2f((bf16)(ww & 0xffffu)); s += q[8 * i + 2 * e + 1] * bf2f((bf16)(ww >> 16)); } }
            if (relh) { int r = t - kp; r = r < -128 ? -128 : (r > 128 ? 128 : r); s += relh[r + 128] * LOG2E; }
            const float mn = fmaxf(mrun, s), sc = exp2f(mrun - mn), p = exp2f(s - mn);
            l = l * sc + p; mrun = mn;
            const GAS v4u* vp = (const GAS v4u*)(Vp + krow * ldv + hk * 64);
#pragma unroll
            for (int i = 0; i < 8; ++i) { const v4u w = vp[i];
#pragma unroll
                for (int e = 0; e < 4; ++e) { const unsigned ww = w[e]; o[8 * i + 2 * e] = o[8 * i + 2 * e] * sc + p * bf2f((bf16)(ww & 0xffffu)); o[8 * i + 2 * e + 1] = o[8 * i + 2 * e + 1] * sc + p * bf2f((bf16)(ww >> 16)); } }
        }
        const float il = 1.f / l;
        GAS v4u* op = (GAS v4u*)(O + (size_t)row * ldo + hq * 64);
#pragma unroll
        for (int i = 0; i < 8; ++i) { v4u w; w.x = pk2(o[8 * i] * il, o[8 * i + 1] * il); w.y = pk2(o[8 * i + 2] * il, o[8 * i + 3] * il); w.z = pk2(o[8 * i + 4] * il, o[8 * i + 5] * il); w.w = pk2(o[8 * i + 6] * il, o[8 * i + 7] * il); op[i] = w; }
    }
}
__device__ __forceinline__ void p_hgrn_plain(Frame& F, const bf16* P, bf16* O, const float* lb, const float* gw_) {
    const int sb = F.tid >> 7, e = F.tid & 127;
    LAS float* base = (LAS float*)(F.lds + RING_OFF) + sb * 3328;
    LAS float* Fs = base; LAS float* Qs = base + 1024; LAS float* Os = base + 2048; LAS float* Rs = base + 3072;
    for (int u0 = blockIdx.x * 4; u0 < BATCH * 4; u0 += F.G * 4) {
        const int u = u0 + sb, b = u >> 2, h = u & 3;
        float S[128];
#pragma unroll
        for (int d = 0; d < 128; ++d) S[d] = 0.f;
        const float lbd = lb[h * 128 + e], gwe = gw_[h * 128 + e];
#pragma unroll 1
        for (int t0 = 0; t0 < SEQ; t0 += 8) {
#pragma unroll
            for (int s = 0; s < 8; ++s) { const size_t row = (size_t)b * SEQ + t0 + s; const float xf = bf2f(P[row * EVEN_IN + FB_OFF + h * 128 + e]);
                Fs[s * 128 + e] = lbd + (1.f - lbd) / (1.f + expf(-xf)); Qs[s * 128 + e] = bf2f(P[row * EVEN_IN + QB_OFF + h * 128 + e]); }
            __syncthreads();
#pragma unroll 1
            for (int s = 0; s < 8; ++s) { const size_t row = (size_t)b * SEQ + t0 + s; const float iv = bf2f(P[row * EVEN_IN + IB_OFF + h * 128 + e]); float acc = 0.f;
#pragma unroll
                for (int d = 0; d < 128; ++d) { const float f = Fs[s * 128 + d]; S[d] = f * S[d] + (1.f - f) * iv; acc += Qs[s * 128 + d] * S[d]; }
                const float ss = wave_sum(acc * acc); if (F.lane == 0) Rs[s * 2 + (F.wave & 1)] = ss; Os[s * 128 + e] = acc; }
            __syncthreads();
#pragma unroll
            for (int s = 0; s < 8; ++s) { const size_t row = (size_t)b * SEQ + t0 + s; const float tot = Rs[s * 2] + Rs[s * 2 + 1]; const float r = 1.f / sqrtf(tot * (1.f / 128.f) + EPS);
                const float g = bf2f(P[row * EVEN_IN + GB_OFF + h * 128 + e]); const float val = Os[s * 128 + e] * r * gwe * (g / (1.f + expf(-g)));
                O[row * D + 512 + h * 128 + e] = (bf16)f2bf(val); }
            __syncthreads();
        }
    }
}

__device__ __forceinline__ void p_attn1(Frame& F, const bf16* PROJ, bf16* OB) {
    LAS float* tbw = (LAS float*)(F.lds + RING_OFF + attn3::LDS_TB);
    for (int pair = blockIdx.x; pair < BATCH * 16; pair += F.G) {
        const int b = pair >> 4, h = pair & 15;
        if (F.tid < 320) { const int a = 319 - F.tid; tbw[F.tid] = F.odd_rel[h * 257 + (a > 256 ? 256 : a)] * LOG2E; }
        __syncthreads();
#pragma unroll 1
        for (int g4 = 0; g4 < 8; ++g4) {
            const int c0 = 4 * g4, jlo = c0 - 8 < 0 ? 0 : c0 - 8, NT = c0 + 4 - jlo, cw = c0 + (F.wave >> 1), wt1 = cw - jlo, wt0 = cw - 8 - jlo < 0 ? 0 : cw - 8 - jlo, qi0 = 32 * (F.wave & 1);
            const size_t row0 = (size_t)b * SEQ + 64 * cw + qi0, krow0 = (size_t)b * SEQ + 64 * jlo;
            attn3::attn_unit<ODD_IN, D, 8>(PROJ + row0 * ODD_IN + h * 64, PROJ + krow0 * ODD_IN + 1024 + h * 64, PROJ + krow0 * ODD_IN + 2048 + h * 64, OB + row0 * D + h * 64, NT, wt0, wt1, qi0, F.ldsg + RING_OFF);
        }
    }
}
__device__ __forceinline__ void p_attn0(Frame& F, const bf16* PROJ, bf16* OB, int first, int stride) {
#pragma unroll 1
    for (int u = first; u < BATCH * 2 * 32; u += stride) {
        const int c = u & 31, hk = (u >> 5) & 1, b = u >> 6, qh = 4 * hk + (F.wave >> 1), qpos0 = 64 * c + 32 * (F.wave & 1), jlo = c - 2 < 0 ? 0 : c - 2;
        const size_t row0 = (size_t)b * SEQ + qpos0, seq0 = (size_t)b * SEQ;
        attn2::band_unit<EVEN_IN, EVEN_IN, D, false, true>(PROJ + row0 * EVEN_IN + qh * 64, PROJ + seq0 * EVEN_IN + 512 + hk * 64, PROJ + seq0 * EVEN_IN + 640 + hk * 64,
                                                           OB + row0 * D + qh * 64, jlo, c, jlo, c, qpos0, F.even_sinks[qh] * LOG2E, F.ldsg + RING_OFF);
    }
}

__device__ __forceinline__ void p_hgrn(Frame& F, const bf16* PROJ, bf16* OB, const float* lb, int nhw) {
#pragma unroll 1
    for (int pair = blockIdx.x; pair < BATCH * 4; pair += nhw)
        hgrn2::hgrn_pair<EVEN_IN, QB_OFF, FB_OFF, IB_OFF, GB_OFF, D, 512, SEQ>(PROJ, OB, lb, F.hgrn_norm_w, pair >> 2, pair & 3, F.lds + RING_OFF, EPS);
}
constexpr int NPH = 17;
#ifndef MK_REP2_ROLE
#define MK_REP2_ROLE 0
#endif
#ifndef MK_REPEAT
#define MK_REPEAT -1
#endif
struct Args { const float* in[14]; float* out; unsigned char* ws; int ph_lo, ph_hi; };
__global__ void __launch_bounds__(NWAVES * 64, 2) mk_fwd(Args args) {
    extern __shared__ __attribute__((aligned(16))) unsigned char lds[];
    Frame F;
    F.lds = (LAS unsigned char*)lds; F.ldsg = (char*)lds;
    F.MISC = (volatile LAS unsigned*)(F.lds + MISC_OFF);
    F.tid = threadIdx.x; F.lane = F.tid & 63; F.wave = __builtin_amdgcn_readfirstlane(F.tid >> 6);
    F.G = gridDim.x;
    unsigned char* ws = args.ws; F.ws = ws;
    F.ctl = (gu32*)(ws + WS_CTL);
    F.x = args.in[0]; F.even_w_in = args.in[1]; F.even_w_out = args.in[2]; F.even_sinks = args.in[3]; F.lb_logits = args.in[4]; F.hgrn_norm_w = args.in[5];
    F.odd_w_in = args.in[6]; F.odd_w_out = args.in[7]; F.odd_rel = args.in[8]; F.w_up = args.in[9]; F.conv_w = args.in[10]; F.conv_b = args.in[11]; F.w_down = args.in[12]; F.norm_w = args.in[13];
    F.out = args.out;
    for (int u = F.tid; u < (LDS_BYTES - LDSCTL_OFF) / 4; u += NWAVES * 64) ((LAS unsigned*)(F.lds + LDSCTL_OFF))[u] = 0u;
    __syncthreads();
    const int lo = args.ph_lo, hi = args.ph_hi;
    XcdBarrier bar; bar.bar = (unsigned*)(F.ctl + CW_BAR); bar.x = 0; bar.st = nullptr;
    if (hi - lo > 1) {
        bar.x = xb_xcc_id(); bar.st = F.MISC + 8;
        if (F.tid == 0) F.MISC[10] = xb_add(&bar.bar[XB_XCNT(bar.x)], 1u);
    }
#ifdef MK_XCD_PROBE
    unsigned xcd_probe_us = 0u;
#endif
    int vcu = (int)blockIdx.x;
#define IN(k) (lo <= (k) && (k) < hi)
#define SEAM(k) do { if (IN(k) && IN((k) + 1)) xcd_barrier(bar); } while (0)
    bf16* const XN = (bf16*)(ws + WS_XN); bf16* const PROJ = (bf16*)(ws + WS_PROJ); bf16* const OB = (bf16*)(ws + WS_O); bf16* const YB = (bf16*)(ws + WS_Y);
    bf16* const UL = (bf16*)(ws + WS_SIDE); bf16* const UF = (bf16*)(ws + WS_SIDE + SIDE_STRIDE); bf16* const VF = (bf16*)(ws + WS_SIDE + 2 * SIDE_STRIDE);
    float* const SCB = (float*)(ws + WS_SC); const float* const tab = (const float*)(ws + WS_TAB); const float* const lbv = (const float*)(ws + WS_LB);

    if (IN(0)) { p_prologue(F); }
    if (MK_REPEAT == 0 && IN(0)) { p_prologue(F); } SEAM(0);
    if (hi - lo > 1 && lo == 0) {
        if (F.tid == 0) { unsigned dense = 0u, nx = 0u; bool ok = (F.G % 8) == 0;
            for (unsigned j = 0; j < 16; ++j) { const unsigned cnt = xb_ld(&bar.bar[XB_XCNT(j)]); if (cnt) { ++nx; if (cnt != (unsigned)F.G / 8u) ok = false; } if (j < bar.x && cnt) ++dense; }
            const unsigned rank = F.MISC[10];
            F.MISC[11] = (ok && nx == 8u && rank < (unsigned)F.G / 8u) ? (8u * rank + dense) : 0xffffffffu; }
        __syncthreads();
        const unsigned v = F.MISC[11]; if (v != 0xffffffffu) vcu = (int)v;
#ifdef MK_XCD_PROBE
        xcd_probe_us = (v == 0xffffffffu ? 300u : 0u) + ((v != 0xffffffffu && (v & 7u) != (blockIdx.x & 7u)) ? 600u : 0u);
#endif
    }

    if (IN(1)) { pg8::Gemm g{XN, (const bf16*)(ws + WS_WIN0), M, EVEN_IN, D}; pg8::StaticOrder S; S.init(M, EVEN_IN, F.G, vcu);
        typedef pg8::EpiIn<EVEN_IN, 640, 512, FB_OFF, FB_OFF + 512, GB_OFF, GB_OFF + 512> EpiIn0; EpiIn0 E{PROJ, C2, tab, lbv};
        pg8::gemm_phase<EpiIn0, pg8::StaticOrder, true, true>(F.lds + RING_OFF, g, S, E); }
    if (MK_REPEAT == 1 && IN(1)) { pg8::Gemm g{XN, (const bf16*)(ws + WS_WIN0), M, EVEN_IN, D}; pg8::StaticOrder S; S.init(M, EVEN_IN, F.G, vcu);
        typedef pg8::EpiIn<EVEN_IN, 640, 512, FB_OFF, FB_OFF + 512, GB_OFF, GB_OFF + 512> EpiIn0; EpiIn0 E{PROJ, C2, tab, lbv};
        pg8::gemm_phase<EpiIn0, pg8::StaticOrder, true, true>(F.lds + RING_OFF, g, S, E); } SEAM(1);
    if (IN(2)) { const int nhw = F.G >= 192 ? 128 : 0;
        if (nhw == 0) { p_attn0(F, PROJ, OB, (int)blockIdx.x, F.G); __syncthreads(); p_hgrn(F, PROJ, OB, lbv, F.G); }
        else if ((int)blockIdx.x < nhw) p_hgrn(F, PROJ, OB, lbv, nhw);
        else p_attn0(F, PROJ, OB, (int)blockIdx.x - nhw, F.G - nhw); }
    if (MK_REPEAT == 2 && IN(2)) { const int nhw = F.G >= 192 ? 128 : 0;
        if (nhw == 0) { p_attn0(F, PROJ, OB, (int)blockIdx.x, F.G); __syncthreads(); p_hgrn(F, PROJ, OB, lbv, F.G); }
        else if ((int)blockIdx.x < nhw) { if (MK_REP2_ROLE != 2) p_hgrn(F, PROJ, OB, lbv, nhw); }
        else { if (MK_REP2_ROLE != 1) p_attn0(F, PROJ, OB, (int)blockIdx.x - nhw, F.G - nhw); } } SEAM(2);
    if (IN(3)) { pg8::Gemm g{OB, (const bf16*)(ws + WS_WOUT0), M, D, D}; pg8::StaticOrder S; S.init(M, D, F.G, vcu);
        pg8::EpiBf16<0> E{YB, D, nullptr, 0, 0, 1.f};
        pg8::gemm_phase<pg8::EpiBf16<0>, pg8::StaticOrder, true, true>(F.lds + RING_OFF, g, S, E); }
    if (MK_REPEAT == 3 && IN(3)) { pg8::Gemm g{OB, (const bf16*)(ws + WS_WOUT0), M, D, D}; pg8::StaticOrder S; S.init(M, D, F.G, vcu);
        pg8::EpiBf16<0> E{YB, D, nullptr, 0, 0, 1.f};
        pg8::gemm_phase<pg8::EpiBf16<0>, pg8::StaticOrder, true, true>(F.lds + RING_OFF, g, S, E); } SEAM(3);
    if (IN(4)) { p_norm(F, XN, SCB, YB, F.norm_w + 1 * D, nullptr); }
    if (MK_REPEAT == 4 && IN(4)) { p_norm(F, XN, SCB, YB, F.norm_w + 1 * D, nullptr); } SEAM(4);
#ifdef MK_CLOCK_PROBE
    long long cp_c0 = 0, cp_c1 = 0; unsigned long long cp_t0 = 0, cp_t1 = 0;
    if (IN(5)) { cp_c0 = clock64(); cp_t0 = __builtin_amdgcn_s_memrealtime(); }
#endif
    if (IN(5)) { pg8::Gemm g{XN, (const bf16*)(ws + WS_WUP), M, UPN, D}; pg8::StaticOrder S; S.init(M, UPN, F.G, vcu);
        pg8::EpiConvGate E{PROJ, UL, UF, VF, F.conv_w, F.conv_b, DFF};
        pg8::gemm_phase<pg8::EpiConvGate, pg8::StaticOrder, true, true>(F.lds + RING_OFF, g, S, E); }
    if (MK_REPEAT == 5 && IN(5)) { pg8::Gemm g{XN, (const bf16*)(ws + WS_WUP), M, UPN, D}; pg8::StaticOrder S; S.init(M, UPN, F.G, vcu);
        pg8::EpiConvGate E{PROJ, UL, UF, VF, F.conv_w, F.conv_b, DFF};
        pg8::gemm_phase<pg8::EpiConvGate, pg8::StaticOrder, true, true>(F.lds + RING_OFF, g, S, E); } SEAM(5);
#ifdef MK_CLOCK_PROBE
    if (IN(5)) { cp_c1 = clock64(); cp_t1 = __builtin_amdgcn_s_memrealtime(); }
#endif
    if (IN(6)) { p_fixup(F, PROJ, UL, UF, VF, F.conv_w, F.conv_b); }
    if (MK_REPEAT == 6 && IN(6)) { p_fixup(F, PROJ, UL, UF, VF, F.conv_w, F.conv_b); } SEAM(6);
    if (IN(7)) { pg8::Gemm g{PROJ, (const bf16*)(ws + WS_WDN), M, D, DFF}; pg8::StaticOrder S; S.init(M, D, F.G, vcu);
        pg8::EpiBf16<0> E{YB, D, nullptr, 0, 0, 1.f};
        pg8::gemm_phase<pg8::EpiBf16<0>, pg8::StaticOrder, true, true>(F.lds + RING_OFF, g, S, E); }
    if (MK_REPEAT == 7 && IN(7)) { pg8::Gemm g{PROJ, (const bf16*)(ws + WS_WDN), M, D, DFF}; pg8::StaticOrder S; S.init(M, D, F.G, vcu);
        pg8::EpiBf16<0> E{YB, D, nullptr, 0, 0, 1.f};
        pg8::gemm_phase<pg8::EpiBf16<0>, pg8::StaticOrder, true, true>(F.lds + RING_OFF, g, S, E); } SEAM(7);
    if (IN(8)) { p_norm(F, XN, SCB, YB, F.norm_w + 3 * D, nullptr); }
    if (MK_REPEAT == 8 && IN(8)) { p_norm(F, XN, SCB, YB, F.norm_w + 3 * D, nullptr); } SEAM(8);
    if (IN(9)) { pg8::Gemm g{XN, (const bf16*)(ws + WS_WIN1), M, ODD_IN, D}; pg8::StaticOrder S; S.init(M, ODD_IN, F.G, vcu);
        typedef pg8::EpiIn<ODD_IN, 0, 1024, 0, 0, 0, 0> EpiIn1; EpiIn1 E{PROJ, C2, tab, lbv};
        pg8::gemm_phase<EpiIn1, pg8::StaticOrder, true, true>(F.lds + RING_OFF, g, S, E); }
    if (MK_REPEAT == 9 && IN(9)) { pg8::Gemm g{XN, (const bf16*)(ws + WS_WIN1), M, ODD_IN, D}; pg8::StaticOrder S; S.init(M, ODD_IN, F.G, vcu);
        typedef pg8::EpiIn<ODD_IN, 0, 1024, 0, 0, 0, 0> EpiIn1; EpiIn1 E{PROJ, C2, tab, lbv};
        pg8::gemm_phase<EpiIn1, pg8::StaticOrder, true, true>(F.lds + RING_OFF, g, S, E); } SEAM(9);
    if (IN(10)) { p_attn1(F, PROJ, OB); }
    if (MK_REPEAT == 10 && IN(10)) { p_attn1(F, PROJ, OB); } SEAM(10);
    if (IN(11)) { pg8::Gemm g{OB, (const bf16*)(ws + WS_WOUT1), M, D, D}; pg8::StaticOrder S; S.init(M, D, F.G, vcu);
        pg8::EpiBf16<0> E{YB, D, nullptr, 0, 0, 1.f};
        pg8::gemm_phase<pg8::EpiBf16<0>, pg8::StaticOrder, true, true>(F.lds + RING_OFF, g, S, E); }
    if (MK_REPEAT == 11 && IN(11)) { pg8::Gemm g{OB, (const bf16*)(ws + WS_WOUT1), M, D, D}; pg8::StaticOrder S; S.init(M, D, F.G, vcu);
        pg8::EpiBf16<0> E{YB, D, nullptr, 0, 0, 1.f};
        pg8::gemm_phase<pg8::EpiBf16<0>, pg8::StaticOrder, true, true>(F.lds + RING_OFF, g, S, E); } SEAM(11);
    if (IN(12)) { p_norm(F, XN, SCB, YB, F.norm_w + 5 * D, nullptr); }
    if (MK_REPEAT == 12 && IN(12)) { p_norm(F, XN, SCB, YB, F.norm_w + 5 * D, nullptr); } SEAM(12);
    if (IN(13)) { pg8::Gemm g{XN, (const bf16*)(ws + WS_WUP + 11 * MiB), M, UPN, D}; pg8::StaticOrder S; S.init(M, UPN, F.G, vcu);
        pg8::EpiConvGate E{PROJ, UL, UF, VF, F.conv_w + 3 * DFF, F.conv_b + DFF, DFF};
        pg8::gemm_phase<pg8::EpiConvGate, pg8::StaticOrder, true, true>(F.lds + RING_OFF, g, S, E); }
    if (MK_REPEAT == 13 && IN(13)) { pg8::Gemm g{XN, (const bf16*)(ws + WS_WUP + 11 * MiB), M, UPN, D}; pg8::StaticOrder S; S.init(M, UPN, F.G, vcu);
        pg8::EpiConvGate E{PROJ, UL, UF, VF, F.conv_w + 3 * DFF, F.conv_b + DFF, DFF};
        pg8::gemm_phase<pg8::EpiConvGate, pg8::StaticOrder, true, true>(F.lds + RING_OFF, g, S, E); } SEAM(13);
    if (IN(14)) { p_fixup(F, PROJ, UL, UF, VF, F.conv_w + 3 * DFF, F.conv_b + DFF); }
    if (MK_REPEAT == 14 && IN(14)) { p_fixup(F, PROJ, UL, UF, VF, F.conv_w + 3 * DFF, F.conv_b + DFF); } SEAM(14);
    if (IN(15)) { pg8::Gemm g{PROJ, (const bf16*)(ws + WS_WDN + (size_t)5632 * 1024), M, D, DFF}; pg8::StaticOrder S; S.init(M, D, F.G, vcu);
        pg8::EpiBf16<0> E{YB, D, nullptr, 0, 0, 1.f};
        pg8::gemm_phase<pg8::EpiBf16<0>, pg8::StaticOrder, true, true>(F.lds + RING_OFF, g, S, E); }
    if (MK_REPEAT == 15 && IN(15)) { pg8::Gemm g{PROJ, (const bf16*)(ws + WS_WDN + (size_t)5632 * 1024), M, D, DFF}; pg8::StaticOrder S; S.init(M, D, F.G, vcu);
        pg8::EpiBf16<0> E{YB, D, nullptr, 0, 0, 1.f};
        pg8::gemm_phase<pg8::EpiBf16<0>, pg8::StaticOrder, true, true>(F.lds + RING_OFF, g, S, E); } SEAM(15);
    if (IN(16)) { p_norm(F, XN, SCB, YB, F.norm_w + 7 * D, F.out); }
#ifdef MK_XCD_PROBE
    if (F.tid == 0 && xcd_probe_us) { const unsigned long long tend = __builtin_amdgcn_s_memrealtime() + 100ull * xcd_probe_us; while (__builtin_amdgcn_s_memrealtime() < tend) __builtin_amdgcn_s_sleep(8); }
#endif
#ifdef MK_CLOCK_PROBE
    if (blockIdx.x == 0 && F.tid == 0 && hi == NPH) {
        const unsigned long long dt = cp_t1 - cp_t0; const unsigned long long mhz = dt ? (unsigned long long)(cp_c1 - cp_c0) * 100ull / dt : 0ull;
        const unsigned long long tend = __builtin_amdgcn_s_memrealtime() + mhz * 100ull;
        while (__builtin_amdgcn_s_memrealtime() < tend) __builtin_amdgcn_s_sleep(8); }
#endif
#undef IN
#undef SEAM
}

#ifndef MK_ONE_LAUNCH
#define MK_ONE_LAUNCH 1
#endif
extern "C" void kernel_launch(void* const* d_in, const int* in_sizes, int n_in, void* d_out, int out_size, void* d_ws, size_t ws_size, hipStream_t stream) {
    static int grid = 0;
    if (grid == 0) {
        if (n_in != 14 || in_sizes[0] != M * D || out_size != M * D || ws_size < WS_END) { fprintf(stderr, "kernel_launch: unexpected shapes (n_in %d, in0 %d, out %d, ws %zu); nothing launched\n", n_in, n_in > 0 ? in_sizes[0] : -1, out_size, ws_size); grid = -1; return; }
        int dev = 0, cus = 0, per_cu = 0;
        if (hipGetDevice(&dev) != hipSuccess || hipDeviceGetAttribute(&cus, hipDeviceAttributeMultiprocessorCount, dev) != hipSuccess) { grid = -1; return; }
        if (hipFuncSetAttribute((const void*)mk_fwd, hipFuncAttributeMaxDynamicSharedMemorySize, LDS_BYTES) != hipSuccess) { fprintf(stderr, "kernel_launch: hipFuncSetAttribute failed\n"); grid = -1; return; }
        if (hipOccupancyMaxActiveBlocksPerMultiprocessor(&per_cu, (const void*)mk_fwd, NWAVES * 64, LDS_BYTES) != hipSuccess || per_cu < 1) { fprintf(stderr, "kernel_launch: occupancy query says %d\n", per_cu); }
        (void)hipGetLastError();
        grid = cus;
    }
    if (grid < 0) return;
    if (hipMemsetAsync((char*)d_ws + WS_CTL, 0, CTL_ZERO_BYTES, stream) != hipSuccess) return;
    Args a{};
    for (int i = 0; i < 14; ++i) a.in[i] = (const float*)d_in[i];
    a.out = (float*)d_out; a.ws = (unsigned char*)d_ws;
#if MK_ONE_LAUNCH
    a.ph_lo = 0; a.ph_hi = NPH;
    hipLaunchKernelGGL(mk_fwd, dim3(grid), dim3(NWAVES * 64), LDS_BYTES, stream, a);
#else
    for (int k = 0; k < NPH; ++k) { a.ph_lo = k; a.ph_hi = k + 1; hipLaunchKernelGGL(mk_fwd, dim3(grid), dim3(NWAVES * 64), LDS_BYTES, stream, a); }
#endif
}
```

```cpp
#include <hip/hip_runtime.h>
#include <cstdio>
#include <cstdint>
#include <cmath>
namespace pg8 {
#define PG8_LAS __attribute__((address_space(3)))
typedef unsigned short bf16_t;
typedef short bf16x8 __attribute__((ext_vector_type(8)));
typedef float f32x4 __attribute__((ext_vector_type(4)));
typedef unsigned u32x4 __attribute__((ext_vector_type(4)));
constexpr int BM = 256, BK = 64, HALF = 128, HTB = HALF * BK * 2  , STAGE_BYTES = 8 * HTB, NXCD = 8, WGM = 8;

__host__ __device__ __forceinline__ int lds_byte(int r, int c) { const int st = (r >> 4) * 2 + (c >> 5), rr = r & 15, cc = c & 31, ob = rr * 64 + cc * 2; return st * 1024 + (ob ^ (((ob >> 9) & 1) << 5)); }
__host__ __device__ __forceinline__ void stage_rc(int b, int& R, int& C) { const int st = b / 1024, sb = b % 1024, swz = sb ^ (((sb >> 9) & 1) << 5); R = (st >> 1) * 16 + swz / 64; C = (st & 1) * 32 + (swz % 64) / 2; }
__host__ __device__ __forceinline__ int perm32(int rho) { const int n = rho >> 4, i = rho & 15; return 8 * (i >> 2) + 4 * n + (i & 3); }

struct Unit { int pm, pn; };
struct Gemm { const bf16_t* A; const bf16_t* Bt; int M, N, K; };

struct StaticOrder {
    int nM, nN, nwg, G, c;
    __host__ __device__ void init(int M, int N, int G_, int c_) { nM = M / BM; nN = N / BM; nwg = nM * nN; G = G_; c = c_; }
    __host__ __device__ bool next(int i, Unit& u) const {
        const long L = (long)i * G + c; if (L >= nwg) return false;
        int wgid = (int)L; { const int q = nwg / NXCD, r = nwg % NXCD, xcd = wgid % NXCD, off = wgid / NXCD; wgid = (xcd < r ? xcd * (q + 1) : r * (q + 1) + (xcd - r) * q) + off; }
        const int nig = WGM * nN, gid = wgid / nig, fm = gid * WGM, gsz = (nM - fm) < WGM ? (nM - fm) : WGM;
        u.pm = fm + ((wgid % nig) % gsz); u.pn = (wgid % nig) / gsz; return true;
    }
    __device__ __forceinline__ void a_ready(const Unit&) const {}
    __device__ __forceinline__ void done(const Unit&) const {}
};

__device__ __forceinline__ unsigned cvt_pk_bf16(float lo, float hi) { unsigned r; asm volatile("v_cvt_pk_bf16_f32 %0, %1, %2" : "=v"(r) : "v"(lo), "v"(hi)); return r; }
typedef float f32x2 __attribute__((ext_vector_type(2)));
__device__ __forceinline__ f32x2 gelu_pk(f32x2 v) {
    const f32x2 av = __builtin_elementwise_abs(v), d = av * 0.2316418882f + 1.0f;
    f32x2 t; t.x = __builtin_amdgcn_rcpf(d.x); t.y = __builtin_amdgcn_rcpf(d.y);
    f32x2 q = t * 0.5307027145f + (-0.7265760135f); q = q * t + 0.7107068705f; q = q * t + (-0.142248368f); q = q * t + 0.127414796f; q = q * t;
    const f32x2 s = (v * v) * (-0.72134752044f);
    f32x2 e; e.x = __builtin_amdgcn_exp2f(s.x); e.y = __builtin_amdgcn_exp2f(s.y);
    const f32x2 m = v * (q * e), r = v - m;
    f32x2 o; o.x = v.x < 0.f ? m.x : r.x; o.y = v.y < 0.f ? m.y : r.y; return o;
}

template <int ACT  > struct EpiBf16 {
    static constexpr bool PERM = true, AFTER_DRAIN = false; static_assert(ACT == 0 || ACT == 1, "EpiBf16: ACT is 0 (none) or 1 (gelu_pk)");
    bf16_t* O; int ldc; const float* bias; int split_cols; size_t split_stride; float scale0;
    __device__ __forceinline__ void operator()(const f32x4 (&acc)[2][2][4][2], const Unit& u, int wr, int wc, int fr, int fq) const {
        const int row0 = u.pm * BM + wr * 64 + fr; int colt = u.pn * BM; bf16_t* base = O;
        float sc = 1.f; if (split_cols) { const int t = colt / split_cols; base += (size_t)t * split_stride; colt -= t * split_cols; if (t == 0) sc = scale0; }
        const int col0 = colt + wc * 32 + 8 * fq, bcol0 = u.pn * BM + wc * 32 + 8 * fq;
        f32x4 bv[2][2];
#pragma unroll
        for (int bj = 0; bj < 2; ++bj)
#pragma unroll
            for (int n = 0; n < 2; ++n) bv[bj][n] = bias ? *(const f32x4*)(bias + bcol0 + bj * HALF + 4 * n) : (f32x4){0.f, 0.f, 0.f, 0.f};
#pragma unroll
        for (int ai = 0; ai < 2; ++ai)
#pragma unroll
            for (int m = 0; m < 4; ++m) { bf16_t* rowp = base + (size_t)(row0 + ai * HALF + m * 16) * ldc + col0;
#pragma unroll
                for (int bj = 0; bj < 2; ++bj) { f32x4 v0 = acc[ai][bj][m][0] + bv[bj][0], v1 = acc[ai][bj][m][1] + bv[bj][1];
                    if (ACT == 1) { f32x2 a = gelu_pk((f32x2){v0[0], v0[1]}), b = gelu_pk((f32x2){v0[2], v0[3]}), c = gelu_pk((f32x2){v1[0], v1[1]}), d = gelu_pk((f32x2){v1[2], v1[3]});
                        v0 = (f32x4){a.x, a.y, b.x, b.y}; v1 = (f32x4){c.x, c.y, d.x, d.y}; }
                    v0 = v0 * sc; v1 = v1 * sc; u32x4 w; w.x = cvt_pk_bf16(v0[0], v0[1]); w.y = cvt_pk_bf16(v0[2], v0[3]); w.z = cvt_pk_bf16(v1[0], v1[1]); w.w = cvt_pk_bf16(v1[2], v1[3]);
                    *(u32x4*)(rowp + bj * HALF) = w; } }
    }
};
template <int LDC, int ROPE_COLS, int SCALE_COLS, int GATE_LO, int GATE_HI, int SILU_LO, int SILU_HI> struct EpiIn {
    static constexpr bool PERM = true, AFTER_DRAIN = false;
    static constexpr int ldc = LDC, rope_cols = ROPE_COLS, scale_cols = SCALE_COLS, gate_lo = GATE_LO, gate_hi = GATE_HI;
    bf16_t* O; float scale; const float* tab; const float* lb;
    __device__ __forceinline__ void operator()(const f32x4 (&acc)[2][2][4][2], const Unit& u, int wr, int wc, int fr, int fq) const {
        const int row0 = u.pm * BM + wr * 64 + fr; const int colt = u.pn * BM;
        const int col0 = colt + wc * 32 + 8 * fq; const int i0 = 16 * (wc & 1) + 4 * fq;
#pragma unroll
        for (int ai = 0; ai < 2; ++ai)
#pragma unroll
            for (int m = 0; m < 4; ++m) { const int row = row0 + ai * HALF + m * 16; const int t = row & 2047; bf16_t* rowp = O + (size_t)row * ldc + col0;
#pragma unroll
                for (int bj = 0; bj < 2; ++bj) { f32x4 v0 = acc[ai][bj][m][0], v1 = acc[ai][bj][m][1]; const int cb = colt + bj * HALF;
                    if (cb < rope_cols) { const f32x4 c0 = *(const f32x4*)(tab + (size_t)(t * 32 + i0) * 2), c1 = *(const f32x4*)(tab + (size_t)(t * 32 + i0) * 2 + 4);
                        f32x4 r0, r1;
                        r0[0] = v0[0] * c0[0] - v0[1] * c0[1]; r0[1] = v0[1] * c0[0] + v0[0] * c0[1]; r0[2] = v0[2] * c0[2] - v0[3] * c0[3]; r0[3] = v0[3] * c0[2] + v0[2] * c0[3];
                        r1[0] = v1[0] * c1[0] - v1[1] * c1[1]; r1[1] = v1[1] * c1[0] + v1[0] * c1[1]; r1[2] = v1[2] * c1[2] - v1[3] * c1[3]; r1[3] = v1[3] * c1[2] + v1[2] * c1[3];
                        v0 = r0; v1 = r1; }
                    if (cb < scale_cols) { v0 = v0 * scale; v1 = v1 * scale; }
                    if (cb >= SILU_LO && cb < SILU_HI) {
#pragma unroll
                        for (int e_ = 0; e_ < 4; ++e_) { v0[e_] = v0[e_] * __builtin_amdgcn_rcpf(1.f + __expf(-v0[e_])); v1[e_] = v1[e_] * __builtin_amdgcn_rcpf(1.f + __expf(-v1[e_])); } }
                    if (cb >= gate_lo && cb < gate_hi) { const f32x4 l0 = *(const f32x4*)(lb + (col0 + bj * HALF - gate_lo)), l1 = *(const f32x4*)(lb + (col0 + bj * HALF - gate_lo) + 4);
                        f32x4 fa, fb;
#pragma unroll
                        for (int e_ = 0; e_ < 4; ++e_) { fa[e_] = __builtin_fminf((l0[e_] + (1.f - l0[e_]) * __builtin_amdgcn_rcpf(1.f + __expf(-v0[e_]))) * 65536.f + 0.5f, 65535.f);
                            fb[e_] = __builtin_fminf((l1[e_] + (1.f - l1[e_]) * __builtin_amdgcn_rcpf(1.f + __expf(-v1[e_]))) * 65536.f + 0.5f, 65535.f); }
                        u32x4 wq; wq.x = (unsigned)fa[0] | ((unsigned)fa[1] << 16); wq.y = (unsigned)fa[2] | ((unsigned)fa[3] << 16); wq.z = (unsigned)fb[0] | ((unsigned)fb[1] << 16); wq.w = (unsigned)fb[2] | ((unsigned)fb[3] << 16);
                        *(u32x4*)(rowp + bj * HALF) = wq; }
                    else {
                    u32x4 w; w.x = cvt_pk_bf16(v0[0], v0[1]); w.y = cvt_pk_bf16(v0[2], v0[3]); w.z = cvt_pk_bf16(v1[0], v1[1]); w.w = cvt_pk_bf16(v1[2], v1[3]);
                    *(u32x4*)(rowp + bj * HALF) = w; } } }
    }
};
struct EpiConvGate {
    static constexpr bool PERM = true, AFTER_DRAIN = false;
    bf16_t* H; bf16_t* UL; bf16_t* UF; bf16_t* VF; const float* cw; const float* cb; int ff;
    __device__ __forceinline__ void operator()(const f32x4 (&acc)[2][2][4][2], const Unit& u, int wr, int wc, int fr, int fq) const {
        const int j0 = u.pn * HALF + wc * 32 + 8 * fq; const int lane = (int)(threadIdx.x & 63);
        float k0[8], k1[8], k2[8], kb[8];
#pragma unroll
        for (int q = 0; q < 2; ++q) { const f32x4 a = *(const f32x4*)(cw + j0 + 4 * q), b = *(const f32x4*)(cw + ff + j0 + 4 * q), c = *(const f32x4*)(cw + 2 * ff + j0 + 4 * q), d = *(const f32x4*)(cb + j0 + 4 * q);
#pragma unroll
            for (int e = 0; e < 4; ++e) { k0[4 * q + e] = a[e]; k1[4 * q + e] = b[e]; k2[4 * q + e] = c[e]; kb[4 * q + e] = d[e]; } }
#pragma unroll
        for (int ai = 0; ai < 2; ++ai) {
            float pr1[8], pr2[8];
#pragma unroll
            for (int e = 0; e < 8; ++e) { pr1[e] = 0.f; pr2[e] = 0.f; }
#pragma unroll
            for (int m = 0; m < 4; ++m) { const int row = u.pm * BM + ai * HALF + wr * 64 + m * 16 + fr;
                float uu[8], vv[8], hh[8];
#pragma unroll
                for (int e = 0; e < 4; ++e) { uu[e] = acc[ai][0][m][0][e]; uu[4 + e] = acc[ai][0][m][1][e]; vv[e] = acc[ai][1][m][0][e]; vv[4 + e] = acc[ai][1][m][1][e]; }
#pragma unroll
                for (int e = 0; e < 8; ++e) { const float r1 = __builtin_bit_cast(float, __builtin_amdgcn_update_dpp(0, __builtin_bit_cast(int, uu[e]), 0x121  , 0xF, 0xF, false)),
                                                          r2 = __builtin_bit_cast(float, __builtin_amdgcn_update_dpp(0, __builtin_bit_cast(int, uu[e]), 0x122  , 0xF, 0xF, false));
                    const float p1 = fr >= 1 ? r1 : pr1[e], p2 = fr >= 2 ? r2 : pr2[e]; pr1[e] = r1; pr2[e] = r2;
                    hh[e] = kb[e] + k0[e] * p2 + k1[e] * p1 + k2[e] * uu[e]; }
#pragma unroll
                for (int e = 0; e < 8; e += 2) { const f32x2 g = gelu_pk((f32x2){hh[e], hh[e + 1]}); hh[e] = g.x * vv[e]; hh[e + 1] = g.y * vv[e + 1]; }
                u32x4 w; w.x = cvt_pk_bf16(hh[0], hh[1]); w.y = cvt_pk_bf16(hh[2], hh[3]); w.z = cvt_pk_bf16(hh[4], hh[5]); w.w = cvt_pk_bf16(hh[6], hh[7]);
                *(u32x4*)(H + (size_t)row * ff + j0) = w;
                if (m == 3 && fr >= 14) { u32x4 s; s.x = cvt_pk_bf16(uu[0], uu[1]); s.y = cvt_pk_bf16(uu[2], uu[3]); s.z = cvt_pk_bf16(uu[4], uu[5]); s.w = cvt_pk_bf16(uu[6], uu[7]);
                    *(u32x4*)(UL + ((size_t)(row >> 6) * 2 + (fr - 14)) * ff + j0) = s; }
                if (m == 0 && fr < 2) { u32x4 s; s.x = cvt_pk_bf16(uu[0], uu[1]); s.y = cvt_pk_bf16(uu[2], uu[3]); s.z = cvt_pk_bf16(uu[4], uu[5]); s.w = cvt_pk_bf16(uu[6], uu[7]);
                    *(u32x4*)(UF + ((size_t)(row >> 6) * 2 + fr) * ff + j0) = s;
                    u32x4 z; z.x = cvt_pk_bf16(vv[0], vv[1]); z.y = cvt_pk_bf16(vv[2], vv[3]); z.z = cvt_pk_bf16(vv[4], vv[5]); z.w = cvt_pk_bf16(vv[6], vv[7]);
                    *(u32x4*)(VF + ((size_t)(row >> 6) * 2 + fr) * ff + j0) = z; }
            }
        }
    }
};
template <class Epi, class Sched, bool ALIGN_EPI = false, bool SP2 = false>
__device__ __forceinline__ void gemm_phase(PG8_LAS unsigned char* lds, const Gemm g, const Sched& S, const Epi& E) {
    const int tid = threadIdx.x, wid = __builtin_amdgcn_readfirstlane(tid >> 6), lane = tid & 63, wr = wid >> 2, wc = wid & 3, fr = lane & 15, fq = lane >> 4;
    const int K = g.K, nt = K / BK;
    unsigned voffA[2], voffB[2];
#pragma unroll
    for (int i = 0; i < 2; ++i) { int R, C; stage_rc(tid * 16 + i * 8192, R, C); const int Rb = Epi::PERM ? ((R & ~31) + perm32(R & 31)) : R;
        voffA[i] = (unsigned)(R * K + C) * 2u; voffB[i] = (unsigned)(Rb * K + C) * 2u; }
    const size_t kstep = (size_t)(BK * 2);
    const size_t hstep = (size_t)HALF * K * 2;
    const size_t tstep = 2 * hstep;
    const unsigned ldsw = (unsigned)wid * 1024u;
    const int aoff = lds_byte(wr * 64 + fr, fq * 8), boff = lds_byte(wc * 32 + fr, fq * 8);
#define PG8_SA(b, h) (((b) * 2 + (h)) * HTB)
#define PG8_SB(b, h) ((4 + (b) * 2 + (h)) * HTB)
#define PG8_STAGE(bufoff, gbase, voff) do { _Pragma("unroll") for (int _i = 0; _i < 2; ++_i) \
        __builtin_amdgcn_global_load_lds((const unsigned*)((const char*)(gbase) + (voff)[_i]), (PG8_LAS unsigned*)(lds + (bufoff) + ldsw + _i * 8192), 16, 0, 0); } while (0)
#define PG8_LDA(dst, b, h) do { __builtin_amdgcn_s_setprio(2); _Pragma("unroll") for (int m = 0; m < 4; ++m) _Pragma("unroll") for (int k = 0; k < 2; ++k) dst[m][k] = *(const PG8_LAS bf16x8*)(lds + PG8_SA(b, h) + aoff + m * 2048 + k * 1024); } while (0)
#define PG8_LDB(dst, b, h) do { __builtin_amdgcn_s_setprio(2); _Pragma("unroll") for (int n = 0; n < 2; ++n) _Pragma("unroll") for (int k = 0; k < 2; ++k) dst[n][k] = *(const PG8_LAS bf16x8*)(lds + PG8_SB(b, h) + boff + n * 2048 + k * 1024); } while (0)
#define PG8_MMA(ai, bj, At, Bt) do { __builtin_amdgcn_s_setprio(1); _Pragma("unroll") for (int m = 0; m < 4; ++m) _Pragma("unroll") for (int n = 0; n < 2; ++n) _Pragma("unroll") for (int k = 0; k < 2; ++k) \
        acc[ai][bj][m][n] = __builtin_amdgcn_mfma_f32_16x16x32_bf16(Bt[n][k], At[m][k], acc[ai][bj][m][n], 0, 0, 0); __builtin_amdgcn_s_setprio(0); } while (0)
#define PG8_WAIT_V(n) asm volatile("s_setprio 0\n\ts_waitcnt vmcnt(" #n ")" ::: "memory")
#define PG8_WAIT_L(n) asm volatile("s_waitcnt lgkmcnt(" #n ")" ::: "memory")
#define PG8_BAR __builtin_amdgcn_s_barrier()
#define PG8_SCHED __builtin_amdgcn_sched_barrier(0)
    Unit cur, nxt; int ui = 0;
    if (!S.next(0, cur)) return;
    f32x4 acc[2][2][4][2];
#pragma unroll
    for (int a = 0; a < 2; ++a)
#pragma unroll
        for (int b = 0; b < 2; ++b)
#pragma unroll
            for (int m = 0; m < 4; ++m)
#pragma unroll
                for (int n = 0; n < 2; ++n) acc[a][b][m][n] = (f32x4){0.f, 0.f, 0.f, 0.f};
    bf16x8 At[4][2], B0[2][2], B1[2][2];
    const char* cA = (const char*)g.A + (size_t)cur.pm * tstep; const char* cB = (const char*)g.Bt + (size_t)cur.pn * tstep;
    S.a_ready(cur);
    if constexpr (SP2) {
        PG8_STAGE(PG8_SB(0, 0), cB, voffB); PG8_STAGE(PG8_SB(0, 1), cB + hstep, voffB); PG8_STAGE(PG8_SA(0, 0), cA, voffA); PG8_STAGE(PG8_SA(0, 1), cA + hstep, voffA);
        if (wr == 1) PG8_BAR;
        PG8_WAIT_V(2); PG8_BAR;
        PG8_STAGE(PG8_SB(1, 0), cB + kstep, voffB); PG8_STAGE(PG8_SA(1, 0), cA + kstep, voffA); PG8_STAGE(PG8_SB(1, 1), cB + hstep + kstep, voffB);
        PG8_WAIT_V(6); PG8_BAR;
    } else {
        PG8_STAGE(PG8_SB(0, 0), cB, voffB); PG8_STAGE(PG8_SA(0, 0), cA, voffA); PG8_STAGE(PG8_SB(0, 1), cB + hstep, voffB); PG8_STAGE(PG8_SA(0, 1), cA + hstep, voffA);
        if (wr == 1) PG8_BAR;
        PG8_WAIT_V(4); PG8_BAR;
        PG8_STAGE(PG8_SB(1, 0), cB + kstep, voffB); PG8_STAGE(PG8_SA(1, 0), cA + kstep, voffA); PG8_STAGE(PG8_SB(1, 1), cB + hstep + kstep, voffB);
        PG8_WAIT_V(6); PG8_BAR;
    }
    for (;;) {
        const bool has_next = S.next(ui + 1, nxt);
        const char* nA = has_next ? (const char*)g.A + (size_t)nxt.pm * tstep : cA; const char* nB = has_next ? (const char*)g.Bt + (size_t)nxt.pn * tstep : cB;
        for (int t = 0; t < nt; t += 2) {
            const bool last = (t == nt - 2);
            const char* a1 = cA + (size_t)(t + 1) * kstep;
            const char* a2 = last ? nA : cA + (size_t)(t + 2) * kstep; const char* b2 = last ? nB : cB + (size_t)(t + 2) * kstep;
            const char* a3 = a2 + kstep; const char* b3 = b2 + kstep;
            if (last && has_next) S.a_ready(nxt);
            if constexpr (SP2) {
            PG8_LDB(B0, 0, 0); PG8_LDB(B1, 0, 1); PG8_SCHED; PG8_LDA(At, 0, 0); PG8_STAGE(PG8_SA(1, 1), a1 + hstep, voffA);
            PG8_WAIT_V(8); PG8_WAIT_L(0); PG8_BAR; PG8_MMA(0, 0, At, B0); PG8_MMA(0, 1, At, B1); PG8_BAR; PG8_SCHED;
            PG8_LDA(At, 0, 1); PG8_STAGE(PG8_SB(0, 0), b2, voffB); PG8_STAGE(PG8_SB(0, 1), b2 + hstep, voffB); PG8_STAGE(PG8_SA(0, 0), a2, voffA);
            PG8_WAIT_V(8); PG8_WAIT_L(0); PG8_BAR; PG8_MMA(1, 0, At, B0); PG8_MMA(1, 1, At, B1); PG8_BAR; PG8_SCHED;
            PG8_LDB(B0, 1, 0); PG8_LDB(B1, 1, 1); PG8_SCHED; PG8_LDA(At, 1, 0); PG8_STAGE(PG8_SA(0, 1), a2 + hstep, voffA);
            PG8_WAIT_V(8); PG8_WAIT_L(0); PG8_BAR; PG8_MMA(0, 0, At, B0); PG8_MMA(0, 1, At, B1); PG8_BAR; PG8_SCHED;
            PG8_LDA(At, 1, 1); PG8_STAGE(PG8_SB(1, 0), b3, voffB); PG8_STAGE(PG8_SB(1, 1), b3 + hstep, voffB); PG8_STAGE(PG8_SA(1, 0), a3, voffA);
            PG8_WAIT_V(8); PG8_WAIT_L(0); PG8_BAR; PG8_MMA(1, 0, At, B0); PG8_MMA(1, 1, At, B1); PG8_BAR; PG8_SCHED;
            } else {
            PG8_LDB(B0, 0, 0); PG8_SCHED; PG8_LDA(At, 0, 0); PG8_STAGE(PG8_SA(1, 1), a1 + hstep, voffA);
            PG8_WAIT_L(8); PG8_BAR; PG8_WAIT_L(0); PG8_MMA(0, 0, At, B0); PG8_BAR; PG8_SCHED;
            PG8_LDB(B1, 0, 1); PG8_STAGE(PG8_SB(0, 0), b2, voffB);
            PG8_BAR; PG8_WAIT_L(0); PG8_MMA(0, 1, At, B1); PG8_BAR;
            PG8_LDA(At, 0, 1); PG8_STAGE(PG8_SA(0, 0), a2, voffA);
            PG8_BAR; PG8_WAIT_L(0); PG8_MMA(1, 0, At, B0); PG8_BAR; PG8_SCHED;
            PG8_STAGE(PG8_SB(0, 1), b2 + hstep, voffB);
            PG8_WAIT_V(6); PG8_BAR; PG8_MMA(1, 1, At, B1); PG8_BAR;
            PG8_LDB(B0, 1, 0); PG8_SCHED; PG8_LDA(At, 1, 0); PG8_STAGE(PG8_SA(0, 1), a2 + hstep, voffA);
            PG8_WAIT_L(8); PG8_BAR; PG8_WAIT_L(0); PG8_MMA(0, 0, At, B0); PG8_BAR; PG8_SCHED;
            PG8_LDB(B1, 1, 1); PG8_STAGE(PG8_SB(1, 0), b3, voffB);
            PG8_BAR; PG8_WAIT_L(0); PG8_MMA(0, 1, At, B1); PG8_BAR;
            PG8_LDA(At, 1, 1); PG8_STAGE(PG8_SA(1, 0), a3, voffA);
            PG8_BAR; PG8_WAIT_L(0); PG8_MMA(1, 0, At, B0); PG8_BAR; PG8_SCHED;
            PG8_STAGE(PG8_SB(1, 1), b3 + hstep, voffB);
            PG8_WAIT_V(6); PG8_BAR; PG8_MMA(1, 1, At, B1); PG8_BAR;
            }
        }
        if constexpr (ALIGN_EPI) { if (wr == 0) PG8_BAR; }
        if constexpr (!Epi::AFTER_DRAIN) { E(acc, cur, wr, wc, fr, fq); S.done(cur); }
        if (!has_next) break;
#pragma unroll
        for (int a = 0; a < 2; ++a)
#pragma unroll
            for (int b = 0; b < 2; ++b)
#pragma unroll
                for (int m = 0; m < 4; ++m)
#pragma unroll
                    for (int n = 0; n < 2; ++n) acc[a][b][m][n] = (f32x4){0.f, 0.f, 0.f, 0.f};
        cur = nxt; cA = nA; cB = nB; ++ui;
        if constexpr (ALIGN_EPI) { if (wr == 1) PG8_BAR; }
    }
    PG8_WAIT_V(0);
    if constexpr (!ALIGN_EPI) { if (wr == 0) PG8_BAR; }
    PG8_BAR;
    if constexpr (Epi::AFTER_DRAIN) { E.fused(acc, cur, wr, wc, fr, fq, lds, wid, lane); S.done(cur); }
#undef PG8_SA
#undef PG8_SB
#undef PG8_STAGE
#undef PG8_LDA
#undef PG8_LDB
#undef PG8_MMA
#undef PG8_WAIT_V
#undef PG8_WAIT_L
#undef PG8_BAR
#undef PG8_SCHED
}
}
constexpr int NWAVES = 8;
constexpr int BATCH = 32, SEQ = 2048, D = 1024, M = BATCH * SEQ;
constexpr int EVEN_IN = 2816, ODD_IN = 3072, DFF = 2816, UPN = 2 * DFF;
constexpr int QB_OFF = 768, FB_OFF = 1280, IB_OFF = 1792, GB_OFF = 2304;
constexpr float EPS = 1e-6f;
constexpr float LOG2E = 1.4426950408889634f;
constexpr float C2 = 0.125f * LOG2E;

constexpr size_t MiB = 1u << 20;
constexpr size_t WS_CTL = 0, CTL_ZERO_BYTES = 64 * 1024;
constexpr size_t WS_TAB = 1 * MiB;
constexpr size_t WS_LB = WS_TAB + 768 * 1024;
constexpr size_t WS_WIN0 = 2 * MiB, WS_WOUT0 = 8 * MiB, WS_WIN1 = 10 * MiB, WS_WOUT1 = 16 * MiB, WS_WUP = 18 * MiB  , WS_WDN = 40 * MiB  ;
constexpr size_t WS_SIDE = 52 * MiB, SIDE_STRIDE = 12 * MiB;
constexpr size_t WS_SC = 90 * MiB;
constexpr size_t WS_XN = 96 * MiB;
constexpr size_t WS_PROJ = 224 * MiB;
constexpr size_t WS_O = 608 * MiB;
constexpr size_t WS_Y = 736 * MiB;
constexpr size_t WS_END = 864 * MiB;
constexpr int CW_BAR = 4096;

constexpr int RING_OFF = 0, RING_BYTES = 131072;
constexpr int LDSCTL_OFF = RING_BYTES, MISC_OFF = LDSCTL_OFF + 320;
constexpr int LDS_BYTES = 147456;

namespace attn2 {
using bf16x8 = __attribute__((ext_vector_type(8))) short;
using s16x4 = __attribute__((ext_vector_type(4))) short;
using f32x16 = __attribute__((ext_vector_type(16))) float;
using u32x4 = __attribute__((ext_vector_type(4))) unsigned;
typedef unsigned short bf16;
constexpr int NSLOT = 3, SLOTB = 8192;
constexpr int LDS_K = 0, LDS_V = NSLOT * SLOTB, LDS_WS = 2 * NSLOT * SLOTB, LDS_OST = LDS_WS + 8 * 64 * 4, LDS_TB = LDS_OST + 8 * 4096, LDS_BYTES = LDS_TB + 1088;
constexpr float THR = 8.f;
__device__ __forceinline__ int crow(int r, int hi) { return (r & 3) + 8 * (r >> 2) + 4 * hi; }
__device__ __forceinline__ void glds16(const void* gsrc, unsigned lds_dst) { unsigned keep;
    asm volatile("s_mov_b32 %0, m0\n\ts_mov_b32 m0, %2\n\ts_nop 0\n\tglobal_load_lds_dwordx4 %1, off\n\ts_mov_b32 m0, %0" : "=&s"(keep) : "v"(gsrc), "s"(lds_dst) : "memory"); }
typedef float f32x2_t __attribute__((ext_vector_type(2))); typedef __bf16 bf16x2_t __attribute__((ext_vector_type(2)));
__device__ __forceinline__ unsigned cvtpk_s(float lo, float hi) { f32x2_t v = {lo, hi}; bf16x2_t b = __builtin_convertvector(v, bf16x2_t); return __builtin_bit_cast(unsigned, b); }
__device__ __forceinline__ void qkt(f32x16& p0, f32x16& p1, const char* Kslot, const bf16x8* qr, const f32x16& cin, int r32, int hi) {
    const char* kb = Kslot + hi * 1024 + r32 * 16;
#pragma unroll
    for (int d0 = 0; d0 < 4; ++d0) {
        const bf16x8 b0 = *reinterpret_cast<const bf16x8*>(kb + d0 * 2048);
        const bf16x8 b1 = *reinterpret_cast<const bf16x8*>(kb + d0 * 2048 + 512);
        if (d0 == 0) { p0 = __builtin_amdgcn_mfma_f32_32x32x16_bf16(b0, qr[0], cin, 0, 0, 0); p1 = __builtin_amdgcn_mfma_f32_32x32x16_bf16(b1, qr[0], cin, 0, 0, 0); }
        else { p0 = __builtin_amdgcn_mfma_f32_32x32x16_bf16(b0, qr[d0], p0, 0, 0, 0); p1 = __builtin_amdgcn_mfma_f32_32x32x16_bf16(b1, qr[d0], p1, 0, 0, 0); } }
}
__device__ __forceinline__ void pv(f32x16* o, int vb, bf16x8 pa0, bf16x8 pa1, bf16x8 pa2, bf16x8 pa3) {
#pragma unroll
    for (int d0 = 0; d0 < 2; ++d0) { s16x4 lo[4], hi[4];
#pragma unroll
        for (int ks = 0; ks < 4; ++ks) {
            asm volatile("ds_read_b64_tr_b16 %0,%1 offset:%c2" : "=&v"(lo[ks]) : "v"(vb), "i"(d0 * 4096 + ks * 1024) : "memory");
            asm volatile("ds_read_b64_tr_b16 %0,%1 offset:%c2" : "=&v"(hi[ks]) : "v"(vb), "i"(d0 * 4096 + ks * 1024 + 512) : "memory"); }
        asm volatile("s_waitcnt lgkmcnt(0)" ::: "memory"); __builtin_amdgcn_sched_barrier(0);
#define ATT_PK(k) (bf16x8){lo[k][0], lo[k][1], lo[k][2], lo[k][3], hi[k][0], hi[k][1], hi[k][2], hi[k][3]}
        o[d0] = __builtin_amdgcn_mfma_f32_32x32x16_bf16(pa0, ATT_PK(0), o[d0], 0, 0, 0);
        o[d0] = __builtin_amdgcn_mfma_f32_32x32x16_bf16(pa1, ATT_PK(1), o[d0], 0, 0, 0);
        o[d0] = __builtin_amdgcn_mfma_f32_32x32x16_bf16(pa2, ATT_PK(2), o[d0], 0, 0, 0);
        o[d0] = __builtin_amdgcn_mfma_f32_32x32x16_bf16(pa3, ATT_PK(3), o[d0], 0, 0, 0);
#undef ATT_PK
    }
}
template <int LDQ, int LDKV, int LDO, bool BIAS, bool SINK>
__device__ __forceinline__ void band_unit(const bf16* Qw, const bf16* Kt, const bf16* Vt, bf16* Ow, int jlo, int jhi, int wlo, int whi, int qpos0, float sink2, char* shm) {
    const int tid = threadIdx.x, lane = tid & 63, r32 = lane & 31, hi = lane >> 5; const int wid = __builtin_amdgcn_readfirstlane(tid >> 6);
    const unsigned lds0 = (unsigned)(uintptr_t)shm;
    float* wsf = (float*)(shm + LDS_WS) + wid * 64;
    const float* tb = (const float*)(shm + LDS_TB);
    const bf16* ksrc = Kt + (long)lane * LDKV + wid * 8;
    const bf16* vsrc = Vt + (long)(16 * (wid & 3) + (lane >> 2)) * LDKV + (wid >> 2) * 32 + (lane & 3) * 8;
    const unsigned kdst = lds0 + LDS_K + wid * 1024, vdst = lds0 + LDS_V + wid * 1024;
#define ATT_DMAK(t, slot) glds16(ksrc + (long)(t) * 64 * LDKV, (unsigned)__builtin_amdgcn_readfirstlane(kdst + (slot)))
#define ATT_DMAV(t, slot) glds16(vsrc + (long)(t) * 64 * LDKV, (unsigned)__builtin_amdgcn_readfirstlane(vdst + (slot)))
#define ATT_SLOT(t) ((((t) - jlo) % 3) * SLOTB)
    const int vb0 = (int)(lds0 + LDS_V) + ((lane >> 4) & 1) * 32 + (lane & 3) * 8 + (4 * hi + ((lane & 15) >> 2)) * 64;
    bf16x8 qr[4];
#pragma unroll
    for (int d0 = 0; d0 < 4; ++d0) qr[d0] = *reinterpret_cast<const bf16x8*>(&Qw[(long)r32 * LDQ + d0 * 16 + hi * 8]);
    ATT_DMAK(jlo, 0);
    if (jlo + 1 <= jhi) ATT_DMAK(jlo + 1, SLOTB);
    ATT_DMAV(jlo, 0);
    if (jlo + 2 <= jhi) ATT_DMAK(jlo + 2, 2 * SLOTB);
    if (jlo + 1 <= jhi) ATT_DMAV(jlo + 1, SLOTB);
    float mhat = SINK ? sink2 : 0.f, l_reg = (SINK && hi == 0) ? 1.f : 0.f; bool first = !SINK;
    f32x16 o[2]; o[0] = f32x16{}; o[1] = f32x16{};
    f32x16 negm;
#pragma unroll
    for (int r = 0; r < 16; ++r) negm[r] = -mhat;
    asm volatile("s_waitcnt vmcnt(0) lgkmcnt(0)\n\ts_barrier" ::: "memory");
    asm volatile("" :: "v"(qr[0]), "v"(qr[1]), "v"(qr[2]), "v"(qr[3]));
    f32x16 pc0 = f32x16{}, pc1 = f32x16{}, pn0 = f32x16{}, pn1 = f32x16{};
    if (jlo >= wlo && jlo <= whi) qkt(pc0, pc1, shm + LDS_K, qr, negm, r32, hi);
    for (int j = jlo; j <= jhi; ++j) {
        if (j + 2 <= jhi) asm volatile("s_waitcnt vmcnt(2) lgkmcnt(0)\n\ts_barrier" ::: "memory");
        else if (j + 1 <= jhi) asm volatile("s_waitcnt vmcnt(1) lgkmcnt(0)\n\ts_barrier" ::: "memory");
        else asm volatile("s_waitcnt vmcnt(0) lgkmcnt(0)\n\ts_barrier" ::: "memory");
        if (j + 3 <= jhi) ATT_DMAK(j + 3, ATT_SLOT(j + 3));
        if (j + 2 <= jhi) ATT_DMAV(j + 2, ATT_SLOT(j + 2));
        const bool actn = (j + 1 <= jhi) && (j + 1 >= wlo) && (j + 1 <= whi);
        if (actn) qkt(pn0, pn1, shm + LDS_K + ATT_SLOT(j + 1), qr, negm, r32, hi);
        __builtin_amdgcn_sched_barrier(0);
        if (j >= wlo && j <= whi) {
            if (BIAS) {
                const int dq = qpos0 + r32 - 64 * j;
                if ((qpos0 & ~63) - 64 * j >= 192) { const float c = tb[256];
#pragma unroll
                    for (int r = 0; r < 16; ++r) { pc0[r] += c; pc1[r] += c; } }
                else {
#pragma unroll
                    for (int r = 0; r < 16; ++r) { const int a = dq - crow(r, hi) + 128; const int i0 = a > 256 ? 256 : a, i1 = a - 32 > 256 ? 256 : a - 32; pc0[r] += tb[i0]; pc1[r] += tb[i1]; } }
            }
            float ra = fmaxf(fmaxf(pc0[0], pc0[1]), pc1[0]), rb = fmaxf(fmaxf(pc0[2], pc0[3]), pc1[1]); ra = fmaxf(fmaxf(ra, pc1[2]), pc1[3]);
#pragma unroll
            for (int r = 4; r < 16; r += 4) { ra = fmaxf(fmaxf(ra, pc0[r]), pc0[r + 1]); rb = fmaxf(fmaxf(rb, pc0[r + 2]), pc0[r + 3]); ra = fmaxf(fmaxf(ra, pc1[r]), pc1[r + 1]); rb = fmaxf(fmaxf(rb, pc1[r + 2]), pc1[r + 3]); }
            float rm = fmaxf(ra, rb);
            { auto rr = __builtin_amdgcn_permlane32_swap(__float_as_uint(rm), __float_as_uint(rm), false, false); rm = fmaxf(__uint_as_float(rr[0]), __uint_as_float(rr[1])); }
            bool resc = false;
            if (first) { const float dl = rm; mhat = dl;
#pragma unroll
                for (int r = 0; r < 16; ++r) { pc0[r] -= dl; pc1[r] -= dl; pn0[r] -= dl; pn1[r] -= dl; negm[r] = -mhat; }
                first = false; }
            else if (__any(rm > THR)) { const float dl = fmaxf(rm, 0.f); mhat += dl;
#pragma unroll
                for (int r = 0; r < 16; ++r) { pc0[r] -= dl; pc1[r] -= dl; pn0[r] -= dl; pn1[r] -= dl; negm[r] = -mhat; }
                const float f = __builtin_amdgcn_exp2f(-dl); l_reg *= f; if (hi == 0) wsf[r32] = f; resc = true; }
            f32x2_t sacc = {0.f, 0.f};
#pragma unroll
            for (int r = 0; r < 16; ++r) { pc0[r] = __builtin_amdgcn_exp2f(pc0[r]); pc1[r] = __builtin_amdgcn_exp2f(pc1[r]); }
#pragma unroll
            for (int r = 0; r < 16; r += 2) { sacc += (f32x2_t){pc0[r], pc0[r + 1]}; sacc += (f32x2_t){pc1[r], pc1[r + 1]}; }
            l_reg += sacc[0] + sacc[1];
            u32x4 pw0, pw1, pw2, pw3;
            pw0 = (u32x4){cvtpk_s(pc0[0], pc0[1]), cvtpk_s(pc0[2], pc0[3]), cvtpk_s(pc0[4], pc0[5]), cvtpk_s(pc0[6], pc0[7])};
            pw1 = (u32x4){cvtpk_s(pc0[8], pc0[9]), cvtpk_s(pc0[10], pc0[11]), cvtpk_s(pc0[12], pc0[13]), cvtpk_s(pc0[14], pc0[15])};
            pw2 = (u32x4){cvtpk_s(pc1[0], pc1[1]), cvtpk_s(pc1[2], pc1[3]), cvtpk_s(pc1[4], pc1[5]), cvtpk_s(pc1[6], pc1[7])};
            pw3 = (u32x4){cvtpk_s(pc1[8], pc1[9]), cvtpk_s(pc1[10], pc1[11]), cvtpk_s(pc1[12], pc1[13]), cvtpk_s(pc1[14], pc1[15])};
            if (resc) { asm volatile("s_waitcnt lgkmcnt(0)" ::: "memory");
#pragma unroll
                for (int d_ = 0; d_ < 2; ++d_)
#pragma unroll
                    for (int r = 0; r < 16; ++r) o[d_][r] *= wsf[crow(r, hi)]; }
            pv(o, vb0 + ATT_SLOT(j), __builtin_bit_cast(bf16x8, pw0), __builtin_bit_cast(bf16x8, pw1), __builtin_bit_cast(bf16x8, pw2), __builtin_bit_cast(bf16x8, pw3));
        }
        pc0 = pn0; pc1 = pn1;
    }
    { auto rr = __builtin_amdgcn_permlane32_swap(__float_as_uint(l_reg), __float_as_uint(l_reg), false, false); l_reg = __uint_as_float(rr[0]) + __uint_as_float(rr[1]); }
    if (hi == 0) wsf[32 + r32] = l_reg; asm volatile("s_waitcnt lgkmcnt(0)" ::: "memory");
    float rli[16];
#pragma unroll
    for (int r = 0; r < 16; ++r) rli[r] = __builtin_amdgcn_rcpf(wsf[32 + crow(r, hi)]);
    { bf16* stg = (bf16*)(shm + LDS_OST) + wid * 2048;
#pragma unroll
      for (int r = 0; r < 16; ++r) { const int orow = crow(r, hi);
#pragma unroll
          for (int d0 = 0; d0 < 2; ++d0) { const float v = o[d0][r] * rli[r]; const unsigned u = __builtin_bit_cast(unsigned, v); stg[orow * 64 + d0 * 32 + r32] = (bf16)((u + 0x7fffu + ((u >> 16) & 1u)) >> 16); } }
      asm volatile("s_waitcnt lgkmcnt(0)" ::: "memory");
#pragma unroll
      for (int i = 0; i < 4; ++i) { const int row = i * 8 + (lane >> 3), ch = lane & 7; const u32x4 v = *(const u32x4*)(stg + row * 64 + ch * 8); *(u32x4*)(Ow + (long)row * LDO + ch * 8) = v; } }
    asm volatile("s_waitcnt lgkmcnt(0)\n\ts_barrier" ::: "memory");
#undef ATT_DMAK
#undef ATT_DMAV
#undef ATT_SLOT
}
}
namespace attn3 {
typedef unsigned short bf16;
using bf16x8=__attribute__((ext_vector_type(8)))short;
using s16x4=__attribute__((ext_vector_type(4)))short;
using f32x16=__attribute__((ext_vector_type(16)))float;
using u32x4=__attribute__((ext_vector_type(4)))unsigned;
constexpr int NW=8,QBLK=32,KVBLK=64;
__device__ __forceinline__ int crow(int r,int hi){return (r&3)+8*(r>>2)+4*hi;}
#define SBAR() __builtin_amdgcn_sched_barrier(0)
constexpr int NSLOT=3, SLOTB=8192;
constexpr int LDS_K=0, LDS_V=NSLOT*SLOTB, LDS_WS=2*NSLOT*SLOTB, LDS_OST=LDS_WS+NW*64*4, LDS_TB=LDS_OST+NW*4096,LDS_BYTES=LDS_TB+1280;
constexpr float MASKV=-4096.f;
__device__ __forceinline__ void glds16(const void*gbase,unsigned voff,unsigned lds_dst){unsigned keep;
  asm volatile("s_mov_b32 %0, m0\n\ts_mov_b32 m0, %3\n\ts_nop 0\n\tglobal_load_lds_dwordx4 %1, %2\n\ts_mov_b32 m0, %0":"=&s"(keep):"v"(voff),"s"(gbase),"s"(lds_dst):"memory");}
__device__ __forceinline__ float max3f(float a,float b,float c){float r;asm("v_max3_f32 %0, %1, %2, %3":"=v"(r):"v"(a),"v"(b),"v"(c));return r;}
__device__ __forceinline__ float max2f(float a,float b){float r;asm("v_max_f32_e32 %0, %1, %2":"=v"(r):"v"(a),"v"(b));return r;}
__device__ __forceinline__ float fadd_s(float a,float b){float r;asm("v_add_f32_e32 %0, %1, %2":"=v"(r):"v"(a),"v"(b));return r;}
__device__ __forceinline__ float fsub_s(float a,float b){float r;asm("v_sub_f32_e32 %0, %1, %2":"=v"(r):"v"(a),"v"(b));return r;}
typedef float f32x2_t __attribute__((ext_vector_type(2))); typedef __bf16 bf16x2_t __attribute__((ext_vector_type(2)));
__device__ __forceinline__ unsigned cvtpk_s(float lo,float hi){f32x2_t v={lo,hi};bf16x2_t b=__builtin_convertvector(v,bf16x2_t);return __builtin_bit_cast(unsigned,b);}
#define WAIT_BAR(N) asm volatile("s_waitcnt vmcnt(" #N ") lgkmcnt(0)\n\ts_barrier":::"memory")

__device__ __forceinline__ void qkt(f32x16&p0,f32x16&p1,const char*Kslot,const bf16x8*qr,int r32,int hi){ const f32x16 zz=f32x16{};
  const char*kb=Kslot+hi*1024+r32*16;
  #pragma unroll
  for(int d0=0;d0<4;++d0){
    const bf16x8 b0=*reinterpret_cast<const bf16x8*>(kb+d0*2048);
    const bf16x8 b1=*reinterpret_cast<const bf16x8*>(kb+d0*2048+512);
    if(d0==0){p0=__builtin_amdgcn_mfma_f32_32x32x16_bf16(b0,qr[0],zz,0,0,0);p1=__builtin_amdgcn_mfma_f32_32x32x16_bf16(b1,qr[0],zz,0,0,0);}
    else{p0=__builtin_amdgcn_mfma_f32_32x32x16_bf16(b0,qr[d0],p0,0,0,0);p1=__builtin_amdgcn_mfma_f32_32x32x16_bf16(b1,qr[d0],p1,0,0,0);}}
}
typedef __attribute__((address_space(3))) const char* lds_cptr;
typedef short v4i16_t __attribute__((ext_vector_type(4)));
__device__ __forceinline__ void kload8(bf16x8*kf,lds_cptr kp){
  kf[0]=*(const __attribute__((address_space(3))) bf16x8*)(kp);      kf[1]=*(const __attribute__((address_space(3))) bf16x8*)(kp+512);
  kf[2]=*(const __attribute__((address_space(3))) bf16x8*)(kp+2048); kf[3]=*(const __attribute__((address_space(3))) bf16x8*)(kp+2560);
  kf[4]=*(const __attribute__((address_space(3))) bf16x8*)(kp+4096); kf[5]=*(const __attribute__((address_space(3))) bf16x8*)(kp+4608);
  kf[6]=*(const __attribute__((address_space(3))) bf16x8*)(kp+6144); kf[7]=*(const __attribute__((address_space(3))) bf16x8*)(kp+6656);
}
__device__ __forceinline__ void kload2(bf16x8*kf,lds_cptr kp,int j){ kf[2*j]=*(const __attribute__((address_space(3))) bf16x8*)(kp+j*2048); kf[2*j+1]=*(const __attribute__((address_space(3))) bf16x8*)(kp+j*2048+512); }
__device__ __forceinline__ s16x4 vtr(lds_cptr p){ return __builtin_bit_cast(s16x4,__builtin_amdgcn_ds_read_tr16_b64_v4i16((__attribute__((address_space(3))) v4i16_t*)p)); }
__device__ __forceinline__ float rowmax(const f32x16&p0,const f32x16&p1){
  float a=max3f(p0[0],p0[1],p1[0]),b=max3f(p0[2],p0[3],p1[1]);a=max3f(a,p1[2],p1[3]);
  #pragma unroll
  for(int r=4;r<16;r+=4){a=max3f(a,p0[r],p0[r+1]);b=max3f(b,p0[r+2],p0[r+3]);a=max3f(a,p1[r],p1[r+1]);b=max3f(b,p1[r+2],p1[r+3]);}
  const float m=max2f(a,b);
  auto rr=__builtin_amdgcn_permlane32_swap(__float_as_uint(m),__float_as_uint(m),false,false);
  return max2f(__uint_as_float(rr[0]),__uint_as_float(rr[1]));
}
__device__ __forceinline__ void pv(f32x16*o,int vb,bf16x8 pa0,bf16x8 pa1,bf16x8 pa2,bf16x8 pa3){
  #pragma unroll
  for(int d0=0;d0<2;++d0){s16x4 lo[4],hi[4];
    #pragma unroll
    for(int ks=0;ks<4;++ks){
      asm volatile("ds_read_b64_tr_b16 %0,%1 offset:%c2":"=&v"(lo[ks]):"v"(vb),"i"(d0*4096+ks*1024):"memory");
      asm volatile("ds_read_b64_tr_b16 %0,%1 offset:%c2":"=&v"(hi[ks]):"v"(vb),"i"(d0*4096+ks*1024+512):"memory");}
    asm volatile("s_waitcnt lgkmcnt(0)":::"memory");SBAR();
    #define PK(k) (bf16x8){lo[k][0],lo[k][1],lo[k][2],lo[k][3],hi[k][0],hi[k][1],hi[k][2],hi[k][3]}
    o[d0]=__builtin_amdgcn_mfma_f32_32x32x16_bf16(pa0,PK(0),o[d0],0,0,0);
    o[d0]=__builtin_amdgcn_mfma_f32_32x32x16_bf16(pa1,PK(1),o[d0],0,0,0);
    o[d0]=__builtin_amdgcn_mfma_f32_32x32x16_bf16(pa2,PK(2),o[d0],0,0,0);
    o[d0]=__builtin_amdgcn_mfma_f32_32x32x16_bf16(pa3,PK(3),o[d0],0,0,0);
    #undef PK
  }
}

#ifndef ATTN_STORE16
#define ATTN_STORE16(p,v) (*(u32x4*)(p)=(v))
#endif
template<int DM,int LDO,int THRL> __device__ __forceinline__ void attn_unit(const bf16*Qw,const bf16*__restrict__ Kh,const bf16*__restrict__ Vh,bf16*Ow,int NT,int wt0,int wt1,int qi0,char*shm){
  const int tid=threadIdx.x,lane=tid&63,r32=lane&31,hi=lane>>5; const int wid=__builtin_amdgcn_readfirstlane(tid>>6);
  const unsigned lds0=(unsigned)(uintptr_t)shm;
  float*wsf=(float*)(shm+LDS_WS)+wid*64;
  const unsigned koff=(unsigned)(lane*DM+wid*8)*2u, voff=(unsigned)((16*(wid&3)+(lane>>2))*DM+(wid>>2)*32+(lane&3)*8)*2u;
  const unsigned kdst=lds0+LDS_K+wid*1024, vdst=lds0+LDS_V+wid*1024;
  #define DMA_K(t,slot) glds16(Kh+(long)(t)*KVBLK*DM,koff,(unsigned)__builtin_amdgcn_readfirstlane(kdst+(slot)))
  #define DMA_V(t,slot) glds16(Vh+(long)(t)*KVBLK*DM,voff,(unsigned)__builtin_amdgcn_readfirstlane(vdst+(slot)))
  const char*Kbase=shm+LDS_K; bf16x8 kf[8];
  const lds_cptr shm3=(lds_cptr)shm; const lds_cptr kp0=shm3+LDS_K+hi*1024+r32*16; const lds_cptr vp0=shm3+LDS_V+((lane>>4)&1)*32+(lane&3)*8+(4*hi+((lane&15)>>2))*64;
  DMA_K(0,0);DMA_V(0,0);DMA_K(1,SLOTB);
  bf16x8 qr[4];
  #pragma unroll
  for(int d0=0;d0<4;++d0)qr[d0]=*reinterpret_cast<const bf16x8*>(&Qw[(long)r32*DM+d0*16+hi*8]);
  float mhat=0.f,l_reg=0.f;f32x16 o[2];o[0]=f32x16{};o[1]=f32x16{};const f32x16 zz=f32x16{};
  const __attribute__((address_space(3))) float*tbr=(const __attribute__((address_space(3))) float*)((lds_cptr)shm+LDS_TB); const float cfar=__uint_as_float(__builtin_amdgcn_readfirstlane(__float_as_uint(tbr[0])));
  #define CMASK(P0,P1,t) do{ const int dc_=wt1-(t); \
    if(dc_<0||(t)<wt0){ const float mv_=MASKV-mhat; _Pragma("unroll") for(int r=0;r<16;++r){P0[r]=mv_;P1[r]=mv_;} } \
    else if(dc_>=3){ const float c_=cfar-mhat; _Pragma("unroll") for(int r=0;r<16;++r){P0[r]+=c_;P1[r]+=c_;} } \
    else{ const __attribute__((address_space(3))) float*tp_=tbr+(191-64*dc_-qi0-(int)(threadIdx.x&31u)+4*(int)((threadIdx.x>>5)&1u)); \
      _Pragma("unroll") for(int r=0;r<16;++r){ P0[r]+=tp_[(r&3)+8*(r>>2)]-mhat; P1[r]+=tp_[(r&3)+8*(r>>2)+32]-mhat; } } }while(0)
  bool resc=false;
  #define START(P0,P1) do{ const float rm=rowmax(P0,P1); resc=false; \
    { const float dl=rm; mhat=fadd_s(mhat,dl); \
      _Pragma("unroll") for(int r=0;r<16;++r){P0[r]=fsub_s(P0[r],dl);P1[r]=fsub_s(P1[r],dl);} \
      } \
    _Pragma("unroll") for(int r=0;r<16;++r)P0[r]=__builtin_amdgcn_exp2f(P0[r]); }while(0)
  #define RESC() do{ if(resc){ asm volatile("s_waitcnt lgkmcnt(0)":::"memory"); \
      _Pragma("unroll") for(int d_=0;d_<2;++d_) _Pragma("unroll") for(int r=0;r<16;++r)o[d_][r]*=wsf[crow(r,hi)]; } }while(0)
  f32x16 pA0,pA1,pB0,pB1;
  int sl_prev=0,sl_cur=0,sl_next=SLOTB;
  #define ROT() do{sl_prev=sl_cur;sl_cur=sl_next;sl_next=(sl_next==(NSLOT-1)*SLOTB)?0:sl_next+SLOTB;}while(0)
  DMA_K(2,2*SLOTB);
  WAIT_BAR(3);
  qkt(pA0,pA1,Kbase,qr,r32,hi);asm volatile("s_nop 15\n\ts_nop 7":"+v"(pA0),"+v"(pA1));CMASK(pA0,pA1,0);
  START(pA0,pA1);
  _Pragma("unroll") for(int r=0;r<16;++r)pA1[r]=__builtin_amdgcn_exp2f(pA1[r]);
  WAIT_BAR(0);
  DMA_K(3,0);DMA_V(1,SLOTB);
  ROT();
  kload8(kf,kp0+sl_cur);
  WAIT_BAR(2);
  s16x4 vlo[8],vhi[8]; u32x4 pw0,pw1,pw2,pw3;
  #define PKW(P,B) cvtpk_s(P[B],P[B+1])
  #define PAF(k) __builtin_bit_cast(bf16x8,pw##k)
  #define VFR(i) (bf16x8){vlo[i][0],vlo[i][1],vlo[i][2],vlo[i][3],vhi[i][0],vhi[i][1],vhi[i][2],vhi[i][3]}
  #define PIN(x) asm volatile("":"+v"(x))
  #define MX3(a,b,c) __builtin_fmaxf(__builtin_fmaxf((a),(b)),(c))
  #define GAPA(MF,A0,A1,A2,A3,W0,W1,PW) do{ MF; sacc+=A0; sacc+=A1; sacc+=A2; sacc+=A3; PIN(sacc); W0; W1; PIN(PW); SBAR(); }while(0)
  #define EX(v) __builtin_amdgcn_exp2f(v)
  #define GAPB(MF,X,B) do{ MF; X[B]=EX(X[B]); X[B+1]=EX(X[B+1]); X[B+2]=EX(X[B+2]); X[B+3]=EX(X[B+3]); PIN(X); SBAR(); }while(0)
  #define VRD(i) do{ vlo[i]=vtr(vp_+(((i)>>2)*4096+((i)&3)*1024)); vhi[i]=vtr(vp_+(((i)>>2)*4096+((i)&3)*1024+512)); }while(0)
  #define KRD(G,j) do{ if(G){ kload2(kf,kp0+sl_next,j); SBAR(); } }while(0)
  #define STEP(C0,C1,P0,P1,t,GK,GV,GL) do{ SBAR(); \
    const lds_cptr vp_=vp0+sl_prev; \
    VRD(0); SBAR(); float sacc=(P0[0]+P0[1]); \
    GAPA(C0=__builtin_amdgcn_mfma_f32_32x32x16_bf16(kf[0],qr[0],zz,0,0,0), P0[2],P0[3],P0[4],P0[5],     pw0[0]=PKW(P0,0), pw0[1]=PKW(P0,2), pw0); \
    VRD(4); SBAR(); GAPA(C1=__builtin_amdgcn_mfma_f32_32x32x16_bf16(kf[1],qr[0],zz,0,0,0), P0[6],P0[7],P0[8],P0[9],     pw0[2]=PKW(P0,4), pw0[3]=PKW(P0,6), pw0); \
    VRD(1); SBAR(); GAPA(C0=__builtin_amdgcn_mfma_f32_32x32x16_bf16(kf[2],qr[1],C0,0,0,0),   P0[10],P0[11],P0[12],P0[13], pw1[0]=PKW(P0,8), pw1[1]=PKW(P0,10), pw1); \
    VRD(5); SBAR(); GAPA(C1=__builtin_amdgcn_mfma_f32_32x32x16_bf16(kf[3],qr[1],C1,0,0,0),   P0[14],P0[15],P1[0],P1[1],   pw1[2]=PKW(P0,12),pw1[3]=PKW(P0,14), pw1); \
    VRD(2); SBAR(); GAPA(C0=__builtin_amdgcn_mfma_f32_32x32x16_bf16(kf[4],qr[2],C0,0,0,0),   P1[2],P1[3],P1[4],P1[5],     pw2[0]=PKW(P1,0), pw2[1]=PKW(P1,2), pw2); \
    VRD(6); SBAR(); GAPA(C1=__builtin_amdgcn_mfma_f32_32x32x16_bf16(kf[5],qr[2],C1,0,0,0),   P1[6],P1[7],P1[8],P1[9],     pw2[2]=PKW(P1,4), pw2[3]=PKW(P1,6), pw2); \
    VRD(3); SBAR(); GAPA(C0=__builtin_amdgcn_mfma_f32_32x32x16_bf16(kf[6],qr[3],C0,0,0,0),   P1[10],P1[11],P1[12],P1[13], pw3[0]=PKW(P1,8), pw3[1]=PKW(P1,10), pw3); \
    VRD(7); SBAR(); GAPA(C1=__builtin_amdgcn_mfma_f32_32x32x16_bf16(kf[7],qr[3],C1,0,0,0),   P1[14],P1[15],0.f,0.f,       pw3[2]=PKW(P1,12),pw3[3]=PKW(P1,14), pw3); \
    l_reg+=sacc; \
    if(GK){DMA_K((t)+3,sl_cur);} if(GV){DMA_V((t)+1,sl_next);} \
    CMASK(C0,C1,t); \
    { float a=MX3(C0[0],C0[1],C1[0]),b=MX3(C0[2],C0[3],C1[1]); a=MX3(a,C1[2],C1[3]); \
      _Pragma("unroll") for(int r=4;r<16;r+=4){a=MX3(a,C0[r],C0[r+1]);b=MX3(b,C0[r+2],C0[r+3]);a=MX3(a,C1[r],C1[r+1]);b=MX3(b,C1[r+2],C1[r+3]);} \
      float rm=__builtin_fmaxf(a,b); { auto rr=__builtin_amdgcn_permlane32_swap(__float_as_uint(rm),__float_as_uint(rm),false,false); rm=__builtin_fmaxf(__uint_as_float(rr[0]),__uint_as_float(rr[1])); } \
      resc=false; \
      if(__builtin_expect(__any(rm>(float)THRL),0)){ const float dl=__builtin_fmaxf(rm,0.f); mhat+=dl; \
        _Pragma("unroll") for(int r=0;r<16;++r){C0[r]-=dl;C1[r]-=dl;} \
        const float f=__builtin_amdgcn_exp2f(-dl); l_reg*=f; if(hi==0)wsf[r32]=f; resc=true; } } \
    SBAR(); \
    GAPB(o[0]=__builtin_amdgcn_mfma_f32_32x32x16_bf16(PAF(0),VFR(0),o[0],0,0,0), C0,0); \
    GAPB(o[1]=__builtin_amdgcn_mfma_f32_32x32x16_bf16(PAF(0),VFR(4),o[1],0,0,0), C0,4); \
    KRD(GL,0); GAPB(o[0]=__builtin_amdgcn_mfma_f32_32x32x16_bf16(PAF(1),VFR(1),o[0],0,0,0), C0,8); \
    KRD(GL,1); GAPB(o[1]=__builtin_amdgcn_mfma_f32_32x32x16_bf16(PAF(1),VFR(5),o[1],0,0,0), C0,12); \
    KRD(GL,2); GAPB(o[0]=__builtin_amdgcn_mfma_f32_32x32x16_bf16(PAF(2),VFR(2),o[0],0,0,0), C1,0); \
    KRD(GL,3); GAPB(o[1]=__builtin_amdgcn_mfma_f32_32x32x16_bf16(PAF(2),VFR(6),o[1],0,0,0), C1,4); \
    GAPB(o[0]=__builtin_amdgcn_mfma_f32_32x32x16_bf16(PAF(3),VFR(3),o[0],0,0,0), C1,8); \
    GAPB(o[1]=__builtin_amdgcn_mfma_f32_32x32x16_bf16(PAF(3),VFR(7),o[1],0,0,0), C1,12); \
    }while(0)
  int t=1;
  for(;t+5<NT;t+=2){
    STEP(pB0,pB1,pA0,pA1,t,true,true,true);     WAIT_BAR(2); RESC(); ROT();
    STEP(pA0,pA1,pB0,pB1,t+1,true,true,true);   WAIT_BAR(2); RESC(); ROT();
  }
  #define ENDW(tt) do{ if((tt)+3<NT){WAIT_BAR(2);} else if((tt)+2<NT){WAIT_BAR(1);} else {WAIT_BAR(0);} }while(0)
  for(;t+1<NT;t+=2){
    STEP(pB0,pB1,pA0,pA1,t,(t+3<NT),(t+1<NT),(t+1<NT));       ENDW(t);   RESC(); ROT();
    STEP(pA0,pA1,pB0,pB1,t+1,(t+4<NT),(t+2<NT),(t+2<NT));     ENDW(t+1); RESC(); ROT();
  }
  STEP(pB0,pB1,pA0,pA1,NT-1,false,false,false); RESC();
  { float sacc=pB0[0]+pB0[1]; _Pragma("unroll") for(int r=2;r<16;++r)sacc+=pB0[r]; _Pragma("unroll") for(int r=0;r<16;++r)sacc+=pB1[r]; l_reg+=sacc;
    pw0=(u32x4){PKW(pB0,0),PKW(pB0,2),PKW(pB0,4),PKW(pB0,6)};pw1=(u32x4){PKW(pB0,8),PKW(pB0,10),PKW(pB0,12),PKW(pB0,14)};pw2=(u32x4){PKW(pB1,0),PKW(pB1,2),PKW(pB1,4),PKW(pB1,6)};pw3=(u32x4){PKW(pB1,8),PKW(pB1,10),PKW(pB1,12),PKW(pB1,14)};
    SBAR(); pv(o,(int)(unsigned)(uintptr_t)(vp0+sl_cur),PAF(0),PAF(1),PAF(2),PAF(3)); }
  #undef PKW
  #undef PAF
  #undef VFR
  #undef PIN
  #undef MX3
  #undef GAPA
  #undef GAPB
  #undef EX
  #undef VRD
  #undef KRD
  #undef STEP
  #undef ENDW
  {auto rr=__builtin_amdgcn_permlane32_swap(__float_as_uint(l_reg),__float_as_uint(l_reg),false,false);l_reg=__uint_as_float(rr[0])+__uint_as_float(rr[1]);}
  if(hi==0)wsf[32+r32]=l_reg;asm volatile("s_waitcnt lgkmcnt(0)":::"memory");
  float rli[16];
  #pragma unroll
  for(int r=0;r<16;++r)rli[r]=__builtin_amdgcn_rcpf(wsf[32+crow(r,hi)]);
  { bf16*stg=(bf16*)(shm+LDS_OST)+wid*2048;
    #pragma unroll
    for(int r=0;r<16;++r){const int orow=crow(r,hi);
      #pragma unroll
      for(int d0=0;d0<2;++d0){ const float v_=o[d0][r]*rli[r]; const unsigned u_=__builtin_bit_cast(unsigned,v_); stg[orow*64+d0*32+r32]=(bf16)((u_+0x7fffu+((u_>>16)&1u))>>16); } }
    asm volatile("s_waitcnt lgkmcnt(0)":::"memory");
    #pragma unroll
    for(int i=0;i<4;++i){const int row=i*8+(lane>>3),ch=lane&7; const u32x4 v=*(const u32x4*)(stg+row*64+ch*8); *(u32x4*)(Ow+(long)row*LDO+ch*8)=v;} }
  asm volatile("s_waitcnt lgkmcnt(0)\n\ts_barrier":::"memory");
  #undef DMA_K
  #undef DMA_V
  #undef CMASK
  #undef START
  #undef RESC
  #undef ROT
}
#undef SBAR
#undef WAIT_BAR
}
namespace hgrn2 {
using bf16x8 = __attribute__((ext_vector_type(8))) short;
using f32x16 = __attribute__((ext_vector_type(16))) float;
using f32x4 = __attribute__((ext_vector_type(4))) float;
using u32x4 = __attribute__((ext_vector_type(4))) unsigned;
using u32x2 = __attribute__((ext_vector_type(2))) unsigned;
typedef unsigned short bf16;
#define HG_LAS __attribute__((address_space(3)))
constexpr int QS = 136, KS = 40, OS = 33;
constexpr int QD = 0, KD = QD + 32 * QS * 2, KET = KD + 32 * QS * 2, VT = KET + 128 * KS * 2, DEC = VT + 128 * KS * 2, PBSZ = DEC + 512;
constexpr int OT = 2 * PBSZ, SSP = OT + 4 * 32 * OS * 4, WG_BYTES = SSP + 2 * 512;
static_assert(WG_BYTES <= 131072 && PBSZ % 16 == 0 && OT % 16 == 0, "hgrn LDS map");
__device__ __forceinline__ int crow(int r, int hi) { return (r & 3) + 8 * (r >> 2) + 4 * hi; }
typedef float f32x2_t __attribute__((ext_vector_type(2))); typedef __bf16 bf16x2_t __attribute__((ext_vector_type(2)));
__device__ __forceinline__ unsigned cvtpk(float lo, float hi) { f32x2_t v = {lo, hi}; bf16x2_t b = __builtin_convertvector(v, bf16x2_t); return __builtin_bit_cast(unsigned, b); }
__device__ __forceinline__ float bf2f(unsigned short b) { return __builtin_bit_cast(float, (unsigned)b << 16); }
__device__ __forceinline__ bf16x8 packacc(const f32x16& x, int s) {
    u32x4 p; p[0] = cvtpk(x[8 * s], x[8 * s + 1]); p[1] = cvtpk(x[8 * s + 2], x[8 * s + 3]); p[2] = cvtpk(x[8 * s + 4], x[8 * s + 5]); p[3] = cvtpk(x[8 * s + 6], x[8 * s + 7]);
    return __builtin_bit_cast(bf16x8, p); }
__device__ __forceinline__ bf16x8 ldperm(const HG_LAS bf16* rowp, int k0, int hi) {
    const u32x2 a = *(const HG_LAS u32x2*)(rowp + k0 + 4 * hi), b = *(const HG_LAS u32x2*)(rowp + k0 + 8 + 4 * hi);
    u32x4 p; p[0] = a[0]; p[1] = a[1]; p[2] = b[0]; p[3] = b[1]; return __builtin_bit_cast(bf16x8, p); }
#define HG_MFMA(a, b, c) __builtin_amdgcn_mfma_f32_32x32x16_bf16((a), (b), (c), 0, 0, 0)

template <int LDP, int QOFF, int FOFF, int IOFF, int GOFF, int LDO, int OOFF, int SEQ_>
__device__ __forceinline__ void hgrn_pair(const bf16* P, bf16* O, const float* lb, const float* gw, int b, int h, HG_LAS unsigned char* lds, float eps) {
    constexpr int NB = SEQ_ / 32;
    const int tid = threadIdx.x, tid4 = tid & 255, lane = tid & 63, r32 = lane & 31, hi = lane >> 5; const int wave = __builtin_amdgcn_readfirstlane(tid >> 6); const int w4 = wave & 3;
    const size_t seq0 = (size_t)b * SEQ_;
    if (wave >= 4) {
        const int plane = tid4 & 63, rp = plane & 15, d0 = 8 * (4 * (tid4 >> 6) + (plane >> 4));
        const bf16* src0 = P + (seq0 + 2 * rp) * LDP + h * 128 + d0;
        u32x4 aF[2], aQ[2], aV[2], bF[2], bQ[2], bV[2];
#define HG_LOAD(F_, Q_, V_, n) do { const bf16* s_ = src0 + (size_t)(n) * 32 * LDP; _Pragma("unroll") for (int j = 0; j < 2; ++j) { F_[j] = *(const u32x4*)(s_ + (size_t)j * LDP + FOFF); Q_[j] = *(const u32x4*)(s_ + (size_t)j * LDP + QOFF); V_[j] = *(const u32x4*)(s_ + (size_t)j * LDP + IOFF); } } while (0)
#define HG_SHR(x, ctrl) __builtin_bit_cast(float, __builtin_amdgcn_update_dpp(0x3f800000, __builtin_bit_cast(int, (x)), (ctrl), 0xF, 0xF, false))
#define HG_PREP(F_, Q_, V_, pbo) do { \
        HG_LAS bf16* qd = (HG_LAS bf16*)(lds + (pbo) + QD); HG_LAS bf16* kd = (HG_LAS bf16*)(lds + (pbo) + KD); HG_LAS bf16* ket = (HG_LAS bf16*)(lds + (pbo) + KET); HG_LAS bf16* vt = (HG_LAS bf16*)(lds + (pbo) + VT); \
        HG_LAS float* dec = (HG_LAS float*)(lds + (pbo) + DEC); \
        float fa[8], fb[8], inc[8], exc[8]; \
        _Pragma("unroll") for (int e = 0; e < 8; ++e) { const unsigned wa = F_[0][e >> 1], wb = F_[1][e >> 1]; \
            fa[e] = (float)((e & 1) ? (wa >> 16) : (wa & 0xffffu)) * (1.f / 65536.f); fb[e] = (float)((e & 1) ? (wb >> 16) : (wb & 0xffffu)) * (1.f / 65536.f); inc[e] = fa[e] * fb[e]; } \
        _Pragma("unroll") for (int e = 0; e < 8; ++e) { inc[e] *= HG_SHR(inc[e], 0x111); inc[e] *= HG_SHR(inc[e], 0x112); inc[e] *= HG_SHR(inc[e], 0x114); inc[e] *= HG_SHR(inc[e], 0x118); exc[e] = HG_SHR(inc[e], 0x111); } \
        unsigned qwa[4], qwb[4], kwa[4], kwb[4]; float dtot[8], kea[8], keb[8]; \
        _Pragma("unroll") for (int e = 0; e < 8; ++e) dtot[e] = __shfl(inc[e], plane | 15); \
        _Pragma("unroll") for (int e = 0; e < 8; e += 2) { \
            const unsigned qa_ = Q_[0][e >> 1], qb_ = Q_[1][e >> 1]; \
            const float pa0 = exc[e] * fa[e], pa1 = exc[e + 1] * fa[e + 1], pb0 = inc[e], pb1 = inc[e + 1]; \
            qwa[e >> 1] = cvtpk(__builtin_bit_cast(float, qa_ << 16) * pa0, __builtin_bit_cast(float, qa_ & 0xffff0000u) * pa1); \
            qwb[e >> 1] = cvtpk(__builtin_bit_cast(float, qb_ << 16) * pb0, __builtin_bit_cast(float, qb_ & 0xffff0000u) * pb1); \
            const float ka0 = (1.f - fa[e]) * __builtin_amdgcn_rcpf(pa0), ka1 = (1.f - fa[e + 1]) * __builtin_amdgcn_rcpf(pa1), kb0 = (1.f - fb[e]) * __builtin_amdgcn_rcpf(pb0), kb1 = (1.f - fb[e + 1]) * __builtin_amdgcn_rcpf(pb1); \
            kwa[e >> 1] = cvtpk(ka0, ka1); kwb[e >> 1] = cvtpk(kb0, kb1); \
            kea[e] = ka0 * dtot[e]; kea[e + 1] = ka1 * dtot[e + 1]; keb[e] = kb0 * dtot[e]; keb[e + 1] = kb1 * dtot[e + 1]; } \
        *(HG_LAS u32x4*)(qd + (2 * rp) * QS + d0) = (u32x4){qwa[0], qwa[1], qwa[2], qwa[3]}; *(HG_LAS u32x4*)(qd + (2 * rp + 1) * QS + d0) = (u32x4){qwb[0], qwb[1], qwb[2], qwb[3]}; \
        *(HG_LAS u32x4*)(kd + (2 * rp) * QS + d0) = (u32x4){kwa[0], kwa[1], kwa[2], kwa[3]}; *(HG_LAS u32x4*)(kd + (2 * rp + 1) * QS + d0) = (u32x4){kwb[0], kwb[1], kwb[2], kwb[3]}; \
        _Pragma("unroll") for (int e = 0; e < 8; ++e) { const unsigned va_ = V_[0][e >> 1], vb_ = V_[1][e >> 1]; \
            *(HG_LAS unsigned*)(ket + (d0 + e) * KS + 2 * rp) = cvtpk(kea[e], keb[e]); \
            *(HG_LAS unsigned*)(vt + (d0 + e) * KS + 2 * rp) = (e & 1) ? ((va_ >> 16) | (vb_ & 0xffff0000u)) : ((va_ & 0xffffu) | (vb_ << 16)); } \
        if (rp == 15) { *(HG_LAS f32x4*)(dec + d0) = (f32x4){inc[0], inc[1], inc[2], inc[3]}; *(HG_LAS f32x4*)(dec + d0 + 4) = (f32x4){inc[4], inc[5], inc[6], inc[7]}; } } while (0)
        HG_LOAD(aF, aQ, aV, 0);
#pragma unroll 1
        for (int n = 0; n < NB + 2; n += 2) {
            if (n + 1 < NB) HG_LOAD(bF, bQ, bV, n + 1);
            if (n < NB) HG_PREP(aF, aQ, aV, 0);
            __syncthreads();
            if (n + 2 < NB) HG_LOAD(aF, aQ, aV, n + 2);
            if (n + 1 < NB) HG_PREP(bF, bQ, bV, PBSZ);
            __syncthreads();
        }
#undef HG_LOAD
#undef HG_PREP
#undef HG_SHR
    } else {
        __builtin_amdgcn_s_setprio(3);
        HG_LAS float* ot = (HG_LAS float*)(lds + OT) + w4 * 32 * OS;
        const int fl_ = lane & 31, eh = lane >> 5, ecol = 32 * w4 + 16 * eh;
        float gwv[16];
#pragma unroll
        for (int k = 0; k < 16; ++k) gwv[k] = gw[h * 128 + ecol + k];
        f32x16 S[4];
#pragma unroll
        for (int k = 0; k < 4; ++k) S[k] = f32x16{};
        float ov[16]; u32x4 g0 = {0u, 0u, 0u, 0u}, g1 = {0u, 0u, 0u, 0u};
#pragma unroll
        for (int k = 0; k < 16; ++k) ov[k] = 0.f;
#define HG_MMA(nb, pbo, sso) do { \
        const HG_LAS bf16* qd = (const HG_LAS bf16*)(lds + (pbo) + QD); const HG_LAS bf16* kd = (const HG_LAS bf16*)(lds + (pbo) + KD); const HG_LAS bf16* ket = (const HG_LAS bf16*)(lds + (pbo) + KET); \
        const HG_LAS bf16* vt = (const HG_LAS bf16*)(lds + (pbo) + VT); const HG_LAS float* dec = (const HG_LAS float*)(lds + (pbo) + DEC); HG_LAS float* ssp = (HG_LAS float*)(lds + SSP + (sso)); \
        { const bf16* gsrc = P + (seq0 + (size_t)(nb) * 32 + fl_) * LDP + GOFF + h * 128 + ecol; g0 = *(const u32x4*)(gsrc); g1 = *(const u32x4*)(gsrc + 8); } \
        f32x16 X = f32x16{}, X2 = f32x16{};                                       \
        _Pragma("unroll") for (int s = 0; s < 8; s += 2) { const bf16x8 a = *(const HG_LAS bf16x8*)(kd + r32 * QS + 16 * s + 8 * hi), bq_ = *(const HG_LAS bf16x8*)(qd + r32 * QS + 16 * s + 8 * hi); X = HG_MFMA(a, bq_, X); \
            const bf16x8 a2 = *(const HG_LAS bf16x8*)(kd + r32 * QS + 16 * (s + 1) + 8 * hi), bq2 = *(const HG_LAS bf16x8*)(qd + r32 * QS + 16 * (s + 1) + 8 * hi); X2 = HG_MFMA(a2, bq2, X2); } \
        _Pragma("unroll") for (int r = 0; r < 16; ++r) X[r] = crow(r, hi) <= r32 ? X[r] + X2[r] : 0.f; \
        const bf16x8 vf0 = ldperm(vt + (32 * w4 + r32) * KS, 0, hi), vf1 = ldperm(vt + (32 * w4 + r32) * KS, 16, hi); \
        f32x16 Oa = f32x16{}, Ob = f32x16{}, Oc = f32x16{}; \
        _Pragma("unroll") for (int blk = 0; blk < 2; ++blk) _Pragma("unroll") for (int s = 0; s < 2; ++s) { Ob = HG_MFMA(ldperm(qd + r32 * QS, 32 * blk + 16 * s, hi), packacc(S[blk], s), Ob); \
            Oc = HG_MFMA(ldperm(qd + r32 * QS, 32 * (blk + 2) + 16 * s, hi), packacc(S[blk + 2], s), Oc); } \
        Oa = HG_MFMA(packacc(X, 0), vf0, Oa); Oa = HG_MFMA(packacc(X, 1), vf1, Oa); \
        _Pragma("unroll") for (int r = 0; r < 16; ++r) Oa[r] += Ob[r] + Oc[r]; \
        _Pragma("unroll") for (int blk = 0; blk < 4; ++blk) { \
            _Pragma("unroll") for (int q4 = 0; q4 < 4; ++q4) { const f32x4 dv = *(const HG_LAS f32x4*)(dec + 32 * blk + 8 * q4 + 4 * hi); \
                _Pragma("unroll") for (int e = 0; e < 4; ++e) S[blk][4 * q4 + e] *= dv[e]; } \
            S[blk] = HG_MFMA(ldperm(ket + (32 * blk + r32) * KS, 0, hi), vf0, S[blk]); \
            S[blk] = HG_MFMA(ldperm(ket + (32 * blk + r32) * KS, 16, hi), vf1, S[blk]); } \
        _Pragma("unroll") for (int r = 0; r < 16; ++r) ot[crow(r, hi) * OS + r32] = Oa[r]; \
        asm volatile("s_waitcnt lgkmcnt(0)" ::: "memory"); \
        float ss = 0.f; \
        _Pragma("unroll") for (int k = 0; k < 16; ++k) { ov[k] = ot[fl_ * OS + 16 * eh + k]; ss += ov[k] * ov[k]; } \
        ss += __shfl_xor(ss, 32); \
        if (lane < 32) ssp[w4 * 32 + fl_] = ss; } while (0)
#define HG_FIN(nb, sso) do { \
        const HG_LAS float* ssp = (const HG_LAS float*)(lds + SSP + (sso)); \
        const float tot = (ssp[fl_] + ssp[32 + fl_]) + (ssp[64 + fl_] + ssp[96 + fl_]); const float rstd = 1.f / sqrtf(tot * (1.f / 128.f) + eps); \
        unsigned ow[8]; \
        _Pragma("unroll") for (int k = 0; k < 16; k += 2) { const unsigned gwd = k < 8 ? g0[k >> 1] : g1[(k - 8) >> 1]; \
            const float ga = bf2f((unsigned short)(gwd & 0xffffu)), gb = bf2f((unsigned short)(gwd >> 16)); \
            const float ra = ov[k] * rstd * gwv[k] * ga, rb = ov[k + 1] * rstd * gwv[k + 1] * gb;     \
            ow[k >> 1] = cvtpk(ra, rb); } \
        bf16* dst = O + (seq0 + (size_t)(nb) * 32 + fl_) * LDO + OOFF + h * 128 + ecol; \
        *(u32x4*)(dst) = (u32x4){ow[0], ow[1], ow[2], ow[3]}; *(u32x4*)(dst + 8) = (u32x4){ow[4], ow[5], ow[6], ow[7]}; } while (0)
#pragma unroll 1
        for (int n = 0; n < NB + 2; n += 2) {
            if (n >= 2) HG_FIN(n - 2, 0);
            if (n >= 1 && n <= NB) HG_MMA(n - 1, PBSZ, 512);
            __syncthreads();
            if (n >= 1 && n <= NB) HG_FIN(n - 1, 512);
            if (n < NB) HG_MMA(n, 0, 0);
            __syncthreads();
        }
#undef HG_MMA
#undef HG_FIN
        __builtin_amdgcn_s_setprio(0);
    }
    __syncthreads();
}
#undef HG_MFMA
}
#define GAS __attribute__((address_space(1)))
#define LAS __attribute__((address_space(3)))
typedef unsigned short bf16;
typedef unsigned v4u __attribute__((ext_vector_type(4)));
typedef float f32x4 __attribute__((ext_vector_type(4)));
typedef short bf16x8 __attribute__((ext_vector_type(8)));
typedef GAS unsigned gu32;
typedef GAS unsigned long long gu64;
#define RLX_AGENT __ATOMIC_RELAXED, __HIP_MEMORY_SCOPE_AGENT
#define LDS_WAIT() asm volatile("s_waitcnt lgkmcnt(0)" ::: "memory")
#define VM_WAIT() asm volatile("s_waitcnt vmcnt(0)" ::: "memory")
__device__ __forceinline__ unsigned long long rt() { return __builtin_amdgcn_s_memrealtime(); }
__device__ __forceinline__ unsigned f2bf(float f) { unsigned u = __builtin_bit_cast(unsigned, f); return (u + 0x7fffu + ((u >> 16) & 1u)) >> 16; }
__device__ __forceinline__ unsigned pk2(float lo, float hi) { return f2bf(lo) | (f2bf(hi) << 16); }

#define XB_TMO      128
#define XB_XCNT(j)  (256  + 64 * (j))
#define XB_XSUB(j)  (1280 + 64 * (j))
#define XB_XGEN(j)  (2304 + 64 * (j))
#define XB_TOP      3328
#define XB_TOPGEN   3392
#define XCD_BAR_WORDS 3456
#define XB_SPIN_CAP (1u << 18)

__device__ __forceinline__ unsigned xb_ld(unsigned* p)              { return __hip_atomic_load(p, __ATOMIC_RELAXED, __HIP_MEMORY_SCOPE_AGENT); }
__device__ __forceinline__ unsigned xb_add(unsigned* p, unsigned v) { return __hip_atomic_fetch_add(p, v, __ATOMIC_RELAXED, __HIP_MEMORY_SCOPE_AGENT); }
__device__ __forceinline__ unsigned xb_xcc_id() { return (unsigned)__builtin_amdgcn_s_getreg((3 << 11) | 20) & 0xFu; }
#define XB_SPIN(cond, bar) do { unsigned _sp = 0; while (cond) { __builtin_amdgcn_s_sleep(1); \
    if ((++_sp & 255u) == 0u) { if (xb_ld(&(bar)[XB_TMO])) break; if (_sp > XB_SPIN_CAP) { atomicAdd(&(bar)[XB_TMO], 1u); break; } } } } while (0)

struct XcdBarrier {
    unsigned* bar; unsigned x;
    volatile LAS unsigned* st;
};

__device__ __forceinline__ XcdBarrier xcd_barrier_post(unsigned* bar, volatile LAS unsigned* st) {
    XcdBarrier b; b.bar = bar; b.x = xb_xcc_id(); b.st = st;
    if (threadIdx.x == 0) (void)xb_add(&bar[XB_XCNT(b.x)], 1u);
    return b;
}
__device__ __forceinline__ void xcd_barrier_complete(unsigned* bar, unsigned x, unsigned& nloc, unsigned& nx) {
    const unsigned G = gridDim.x * gridDim.y * gridDim.z;
    unsigned sum, cnt, mine, sp = 0u;
    for (;;) {
        sum = 0u; cnt = 0u; mine = 0u;
#pragma unroll
        for (unsigned j = 0; j < 16; ++j) { const unsigned c = xb_ld(&bar[XB_XCNT(j)]); sum += c; cnt += (c > 0u) ? 1u : 0u; mine = (j == x) ? c : mine; }
        if (sum == G) break;
        __builtin_amdgcn_s_sleep(1);
        if ((++sp & 255u) == 0u) { if (xb_ld(&bar[XB_TMO])) break; if (sp > XB_SPIN_CAP) { atomicAdd(&bar[XB_TMO], 1u); break; } }
    }
    nloc = mine > 0u ? mine : 1u; nx = cnt > 0u ? cnt : 1u;
}

__device__ __forceinline__ void xcd_barrier(const XcdBarrier& b) {
    asm volatile("s_waitcnt vmcnt(0)" ::: "memory");
    __syncthreads();
    if (threadIdx.x == 0) {
        unsigned* bar = b.bar;
        __builtin_amdgcn_s_waitcnt(0);
        unsigned nloc = b.st[0], nx = b.st[1];
        if (nloc == 0u) { xcd_barrier_complete(bar, b.x, nloc, nx); b.st[0] = nloc; b.st[1] = nx; }
        const unsigned old = xb_add(&bar[XB_XSUB(b.x)], 1u);
        const unsigned gen = old / nloc;
        if (old + 1u == (gen + 1u) * nloc) {
            __builtin_amdgcn_fence(__ATOMIC_RELEASE, "agent");
            asm volatile("s_waitcnt vmcnt(0)" ::: "memory");
            const unsigned og = xb_add(&bar[XB_TOP], 1u);
            const unsigned tg = og / nx;
            if (og + 1u == (tg + 1u) * nx) xb_add(&bar[XB_TOPGEN], 1u);
            else XB_SPIN(xb_ld(&bar[XB_TOPGEN]) == tg, bar);
            __builtin_amdgcn_fence(__ATOMIC_ACQUIRE, "agent");
            xb_add(&bar[XB_XGEN(b.x)], 1u);
            asm volatile("s_waitcnt vmcnt(0)" ::: "memory");
        } else {
            XB_SPIN(xb_ld(&bar[XB_XGEN(b.x)]) == gen, bar);
            __builtin_amdgcn_fence(__ATOMIC_ACQUIRE, "agent");
            asm volatile("s_waitcnt vmcnt(0)" ::: "memory");
        }
    }
    __syncthreads();
}
struct Frame {
    LAS unsigned char* lds; char* ldsg;
    volatile LAS unsigned* MISC;
    gu32* ctl;
    int tid, lane, wave, G;
    unsigned char* ws;
    const float *x, *even_w_in, *even_w_out, *even_sinks, *lb_logits, *hgrn_norm_w, *odd_w_in, *odd_w_out, *odd_rel, *w_up, *conv_w, *conv_b, *w_down, *norm_w;
    float* out;
};
__device__ __forceinline__ float bf2f(bf16 b) { return __builtin_bit_cast(float, (unsigned)b << 16); }
__device__ __forceinline__ float wave_sum(float v) {
#pragma unroll
    for (int o = 1; o < 64; o <<= 1) v += __shfl_xor(v, o);
    return v;
}
__device__ __forceinline__ int colmap(int cmode, int n) {
    if (cmode == 1) { if (n >= 640) return n; const int p = n & 63; return (n - p) + (p >> 1) + 32 * (p & 1); }
    if (cmode == 2) { const int pn = n >> 8, r = n & 255; return r < 128 ? pn * 128 + r : DFF + pn * 128 + (r - 128); }
    return n;
}
__device__ __forceinline__ void transpose_item(const float* W, int K, int Nsrc, int Nout, bf16* WT, const float* kscale, int cmode, LAS float* scr, int item, int lane) {
    const int nblk = Nout / 32, kb = item / nblk, nb = item % nblk, k0 = 64 * kb, n0 = 32 * nb;
    const int nsrc = colmap(cmode, n0 + (lane & 31));
    float wv[32];
#pragma unroll
    for (int i = 0; i < 32; ++i) wv[i] = W[(size_t)(k0 + 2 * i + (lane >> 5)) * Nsrc + nsrc];
#pragma unroll
    for (int i = 0; i < 32; ++i) scr[(2 * i + (lane >> 5)) * 33 + (lane & 31)] = wv[i];
    LDS_WAIT(); asm volatile("" ::: "memory");
    const int c = lane & 7;
    f32x4 ksa = {1.f, 1.f, 1.f, 1.f}, ksb = {1.f, 1.f, 1.f, 1.f};
    if (kscale) { ksa = *(const GAS f32x4*)(kscale + k0 + 8 * c); ksb = *(const GAS f32x4*)(kscale + k0 + 8 * c + 4); }
#pragma unroll
    for (int j = 0; j < 4; ++j) { const int n = (lane >> 3) + 8 * j; const LAS float* s = scr + (8 * c) * 33 + n;
        v4u o; o.x = pk2(s[0 * 33] * ksa[0], s[1 * 33] * ksa[1]); o.y = pk2(s[2 * 33] * ksa[2], s[3 * 33] * ksa[3]); o.z = pk2(s[4 * 33] * ksb[0], s[5 * 33] * ksb[1]); o.w = pk2(s[6 * 33] * ksb[2], s[7 * 33] * ksb[3]);
        *(GAS v4u*)(WT + (size_t)(n0 + n) * K + k0 + 8 * c) = o; }
    LDS_WAIT(); asm volatile("" ::: "memory");
}
__device__ __forceinline__ void rms_row_to_bf16(int lane, const float* xrow, bf16* orow, float* scp) {
    const GAS f32x4* xr = (const GAS f32x4*)xrow + lane;
    f32x4 v[4]; float s = 0.f;
#pragma unroll
    for (int j = 0; j < 4; ++j) { v[j] = xr[64 * j]; s += (v[j].x * v[j].x + v[j].y * v[j].y) + (v[j].z * v[j].z + v[j].w * v[j].w); }
    const float rms = sqrtf(wave_sum(s) * (1.f / D) + EPS), rstd = 1.f / rms;
    if (lane == 0) *scp = rms;
    GAS unsigned long long* o8 = (GAS unsigned long long*)orow + lane;
#pragma unroll
    for (int j = 0; j < 4; ++j) o8[64 * j] = (unsigned long long)pk2(v[j].x * rstd, v[j].y * rstd) | ((unsigned long long)pk2(v[j].z * rstd, v[j].w * rstd) << 32);
}
__device__ __forceinline__ void p_prologue(Frame& F) {
    LAS float* scr = (LAS float*)(F.lds + RING_OFF + F.wave * 16384);
    const int gw = blockIdx.x * NWAVES + F.wave, NGW = F.G * NWAVES;
    constexpr int C0 = 1408, C1 = C0 + 512, C2_ = C1 + 1536, C3 = C2_ + 512, C4 = C3 + 2816, C5 = C4 + 2816, C6 = C5 + 1408, C7 = C6 + 1408;
#pragma unroll 1
    for (int git = gw; git < C7; git += NGW) {
        const int mat = git < C0 ? 0 : git < C1 ? 1 : git < C2_ ? 2 : git < C3 ? 3 : git < C4 ? 4 : git < C5 ? 5 : git < C6 ? 6 : 7;
        const int it = git - (mat == 0 ? 0 : mat == 1 ? C0 : mat == 2 ? C1 : mat == 3 ? C2_ : mat == 4 ? C3 : mat == 5 ? C4 : mat == 6 ? C5 : C6);
        const float* W; int K, Nsrc, Nout, cmode = 0; const float* ks = nullptr; size_t dst;
        if (mat == 0)      { W = F.even_w_in;  K = D; Nsrc = EVEN_IN; Nout = EVEN_IN; cmode = 1; ks = F.norm_w + 0 * D; dst = WS_WIN0; }
        else if (mat == 1) { W = F.even_w_out; K = D; Nsrc = D; Nout = D; dst = WS_WOUT0; }
        else if (mat == 2) { W = F.odd_w_in;   K = D; Nsrc = ODD_IN; Nout = ODD_IN; ks = F.norm_w + 4 * D; dst = WS_WIN1; }
        else if (mat == 3) { W = F.odd_w_out;  K = D; Nsrc = D; Nout = D; dst = WS_WOUT1; }
        else if (mat < 6)  { const int l = mat - 4; W = F.w_up + (size_t)l * D * UPN; K = D; Nsrc = UPN; Nout = UPN; cmode = 2; ks = F.norm_w + (size_t)(l * 4 + 2) * D; dst = WS_WUP + (size_t)l * 11 * MiB; }
        else               { const int l = mat - 6; W = F.w_down + (size_t)l * DFF * D; K = DFF; Nsrc = D; Nout = D; dst = WS_WDN + (size_t)l * 5632 * 1024; }
        transpose_item(W, K, Nsrc, Nout, (bf16*)(F.ws + dst), ks, cmode, scr, it, F.lane);
    }
    { float* tab = (float*)(F.ws + WS_TAB); const int gt = blockIdx.x * (NWAVES * 64) + F.tid, NT = F.G * NWAVES * 64;
      for (int e = gt; e < SEQ * 32; e += NT) { const int t = e >> 5, i = e & 31; const float inv = powf(10000.f, -(float)(2 * i) / 64.f); const float ang = (float)t * inv;
          tab[2 * e] = (float)cos((double)ang); tab[2 * e + 1] = (float)sin((double)ang); }
      float* lb = (float*)(F.ws + WS_LB);
      for (int e = gt; e < 512; e += NT) { const float a = F.lb_logits[e], b = F.lb_logits[512 + e]; const float mx = fmaxf(a, b); const float ea = expf(a - mx), eb = expf(b - mx); lb[e] = ea / (ea + eb); } }
    for (int m0 = gw; m0 < M; m0 += 2 * NGW) {
        const int m1 = m0 + NGW < M ? m0 + NGW : m0;
        const GAS f32x4* xa = (const GAS f32x4*)(F.x + (size_t)m0 * D) + F.lane; const GAS f32x4* xb = (const GAS f32x4*)(F.x + (size_t)m1 * D) + F.lane;
        f32x4 va[4], vb[4]; float sa = 0.f, sb = 0.f;
#pragma unroll
        for (int j = 0; j < 4; ++j) { va[j] = xa[64 * j]; vb[j] = xb[64 * j]; }
#pragma unroll
        for (int j = 0; j < 4; ++j) { sa += (va[j].x * va[j].x + va[j].y * va[j].y) + (va[j].z * va[j].z + va[j].w * va[j].w); sb += (vb[j].x * vb[j].x + vb[j].y * vb[j].y) + (vb[j].z * vb[j].z + vb[j].w * vb[j].w); }
        const float rmsa = sqrtf(wave_sum(sa) * (1.f / D) + EPS), rmsb = sqrtf(wave_sum(sb) * (1.f / D) + EPS), ra = 1.f / rmsa, rb = 1.f / rmsb;
        float* scp = (float*)(F.ws + WS_SC);
        GAS unsigned long long* oa = (GAS unsigned long long*)((bf16*)(F.ws + WS_XN) + (size_t)m0 * D) + F.lane; GAS unsigned long long* ob = (GAS unsigned long long*)((bf16*)(F.ws + WS_XN) + (size_t)m1 * D) + F.lane;
        if (F.lane == 0) { scp[m0] = rmsa; if (m1 != m0) scp[m1] = rmsb; }
#pragma unroll
        for (int j = 0; j < 4; ++j) oa[64 * j] = (unsigned long long)pk2(va[j].x * ra, va[j].y * ra) | ((unsigned long long)pk2(va[j].z * ra, va[j].w * ra) << 32);
        if (m1 != m0) {
#pragma unroll
            for (int j = 0; j < 4; ++j) ob[64 * j] = (unsigned long long)pk2(vb[j].x * rb, vb[j].y * rb) | ((unsigned long long)pk2(vb[j].z * rb, vb[j].w * rb) << 32); }
    }
}
__device__ __forceinline__ void p_norm(Frame& F, bf16* XNp, float* sc, const bf16* Y, const float* g, float* outf) {
    const int gw = blockIdx.x * NWAVES + F.wave, NGW = F.G * NWAVES;
    f32x4 gv[4];
#pragma unroll
    for (int j = 0; j < 4; ++j) gv[j] = ((const GAS f32x4*)g)[F.lane + 64 * j];
    constexpr int R = 2;
    for (int m0 = gw; m0 < M; m0 += R * NGW) {
        unsigned long long wx[R][4], wy[R][4]; float scm[R];
#pragma unroll
        for (int r = 0; r < R; ++r) { const int m = m0 + r * NGW; const int mm = m < M ? m : m0;
            const GAS unsigned long long* xr = (const GAS unsigned long long*)(XNp + (size_t)mm * D) + F.lane;
            const GAS unsigned long long* yr = (const GAS unsigned long long*)(Y + (size_t)mm * D) + F.lane;
            scm[r] = sc[mm];
#pragma unroll
            for (int j = 0; j < 4; ++j) { wx[r][j] = xr[64 * j]; wy[r][j] = yr[64 * j]; } }
#pragma unroll
        for (int r = 0; r < R; ++r) { const int m = m0 + r * NGW; if (m >= M) break;
            f32x4 h[4], y[4]; float s = 0.f;
#pragma unroll
            for (int j = 0; j < 4; ++j) { const unsigned long long a = wx[r][j], w = wy[r][j];
                h[j].x = __builtin_bit_cast(float, (unsigned)(a & 0xffffu) << 16); h[j].y = __builtin_bit_cast(float, (unsigned)(a >> 16 & 0xffffu) << 16);
                h[j].z = __builtin_bit_cast(float, (unsigned)(a >> 32 & 0xffffu) << 16); h[j].w = __builtin_bit_cast(float, (unsigned)(a >> 48 & 0xffffu) << 16);
                y[j].x = __builtin_bit_cast(float, (unsigned)(w & 0xffffu) << 16); y[j].y = __builtin_bit_cast(float, (unsigned)(w >> 16 & 0xffffu) << 16);
                y[j].z = __builtin_bit_cast(float, (unsigned)(w >> 32 & 0xffffu) << 16); y[j].w = __builtin_bit_cast(float, (unsigned)(w >> 48 & 0xffffu) << 16);
                s += (y[j].x * y[j].x + y[j].y * y[j].y) + (y[j].z * y[j].z + y[j].w * y[j].w); }
            const float r1 = 1.f / sqrtf(wave_sum(s) * (1.f / D) + EPS); float s2 = 0.f;
#pragma unroll
            for (int j = 0; j < 4; ++j) { h[j] = h[j] * scm[r] + y[j] * r1 * gv[j]; s2 += (h[j].x * h[j].x + h[j].y * h[j].y) + (h[j].z * h[j].z + h[j].w * h[j].w); }
            if (outf) { GAS f32x4* ho = (GAS f32x4*)(outf + (size_t)m * D) + F.lane;
#pragma unroll
                for (int j = 0; j < 4; ++j) ho[64 * j] = h[j]; }
            else { const float rms = sqrtf(wave_sum(s2) * (1.f / D) + EPS), r2 = 1.f / rms;
                if (F.lane == 0) sc[m] = rms;
                GAS unsigned long long* xo = (GAS unsigned long long*)(XNp + (size_t)m * D) + F.lane;
#pragma unroll
                for (int j = 0; j < 4; ++j) xo[64 * j] = (unsigned long long)pk2(h[j].x * r2, h[j].y * r2) | ((unsigned long long)pk2(h[j].z * r2, h[j].w * r2) << 32); }
        }
    }
}
__device__ __forceinline__ void p_fixup(Frame& F, bf16* H, const bf16* UL, const bf16* UF, const bf16* VF, const float* cw, const float* cb) {
    const int gt = blockIdx.x * (NWAVES * 64) + F.tid, NT = F.G * NWAVES * 64;
    constexpr int CH = DFF / 8, NIT = (M / 64) * 2 * CH;
    for (int it = gt; it < NIT; it += NT) {
        const int ch = it % CH, gr = it / CH, r = gr & 1, g = gr >> 1, j0 = ch * 8;
        const bool has_prev = (g & 31) != 0;
        const v4u z4 = {0u, 0u, 0u, 0u};
        const v4u u0 = *(const GAS v4u*)(UF + ((size_t)g * 2 + r) * DFF + j0);
        const v4u vv = *(const GAS v4u*)(VF + ((size_t)g * 2 + r) * DFF + j0);
        const v4u pl1 = has_prev ? *(const GAS v4u*)(UL + ((size_t)(g - 1) * 2 + 1) * DFF + j0) : z4;
        const v4u pl0 = has_prev ? *(const GAS v4u*)(UL + ((size_t)(g - 1) * 2 + 0) * DFF + j0) : z4;
        const v4u uf0 = *(const GAS v4u*)(UF + ((size_t)g * 2 + 0) * DFF + j0);
        const v4u um1 = r ? uf0 : pl1, um2 = r ? pl1 : pl0;
        float hh[8];
        const f32x4 kb0 = *(const GAS f32x4*)(cb + j0), kb1 = *(const GAS f32x4*)(cb + j0 + 4), k00 = *(const GAS f32x4*)(cw + j0), k01 = *(const GAS f32x4*)(cw + j0 + 4),
                    k10 = *(const GAS f32x4*)(cw + DFF + j0), k11 = *(const GAS f32x4*)(cw + DFF + j0 + 4), k20 = *(const GAS f32x4*)(cw + 2 * DFF + j0), k21 = *(const GAS f32x4*)(cw + 2 * DFF + j0 + 4);
#pragma unroll
        for (int e = 0; e < 8; ++e) { const int sh = (e & 1) * 16; const unsigned wa = u0[e >> 1], wb = um1[e >> 1], wc_ = um2[e >> 1], wv = vv[e >> 1];
            const float a = bf2f((bf16)(wa >> sh)), b = bf2f((bf16)(wb >> sh)), c = bf2f((bf16)(wc_ >> sh)), v = bf2f((bf16)(wv >> sh));
            const float pre = (e < 4 ? kb0[e & 3] : kb1[e & 3]) + (e < 4 ? k00[e & 3] : k01[e & 3]) * c + (e < 4 ? k10[e & 3] : k11[e & 3]) * b + (e < 4 ? k20[e & 3] : k21[e & 3]) * a;
            const pg8::f32x2 gg = pg8::gelu_pk((pg8::f32x2){pre, pre}); hh[e] = gg.x * v; }
        v4u o; o.x = pk2(hh[0], hh[1]); o.y = pk2(hh[2], hh[3]); o.z = pk2(hh[4], hh[5]); o.w = pk2(hh[6], hh[7]);
        *(GAS v4u*)(H + ((size_t)g * 64 + r) * DFF + j0) = o;
    }
}
__device__ __forceinline__ void p_attn1(Frame& F, const bf16* PROJ, bf16* OB) {
    LAS float* tbw = (LAS float*)(F.lds + RING_OFF + attn3::LDS_TB);
    for (int pair = blockIdx.x; pair < BATCH * 16; pair += F.G) {
        const int b = pair >> 4, h = pair & 15;
        if (F.tid < 320) { const int a = 319 - F.tid; tbw[F.tid] = F.odd_rel[h * 257 + (a > 256 ? 256 : a)] * LOG2E; }
        __syncthreads();
#pragma unroll 1
        for (int g4 = 0; g4 < 8; ++g4) {
            const int c0 = 4 * g4, jlo = c0 - 8 < 0 ? 0 : c0 - 8, NT = c0 + 4 - jlo, cw = c0 + (F.wave >> 1), wt1 = cw - jlo, wt0 = cw - 8 - jlo < 0 ? 0 : cw - 8 - jlo, qi0 = 32 * (F.wave & 1);
            const size_t row0 = (size_t)b * SEQ + 64 * cw + qi0, krow0 = (size_t)b * SEQ + 64 * jlo;
            attn3::attn_unit<ODD_IN, D, 8>(PROJ + row0 * ODD_IN + h * 64, PROJ + krow0 * ODD_IN + 1024 + h * 64, PROJ + krow0 * ODD_IN + 2048 + h * 64, OB + row0 * D + h * 64, NT, wt0, wt1, qi0, F.ldsg + RING_OFF);
        }
    }
}
__device__ __forceinline__ void p_attn0(Frame& F, const bf16* PROJ, bf16* OB, int first, int stride) {
#pragma unroll 1
    for (int u = first; u < BATCH * 2 * 32; u += stride) {
        const int c = u & 31, hk = (u >> 5) & 1, b = u >> 6, qh = 4 * hk + (F.wave >> 1), qpos0 = 64 * c + 32 * (F.wave & 1), jlo = c - 2 < 0 ? 0 : c - 2;
        const size_t row0 = (size_t)b * SEQ + qpos0, seq0 = (size_t)b * SEQ;
        attn2::band_unit<EVEN_IN, EVEN_IN, D, false, true>(PROJ + row0 * EVEN_IN + qh * 64, PROJ + seq0 * EVEN_IN + 512 + hk * 64, PROJ + seq0 * EVEN_IN + 640 + hk * 64,
                                                           OB + row0 * D + qh * 64, jlo, c, jlo, c, qpos0, F.even_sinks[qh] * LOG2E, F.ldsg + RING_OFF);
    }
}

__device__ __forceinline__ void p_hgrn(Frame& F, const bf16* PROJ, bf16* OB, const float* lb, int nhw) {
#pragma unroll 1
    for (int pair = blockIdx.x; pair < BATCH * 4; pair += nhw)
        hgrn2::hgrn_pair<EVEN_IN, QB_OFF, FB_OFF, IB_OFF, GB_OFF, D, 512, SEQ>(PROJ, OB, lb, F.hgrn_norm_w, pair >> 2, pair & 3, F.lds + RING_OFF, EPS);
}
constexpr int NPH = 17;
struct Args { const float* in[14]; float* out; unsigned char* ws; int ph_lo, ph_hi; };
__global__ void __launch_bounds__(NWAVES * 64, 2) mk_fwd(Args args) {
    extern __shared__ __attribute__((aligned(16))) unsigned char lds[];
    Frame F;
    F.lds = (LAS unsigned char*)lds; F.ldsg = (char*)lds;
    F.MISC = (volatile LAS unsigned*)(F.lds + MISC_OFF);
    F.tid = threadIdx.x; F.lane = F.tid & 63; F.wave = __builtin_amdgcn_readfirstlane(F.tid >> 6);
    F.G = gridDim.x;
    unsigned char* ws = args.ws; F.ws = ws;
    F.ctl = (gu32*)(ws + WS_CTL);
    F.x = args.in[0]; F.even_w_in = args.in[1]; F.even_w_out = args.in[2]; F.even_sinks = args.in[3]; F.lb_logits = args.in[4]; F.hgrn_norm_w = args.in[5];
    F.odd_w_in = args.in[6]; F.odd_w_out = args.in[7]; F.odd_rel = args.in[8]; F.w_up = args.in[9]; F.conv_w = args.in[10]; F.conv_b = args.in[11]; F.w_down = args.in[12]; F.norm_w = args.in[13];
    F.out = args.out;
    for (int u = F.tid; u < (LDS_BYTES - LDSCTL_OFF) / 4; u += NWAVES * 64) ((LAS unsigned*)(F.lds + LDSCTL_OFF))[u] = 0u;
    __syncthreads();
    const int lo = args.ph_lo, hi = args.ph_hi;
    XcdBarrier bar; bar.bar = (unsigned*)(F.ctl + CW_BAR); bar.x = 0; bar.st = nullptr;
    if (hi - lo > 1) {
        bar.x = xb_xcc_id(); bar.st = F.MISC + 8;
        if (F.tid == 0) F.MISC[10] = xb_add(&bar.bar[XB_XCNT(bar.x)], 1u);
    }
    int vcu = (int)blockIdx.x;
#define IN(k) (lo <= (k) && (k) < hi)
#define SEAM(k) do { if (IN(k) && IN((k) + 1)) xcd_barrier(bar); } while (0)
    bf16* const XN = (bf16*)(ws + WS_XN); bf16* const PROJ = (bf16*)(ws + WS_PROJ); bf16* const OB = (bf16*)(ws + WS_O); bf16* const YB = (bf16*)(ws + WS_Y);
    bf16* const UL = (bf16*)(ws + WS_SIDE); bf16* const UF = (bf16*)(ws + WS_SIDE + SIDE_STRIDE); bf16* const VF = (bf16*)(ws + WS_SIDE + 2 * SIDE_STRIDE);
    float* const SCB = (float*)(ws + WS_SC); const float* const tab = (const float*)(ws + WS_TAB); const float* const lbv = (const float*)(ws + WS_LB);

    if (IN(0)) { p_prologue(F); } SEAM(0);
    if (hi - lo > 1 && lo == 0) {
        if (F.tid == 0) { unsigned dense = 0u, nx = 0u; bool ok = (F.G % 8) == 0;
            for (unsigned j = 0; j < 16; ++j) { const unsigned cnt = xb_ld(&bar.bar[XB_XCNT(j)]); if (cnt) { ++nx; if (cnt != (unsigned)F.G / 8u) ok = false; } if (j < bar.x && cnt) ++dense; }
            const unsigned rank = F.MISC[10];
            F.MISC[11] = (ok && nx == 8u && rank < (unsigned)F.G / 8u) ? (8u * rank + dense) : 0xffffffffu; }
        __syncthreads();
        const unsigned v = F.MISC[11]; if (v != 0xffffffffu) vcu = (int)v;
    }

    if (IN(1)) { pg8::Gemm g{XN, (const bf16*)(ws + WS_WIN0), M, EVEN_IN, D}; pg8::StaticOrder S; S.init(M, EVEN_IN, F.G, vcu);
        typedef pg8::EpiIn<EVEN_IN, 640, 512, FB_OFF, FB_OFF + 512, GB_OFF, GB_OFF + 512> EpiIn0; EpiIn0 E{PROJ, C2, tab, lbv};
        pg8::gemm_phase<EpiIn0, pg8::StaticOrder, true, true>(F.lds + RING_OFF, g, S, E); } SEAM(1);
    if (IN(2)) { const int nhw = F.G >= 192 ? 128 : 0;
        if (nhw == 0) { p_attn0(F, PROJ, OB, (int)blockIdx.x, F.G); __syncthreads(); p_hgrn(F, PROJ, OB, lbv, F.G); }
        else if ((int)blockIdx.x < nhw) p_hgrn(F, PROJ, OB, lbv, nhw);
        else p_attn0(F, PROJ, OB, (int)blockIdx.x - nhw, F.G - nhw); } SEAM(2);
    if (IN(3)) { pg8::Gemm g{OB, (const bf16*)(ws + WS_WOUT0), M, D, D}; pg8::StaticOrder S; S.init(M, D, F.G, vcu);
        pg8::EpiBf16<0> E{YB, D, nullptr, 0, 0, 1.f};
        pg8::gemm_phase<pg8::EpiBf16<0>, pg8::StaticOrder, true, true>(F.lds + RING_OFF, g, S, E); } SEAM(3);
    if (IN(4)) { p_norm(F, XN, SCB, YB, F.norm_w + 1 * D, nullptr); } SEAM(4);
    if (IN(5)) { pg8::Gemm g{XN, (const bf16*)(ws + WS_WUP), M, UPN, D}; pg8::StaticOrder S; S.init(M, UPN, F.G, vcu);
        pg8::EpiConvGate E{PROJ, UL, UF, VF, F.conv_w, F.conv_b, DFF};
        pg8::gemm_phase<pg8::EpiConvGate, pg8::StaticOrder, true, true>(F.lds + RING_OFF, g, S, E); } SEAM(5);
    if (IN(6)) { p_fixup(F, PROJ, UL, UF, VF, F.conv_w, F.conv_b); } SEAM(6);
    if (IN(7)) { pg8::Gemm g{PROJ, (const bf16*)(ws + WS_WDN), M, D, DFF}; pg8::StaticOrder S; S.init(M, D, F.G, vcu);
        pg8::EpiBf16<0> E{YB, D, nullptr, 0, 0, 1.f};
        pg8::gemm_phase<pg8::EpiBf16<0>, pg8::StaticOrder, true, true>(F.lds + RING_OFF, g, S, E); } SEAM(7);
    if (IN(8)) { p_norm(F, XN, SCB, YB, F.norm_w + 3 * D, nullptr); } SEAM(8);
    if (IN(9)) { pg8::Gemm g{XN, (const bf16*)(ws + WS_WIN1), M, ODD_IN, D}; pg8::StaticOrder S; S.init(M, ODD_IN, F.G, vcu);
        typedef pg8::EpiIn<ODD_IN, 0, 1024, 0, 0, 0, 0> EpiIn1; EpiIn1 E{PROJ, C2, tab, lbv};
        pg8::gemm_phase<EpiIn1, pg8::StaticOrder, true, true>(F.lds + RING_OFF, g, S, E); } SEAM(9);
    if (IN(10)) { p_attn1(F, PROJ, OB); } SEAM(10);
    if (IN(11)) { pg8::Gemm g{OB, (const bf16*)(ws + WS_WOUT1), M, D, D}; pg8::StaticOrder S; S.init(M, D, F.G, vcu);
        pg8::EpiBf16<0> E{YB, D, nullptr, 0, 0, 1.f};
        pg8::gemm_phase<pg8::EpiBf16<0>, pg8::StaticOrder, true, true>(F.lds + RING_OFF, g, S, E); } SEAM(11);
    if (IN(12)) { p_norm(F, XN, SCB, YB, F.norm_w + 5 * D, nullptr); } SEAM(12);
    if (IN(13)) { pg8::Gemm g{XN, (const bf16*)(ws + WS_WUP + 11 * MiB), M, UPN, D}; pg8::StaticOrder S; S.init(M, UPN, F.G, vcu);
        pg8::EpiConvGate E{PROJ, UL, UF, VF, F.conv_w + 3 * DFF, F.conv_b + DFF, DFF};
        pg8::gemm_phase<pg8::EpiConvGate, pg8::StaticOrder, true, true>(F.lds + RING_OFF, g, S, E); } SEAM(13);
    if (IN(14)) { p_fixup(F, PROJ, UL, UF, VF, F.conv_w + 3 * DFF, F.conv_b + DFF); } SEAM(14);
    if (IN(15)) { pg8::Gemm g{PROJ, (const bf16*)(ws + WS_WDN + (size_t)5632 * 1024), M, D, DFF}; pg8::StaticOrder S; S.init(M, D, F.G, vcu);
        pg8::EpiBf16<0> E{YB, D, nullptr, 0, 0, 1.f};
        pg8::gemm_phase<pg8::EpiBf16<0>, pg8::StaticOrder, true, true>(F.lds + RING_OFF, g, S, E); } SEAM(15);
    if (IN(16)) { p_norm(F, XN, SCB, YB, F.norm_w + 7 * D, F.out); }
#undef IN
#undef SEAM
}

#ifndef MK_ONE_LAUNCH
#define MK_ONE_LAUNCH 1
#endif
extern "C" void kernel_launch(void* const* d_in, const int* in_sizes, int n_in, void* d_out, int out_size, void* d_ws, size_t ws_size, hipStream_t stream) {
    static int grid = 0;
    if (grid == 0) {
        if (n_in != 14 || in_sizes[0] != M * D || out_size != M * D || ws_size < WS_END) { fprintf(stderr, "kernel_launch: unexpected shapes (n_in %d, in0 %d, out %d, ws %zu); nothing launched\n", n_in, n_in > 0 ? in_sizes[0] : -1, out_size, ws_size); grid = -1; return; }
        int dev = 0, cus = 0, per_cu = 0;
        if (hipGetDevice(&dev) != hipSuccess || hipDeviceGetAttribute(&cus, hipDeviceAttributeMultiprocessorCount, dev) != hipSuccess) { grid = -1; return; }
        if (hipFuncSetAttribute((const void*)mk_fwd, hipFuncAttributeMaxDynamicSharedMemorySize, LDS_BYTES) != hipSuccess) { fprintf(stderr, "kernel_launch: hipFuncSetAttribute failed\n"); grid = -1; return; }
        if (hipOccupancyMaxActiveBlocksPerMultiprocessor(&per_cu, (const void*)mk_fwd, NWAVES * 64, LDS_BYTES) != hipSuccess || per_cu < 1) { fprintf(stderr, "kernel_launch: occupancy query says %d\n", per_cu); }
        (void)hipGetLastError();
        grid = cus;
    }
    if (grid < 0) return;
    if (hipMemsetAsync((char*)d_ws + WS_CTL, 0, CTL_ZERO_BYTES, stream) != hipSuccess) return;
    Args a{};
    for (int i = 0; i < 14; ++i) a.in[i] = (const float*)d_in[i];
    a.out = (float*)d_out; a.ws = (unsigned char*)d_ws;
#if MK_ONE_LAUNCH
    a.ph_lo = 0; a.ph_hi = NPH;
    hipLaunchKernelGGL(mk_fwd, dim3(grid), dim3(NWAVES * 64), LDS_BYTES, stream, a);
#else
    for (int k = 0; k < NPH; ++k) { a.ph_lo = k; a.ph_hi = k + 1; hipLaunchKernelGGL(mk_fwd, dim3(grid), dim3(NWAVES * 64), LDS_BYTES, stream, a); }
#endif
}
```

```cpp
#include <hip/hip_runtime.h>
#include <cstdio>
#include <cstdint>
#include <cmath>
namespace pg8 {
#define PG8_LAS __attribute__((address_space(3)))
typedef unsigned short bf16_t;
typedef short bf16x8 __attribute__((ext_vector_type(8)));
typedef float f32x4 __attribute__((ext_vector_type(4)));
typedef unsigned u32x4 __attribute__((ext_vector_type(4)));
constexpr int BM = 256, BK = 64, HALF = 128, HTB = HALF * BK * 2  , STAGE_BYTES = 8 * HTB, NXCD = 8, WGM = 8;

__host__ __device__ __forceinline__ int lds_byte(int r, int c) { const int st = (r >> 4) * 2 + (c >> 5), rr = r & 15, cc = c & 31, ob = rr * 64 + cc * 2; return st * 1024 + (ob ^ (((ob >> 9) & 1) << 5)); }
__host__ __device__ __forceinline__ void stage_rc(int b, int& R, int& C) { const int st = b / 1024, sb = b % 1024, swz = sb ^ (((sb >> 9) & 1) << 5); R = (st >> 1) * 16 + swz / 64; C = (st & 1) * 32 + (swz % 64) / 2; }
__host__ __device__ __forceinline__ int perm32(int rho) { const int n = rho >> 4, i = rho & 15; return 8 * (i >> 2) + 4 * n + (i & 3); }

struct Unit { int pm, pn; };
struct Gemm { const bf16_t* A; const bf16_t* Bt; int M, N, K; };

struct StaticOrder {
    int nM, nN, nwg, G, c;
    __host__ __device__ void init(int M, int N, int G_, int c_) { nM = M / BM; nN = N / BM; nwg = nM * nN; G = G_; c = c_; }
    __host__ __device__ bool next(int i, Unit& u) const {
        const long L = (long)i * G + c; if (L >= nwg) return false;
        int wgid = (int)L; { const int q = nwg / NXCD, r = nwg % NXCD, xcd = wgid % NXCD, off = wgid / NXCD; wgid = (xcd < r ? xcd * (q + 1) : r * (q + 1) + (xcd - r) * q) + off; }
        const int nig = WGM * nN, gid = wgid / nig, fm = gid * WGM, gsz = (nM - fm) < WGM ? (nM - fm) : WGM;
        u.pm = fm + ((wgid % nig) % gsz); u.pn = (wgid % nig) / gsz; return true;
    }
    __device__ __forceinline__ void a_ready(const Unit&) const {}
    __device__ __forceinline__ void done(const Unit&) const {}
};

__device__ __forceinline__ unsigned cvt_pk_bf16(float lo, float hi) { unsigned r; asm volatile("v_cvt_pk_bf16_f32 %0, %1, %2" : "=v"(r) : "v"(lo), "v"(hi)); return r; }
typedef float f32x2 __attribute__((ext_vector_type(2)));
__device__ __forceinline__ f32x2 gelu_pk(f32x2 v) {
    const f32x2 av = __builtin_elementwise_abs(v), d = av * 0.2316418882f + 1.0f;
    f32x2 t; t.x = __builtin_amdgcn_rcpf(d.x); t.y = __builtin_amdgcn_rcpf(d.y);
    f32x2 q = t * 0.5307027145f + (-0.7265760135f); q = q * t + 0.7107068705f; q = q * t + (-0.142248368f); q = q * t + 0.127414796f; q = q * t;
    const f32x2 s = (v * v) * (-0.72134752044f);
    f32x2 e; e.x = __builtin_amdgcn_exp2f(s.x); e.y = __builtin_amdgcn_exp2f(s.y);
    const f32x2 m = v * (q * e), r = v - m;
    f32x2 o; o.x = v.x < 0.f ? m.x : r.x; o.y = v.y < 0.f ? m.y : r.y; return o;
}

template <int ACT  > struct EpiBf16 {
    static constexpr bool PERM = true, AFTER_DRAIN = false; static_assert(ACT == 0 || ACT == 1, "EpiBf16: ACT is 0 (none) or 1 (gelu_pk)");
    bf16_t* O; int ldc; const float* bias; int split_cols; size_t split_stride; float scale0;
    __device__ __forceinline__ void operator()(const f32x4 (&acc)[2][2][4][2], const Unit& u, int wr, int wc, int fr, int fq) const {
        const int row0 = u.pm * BM + wr * 64 + fr; int colt = u.pn * BM; bf16_t* base = O;
        float sc = 1.f; if (split_cols) { const int t = colt / split_cols; base += (size_t)t * split_stride; colt -= t * split_cols; if (t == 0) sc = scale0; }
        const int col0 = colt + wc * 32 + 8 * fq, bcol0 = u.pn * BM + wc * 32 + 8 * fq;
        f32x4 bv[2][2];
#pragma unroll
        for (int bj = 0; bj < 2; ++bj)
#pragma unroll
            for (int n = 0; n < 2; ++n) bv[bj][n] = bias ? *(const f32x4*)(bias + bcol0 + bj * HALF + 4 * n) : (f32x4){0.f, 0.f, 0.f, 0.f};
#pragma unroll
        for (int ai = 0; ai < 2; ++ai)
#pragma unroll
            for (int m = 0; m < 4; ++m) { bf16_t* rowp = base + (size_t)(row0 + ai * HALF + m * 16) * ldc + col0;
#pragma unroll
                for (int bj = 0; bj < 2; ++bj) { f32x4 v0 = acc[ai][bj][m][0] + bv[bj][0], v1 = acc[ai][bj][m][1] + bv[bj][1];
                    if (ACT == 1) { f32x2 a = gelu_pk((f32x2){v0[0], v0[1]}), b = gelu_pk((f32x2){v0[2], v0[3]}), c = gelu_pk((f32x2){v1[0], v1[1]}), d = gelu_pk((f32x2){v1[2], v1[3]});
                        v0 = (f32x4){a.x, a.y, b.x, b.y}; v1 = (f32x4){c.x, c.y, d.x, d.y}; }
                    v0 = v0 * sc; v1 = v1 * sc; u32x4 w; w.x = cvt_pk_bf16(v0[0], v0[1]); w.y = cvt_pk_bf16(v0[2], v0[3]); w.z = cvt_pk_bf16(v1[0], v1[1]); w.w = cvt_pk_bf16(v1[2], v1[3]);
                    *(u32x4*)(rowp + bj * HALF) = w; } }
    }
};
template <int LDC, int ROPE_COLS, int SCALE_COLS, int GATE_LO, int GATE_HI, int SILU_LO, int SILU_HI> struct EpiIn {
    static constexpr bool PERM = true, AFTER_DRAIN = false;
    static constexpr int ldc = LDC, rope_cols = ROPE_COLS, scale_cols = SCALE_COLS, gate_lo = GATE_LO, gate_hi = GATE_HI;
    bf16_t* O; float scale; const float* tab; const float* lb;
    __device__ __forceinline__ void operator()(const f32x4 (&acc)[2][2][4][2], const Unit& u, int wr, int wc, int fr, int fq) const {
        const int row0 = u.pm * BM + wr * 64 + fr; const int colt = u.pn * BM;
        const int col0 = colt + wc * 32 + 8 * fq; const int i0 = 16 * (wc & 1) + 4 * fq;
#pragma unroll
        for (int ai = 0; ai < 2; ++ai)
#pragma unroll
            for (int m = 0; m < 4; ++m) { const int row = row0 + ai * HALF + m * 16; const int t = row & 2047; bf16_t* rowp = O + (size_t)row * ldc + col0;
#pragma unroll
                for (int bj = 0; bj < 2; ++bj) { f32x4 v0 = acc[ai][bj][m][0], v1 = acc[ai][bj][m][1]; const int cb = colt + bj * HALF;
                    if (cb < rope_cols) { const f32x4 c0 = *(const f32x4*)(tab + (size_t)(t * 32 + i0) * 2), c1 = *(const f32x4*)(tab + (size_t)(t * 32 + i0) * 2 + 4);
                        f32x4 r0, r1;
                        r0[0] = v0[0] * c0[0] - v0[1] * c0[1]; r0[1] = v0[1] * c0[0] + v0[0] * c0[1]; r0[2] = v0[2] * c0[2] - v0[3] * c0[3]; r0[3] = v0[3] * c0[2] + v0[2] * c0[3];
                        r1[0] = v1[0] * c1[0] - v1[1] * c1[1]; r1[1] = v1[1] * c1[0] + v1[0] * c1[1]; r1[2] = v1[2] * c1[2] - v1[3] * c1[3]; r1[3] = v1[3] * c1[2] + v1[2] * c1[3];
                        v0 = r0; v1 = r1; }
                    if (cb < scale_cols) { v0 = v0 * scale; v1 = v1 * scale; }
                    if (cb >= SILU_LO && cb < SILU_HI) {
#pragma unroll
                        for (int e_ = 0; e_ < 4; ++e_) { v0[e_] = v0[e_] * __builtin_amdgcn_rcpf(1.f + __expf(-v0[e_])); v1[e_] = v1[e_] * __builtin_amdgcn_rcpf(1.f + __expf(-v1[e_])); } }
                    if (cb >= gate_lo && cb < gate_hi) { const f32x4 l0 = *(const f32x4*)(lb + (col0 + bj * HALF - gate_lo)), l1 = *(const f32x4*)(lb + (col0 + bj * HALF - gate_lo) + 4);
                        f32x4 fa, fb;
#pragma unroll
                        for (int e_ = 0; e_ < 4; ++e_) { fa[e_] = __builtin_fminf((l0[e_] + (1.f - l0[e_]) * __builtin_amdgcn_rcpf(1.f + __expf(-v0[e_]))) * 65536.f + 0.5f, 65535.f);
                            fb[e_] = __builtin_fminf((l1[e_] + (1.f - l1[e_]) * __builtin_amdgcn_rcpf(1.f + __expf(-v1[e_]))) * 65536.f + 0.5f, 65535.f); }
                        u32x4 wq; wq.x = (unsigned)fa[0] | ((unsigned)fa[1] << 16); wq.y = (unsigned)fa[2] | ((unsigned)fa[3] << 16); wq.z = (unsigned)fb[0] | ((unsigned)fb[1] << 16); wq.w = (unsigned)fb[2] | ((unsigned)fb[3] << 16);
                        *(u32x4*)(rowp + bj * HALF) = wq; }
                    else {
                    u32x4 w; w.x = cvt_pk_bf16(v0[0], v0[1]); w.y = cvt_pk_bf16(v0[2], v0[3]); w.z = cvt_pk_bf16(v1[0], v1[1]); w.w = cvt_pk_bf16(v1[2], v1[3]);
                    *(u32x4*)(rowp + bj * HALF) = w; } } }
    }
};
struct EpiConvGate {
    static constexpr bool PERM = true, AFTER_DRAIN = false;
    bf16_t* H; bf16_t* UL; bf16_t* UF; bf16_t* VF; const float* cw; const float* cb; int ff;
    __device__ __forceinline__ void operator()(const f32x4 (&acc)[2][2][4][2], const Unit& u, int wr, int wc, int fr, int fq) const {
        const int j0 = u.pn * HALF + wc * 32 + 8 * fq; const int lane = (int)(threadIdx.x & 63);
        float k0[8], k1[8], k2[8], kb[8];
#pragma unroll
        for (int q = 0; q < 2; ++q) { const f32x4 a = *(const f32x4*)(cw + j0 + 4 * q), b = *(const f32x4*)(cw + ff + j0 + 4 * q), c = *(const f32x4*)(cw + 2 * ff + j0 + 4 * q), d = *(const f32x4*)(cb + j0 + 4 * q);
#pragma unroll
            for (int e = 0; e < 4; ++e) { k0[4 * q + e] = a[e]; k1[4 * q + e] = b[e]; k2[4 * q + e] = c[e]; kb[4 * q + e] = d[e]; } }
#pragma unroll
        for (int ai = 0; ai < 2; ++ai) {
            float pr1[8], pr2[8];
#pragma unroll
            for (int e = 0; e < 8; ++e) { pr1[e] = 0.f; pr2[e] = 0.f; }
#pragma unroll
            for (int m = 0; m < 4; ++m) { const int row = u.pm * BM + ai * HALF + wr * 64 + m * 16 + fr;
                float uu[8], vv[8], hh[8];
#pragma unroll
                for (int e = 0; e < 4; ++e) { uu[e] = acc[ai][0][m][0][e]; uu[4 + e] = acc[ai][0][m][1][e]; vv[e] = acc[ai][1][m][0][e]; vv[4 + e] = acc[ai][1][m][1][e]; }
#pragma unroll
                for (int e = 0; e < 8; ++e) { const float r1 = __builtin_bit_cast(float, __builtin_amdgcn_update_dpp(0, __builtin_bit_cast(int, uu[e]), 0x121  , 0xF, 0xF, false)),
                                                          r2 = __builtin_bit_cast(float, __builtin_amdgcn_update_dpp(0, __builtin_bit_cast(int, uu[e]), 0x122  , 0xF, 0xF, false));
                    const float p1 = fr >= 1 ? r1 : pr1[e], p2 = fr >= 2 ? r2 : pr2[e]; pr1[e] = r1; pr2[e] = r2;
                    hh[e] = kb[e] + k0[e] * p2 + k1[e] * p1 + k2[e] * uu[e]; }
#pragma unroll
                for (int e = 0; e < 8; e += 2) { const f32x2 g = gelu_pk((f32x2){hh[e], hh[e + 1]}); hh[e] = g.x * vv[e]; hh[e + 1] = g.y * vv[e + 1]; }
                u32x4 w; w.x = cvt_pk_bf16(hh[0], hh[1]); w.y = cvt_pk_bf16(hh[2], hh[3]); w.z = cvt_pk_bf16(hh[4], hh[5]); w.w = cvt_pk_bf16(hh[6], hh[7]);
                *(u32x4*)(H + (size_t)row * ff + j0) = w;
                if (m == 3 && fr >= 14) { u32x4 s; s.x = cvt_pk_bf16(uu[0], uu[1]); s.y = cvt_pk_bf16(uu[2], uu[3]); s.z = cvt_pk_bf16(uu[4], uu[5]); s.w = cvt_pk_bf16(uu[6], uu[7]);
                    *(u32x4*)(UL + ((size_t)(row >> 6) * 2 + (fr - 14)) * ff + j0) = s; }
                if (m == 0 && fr < 2) { u32x4 s; s.x = cvt_pk_bf16(uu[0], uu[1]); s.y = cvt_pk_bf16(uu[2], uu[3]); s.z = cvt_pk_bf16(uu[4], uu[5]); s.w = cvt_pk_bf16(uu[6], uu[7]);
                    *(u32x4*)(UF + ((size_t)(row >> 6) * 2 + fr) * ff + j0) = s;
                    u32x4 z; z.x = cvt_pk_bf16(vv[0], vv[1]); z.y = cvt_pk_bf16(vv[2], vv[3]); z.z = cvt_pk_bf16(vv[4], vv[5]); z.w = cvt_pk_bf16(vv[6], vv[7]);
                    *(u32x4*)(VF + ((size_t)(row >> 6) * 2 + fr) * ff + j0) = z; }
            }
        }
    }
};
template <class Epi, class Sched, bool ALIGN_EPI = false, bool SP2 = false>
__device__ __forceinline__ void gemm_phase(PG8_LAS unsigned char* lds, const Gemm g, const Sched& S, const Epi& E) {
    const int tid = threadIdx.x, wid = __builtin_amdgcn_readfirstlane(tid >> 6), lane = tid & 63, wr = wid >> 2, wc = wid & 3, fr = lane & 15, fq = lane >> 4;
    const int K = g.K, nt = K / BK;
    unsigned voffA[2], voffB[2];
#pragma unroll
    for (int i = 0; i < 2; ++i) { int R, C; stage_rc(tid * 16 + i * 8192, R, C); const int Rb = Epi::PERM ? ((R & ~31) + perm32(R & 31)) : R;
        voffA[i] = (unsigned)(R * K + C) * 2u; voffB[i] = (unsigned)(Rb * K + C) * 2u; }
    const size_t kstep = (size_t)(BK * 2);
    const size_t hstep = (size_t)HALF * K * 2;
    const size_t tstep = 2 * hstep;
    const unsigned ldsw = (unsigned)wid * 1024u;
    const int aoff = lds_byte(wr * 64 + fr, fq * 8), boff = lds_byte(wc * 32 + fr, fq * 8);
#define PG8_SA(b, h) (((b) * 2 + (h)) * HTB)
#define PG8_SB(b, h) ((4 + (b) * 2 + (h)) * HTB)
#define PG8_STAGE(bufoff, gbase, voff) do { _Pragma("unroll") for (int _i = 0; _i < 2; ++_i) \
        __builtin_amdgcn_global_load_lds((const unsigned*)((const char*)(gbase) + (voff)[_i]), (PG8_LAS unsigned*)(lds + (bufoff) + ldsw + _i * 8192), 16, 0, 0); } while (0)
#define PG8_LDA(dst, b, h) do { __builtin_amdgcn_s_setprio(2); _Pragma("unroll") for (int m = 0; m < 4; ++m) _Pragma("unroll") for (int k = 0; k < 2; ++k) dst[m][k] = *(const PG8_LAS bf16x8*)(lds + PG8_SA(b, h) + aoff + m * 2048 + k * 1024); } while (0)
#define PG8_LDB(dst, b, h) do { __builtin_amdgcn_s_setprio(2); _Pragma("unroll") for (int n = 0; n < 2; ++n) _Pragma("unroll") for (int k = 0; k < 2; ++k) dst[n][k] = *(const PG8_LAS bf16x8*)(lds + PG8_SB(b, h) + boff + n * 2048 + k * 1024); } while (0)
#define PG8_MMA(ai, bj, At, Bt) do { __builtin_amdgcn_s_setprio(1); _Pragma("unroll") for (int m = 0; m < 4; ++m) _Pragma("unroll") for (int n = 0; n < 2; ++n) _Pragma("unroll") for (int k = 0; k < 2; ++k) \
        acc[ai][bj][m][n] = __builtin_amdgcn_mfma_f32_16x16x32_bf16(Bt[n][k], At[m][k], acc[ai][bj][m][n], 0, 0, 0); __builtin_amdgcn_s_setprio(0); } while (0)
#define PG8_WAIT_V(n) asm volatile("s_setprio 0\n\ts_waitcnt vmcnt(" #n ")" ::: "memory")
#define PG8_WAIT_L(n) asm volatile("s_waitcnt lgkmcnt(" #n ")" ::: "memory")
#define PG8_BAR __builtin_amdgcn_s_barrier()
#define PG8_SCHED __builtin_amdgcn_sched_barrier(0)
    Unit cur, nxt; int ui = 0;
    if (!S.next(0, cur)) return;
    f32x4 acc[2][2][4][2];
#pragma unroll
    for (int a = 0; a < 2; ++a)
#pragma unroll
        for (int b = 0; b < 2; ++b)
#pragma unroll
            for (int m = 0; m < 4; ++m)
#pragma unroll
                for (int n = 0; n < 2; ++n) acc[a][b][m][n] = (f32x4){0.f, 0.f, 0.f, 0.f};
    bf16x8 At[4][2], B0[2][2], B1[2][2];
    const char* cA = (const char*)g.A + (size_t)cur.pm * tstep; const char* cB = (const char*)g.Bt + (size_t)cur.pn * tstep;
    S.a_ready(cur);
    if constexpr (SP2) {
        PG8_STAGE(PG8_SB(0, 0), cB, voffB); PG8_STAGE(PG8_SB(0, 1), cB + hstep, voffB); PG8_STAGE(PG8_SA(0, 0), cA, voffA); PG8_STAGE(PG8_SA(0, 1), cA + hstep, voffA);
        if (wr == 1) PG8_BAR;
        PG8_WAIT_V(2); PG8_BAR;
        PG8_STAGE(PG8_SB(1, 0), cB + kstep, voffB); PG8_STAGE(PG8_SA(1, 0), cA + kstep, voffA); PG8_STAGE(PG8_SB(1, 1), cB + hstep + kstep, voffB);
        PG8_WAIT_V(6); PG8_BAR;
    } else {
        PG8_STAGE(PG8_SB(0, 0), cB, voffB); PG8_STAGE(PG8_SA(0, 0), cA, voffA); PG8_STAGE(PG8_SB(0, 1), cB + hstep, voffB); PG8_STAGE(PG8_SA(0, 1), cA + hstep, voffA);
        if (wr == 1) PG8_BAR;
        PG8_WAIT_V(4); PG8_BAR;
        PG8_STAGE(PG8_SB(1, 0), cB + kstep, voffB); PG8_STAGE(PG8_SA(1, 0), cA + kstep, voffA); PG8_STAGE(PG8_SB(1, 1), cB + hstep + kstep, voffB);
        PG8_WAIT_V(6); PG8_BAR;
    }
    for (;;) {
        const bool has_next = S.next(ui + 1, nxt);
        const char* nA = has_next ? (const char*)g.A + (size_t)nxt.pm * tstep : cA; const char* nB = has_next ? (const char*)g.Bt + (size_t)nxt.pn * tstep : cB;
        for (int t = 0; t < nt; t += 2) {
            const bool last = (t == nt - 2);
            const char* a1 = cA + (size_t)(t + 1) * kstep;
            const char* a2 = last ? nA : cA + (size_t)(t + 2) * kstep; const char* b2 = last ? nB : cB + (size_t)(t + 2) * kstep;
            const char* a3 = a2 + kstep; const char* b3 = b2 + kstep;
            if (last && has_next) S.a_ready(nxt);
            if constexpr (SP2) {
            PG8_LDB(B0, 0, 0); PG8_LDB(B1, 0, 1); PG8_SCHED; PG8_LDA(At, 0, 0); PG8_STAGE(PG8_SA(1, 1), a1 + hstep, voffA);
            PG8_WAIT_V(8); PG8_WAIT_L(0); PG8_BAR; PG8_MMA(0, 0, At, B0); PG8_MMA(0, 1, At, B1); PG8_BAR; PG8_SCHED;
            PG8_LDA(At, 0, 1); PG8_STAGE(PG8_SB(0, 0), b2, voffB); PG8_STAGE(PG8_SB(0, 1), b2 + hstep, voffB); PG8_STAGE(PG8_SA(0, 0), a2, voffA);
            PG8_WAIT_V(8); PG8_WAIT_L(0); PG8_BAR; PG8_MMA(1, 0, At, B0); PG8_MMA(1, 1, At, B1); PG8_BAR; PG8_SCHED;
            PG8_LDB(B0, 1, 0); PG8_LDB(B1, 1, 1); PG8_SCHED; PG8_LDA(At, 1, 0); PG8_STAGE(PG8_SA(0, 1), a2 + hstep, voffA);
            PG8_WAIT_V(8); PG8_WAIT_L(0); PG8_BAR; PG8_MMA(0, 0, At, B0); PG8_MMA(0, 1, At, B1); PG8_BAR; PG8_SCHED;
            PG8_LDA(At, 1, 1); PG8_STAGE(PG8_SB(1, 0), b3, voffB); PG8_STAGE(PG8_SB(1, 1), b3 + hstep, voffB); PG8_STAGE(PG8_SA(1, 0), a3, voffA);
            PG8_WAIT_V(8); PG8_WAIT_L(0); PG8_BAR; PG8_MMA(1, 0, At, B0); PG8_MMA(1, 1, At, B1); PG8_BAR; PG8_SCHED;
            } else {
            PG8_LDB(B0, 0, 0); PG8_SCHED; PG8_LDA(At, 0, 0); PG8_STAGE(PG8_SA(1, 1), a1 + hstep, voffA);
            PG8_WAIT_L(8); PG8_BAR; PG8_WAIT_L(0); PG8_MMA(0, 0, At, B0); PG8_BAR; PG8_SCHED;
            PG8_LDB(B1, 0, 1); PG8_STAGE(PG8_SB(0, 0), b2, voffB);
            PG8_BAR; PG8_WAIT_L(0); PG8_MMA(0, 1, At, B1); PG8_BAR;
            PG8_LDA(At, 0, 1); PG8_STAGE(PG8_SA(0, 0), a2, voffA);
            PG8_BAR; PG8_WAIT_L(0); PG8_MMA(1, 0, At, B0); PG8_BAR; PG8_SCHED;
            PG8_STAGE(PG8_SB(0, 1), b2 + hstep, voffB);
            PG8_WAIT_V(6); PG8_BAR; PG8_MMA(1, 1, At, B1); PG8_BAR;
            PG8_LDB(B0, 1, 0); PG8_SCHED; PG8_LDA(At, 1, 0); PG8_STAGE(PG8_SA(0, 1), a2 + hstep, voffA);
            PG8_WAIT_L(8); PG8_BAR; PG8_WAIT_L(0); PG8_MMA(0, 0, At, B0); PG8_BAR; PG8_SCHED;
            PG8_LDB(B1, 1, 1); PG8_STAGE(PG8_SB(1, 0), b3, voffB);
            PG8_BAR; PG8_WAIT_L(0); PG8_MMA(0, 1, At, B1); PG8_BAR;
            PG8_LDA(At, 1, 1); PG8_STAGE(PG8_SA(1, 0), a3, voffA);
            PG8_BAR; PG8_WAIT_L(0); PG8_MMA(1, 0, At, B0); PG8_BAR; PG8_SCHED;
            PG8_STAGE(PG8_SB(1, 1), b3 + hstep, voffB);
            PG8_WAIT_V(6); PG8_BAR; PG8_MMA(1, 1, At, B1); PG8_BAR;
            }
        }
        if constexpr (ALIGN_EPI) { if (wr == 0) PG8_BAR; }
        if constexpr (!Epi::AFTER_DRAIN) { E(acc, cur, wr, wc, fr, fq); S.done(cur); }
        if (!has_next) break;
#pragma unroll
        for (int a = 0; a < 2; ++a)
#pragma unroll
            for (int b = 0; b < 2; ++b)
#pragma unroll
                for (int m = 0; m < 4; ++m)
#pragma unroll
                    for (int n = 0; n < 2; ++n) acc[a][b][m][n] = (f32x4){0.f, 0.f, 0.f, 0.f};
        cur = nxt; cA = nA; cB = nB; ++ui;
        if constexpr (ALIGN_EPI) { if (wr == 1) PG8_BAR; }
    }
    PG8_WAIT_V(0);
    if constexpr (!ALIGN_EPI) { if (wr == 0) PG8_BAR; }
    PG8_BAR;
    if constexpr (Epi::AFTER_DRAIN) { E.fused(acc, cur, wr, wc, fr, fq, lds, wid, lane); S.done(cur); }
#undef PG8_SA
#undef PG8_SB
#undef PG8_STAGE
#undef PG8_LDA
#undef PG8_LDB
#undef PG8_MMA
#undef PG8_WAIT_V
#undef PG8_WAIT_L
#undef PG8_BAR
#undef PG8_SCHED
}
}
constexpr int NWAVES = 8;
constexpr int BATCH = 32, SEQ = 2048, D = 1024, M = BATCH * SEQ;
constexpr int EVEN_IN = 2816, ODD_IN = 3072, DFF = 2816, UPN = 2 * DFF;
constexpr int QB_OFF = 768, FB_OFF = 1280, IB_OFF = 1792, GB_OFF = 2304;
constexpr float EPS = 1e-6f;
constexpr float LOG2E = 1.4426950408889634f;
constexpr float C2 = 0.125f * LOG2E;

constexpr size_t MiB = 1u << 20;
constexpr size_t WS_CTL = 0, CTL_ZERO_BYTES = 64 * 1024;
constexpr size_t WS_TAB = 1 * MiB;
constexpr size_t WS_LB = WS_TAB + 768 * 1024;
constexpr size_t WS_WIN0 = 2 * MiB, WS_WOUT0 = 8 * MiB, WS_WIN1 = 10 * MiB, WS_WOUT1 = 16 * MiB, WS_WUP = 18 * MiB  , WS_WDN = 40 * MiB  ;
constexpr size_t WS_SIDE = 52 * MiB, SIDE_STRIDE = 12 * MiB;
constexpr size_t WS_SC = 90 * MiB;
constexpr size_t WS_XN = 96 * MiB;
constexpr size_t WS_PROJ = 224 * MiB;
constexpr size_t WS_O = 608 * MiB;
constexpr size_t WS_Y = 736 * MiB;
constexpr size_t WS_END = 864 * MiB;
constexpr int CW_BAR = 4096;

constexpr int RING_OFF = 0, RING_BYTES = 131072;
constexpr int LDSCTL_OFF = RING_BYTES, MISC_OFF = LDSCTL_OFF + 320;
constexpr int LDS_BYTES = 147456;

namespace attn2 {
using bf16x8 = __attribute__((ext_vector_type(8))) short;
using s16x4 = __attribute__((ext_vector_type(4))) short;
using f32x16 = __attribute__((ext_vector_type(16))) float;
using u32x4 = __attribute__((ext_vector_type(4))) unsigned;
typedef unsigned short bf16;
constexpr int NSLOT = 3, SLOTB = 8192;
constexpr int LDS_K = 0, LDS_V = NSLOT * SLOTB, LDS_WS = 2 * NSLOT * SLOTB, LDS_OST = LDS_WS + 8 * 64 * 4, LDS_TB = LDS_OST + 8 * 4096, LDS_BYTES = LDS_TB + 1088;
constexpr float THR = 8.f;
__device__ __forceinline__ int crow(int r, int hi) { return (r & 3) + 8 * (r >> 2) + 4 * hi; }
__device__ __forceinline__ void glds16(const void* gsrc, unsigned lds_dst) { unsigned keep;
    asm volatile("s_mov_b32 %0, m0\n\ts_mov_b32 m0, %2\n\ts_nop 0\n\tglobal_load_lds_dwordx4 %1, off\n\ts_mov_b32 m0, %0" : "=&s"(keep) : "v"(gsrc), "s"(lds_dst) : "memory"); }
typedef float f32x2_t __attribute__((ext_vector_type(2))); typedef __bf16 bf16x2_t __attribute__((ext_vector_type(2)));
__device__ __forceinline__ unsigned cvtpk_s(float lo, float hi) { f32x2_t v = {lo, hi}; bf16x2_t b = __builtin_convertvector(v, bf16x2_t); return __builtin_bit_cast(unsigned, b); }
__device__ __forceinline__ void qkt(f32x16& p0, f32x16& p1, const char* Kslot, const bf16x8* qr, const f32x16& cin, int r32, int hi) {
    const char* kb = Kslot + hi * 1024 + r32 * 16;
#pragma unroll
    for (int d0 = 0; d0 < 4; ++d0) {
        const bf16x8 b0 = *reinterpret_cast<const bf16x8*>(kb + d0 * 2048);
        const bf16x8 b1 = *reinterpret_cast<const bf16x8*>(kb + d0 * 2048 + 512);
        if (d0 == 0) { p0 = __builtin_amdgcn_mfma_f32_32x32x16_bf16(b0, qr[0], cin, 0, 0, 0); p1 = __builtin_amdgcn_mfma_f32_32x32x16_bf16(b1, qr[0], cin, 0, 0, 0); }
        else { p0 = __builtin_amdgcn_mfma_f32_32x32x16_bf16(b0, qr[d0], p0, 0, 0, 0); p1 = __builtin_amdgcn_mfma_f32_32x32x16_bf16(b1, qr[d0], p1, 0, 0, 0); } }
}
__device__ __forceinline__ void pv(f32x16* o, int vb, bf16x8 pa0, bf16x8 pa1, bf16x8 pa2, bf16x8 pa3) {
#pragma unroll
    for (int d0 = 0; d0 < 2; ++d0) { s16x4 lo[4], hi[4];
#pragma unroll
        for (int ks = 0; ks < 4; ++ks) {
            asm volatile("ds_read_b64_tr_b16 %0,%1 offset:%c2" : "=&v"(lo[ks]) : "v"(vb), "i"(d0 * 4096 + ks * 1024) : "memory");
            asm volatile("ds_read_b64_tr_b16 %0,%1 offset:%c2" : "=&v"(hi[ks]) : "v"(vb), "i"(d0 * 4096 + ks * 1024 + 512) : "memory"); }
        asm volatile("s_waitcnt lgkmcnt(0)" ::: "memory"); __builtin_amdgcn_sched_barrier(0);
#define ATT_PK(k) (bf16x8){lo[k][0], lo[k][1], lo[k][2], lo[k][3], hi[k][0], hi[k][1], hi[k][2], hi[k][3]}
        o[d0] = __builtin_amdgcn_mfma_f32_32x32x16_bf16(pa0, ATT_PK(0), o[d0], 0, 0, 0);
        o[d0] = __builtin_amdgcn_mfma_f32_32x32x16_bf16(pa1, ATT_PK(1), o[d0], 0, 0, 0);
        o[d0] = __builtin_amdgcn_mfma_f32_32x32x16_bf16(pa2, ATT_PK(2), o[d0], 0, 0, 0);
        o[d0] = __builtin_amdgcn_mfma_f32_32x32x16_bf16(pa3, ATT_PK(3), o[d0], 0, 0, 0);
#undef ATT_PK
    }
}
template <int LDQ, int LDKV, int LDO, bool BIAS, bool SINK>
__device__ __forceinline__ void band_unit(const bf16* Qw, const bf16* Kt, const bf16* Vt, bf16* Ow, int jlo, int jhi, int wlo, int whi, int qpos0, float sink2, char* shm) {
    const int tid = threadIdx.x, lane = tid & 63, r32 = lane & 31, hi = lane >> 5; const int wid = __builtin_amdgcn_readfirstlane(tid >> 6);
    const unsigned lds0 = (unsigned)(uintptr_t)shm;
    float* wsf = (float*)(shm + LDS_WS) + wid * 64;
    const float* tb = (const float*)(shm + LDS_TB);
    const bf16* ksrc = Kt + (long)lane * LDKV + wid * 8;
    const bf16* vsrc = Vt + (long)(16 * (wid & 3) + (lane >> 2)) * LDKV + (wid >> 2) * 32 + (lane & 3) * 8;
    const unsigned kdst = lds0 + LDS_K + wid * 1024, vdst = lds0 + LDS_V + wid * 1024;
#define ATT_DMAK(t, slot) glds16(ksrc + (long)(t) * 64 * LDKV, (unsigned)__builtin_amdgcn_readfirstlane(kdst + (slot)))
#define ATT_DMAV(t, slot) glds16(vsrc + (long)(t) * 64 * LDKV, (unsigned)__builtin_amdgcn_readfirstlane(vdst + (slot)))
#define ATT_SLOT(t) ((((t) - jlo) % 3) * SLOTB)
    const int vb0 = (int)(lds0 + LDS_V) + ((lane >> 4) & 1) * 32 + (lane & 3) * 8 + (4 * hi + ((lane & 15) >> 2)) * 64;
    bf16x8 qr[4];
#pragma unroll
    for (int d0 = 0; d0 < 4; ++d0) qr[d0] = *reinterpret_cast<const bf16x8*>(&Qw[(long)r32 * LDQ + d0 * 16 + hi * 8]);
    ATT_DMAK(jlo, 0);
    if (jlo + 1 <= jhi) ATT_DMAK(jlo + 1, SLOTB);
    ATT_DMAV(jlo, 0);
    if (jlo + 2 <= jhi) ATT_DMAK(jlo + 2, 2 * SLOTB);
    if (jlo + 1 <= jhi) ATT_DMAV(jlo + 1, SLOTB);
    float mhat = SINK ? sink2 : 0.f, l_reg = (SINK && hi == 0) ? 1.f : 0.f; bool first = !SINK;
    f32x16 o[2]; o[0] = f32x16{}; o[1] = f32x16{};
    f32x16 negm;
#pragma unroll
    for (int r = 0; r < 16; ++r) negm[r] = -mhat;
    asm volatile("s_waitcnt vmcnt(0) lgkmcnt(0)\n\ts_barrier" ::: "memory");
    asm volatile("" :: "v"(qr[0]), "v"(qr[1]), "v"(qr[2]), "v"(qr[3]));
    f32x16 pc0 = f32x16{}, pc1 = f32x16{}, pn0 = f32x16{}, pn1 = f32x16{};
    if (jlo >= wlo && jlo <= whi) qkt(pc0, pc1, shm + LDS_K, qr, negm, r32, hi);
    for (int j = jlo; j <= jhi; ++j) {
        if (j + 2 <= jhi) asm volatile("s_waitcnt vmcnt(2) lgkmcnt(0)\n\ts_barrier" ::: "memory");
        else if (j + 1 <= jhi) asm volatile("s_waitcnt vmcnt(1) lgkmcnt(0)\n\ts_barrier" ::: "memory");
        else asm volatile("s_waitcnt vmcnt(0) lgkmcnt(0)\n\ts_barrier" ::: "memory");
        if (j + 3 <= jhi) ATT_DMAK(j + 3, ATT_SLOT(j + 3));
        if (j + 2 <= jhi) ATT_DMAV(j + 2, ATT_SLOT(j + 2));
        const bool actn = (j + 1 <= jhi) && (j + 1 >= wlo) && (j + 1 <= whi);
        if (actn) qkt(pn0, pn1, shm + LDS_K + ATT_SLOT(j + 1), qr, negm, r32, hi);
        __builtin_amdgcn_sched_barrier(0);
        if (j >= wlo && j <= whi) {
            if (BIAS) {
                const int dq = qpos0 + r32 - 64 * j;
                if ((qpos0 & ~63) - 64 * j >= 192) { const float c = tb[256];
#pragma unroll
                    for (int r = 0; r < 16; ++r) { pc0[r] += c; pc1[r] += c; } }
                else {
#pragma unroll
                    for (int r = 0; r < 16; ++r) { const int a = dq - crow(r, hi) + 128; const int i0 = a > 256 ? 256 : a, i1 = a - 32 > 256 ? 256 : a - 32; pc0[r] += tb[i0]; pc1[r] += tb[i1]; } }
            }
            float ra = fmaxf(fmaxf(pc0[0], pc0[1]), pc1[0]), rb = fmaxf(fmaxf(pc0[2], pc0[3]), pc1[1]); ra = fmaxf(fmaxf(ra, pc1[2]), pc1[3]);
#pragma unroll
            for (int r = 4; r < 16; r += 4) { ra = fmaxf(fmaxf(ra, pc0[r]), pc0[r + 1]); rb = fmaxf(fmaxf(rb, pc0[r + 2]), pc0[r + 3]); ra = fmaxf(fmaxf(ra, pc1[r]), pc1[r + 1]); rb = fmaxf(fmaxf(rb, pc1[r + 2]), pc1[r + 3]); }
            float rm = fmaxf(ra, rb);
            { auto rr = __builtin_amdgcn_permlane32_swap(__float_as_uint(rm), __float_as_uint(rm), false, false); rm = fmaxf(__uint_as_float(rr[0]), __uint_as_float(rr[1])); }
            bool resc = false;
            if (first) { const float dl = rm; mhat = dl;
#pragma unroll
                for (int r = 0; r < 16; ++r) { pc0[r] -= dl; pc1[r] -= dl; pn0[r] -= dl; pn1[r] -= dl; negm[r] = -mhat; }
                first = false; }
            else if (__any(rm > THR)) { const float dl = fmaxf(rm, 0.f); mhat += dl;
#pragma unroll
                for (int r = 0; r < 16; ++r) { pc0[r] -= dl; pc1[r] -= dl; pn0[r] -= dl; pn1[r] -= dl; negm[r] = -mhat; }
                const float f = __builtin_amdgcn_exp2f(-dl); l_reg *= f; if (hi == 0) wsf[r32] = f; resc = true; }
            f32x2_t sacc = {0.f, 0.f};
#pragma unroll
            for (int r = 0; r < 16; ++r) { pc0[r] = __builtin_amdgcn_exp2f(pc0[r]); pc1[r] = __builtin_amdgcn_exp2f(pc1[r]); }
#pragma unroll
            for (int r = 0; r < 16; r += 2) { sacc += (f32x2_t){pc0[r], pc0[r + 1]}; sacc += (f32x2_t){pc1[r], pc1[r + 1]}; }
            l_reg += sacc[0] + sacc[1];
            u32x4 pw0, pw1, pw2, pw3;
            pw0 = (u32x4){cvtpk_s(pc0[0], pc0[1]), cvtpk_s(pc0[2], pc0[3]), cvtpk_s(pc0[4], pc0[5]), cvtpk_s(pc0[6], pc0[7])};
            pw1 = (u32x4){cvtpk_s(pc0[8], pc0[9]), cvtpk_s(pc0[10], pc0[11]), cvtpk_s(pc0[12], pc0[13]), cvtpk_s(pc0[14], pc0[15])};
            pw2 = (u32x4){cvtpk_s(pc1[0], pc1[1]), cvtpk_s(pc1[2], pc1[3]), cvtpk_s(pc1[4], pc1[5]), cvtpk_s(pc1[6], pc1[7])};
            pw3 = (u32x4){cvtpk_s(pc1[8], pc1[9]), cvtpk_s(pc1[10], pc1[11]), cvtpk_s(pc1[12], pc1[13]), cvtpk_s(pc1[14], pc1[15])};
            if (resc) { asm volatile("s_waitcnt lgkmcnt(0)" ::: "memory");
#pragma unroll
                for (int d_ = 0; d_ < 2; ++d_)
#pragma unroll
                    for (int r = 0; r < 16; ++r) o[d_][r] *= wsf[crow(r, hi)]; }
            pv(o, vb0 + ATT_SLOT(j), __builtin_bit_cast(bf16x8, pw0), __builtin_bit_cast(bf16x8, pw1), __builtin_bit_cast(bf16x8, pw2), __builtin_bit_cast(bf16x8, pw3));
        }
        pc0 = pn0; pc1 = pn1;
    }
    { auto rr = __builtin_amdgcn_permlane32_swap(__float_as_uint(l_reg), __float_as_uint(l_reg), false, false); l_reg = __uint_as_float(rr[0]) + __uint_as_float(rr[1]); }
    if (hi == 0) wsf[32 + r32] = l_reg; asm volatile("s_waitcnt lgkmcnt(0)" ::: "memory");
    float rli[16];
#pragma unroll
    for (int r = 0; r < 16; ++r) rli[r] = __builtin_amdgcn_rcpf(wsf[32 + crow(r, hi)]);
    { bf16* stg = (bf16*)(shm + LDS_OST) + wid * 2048;
#pragma unroll
      for (int r = 0; r < 16; ++r) { const int orow = crow(r, hi);
#pragma unroll
          for (int d0 = 0; d0 < 2; ++d0) { const float v = o[d0][r] * rli[r]; const unsigned u = __builtin_bit_cast(unsigned, v); stg[orow * 64 + d0 * 32 + r32] = (bf16)((u + 0x7fffu + ((u >> 16) & 1u)) >> 16); } }
      asm volatile("s_waitcnt lgkmcnt(0)" ::: "memory");
#pragma unroll
      for (int i = 0; i < 4; ++i) { const int row = i * 8 + (lane >> 3), ch = lane & 7; const u32x4 v = *(const u32x4*)(stg + row * 64 + ch * 8); *(u32x4*)(Ow + (long)row * LDO + ch * 8) = v; } }
    asm volatile("s_waitcnt lgkmcnt(0)\n\ts_barrier" ::: "memory");
#undef ATT_DMAK
#undef ATT_DMAV
#undef ATT_SLOT
}
}
namespace attn3 {
typedef unsigned short bf16;
using bf16x8=__attribute__((ext_vector_type(8)))short;
using s16x4=__attribute__((ext_vector_type(4)))short;
using f32x16=__attribute__((ext_vector_type(16)))float;
using u32x4=__attribute__((ext_vector_type(4)))unsigned;
constexpr int NW=8,QBLK=32,KVBLK=64;
__device__ __forceinline__ int crow(int r,int hi){return (r&3)+8*(r>>2)+4*hi;}
#define SBAR() __builtin_amdgcn_sched_barrier(0)
constexpr int NSLOT=3, SLOTB=8192;
constexpr int LDS_K=0, LDS_V=NSLOT*SLOTB, LDS_WS=2*NSLOT*SLOTB, LDS_OST=LDS_WS+NW*64*4, LDS_TB=LDS_OST+NW*4096,LDS_BYTES=LDS_TB+1280;
constexpr float MASKV=-4096.f;
__device__ __forceinline__ void glds16(const void*gbase,unsigned voff,unsigned lds_dst){unsigned keep;
  asm volatile("s_mov_b32 %0, m0\n\ts_mov_b32 m0, %3\n\ts_nop 0\n\tglobal_load_lds_dwordx4 %1, %2\n\ts_mov_b32 m0, %0":"=&s"(keep):"v"(voff),"s"(gbase),"s"(lds_dst):"memory");}
__device__ __forceinline__ float max3f(float a,float b,float c){float r;asm("v_max3_f32 %0, %1, %2, %3":"=v"(r):"v"(a),"v"(b),"v"(c));return r;}
__device__ __forceinline__ float max2f(float a,float b){float r;asm("v_max_f32_e32 %0, %1, %2":"=v"(r):"v"(a),"v"(b));return r;}
__device__ __forceinline__ float fadd_s(float a,float b){float r;asm("v_add_f32_e32 %0, %1, %2":"=v"(r):"v"(a),"v"(b));return r;}
__device__ __forceinline__ float fsub_s(float a,float b){float r;asm("v_sub_f32_e32 %0, %1, %2":"=v"(r):"v"(a),"v"(b));return r;}
typedef float f32x2_t __attribute__((ext_vector_type(2))); typedef __bf16 bf16x2_t __attribute__((ext_vector_type(2)));
__device__ __forceinline__ unsigned cvtpk_s(float lo,float hi){f32x2_t v={lo,hi};bf16x2_t b=__builtin_convertvector(v,bf16x2_t);return __builtin_bit_cast(unsigned,b);}
#define WAIT_BAR(N) asm volatile("s_waitcnt vmcnt(" #N ") lgkmcnt(0)\n\ts_barrier":::"memory")

__device__ __forceinline__ void qkt(f32x16&p0,f32x16&p1,const char*Kslot,const bf16x8*qr,int r32,int hi){ const f32x16 zz=f32x16{};
  const char*kb=Kslot+hi*1024+r32*16;
  #pragma unroll
  for(int d0=0;d0<4;++d0){
    const bf16x8 b0=*reinterpret_cast<const bf16x8*>(kb+d0*2048);
    const bf16x8 b1=*reinterpret_cast<const bf16x8*>(kb+d0*2048+512);
    if(d0==0){p0=__builtin_amdgcn_mfma_f32_32x32x16_bf16(b0,qr[0],zz,0,0,0);p1=__builtin_amdgcn_mfma_f32_32x32x16_bf16(b1,qr[0],zz,0,0,0);}
    else{p0=__builtin_amdgcn_mfma_f32_32x32x16_bf16(b0,qr[d0],p0,0,0,0);p1=__builtin_amdgcn_mfma_f32_32x32x16_bf16(b1,qr[d0],p1,0,0,0);}}
}
typedef __attribute__((address_space(3))) const char* lds_cptr;
typedef short v4i16_t __attribute__((ext_vector_type(4)));
__device__ __forceinline__ void kload8(bf16x8*kf,lds_cptr kp){
  kf[0]=*(const __attribute__((address_space(3))) bf16x8*)(kp);      kf[1]=*(const __attribute__((address_space(3))) bf16x8*)(kp+512);
  kf[2]=*(const __attribute__((address_space(3))) bf16x8*)(kp+2048); kf[3]=*(const __attribute__((address_space(3))) bf16x8*)(kp+2560);
  kf[4]=*(const __attribute__((address_space(3))) bf16x8*)(kp+4096); kf[5]=*(const __attribute__((address_space(3))) bf16x8*)(kp+4608);
  kf[6]=*(const __attribute__((address_space(3))) bf16x8*)(kp+6144); kf[7]=*(const __attribute__((address_space(3))) bf16x8*)(kp+6656);
}
__device__ __forceinline__ void kload2(bf16x8*kf,lds_cptr kp,int j){ kf[2*j]=*(const __attribute__((address_space(3))) bf16x8*)(kp+j*2048); kf[2*j+1]=*(const __attribute__((address_space(3))) bf16x8*)(kp+j*2048+512); }
__device__ __forceinline__ s16x4 vtr(lds_cptr p){ return __builtin_bit_cast(s16x4,__builtin_amdgcn_ds_read_tr16_b64_v4i16((__attribute__((address_space(3))) v4i16_t*)p)); }
__device__ __forceinline__ float rowmax(const f32x16&p0,const f32x16&p1){
  float a=max3f(p0[0],p0[1],p1[0]),b=max3f(p0[2],p0[3],p1[1]);a=max3f(a,p1[2],p1[3]);
  #pragma unroll
  for(int r=4;r<16;r+=4){a=max3f(a,p0[r],p0[r+1]);b=max3f(b,p0[r+2],p0[r+3]);a=max3f(a,p1[r],p1[r+1]);b=max3f(b,p1[r+2],p1[r+3]);}
  const float m=max2f(a,b);
  auto rr=__builtin_amdgcn_permlane32_swap(__float_as_uint(m),__float_as_uint(m),false,false);
  return max2f(__uint_as_float(rr[0]),__uint_as_float(rr[1]));
}
__device__ __forceinline__ void pv(f32x16*o,int vb,bf16x8 pa0,bf16x8 pa1,bf16x8 pa2,bf16x8 pa3){
  #pragma unroll
  for(int d0=0;d0<2;++d0){s16x4 lo[4],hi[4];
    #pragma unroll
    for(int ks=0;ks<4;++ks){
      asm volatile("ds_read_b64_tr_b16 %0,%1 offset:%c2":"=&v"(lo[ks]):"v"(vb),"i"(d0*4096+ks*1024):"memory");
      asm volatile("ds_read_b64_tr_b16 %0,%1 offset:%c2":"=&v"(hi[ks]):"v"(vb),"i"(d0*4096+ks*1024+512):"memory");}
    asm volatile("s_waitcnt lgkmcnt(0)":::"memory");SBAR();
    #define PK(k) (bf16x8){lo[k][0],lo[k][1],lo[k][2],lo[k][3],hi[k][0],hi[k][1],hi[k][2],hi[k][3]}
    o[d0]=__builtin_amdgcn_mfma_f32_32x32x16_bf16(pa0,PK(0),o[d0],0,0,0);
    o[d0]=__builtin_amdgcn_mfma_f32_32x32x16_bf16(pa1,PK(1),o[d0],0,0,0);
    o[d0]=__builtin_amdgcn_mfma_f32_32x32x16_bf16(pa2,PK(2),o[d0],0,0,0);
    o[d0]=__builtin_amdgcn_mfma_f32_32x32x16_bf16(pa3,PK(3),o[d0],0,0,0);
    #undef PK
  }
}

#ifndef ATTN_STORE16
#define ATTN_STORE16(p,v) (*(u32x4*)(p)=(v))
#endif
template<int DM,int LDO,int THRL> __device__ __forceinline__ void attn_unit(const bf16*Qw,const bf16*__restrict__ Kh,const bf16*__restrict__ Vh,bf16*Ow,int NT,int wt0,int wt1,int qi0,char*shm){
  const int tid=threadIdx.x,lane=tid&63,r32=lane&31,hi=lane>>5; const int wid=__builtin_amdgcn_readfirstlane(tid>>6);
  const unsigned lds0=(unsigned)(uintptr_t)shm;
  float*wsf=(float*)(shm+LDS_WS)+wid*64;
  const unsigned koff=(unsigned)(lane*DM+wid*8)*2u, voff=(unsigned)((16*(wid&3)+(lane>>2))*DM+(wid>>2)*32+(lane&3)*8)*2u;
  const unsigned kdst=lds0+LDS_K+wid*1024, vdst=lds0+LDS_V+wid*1024;
  #define DMA_K(t,slot) glds16(Kh+(long)(t)*KVBLK*DM,koff,(unsigned)__builtin_amdgcn_readfirstlane(kdst+(slot)))
  #define DMA_V(t,slot) glds16(Vh+(long)(t)*KVBLK*DM,voff,(unsigned)__builtin_amdgcn_readfirstlane(vdst+(slot)))
  const char*Kbase=shm+LDS_K; bf16x8 kf[8];
  const lds_cptr shm3=(lds_cptr)shm; const lds_cptr kp0=shm3+LDS_K+hi*1024+r32*16; const lds_cptr vp0=shm3+LDS_V+((lane>>4)&1)*32+(lane&3)*8+(4*hi+((lane&15)>>2))*64;
  DMA_K(0,0);DMA_V(0,0);DMA_K(1,SLOTB);
  bf16x8 qr[4];
  #pragma unroll
  for(int d0=0;d0<4;++d0)qr[d0]=*reinterpret_cast<const bf16x8*>(&Qw[(long)r32*DM+d0*16+hi*8]);
  float mhat=0.f,l_reg=0.f;f32x16 o[2];o[0]=f32x16{};o[1]=f32x16{};const f32x16 zz=f32x16{};
  const __attribute__((address_space(3))) float*tbr=(const __attribute__((address_space(3))) float*)((lds_cptr)shm+LDS_TB); const float cfar=__uint_as_float(__builtin_amdgcn_readfirstlane(__float_as_uint(tbr[0])));
  #define CMASK(P0,P1,t) do{ const int dc_=wt1-(t); \
    if(dc_<0||(t)<wt0){ const float mv_=MASKV-mhat; _Pragma("unroll") for(int r=0;r<16;++r){P0[r]=mv_;P1[r]=mv_;} } \
    else if(dc_>=3){ const float c_=cfar-mhat; _Pragma("unroll") for(int r=0;r<16;++r){P0[r]+=c_;P1[r]+=c_;} } \
    else{ const __attribute__((address_space(3))) float*tp_=tbr+(191-64*dc_-qi0-(int)(threadIdx.x&31u)+4*(int)((threadIdx.x>>5)&1u)); \
      _Pragma("unroll") for(int r=0;r<16;++r){ P0[r]+=tp_[(r&3)+8*(r>>2)]-mhat; P1[r]+=tp_[(r&3)+8*(r>>2)+32]-mhat; } } }while(0)
  bool resc=false;
  #define START(P0,P1) do{ const float rm=rowmax(P0,P1); resc=false; \
    { const float dl=rm; mhat=fadd_s(mhat,dl); \
      _Pragma("unroll") for(int r=0;r<16;++r){P0[r]=fsub_s(P0[r],dl);P1[r]=fsub_s(P1[r],dl);} \
      } \
    _Pragma("unroll") for(int r=0;r<16;++r)P0[r]=__builtin_amdgcn_exp2f(P0[r]); }while(0)
  #define RESC() do{ if(resc){ asm volatile("s_waitcnt lgkmcnt(0)":::"memory"); \
      _Pragma("unroll") for(int d_=0;d_<2;++d_) _Pragma("unroll") for(int r=0;r<16;++r)o[d_][r]*=wsf[crow(r,hi)]; } }while(0)
  f32x16 pA0,pA1,pB0,pB1;
  int sl_prev=0,sl_cur=0,sl_next=SLOTB;
  #define ROT() do{sl_prev=sl_cur;sl_cur=sl_next;sl_next=(sl_next==(NSLOT-1)*SLOTB)?0:sl_next+SLOTB;}while(0)
  DMA_K(2,2*SLOTB);
  WAIT_BAR(3);
  qkt(pA0,pA1,Kbase,qr,r32,hi);asm volatile("s_nop 15\n\ts_nop 7":"+v"(pA0),"+v"(pA1));CMASK(pA0,pA1,0);
  START(pA0,pA1);
  _Pragma("unroll") for(int r=0;r<16;++r)pA1[r]=__builtin_amdgcn_exp2f(pA1[r]);
  WAIT_BAR(0);
  DMA_K(3,0);DMA_V(1,SLOTB);
  ROT();
  kload8(kf,kp0+sl_cur);
  WAIT_BAR(2);
  s16x4 vlo[8],vhi[8]; u32x4 pw0,pw1,pw2,pw3;
  #define PKW(P,B) cvtpk_s(P[B],P[B+1])
  #define PAF(k) __builtin_bit_cast(bf16x8,pw##k)
  #define VFR(i) (bf16x8){vlo[i][0],vlo[i][1],vlo[i][2],vlo[i][3],vhi[i][0],vhi[i][1],vhi[i][2],vhi[i][3]}
  #define PIN(x) asm volatile("":"+v"(x))
  #define MX3(a,b,c) __builtin_fmaxf(__builtin_fmaxf((a),(b)),(c))
  #define GAPA(MF,A0,A1,A2,A3,W0,W1,PW) do{ MF; sacc+=A0; sacc+=A1; sacc+=A2; sacc+=A3; PIN(sacc); W0; W1; PIN(PW); SBAR(); }while(0)
  #define EX(v) __builtin_amdgcn_exp2f(v)
  #define GAPB(MF,X,B) do{ MF; X[B]=EX(X[B]); X[B+1]=EX(X[B+1]); X[B+2]=EX(X[B+2]); X[B+3]=EX(X[B+3]); PIN(X); SBAR(); }while(0)
  #define VRD(i) do{ vlo[i]=vtr(vp_+(((i)>>2)*4096+((i)&3)*1024)); vhi[i]=vtr(vp_+(((i)>>2)*4096+((i)&3)*1024+512)); }while(0)
  #define KRD(G,j) do{ if(G){ kload2(kf,kp0+sl_next,j); SBAR(); } }while(0)
  #define STEP(C0,C1,P0,P1,t,GK,GV,GL) do{ SBAR(); \
    const lds_cptr vp_=vp0+sl_prev; \
    VRD(0); SBAR(); float sacc=(P0[0]+P0[1]); \
    GAPA(C0=__builtin_amdgcn_mfma_f32_32x32x16_bf16(kf[0],qr[0],zz,0,0,0), P0[2],P0[3],P0[4],P0[5],     pw0[0]=PKW(P0,0), pw0[1]=PKW(P0,2), pw0); \
    VRD(4); SBAR(); GAPA(C1=__builtin_amdgcn_mfma_f32_32x32x16_bf16(kf[1],qr[0],zz,0,0,0), P0[6],P0[7],P0[8],P0[9],     pw0[2]=PKW(P0,4), pw0[3]=PKW(P0,6), pw0); \
    VRD(1); SBAR(); GAPA(C0=__builtin_amdgcn_mfma_f32_32x32x16_bf16(kf[2],qr[1],C0,0,0,0),   P0[10],P0[11],P0[12],P0[13], pw1[0]=PKW(P0,8), pw1[1]=PKW(P0,10), pw1); \
    VRD(5); SBAR(); GAPA(C1=__builtin_amdgcn_mfma_f32_32x32x16_bf16(kf[3],qr[1],C1,0,0,0),   P0[14],P0[15],P1[0],P1[1],   pw1[2]=PKW(P0,12),pw1[3]=PKW(P0,14), pw1); \
    VRD(2); SBAR(); GAPA(C0=__builtin_amdgcn_mfma_f32_32x32x16_bf16(kf[4],qr[2],C0,0,0,0),   P1[2],P1[3],P1[4],P1[5],     pw2[0]=PKW(P1,0), pw2[1]=PKW(P1,2), pw2); \
    VRD(6); SBAR(); GAPA(C1=__builtin_amdgcn_mfma_f32_32x32x16_bf16(kf[5],qr[2],C1,0,0,0),   P1[6],P1[7],P1[8],P1[9],     pw2[2]=PKW(P1,4), pw2[3]=PKW(P1,6), pw2); \
    VRD(3); SBAR(); GAPA(C0=__builtin_amdgcn_mfma_f32_32x32x16_bf16(kf[6],qr[3],C0,0,0,0),   P1[10],P1[11],P1[12],P1[13], pw3[0]=PKW(P1,8), pw3[1]=PKW(P1,10), pw3); \
    VRD(7); SBAR(); GAPA(C1=__builtin_amdgcn_mfma_f32_32x32x16_bf16(kf[7],qr[3],C1,0,0,0),   P1[14],P1[15],0.f,0.f,       pw3[2]=PKW(P1,12),pw3[3]=PKW(P1,14), pw3); \
    l_reg+=sacc; \
    if(GK){DMA_K((t)+3,sl_cur);} if(GV){DMA_V((t)+1,sl_next);} \
    CMASK(C0,C1,t); \
    { float a=MX3(C0[0],C0[1],C1[0]),b=MX3(C0[2],C0[3],C1[1]); a=MX3(a,C1[2],C1[3]); \
      _Pragma("unroll") for(int r=4;r<16;r+=4){a=MX3(a,C0[r],C0[r+1]);b=MX3(b,C0[r+2],C0[r+3]);a=MX3(a,C1[r],C1[r+1]);b=MX3(b,C1[r+2],C1[r+3]);} \
      float rm=__builtin_fmaxf(a,b); { auto rr=__builtin_amdgcn_permlane32_swap(__float_as_uint(rm),__float_as_uint(rm),false,false); rm=__builtin_fmaxf(__uint_as_float(rr[0]),__uint_as_float(rr[1])); } \
      resc=false; \
      if(__builtin_expect(__any(rm>(float)THRL),0)){ const float dl=__builtin_fmaxf(rm,0.f); mhat+=dl; \
        _Pragma("unroll") for(int r=0;r<16;++r){C0[r]-=dl;C1[r]-=dl;} \
        const float f=__builtin_amdgcn_exp2f(-dl); l_reg*=f; if(hi==0)wsf[r32]=f; resc=true; } } \
    SBAR(); \
    GAPB(o[0]=__builtin_amdgcn_mfma_f32_32x32x16_bf16(PAF(0),VFR(0),o[0],0,0,0), C0,0); \
    GAPB(o[1]=__builtin_amdgcn_mfma_f32_32x32x16_bf16(PAF(0),VFR(4),o[1],0,0,0), C0,4); \
    KRD(GL,0); GAPB(o[0]=__builtin_amdgcn_mfma_f32_32x32x16_bf16(PAF(1),VFR(1),o[0],0,0,0), C0,8); \
    KRD(GL,1); GAPB(o[1]=__builtin_amdgcn_mfma_f32_32x32x16_bf16(PAF(1),VFR(5),o[1],0,0,0), C0,12); \
    KRD(GL,2); GAPB(o[0]=__builtin_amdgcn_mfma_f32_32x32x16_bf16(PAF(2),VFR(2),o[0],0,0,0), C1,0); \
    KRD(GL,3); GAPB(o[1]=__builtin_amdgcn_mfma_f32_32x32x16_bf16(PAF(2),VFR(6),o[1],0,0,0), C1,4); \
    GAPB(o[0]=__builtin_amdgcn_mfma_f32_32x32x16_bf16(PAF(3),VFR(3),o[0],0,0,0), C1,8); \
    GAPB(o[1]=__builtin_amdgcn_mfma_f32_32x32x16_bf16(PAF(3),VFR(7),o[1],0,0,0), C1,12); \
    }while(0)
  int t=1;
  for(;t+5<NT;t+=2){
    STEP(pB0,pB1,pA0,pA1,t,true,true,true);     WAIT_BAR(2); RESC(); ROT();
    STEP(pA0,pA1,pB0,pB1,t+1,true,true,true);   WAIT_BAR(2); RESC(); ROT();
  }
  #define ENDW(tt) do{ if((tt)+3<NT){WAIT_BAR(2);} else if((tt)+2<NT){WAIT_BAR(1);} else {WAIT_BAR(0);} }while(0)
  for(;t+1<NT;t+=2){
    STEP(pB0,pB1,pA0,pA1,t,(t+3<NT),(t+1<NT),(t+1<NT));       ENDW(t);   RESC(); ROT();
    STEP(pA0,pA1,pB0,pB1,t+1,(t+4<NT),(t+2<NT),(t+2<NT));     ENDW(t+1); RESC(); ROT();
  }
  STEP(pB0,pB1,pA0,pA1,NT-1,false,false,false); RESC();
  { float sacc=pB0[0]+pB0[1]; _Pragma("unroll") for(int r=2;r<16;++r)sacc+=pB0[r]; _Pragma("unroll") for(int r=0;r<16;++r)sacc+=pB1[r]; l_reg+=sacc;
    pw0=(u32x4){PKW(pB0,0),PKW(pB0,2),PKW(pB0,4),PKW(pB0,6)};pw1=(u32x4){PKW(pB0,8),PKW(pB0,10),PKW(pB0,12),PKW(pB0,14)};pw2=(u32x4){PKW(pB1,0),PKW(pB1,2),PKW(pB1,4),PKW(pB1,6)};pw3=(u32x4){PKW(pB1,8),PKW(pB1,10),PKW(pB1,12),PKW(pB1,14)};
    SBAR(); pv(o,(int)(unsigned)(uintptr_t)(vp0+sl_cur),PAF(0),PAF(1),PAF(2),PAF(3)); }
  #undef PKW
  #undef PAF
  #undef VFR
  #undef PIN
  #undef MX3
  #undef GAPA
  #undef GAPB
  #undef EX
  #undef VRD
  #undef KRD
  #undef STEP
  #undef ENDW
  {auto rr=__builtin_amdgcn_permlane32_swap(__float_as_uint(l_reg),__float_as_uint(l_reg),false,false);l_reg=__uint_as_float(rr[0])+__uint_as_float(rr[1]);}
  if(hi==0)wsf[32+r32]=l_reg;asm volatile("s_waitcnt lgkmcnt(0)":::"memory");
  float rli[16];
  #pragma unroll
  for(int r=0;r<16;++r)rli[r]=__builtin_amdgcn_rcpf(wsf[32+crow(r,hi)]);
  { bf16*stg=(bf16*)(shm+LDS_OST)+wid*2048;
    #pragma unroll
    for(int r=0;r<16;++r){const int orow=crow(r,hi);
      #pragma unroll
      for(int d0=0;d0<2;++d0){ const float v_=o[d0][r]*rli[r]; const unsigned u_=__builtin_bit_cast(unsigned,v_); stg[orow*64+d0*32+r32]=(bf16)((u_+0x7fffu+((u_>>16)&1u))>>16); } }
    asm volatile("s_waitcnt lgkmcnt(0)":::"memory");
    #pragma unroll
    for(int i=0;i<4;++i){const int row=i*8+(lane>>3),ch=lane&7; const u32x4 v=*(const u32x4*)(stg+row*64+ch*8); *(u32x4*)(Ow+(long)row*LDO+ch*8)=v;} }
  asm volatile("s_waitcnt lgkmcnt(0)\n\ts_barrier":::"memory");
  #undef DMA_K
  #undef DMA_V
  #undef CMASK
  #undef START
  #undef RESC
  #undef ROT
}
#undef SBAR
#undef WAIT_BAR
}
namespace hgrn2 {
using bf16x8 = __attribute__((ext_vector_type(8))) short;
using f32x16 = __attribute__((ext_vector_type(16))) float;
using f32x4 = __attribute__((ext_vector_type(4))) float;
using u32x4 = __attribute__((ext_vector_type(4))) unsigned;
using u32x2 = __attribute__((ext_vector_type(2))) unsigned;
typedef unsigned short bf16;
#define HG_LAS __attribute__((address_space(3)))
constexpr int QS = 136, KS = 40, OS = 33;
constexpr int QD = 0, KD = QD + 32 * QS * 2, KET = KD + 32 * QS * 2, VT = KET + 128 * KS * 2, DEC = VT + 128 * KS * 2, PBSZ = DEC + 512;
constexpr int OT = 2 * PBSZ, SSP = OT + 4 * 32 * OS * 4, WG_BYTES = SSP + 2 * 512;
static_assert(WG_BYTES <= 131072 && PBSZ % 16 == 0 && OT % 16 == 0, "hgrn LDS map");
__device__ __forceinline__ int crow(int r, int hi) { return (r & 3) + 8 * (r >> 2) + 4 * hi; }
typedef float f32x2_t __attribute__((ext_vector_type(2))); typedef __bf16 bf16x2_t __attribute__((ext_vector_type(2)));
__device__ __forceinline__ unsigned cvtpk(float lo, float hi) { f32x2_t v = {lo, hi}; bf16x2_t b = __builtin_convertvector(v, bf16x2_t); return __builtin_bit_cast(unsigned, b); }
__device__ __forceinline__ float bf2f(unsigned short b) { return __builtin_bit_cast(float, (unsigned)b << 16); }
__device__ __forceinline__ bf16x8 packacc(const f32x16& x, int s) {
    u32x4 p; p[0] = cvtpk(x[8 * s], x[8 * s + 1]); p[1] = cvtpk(x[8 * s + 2], x[8 * s + 3]); p[2] = cvtpk(x[8 * s + 4], x[8 * s + 5]); p[3] = cvtpk(x[8 * s + 6], x[8 * s + 7]);
    return __builtin_bit_cast(bf16x8, p); }
__device__ __forceinline__ bf16x8 ldperm(const HG_LAS bf16* rowp, int k0, int hi) {
    const u32x2 a = *(const HG_LAS u32x2*)(rowp + k0 + 4 * hi), b = *(const HG_LAS u32x2*)(rowp + k0 + 8 + 4 * hi);
    u32x4 p; p[0] = a[0]; p[1] = a[1]; p[2] = b[0]; p[3] = b[1]; return __builtin_bit_cast(bf16x8, p); }
#define HG_MFMA(a, b, c) __builtin_amdgcn_mfma_f32_32x32x16_bf16((a), (b), (c), 0, 0, 0)

template <int LDP, int QOFF, int FOFF, int IOFF, int GOFF, int LDO, int OOFF, int SEQ_>
__device__ __forceinline__ void hgrn_pair(const bf16* P, bf16* O, const float* lb, const float* gw, int b, int h, HG_LAS unsigned char* lds, float eps) {
    constexpr int NB = SEQ_ / 32;
    const int tid = threadIdx.x, tid4 = tid & 255, lane = tid & 63, r32 = lane & 31, hi = lane >> 5; const int wave = __builtin_amdgcn_readfirstlane(tid >> 6); const int w4 = wave & 3;
    const size_t seq0 = (size_t)b * SEQ_;
    if (wave >= 4) {
        const int plane = tid4 & 63, rp = plane & 15, d0 = 8 * (4 * (tid4 >> 6) + (plane >> 4));
        const bf16* src0 = P + (seq0 + 2 * rp) * LDP + h * 128 + d0;
        u32x4 aF[2], aQ[2], aV[2], bF[2], bQ[2], bV[2];
#define HG_LOAD(F_, Q_, V_, n) do { const bf16* s_ = src0 + (size_t)(n) * 32 * LDP; _Pragma("unroll") for (int j = 0; j < 2; ++j) { F_[j] = *(const u32x4*)(s_ + (size_t)j * LDP + FOFF); Q_[j] = *(const u32x4*)(s_ + (size_t)j * LDP + QOFF); V_[j] = *(const u32x4*)(s_ + (size_t)j * LDP + IOFF); } } while (0)
#define HG_SHR(x, ctrl) __builtin_bit_cast(float, __builtin_amdgcn_update_dpp(0x3f800000, __builtin_bit_cast(int, (x)), (ctrl), 0xF, 0xF, false))
#define HG_PREP(F_, Q_, V_, pbo) do { \
        HG_LAS bf16* qd = (HG_LAS bf16*)(lds + (pbo) + QD); HG_LAS bf16* kd = (HG_LAS bf16*)(lds + (pbo) + KD); HG_LAS bf16* ket = (HG_LAS bf16*)(lds + (pbo) + KET); HG_LAS bf16* vt = (HG_LAS bf16*)(lds + (pbo) + VT); \
        HG_LAS float* dec = (HG_LAS float*)(lds + (pbo) + DEC); \
        float fa[8], fb[8], inc[8], exc[8]; \
        _Pragma("unroll") for (int e = 0; e < 8; ++e) { const unsigned wa = F_[0][e >> 1], wb = F_[1][e >> 1]; \
            fa[e] = (float)((e & 1) ? (wa >> 16) : (wa & 0xffffu)) * (1.f / 65536.f); fb[e] = (float)((e & 1) ? (wb >> 16) : (wb & 0xffffu)) * (1.f / 65536.f); inc[e] = fa[e] * fb[e]; } \
        _Pragma("unroll") for (int e = 0; e < 8; ++e) { inc[e] *= HG_SHR(inc[e], 0x111); inc[e] *= HG_SHR(inc[e], 0x112); inc[e] *= HG_SHR(inc[e], 0x114); inc[e] *= HG_SHR(inc[e], 0x118); exc[e] = HG_SHR(inc[e], 0x111); } \
        unsigned qwa[4], qwb[4], kwa[4], kwb[4]; float dtot[8], kea[8], keb[8]; \
        _Pragma("unroll") for (int e = 0; e < 8; ++e) dtot[e] = __shfl(inc[e], plane | 15); \
        _Pragma("unroll") for (int e = 0; e < 8; e += 2) { \
            const unsigned qa_ = Q_[0][e >> 1], qb_ = Q_[1][e >> 1]; \
            const float pa0 = exc[e] * fa[e], pa1 = exc[e + 1] * fa[e + 1], pb0 = inc[e], pb1 = inc[e + 1]; \
            qwa[e >> 1] = cvtpk(__builtin_bit_cast(float, qa_ << 16) * pa0, __builtin_bit_cast(float, qa_ & 0xffff0000u) * pa1); \
            qwb[e >> 1] = cvtpk(__builtin_bit_cast(float, qb_ << 16) * pb0, __builtin_bit_cast(float, qb_ & 0xffff0000u) * pb1); \
            const float ka0 = (1.f - fa[e]) * __builtin_amdgcn_rcpf(pa0), ka1 = (1.f - fa[e + 1]) * __builtin_amdgcn_rcpf(pa1), kb0 = (1.f - fb[e]) * __builtin_amdgcn_rcpf(pb0), kb1 = (1.f - fb[e + 1]) * __builtin_amdgcn_rcpf(pb1); \
            kwa[e >> 1] = cvtpk(ka0, ka1); kwb[e >> 1] = cvtpk(kb0, kb1); \
            kea[e] = ka0 * dtot[e]; kea[e + 1] = ka1 * dtot[e + 1]; keb[e] = kb0 * dtot[e]; keb[e + 1] = kb1 * dtot[e + 1]; } \
        *(HG_LAS u32x4*)(qd + (2 * rp) * QS + d0) = (u32x4){qwa[0], qwa[1], qwa[2], qwa[3]}; *(HG_LAS u32x4*)(qd + (2 * rp + 1) * QS + d0) = (u32x4){qwb[0], qwb[1], qwb[2], qwb[3]}; \
        *(HG_LAS u32x4*)(kd + (2 * rp) * QS + d0) = (u32x4){kwa[0], kwa[1], kwa[2], kwa[3]}; *(HG_LAS u32x4*)(kd + (2 * rp + 1) * QS + d0) = (u32x4){kwb[0], kwb[1], kwb[2], kwb[3]}; \
        _Pragma("unroll") for (int e = 0; e < 8; ++e) { const unsigned va_ = V_[0][e >> 1], vb_ = V_[1][e >> 1]; \
            *(HG_LAS unsigned*)(ket + (d0 + e) * KS + 2 * rp) = cvtpk(kea[e], keb[e]); \
            *(HG_LAS unsigned*)(vt + (d0 + e) * KS + 2 * rp) = (e & 1) ? ((va_ >> 16) | (vb_ & 0xffff0000u)) : ((va_ & 0xffffu) | (vb_ << 16)); } \
        if (rp == 15) { *(HG_LAS f32x4*)(dec + d0) = (f32x4){inc[0], inc[1], inc[2], inc[3]}; *(HG_LAS f32x4*)(dec + d0 + 4) = (f32x4){inc[4], inc[5], inc[6], inc[7]}; } } while (0)
        HG_LOAD(aF, aQ, aV, 0);
#pragma unroll 1
        for (int n = 0; n < NB + 2; n += 2) {
            if (n + 1 < NB) HG_LOAD(bF, bQ, bV, n + 1);
            if (n < NB) HG_PREP(aF, aQ, aV, 0);
            __syncthreads();
            if (n + 2 < NB) HG_LOAD(aF, aQ, aV, n + 2);
            if (n + 1 < NB) HG_PREP(bF, bQ, bV, PBSZ);
            __syncthreads();
        }
#undef HG_LOAD
#undef HG_PREP
#undef HG_SHR
    } else {
        __builtin_amdgcn_s_setprio(3);
        HG_LAS float* ot = (HG_LAS float*)(lds + OT) + w4 * 32 * OS;
        const int fl_ = lane & 31, eh = lane >> 5, ecol = 32 * w4 + 16 * eh;
        float gwv[16];
#pragma unroll
        for (int k = 0; k < 16; ++k) gwv[k] = gw[h * 128 + ecol + k];
        f32x16 S[4];
#pragma unroll
        for (int k = 0; k < 4; ++k) S[k] = f32x16{};
        float ov[16]; u32x4 g0 = {0u, 0u, 0u, 0u}, g1 = {0u, 0u, 0u, 0u};
#pragma unroll
        for (int k = 0; k < 16; ++k) ov[k] = 0.f;
#define HG_MMA(nb, pbo, sso) do { \
        const HG_LAS bf16* qd = (const HG_LAS bf16*)(lds + (pbo) + QD); const HG_LAS bf16* kd = (const HG_LAS bf16*)(lds + (pbo) + KD); const HG_LAS bf16* ket = (const HG_LAS bf16*)(lds + (pbo) + KET); \
        const HG_LAS bf16* vt = (const HG_LAS bf16*)(lds + (pbo) + VT); const HG_LAS float* dec = (const HG_LAS float*)(lds + (pbo) + DEC); HG_LAS float* ssp = (HG_LAS float*)(lds + SSP + (sso)); \
        { const bf16* gsrc = P + (seq0 + (size_t)(nb) * 32 + fl_) * LDP + GOFF + h * 128 + ecol; g0 = *(const u32x4*)(gsrc); g1 = *(const u32x4*)(gsrc + 8); } \
        f32x16 X = f32x16{}, X2 = f32x16{};                                       \
        _Pragma("unroll") for (int s = 0; s < 8; s += 2) { const bf16x8 a = *(const HG_LAS bf16x8*)(kd + r32 * QS + 16 * s + 8 * hi), bq_ = *(const HG_LAS bf16x8*)(qd + r32 * QS + 16 * s + 8 * hi); X = HG_MFMA(a, bq_, X); \
            const bf16x8 a2 = *(const HG_LAS bf16x8*)(kd + r32 * QS + 16 * (s + 1) + 8 * hi), bq2 = *(const HG_LAS bf16x8*)(qd + r32 * QS + 16 * (s + 1) + 8 * hi); X2 = HG_MFMA(a2, bq2, X2); } \
        _Pragma("unroll") for (int r = 0; r < 16; ++r) X[r] = crow(r, hi) <= r32 ? X[r] + X2[r] : 0.f; \
        const bf16x8 vf0 = ldperm(vt + (32 * w4 + r32) * KS, 0, hi), vf1 = ldperm(vt + (32 * w4 + r32) * KS, 16, hi); \
        f32x16 Oa = f32x16{}, Ob = f32x16{}, Oc = f32x16{}; \
        _Pragma("unroll") for (int blk = 0; blk < 2; ++blk) _Pragma("unroll") for (int s = 0; s < 2; ++s) { Ob = HG_MFMA(ldperm(qd + r32 * QS, 32 * blk + 16 * s, hi), packacc(S[blk], s), Ob); \
            Oc = HG_MFMA(ldperm(qd + r32 * QS, 32 * (blk + 2) + 16 * s, hi), packacc(S[blk + 2], s), Oc); } \
        Oa = HG_MFMA(packacc(X, 0), vf0, Oa); Oa = HG_MFMA(packacc(X, 1), vf1, Oa); \
        _Pragma("unroll") for (int r = 0; r < 16; ++r) Oa[r] += Ob[r] + Oc[r]; \
        _Pragma("unroll") for (int blk = 0; blk < 4; ++blk) { \
            _Pragma("unroll") for (int q4 = 0; q4 < 4; ++q4) { const f32x4 dv = *(const HG_LAS f32x4*)(dec + 32 * blk + 8 * q4 + 4 * hi); \
                _Pragma("unroll") for (int e = 0; e < 4; ++e) S[blk][4 * q4 + e] *= dv[e]; } \
            S[blk] = HG_MFMA(ldperm(ket + (32 * blk + r32) * KS, 0, hi), vf0, S[blk]); \
            S[blk] = HG_MFMA(ldperm(ket + (32 * blk + r32) * KS, 16, hi), vf1, S[blk]); } \
        _Pragma("unroll") for (int r = 0; r < 16; ++r) ot[crow(r, hi) * OS + r32] = Oa[r]; \
        asm volatile("s_waitcnt lgkmcnt(0)" ::: "memory"); \
        float ss = 0.f; \
        _Pragma("unroll") for (int k = 0; k < 16; ++k) { ov[k] = ot[fl_ * OS + 16 * eh + k]; ss += ov[k] * ov[k]; } \
        ss += __shfl_xor(ss, 32); \
        if (lane < 32) ssp[w4 * 32 + fl_] = ss; } while (0)
#define HG_FIN(nb, sso) do { \
        const HG_LAS float* ssp = (const HG_LAS float*)(lds + SSP + (sso)); \
        const float tot = (ssp[fl_] + ssp[32 + fl_]) + (ssp[64 + fl_] + ssp[96 + fl_]); const float rstd = 1.f / sqrtf(tot * (1.f / 128.f) + eps); \
        unsigned ow[8]; \
        _Pragma("unroll") for (int k = 0; k < 16; k += 2) { const unsigned gwd = k < 8 ? g0[k >> 1] : g1[(k - 8) >> 1]; \
            const float ga = bf2f((unsigned short)(gwd & 0xffffu)), gb = bf2f((unsigned short)(gwd >> 16)); \
            const float ra = ov[k] * rstd * gwv[k] * ga, rb = ov[k + 1] * rstd * gwv[k + 1] * gb;     \
            ow[k >> 1] = cvtpk(ra, rb); } \
        bf16* dst = O + (seq0 + (size_t)(nb) * 32 + fl_) * LDO + OOFF + h * 128 + ecol; \
        *(u32x4*)(dst) = (u32x4){ow[0], ow[1], ow[2], ow[3]}; *(u32x4*)(dst + 8) = (u32x4){ow[4], ow[5], ow[6], ow[7]}; } while (0)
#pragma unroll 1
        for (int n = 0; n < NB + 2; n += 2) {
            if (n >= 2) HG_FIN(n - 2, 0);
            if (n >= 1 && n <= NB) HG_MMA(n - 1, PBSZ, 512);
            __syncthreads();
            if (n >= 1 && n <= NB) HG_FIN(n - 1, 512);
            if (n < NB) HG_MMA(n, 0, 0);
            __syncthreads();
        }
#undef HG_MMA
#undef HG_FIN
        __builtin_amdgcn_s_setprio(0);
    }
    __syncthreads();
}
#undef HG_MFMA
}
#define GAS __attribute__((address_space(1)))
#define LAS __attribute__((address_space(3)))
typedef unsigned short bf16;
typedef unsigned v4u __attribute__((ext_vector_type(4)));
typedef float f32x4 __attribute__((ext_vector_type(4)));
typedef short bf16x8 __attribute__((ext_vector_type(8)));
typedef GAS unsigned gu32;
typedef GAS unsigned long long gu64;
#define RLX_AGENT __ATOMIC_RELAXED, __HIP_MEMORY_SCOPE_AGENT
#define LDS_WAIT() asm volatile("s_waitcnt lgkmcnt(0)" ::: "memory")
#define VM_WAIT() asm volatile("s_waitcnt vmcnt(0)" ::: "memory")
__device__ __forceinline__ unsigned long long rt() { return __builtin_amdgcn_s_memrealtime(); }
__device__ __forceinline__ unsigned f2bf(float f) { unsigned u = __builtin_bit_cast(unsigned, f); return (u + 0x7fffu + ((u >> 16) & 1u)) >> 16; }
__device__ __forceinline__ unsigned pk2(float lo, float hi) { return f2bf(lo) | (f2bf(hi) << 16); }

#define XB_TMO      128
#define XB_XCNT(j)  (256  + 64 * (j))
#define XB_XSUB(j)  (1280 + 64 * (j))
#define XB_XGEN(j)  (2304 + 64 * (j))
#define XB_TOP      3328
#define XB_TOPGEN   3392
#define XCD_BAR_WORDS 3456
#define XB_SPIN_CAP (1u << 18)

__device__ __forceinline__ unsigned xb_ld(unsigned* p)              { return __hip_atomic_load(p, __ATOMIC_RELAXED, __HIP_MEMORY_SCOPE_AGENT); }
__device__ __forceinline__ unsigned xb_add(unsigned* p, unsigned v) { return __hip_atomic_fetch_add(p, v, __ATOMIC_RELAXED, __HIP_MEMORY_SCOPE_AGENT); }
__device__ __forceinline__ unsigned xb_xcc_id() { return (unsigned)__builtin_amdgcn_s_getreg((3 << 11) | 20) & 0xFu; }
#define XB_SPIN(cond, bar) do { unsigned _sp = 0; while (cond) { __builtin_amdgcn_s_sleep(1); \
    if ((++_sp & 255u) == 0u) { if (xb_ld(&(bar)[XB_TMO])) break; if (_sp > XB_SPIN_CAP) { atomicAdd(&(bar)[XB_TMO], 1u); break; } } } } while (0)

struct XcdBarrier {
    unsigned* bar; unsigned x;
    volatile LAS unsigned* st;
};

__device__ __forceinline__ XcdBarrier xcd_barrier_post(unsigned* bar, volatile LAS unsigned* st) {
    XcdBarrier b; b.bar = bar; b.x = xb_xcc_id(); b.st = st;
    if (threadIdx.x == 0) (void)xb_add(&bar[XB_XCNT(b.x)], 1u);
    return b;
}
__device__ __forceinline__ void xcd_barrier_complete(unsigned* bar, unsigned x, unsigned& nloc, unsigned& nx) {
    const unsigned G = gridDim.x * gridDim.y * gridDim.z;
    unsigned sum, cnt, mine, sp = 0u;
    for (;;) {
        sum = 0u; cnt = 0u; mine = 0u;
#pragma unroll
        for (unsigned j = 0; j < 16; ++j) { const unsigned c = xb_ld(&bar[XB_XCNT(j)]); sum += c; cnt += (c > 0u) ? 1u : 0u; mine = (j == x) ? c : mine; }
        if (sum == G) break;
        __builtin_amdgcn_s_sleep(1);
        if ((++sp & 255u) == 0u) { if (xb_ld(&bar[XB_TMO])) break; if (sp > XB_SPIN_CAP) { atomicAdd(&bar[XB_TMO], 1u); break; } }
    }
    nloc = mine > 0u ? mine : 1u; nx = cnt > 0u ? cnt : 1u;
}

__device__ __forceinline__ void xcd_barrier(const XcdBarrier& b) {
    asm volatile("s_waitcnt vmcnt(0)" ::: "memory");
    __syncthreads();
    if (threadIdx.x == 0) {
        unsigned* bar = b.bar;
        __builtin_amdgcn_s_waitcnt(0);
        unsigned nloc = b.st[0], nx = b.st[1];
        if (nloc == 0u) { xcd_barrier_complete(bar, b.x, nloc, nx); b.st[0] = nloc; b.st[1] = nx; }
        const unsigned old = xb_add(&bar[XB_XSUB(b.x)], 1u);
        const unsigned gen = old / nloc;
        if (old + 1u == (gen + 1u) * nloc) {
            __builtin_amdgcn_fence(__ATOMIC_RELEASE, "agent");
            asm volatile("s_waitcnt vmcnt(0)" ::: "memory");
            const unsigned og = xb_add(&bar[XB_TOP], 1u);
            const unsigned tg = og / nx;
            if (og + 1u == (tg + 1u) * nx) xb_add(&bar[XB_TOPGEN], 1u);
            else XB_SPIN(xb_ld(&bar[XB_TOPGEN]) == tg, bar);
            __builtin_amdgcn_fence(__ATOMIC_ACQUIRE, "agent");
            xb_add(&bar[XB_XGEN(b.x)], 1u);
            asm volatile("s_waitcnt vmcnt(0)" ::: "memory");
        } else {
            XB_SPIN(xb_ld(&bar[XB_XGEN(b.x)]) == gen, bar);
            __builtin_amdgcn_fence(__ATOMIC_ACQUIRE, "agent");
            asm volatile("s_waitcnt vmcnt(0)" ::: "memory");
        }
    }
    __syncthreads();
}
struct Frame {
    LAS unsigned char* lds; char* ldsg;
    volatile LAS unsigned* MISC;
    gu32* ctl;
    int tid, lane, wave, G;
    unsigned char* ws;
    const float *x, *even_w_in, *even_w_out, *even_sinks, *lb_logits, *hgrn_norm_w, *odd_w_in, *odd_w_out, *odd_rel, *w_up, *conv_w, *conv_b, *w_down, *norm_w;
    float* out;
};
__device__ __forceinline__ float bf2f(bf16 b) { return __builtin_bit_cast(float, (unsigned)b << 16); }
__device__ __forceinline__ float wave_sum(float v) {
#pragma unroll
    for (int o = 1; o < 64; o <<= 1) v += __shfl_xor(v, o);
    return v;
}
__device__ __forceinline__ int colmap(int cmode, int n) {
    if (cmode == 1) { if (n >= 640) return n; const int p = n & 63; return (n - p) + (p >> 1) + 32 * (p & 1); }
    if (cmode == 2) { const int pn = n >> 8, r = n & 255; return r < 128 ? pn * 128 + r : DFF + pn * 128 + (r - 128); }
    return n;
}
__device__ __forceinline__ void transpose_item(const float* W, int K, int Nsrc, int Nout, bf16* WT, const float* kscale, int cmode, LAS float* scr, int item, int lane) {
    const int nblk = Nout / 32, kb = item / nblk, nb = item % nblk, k0 = 64 * kb, n0 = 32 * nb;
    const int nsrc = colmap(cmode, n0 + (lane & 31));
    float wv[32];
#pragma unroll
    for (int i = 0; i < 32; ++i) wv[i] = W[(size_t)(k0 + 2 * i + (lane >> 5)) * Nsrc + nsrc];
#pragma unroll
    for (int i = 0; i < 32; ++i) scr[(2 * i + (lane >> 5)) * 33 + (lane & 31)] = wv[i];
    LDS_WAIT(); asm volatile("" ::: "memory");
    const int c = lane & 7;
    f32x4 ksa = {1.f, 1.f, 1.f, 1.f}, ksb = {1.f, 1.f, 1.f, 1.f};
    if (kscale) { ksa = *(const GAS f32x4*)(kscale + k0 + 8 * c); ksb = *(const GAS f32x4*)(kscale + k0 + 8 * c + 4); }
#pragma unroll
    for (int j = 0; j < 4; ++j) { const int n = (lane >> 3) + 8 * j; const LAS float* s = scr + (8 * c) * 33 + n;
        v4u o; o.x = pk2(s[0 * 33] * ksa[0], s[1 * 33] * ksa[1]); o.y = pk2(s[2 * 33] * ksa[2], s[3 * 33] * ksa[3]); o.z = pk2(s[4 * 33] * ksb[0], s[5 * 33] * ksb[1]); o.w = pk2(s[6 * 33] * ksb[2], s[7 * 33] * ksb[3]);
        *(GAS v4u*)(WT + (size_t)(n0 + n) * K + k0 + 8 * c) = o; }
    LDS_WAIT(); asm volatile("" ::: "memory");
}
__device__ __forceinline__ void rms_row_to_bf16(int lane, const float* xrow, bf16* orow, float* scp) {
    const GAS f32x4* xr = (const GAS f32x4*)xrow + lane;
    f32x4 v[4]; float s = 0.f;
#pragma unroll
    for (int j = 0; j < 4; ++j) { v[j] = xr[64 * j]; s += (v[j].x * v[j].x + v[j].y * v[j].y) + (v[j].z * v[j].z + v[j].w * v[j].w); }
    const float rms = sqrtf(wave_sum(s) * (1.f / D) + EPS), rstd = 1.f / rms;
    if (lane == 0) *scp = rms;
    GAS unsigned long long* o8 = (GAS unsigned long long*)orow + lane;
#pragma unroll
    for (int j = 0; j < 4; ++j) o8[64 * j] = (unsigned long long)pk2(v[j].x * rstd, v[j].y * rstd) | ((unsigned long long)pk2(v[j].z * rstd, v[j].w * rstd) << 32);
}
__device__ __forceinline__ void p_prologue(Frame& F) {
    LAS float* scr = (LAS float*)(F.lds + RING_OFF + F.wave * 16384);
    const int gw = blockIdx.x * NWAVES + F.wave, NGW = F.G * NWAVES;
    constexpr int C0 = 1408, C1 = C0 + 512, C2_ = C1 + 1536, C3 = C2_ + 512, C4 = C3 + 2816, C5 = C4 + 2816, C6 = C5 + 1408, C7 = C6 + 1408;
#pragma unroll 1
    for (int git = gw; git < C7; git += NGW) {
        const int mat = git < C0 ? 0 : git < C1 ? 1 : git < C2_ ? 2 : git < C3 ? 3 : git < C4 ? 4 : git < C5 ? 5 : git < C6 ? 6 : 7;
        const int it = git - (mat == 0 ? 0 : mat == 1 ? C0 : mat == 2 ? C1 : mat == 3 ? C2_ : mat == 4 ? C3 : mat == 5 ? C4 : mat == 6 ? C5 : C6);
        const float* W; int K, Nsrc, Nout, cmode = 0; const float* ks = nullptr; size_t dst;
        if (mat == 0)      { W = F.even_w_in;  K = D; Nsrc = EVEN_IN; Nout = EVEN_IN; cmode = 1; ks = F.norm_w + 0 * D; dst = WS_WIN0; }
        else if (mat == 1) { W = F.even_w_out; K = D; Nsrc = D; Nout = D; dst = WS_WOUT0; }
        else if (mat == 2) { W = F.odd_w_in;   K = D; Nsrc = ODD_IN; Nout = ODD_IN; ks = F.norm_w + 4 * D; dst = WS_WIN1; }
        else if (mat == 3) { W = F.odd_w_out;  K = D; Nsrc = D; Nout = D; dst = WS_WOUT1; }
        else if (mat < 6)  { const int l = mat - 4; W = F.w_up + (size_t)l * D * UPN; K = D; Nsrc = UPN; Nout = UPN; cmode = 2; ks = F.norm_w + (size_t)(l * 4 + 2) * D; dst = WS_WUP + (size_t)l * 11 * MiB; }
        else               { const int l = mat - 6; W = F.w_down + (size_t)l * DFF * D; K = DFF; Nsrc = D; Nout = D; dst = WS_WDN + (size_t)l * 5632 * 1024; }
        transpose_item(W, K, Nsrc, Nout, (bf16*)(F.ws + dst), ks, cmode, scr, it, F.lane);
    }
    { float* tab = (float*)(F.ws + WS_TAB); const int gt = blockIdx.x * (NWAVES * 64) + F.tid, NT = F.G * NWAVES * 64;
      for (int e = gt; e < SEQ * 32; e += NT) { const int t = e >> 5, i = e & 31; const float inv = powf(10000.f, -(float)(2 * i) / 64.f); const float ang = (float)t * inv;
          tab[2 * e] = (float)cos((double)ang); tab[2 * e + 1] = (float)sin((double)ang); }
      float* lb = (float*)(F.ws + WS_LB);
      for (int e = gt; e < 512; e += NT) { const float a = F.lb_logits[e], b = F.lb_logits[512 + e]; const float mx = fmaxf(a, b); const float ea = expf(a - mx), eb = expf(b - mx); lb[e] = ea / (ea + eb); } }
    for (int m0 = gw; m0 < M; m0 += 2 * NGW) {
        const int m1 = m0 + NGW < M ? m0 + NGW : m0;
        const GAS f32x4* xa = (const GAS f32x4*)(F.x + (size_t)m0 * D); const GAS f32x4* xb = (const GAS f32x4*)(F.x + (size_t)m1 * D);
        f32x4 va[2][2], vb[2][2]; float sa = 0.f, sb = 0.f;
#pragma unroll
        for (int j = 0; j < 2; ++j) { va[j][0] = xa[2 * (F.lane + 64 * j)]; va[j][1] = xa[2 * (F.lane + 64 * j) + 1]; vb[j][0] = xb[2 * (F.lane + 64 * j)]; vb[j][1] = xb[2 * (F.lane + 64 * j) + 1]; }
#pragma unroll
        for (int j = 0; j < 2; ++j)
#pragma unroll
            for (int q = 0; q < 2; ++q) { sa += (va[j][q][0] * va[j][q][0] + va[j][q][1] * va[j][q][1]) + (va[j][q][2] * va[j][q][2] + va[j][q][3] * va[j][q][3]); sb += (vb[j][q][0] * vb[j][q][0] + vb[j][q][1] * vb[j][q][1]) + (vb[j][q][2] * vb[j][q][2] + vb[j][q][3] * vb[j][q][3]); }
        const float rmsa = sqrtf(wave_sum(sa) * (1.f / D) + EPS), rmsb = sqrtf(wave_sum(sb) * (1.f / D) + EPS), ra = 1.f / rmsa, rb = 1.f / rmsb;
        float* scp = (float*)(F.ws + WS_SC);
        GAS v4u* oa = (GAS v4u*)((bf16*)(F.ws + WS_XN) + (size_t)m0 * D) + F.lane; GAS v4u* ob = (GAS v4u*)((bf16*)(F.ws + WS_XN) + (size_t)m1 * D) + F.lane;
        if (F.lane == 0) { scp[m0] = rmsa; if (m1 != m0) scp[m1] = rmsb; }
#pragma unroll
        for (int j = 0; j < 2; ++j) { v4u o; o.x = pk2(va[j][0][0] * ra, va[j][0][1] * ra); o.y = pk2(va[j][0][2] * ra, va[j][0][3] * ra); o.z = pk2(va[j][1][0] * ra, va[j][1][1] * ra); o.w = pk2(va[j][1][2] * ra, va[j][1][3] * ra); oa[64 * j] = o; }
        if (m1 != m0) {
#pragma unroll
            for (int j = 0; j < 2; ++j) { v4u o; o.x = pk2(vb[j][0][0] * rb, vb[j][0][1] * rb); o.y = pk2(vb[j][0][2] * rb, vb[j][0][3] * rb); o.z = pk2(vb[j][1][0] * rb, vb[j][1][1] * rb); o.w = pk2(vb[j][1][2] * rb, vb[j][1][3] * rb); ob[64 * j] = o; } }
    }
}
__device__ __forceinline__ void p_norm(Frame& F, bf16* XNp, float* sc, const bf16* Y, const float* g, float* outf) {
    const int gw = blockIdx.x * NWAVES + F.wave, NGW = F.G * NWAVES;
    f32x4 gv[2][2];
#pragma unroll
    for (int j = 0; j < 2; ++j) { gv[j][0] = ((const GAS f32x4*)g)[2 * (F.lane + 64 * j)]; gv[j][1] = ((const GAS f32x4*)g)[2 * (F.lane + 64 * j) + 1]; }
    constexpr int R = 2;
    for (int m0 = gw; m0 < M; m0 += R * NGW) {
        v4u wx[R][2], wy[R][2]; float scm[R];
#pragma unroll
        for (int r = 0; r < R; ++r) { const int m = m0 + r * NGW; const int mm = m < M ? m : m0;
            const GAS v4u* xr = (const GAS v4u*)(XNp + (size_t)mm * D) + F.lane; const GAS v4u* yr = (const GAS v4u*)(Y + (size_t)mm * D) + F.lane;
            scm[r] = sc[mm];
#pragma unroll
            for (int j = 0; j < 2; ++j) { wx[r][j] = xr[64 * j]; wy[r][j] = yr[64 * j]; } }
#pragma unroll
        for (int r = 0; r < R; ++r) { const int m = m0 + r * NGW; if (m >= M) break;
            f32x4 h[2][2], y[2][2]; float s = 0.f;
#pragma unroll
            for (int j = 0; j < 2; ++j) { const v4u a = wx[r][j], w = wy[r][j];
                h[j][0][0] = __builtin_bit_cast(float, a.x << 16); h[j][0][1] = __builtin_bit_cast(float, a.x & 0xffff0000u); h[j][0][2] = __builtin_bit_cast(float, a.y << 16); h[j][0][3] = __builtin_bit_cast(float, a.y & 0xffff0000u);
                h[j][1][0] = __builtin_bit_cast(float, a.z << 16); h[j][1][1] = __builtin_bit_cast(float, a.z & 0xffff0000u); h[j][1][2] = __builtin_bit_cast(float, a.w << 16); h[j][1][3] = __builtin_bit_cast(float, a.w & 0xffff0000u);
                y[j][0][0] = __builtin_bit_cast(float, w.x << 16); y[j][0][1] = __builtin_bit_cast(float, w.x & 0xffff0000u); y[j][0][2] = __builtin_bit_cast(float, w.y << 16); y[j][0][3] = __builtin_bit_cast(float, w.y & 0xffff0000u);
                y[j][1][0] = __builtin_bit_cast(float, w.z << 16); y[j][1][1] = __builtin_bit_cast(float, w.z & 0xffff0000u); y[j][1][2] = __builtin_bit_cast(float, w.w << 16); y[j][1][3] = __builtin_bit_cast(float, w.w & 0xffff0000u);
#pragma unroll
                for (int q = 0; q < 2; ++q) s += (y[j][q][0] * y[j][q][0] + y[j][q][1] * y[j][q][1]) + (y[j][q][2] * y[j][q][2] + y[j][q][3] * y[j][q][3]); }
            const float r1 = 1.f / sqrtf(wave_sum(s) * (1.f / D) + EPS); float s2 = 0.f;
#pragma unroll
            for (int j = 0; j < 2; ++j)
#pragma unroll
                for (int q = 0; q < 2; ++q) { h[j][q] = h[j][q] * scm[r] + y[j][q] * r1 * gv[j][q]; s2 += (h[j][q][0] * h[j][q][0] + h[j][q][1] * h[j][q][1]) + (h[j][q][2] * h[j][q][2] + h[j][q][3] * h[j][q][3]); }
            if (outf) { GAS f32x4* ho = (GAS f32x4*)(outf + (size_t)m * D);
#pragma unroll
                for (int j = 0; j < 2; ++j) { ho[2 * (F.lane + 64 * j)] = h[j][0]; ho[2 * (F.lane + 64 * j) + 1] = h[j][1]; } }
            else { const float rms = sqrtf(wave_sum(s2) * (1.f / D) + EPS), r2 = 1.f / rms;
                if (F.lane == 0) sc[m] = rms;
                GAS v4u* xo = (GAS v4u*)(XNp + (size_t)m * D) + F.lane;
#pragma unroll
                for (int j = 0; j < 2; ++j) { v4u o; o.x = pk2(h[j][0][0] * r2, h[j][0][1] * r2); o.y = pk2(h[j][0][2] * r2, h[j][0][3] * r2); o.z = pk2(h[j][1][0] * r2, h[j][1][1] * r2); o.w = pk2(h[j][1][2] * r2, h[j][1][3] * r2); xo[64 * j] = o; } }
        }
    }
}
__device__ __forceinline__ void p_fixup(Frame& F, bf16* H, const bf16* UL, const bf16* UF, const bf16* VF, const float* cw, const float* cb) {
    const int gt = blockIdx.x * (NWAVES * 64) + F.tid, NT = F.G * NWAVES * 64;
    constexpr int CH = DFF / 8, NIT = (M / 64) * 2 * CH;
    for (int it = gt; it < NIT; it += NT) {
        const int ch = it % CH, gr = it / CH, r = gr & 1, g = gr >> 1, j0 = ch * 8;
        const bool has_prev = (g & 31) != 0;
        const v4u z4 = {0u, 0u, 0u, 0u};
        const v4u u0 = *(const GAS v4u*)(UF + ((size_t)g * 2 + r) * DFF + j0);
        const v4u vv = *(const GAS v4u*)(VF + ((size_t)g * 2 + r) * DFF + j0);
        const v4u pl1 = has_prev ? *(const GAS v4u*)(UL + ((size_t)(g - 1) * 2 + 1) * DFF + j0) : z4;
        const v4u pl0 = has_prev ? *(const GAS v4u*)(UL + ((size_t)(g - 1) * 2 + 0) * DFF + j0) : z4;
        const v4u uf0 = *(const GAS v4u*)(UF + ((size_t)g * 2 + 0) * DFF + j0);
        const v4u um1 = r ? uf0 : pl1, um2 = r ? pl1 : pl0;
        float hh[8];
        const f32x4 kb0 = *(const GAS f32x4*)(cb + j0), kb1 = *(const GAS f32x4*)(cb + j0 + 4), k00 = *(const GAS f32x4*)(cw + j0), k01 = *(const GAS f32x4*)(cw + j0 + 4),
                    k10 = *(const GAS f32x4*)(cw + DFF + j0), k11 = *(const GAS f32x4*)(cw + DFF + j0 + 4), k20 = *(const GAS f32x4*)(cw + 2 * DFF + j0), k21 = *(const GAS f32x4*)(cw + 2 * DFF + j0 + 4);
#pragma unroll
        for (int e = 0; e < 8; ++e) { const int sh = (e & 1) * 16; const unsigned wa = u0[e >> 1], wb = um1[e >> 1], wc_ = um2[e >> 1], wv = vv[e >> 1];
            const float a = bf2f((bf16)(wa >> sh)), b = bf2f((bf16)(wb >> sh)), c = bf2f((bf16)(wc_ >> sh)), v = bf2f((bf16)(wv >> sh));
            const float pre = (e < 4 ? kb0[e & 3] : kb1[e & 3]) + (e < 4 ? k00[e & 3] : k01[e & 3]) * c + (e < 4 ? k10[e & 3] : k11[e & 3]) * b + (e < 4 ? k20[e & 3] : k21[e & 3]) * a;
            const pg8::f32x2 gg = pg8::gelu_pk((pg8::f32x2){pre, pre}); hh[e] = gg.x * v; }
        v4u o; o.x = pk2(hh[0], hh[1]); o.y = pk2(hh[2], hh[3]); o.z = pk2(hh[4], hh[5]); o.w = pk2(hh[6], hh[7]);
        *(GAS v4u*)(H + ((size_t)g * 64 + r) * DFF + j0) = o;
    }
}
__device__ __forceinline__ void p_attn1(Frame& F, const bf16* PROJ, bf16* OB) {
    LAS float* tbw = (LAS float*)(F.lds + RING_OFF + attn3::LDS_TB);
    for (int pair = blockIdx.x; pair < BATCH * 16; pair += F.G) {
        const int b = pair >> 4, h = pair & 15;
        if (F.tid < 320) { const int a = 319 - F.tid; tbw[F.tid] = F.odd_rel[h * 257 + (a > 256 ? 256 : a)] * LOG2E; }
        __syncthreads();
#pragma unroll 1
        for (int g4 = 0; g4 < 8; ++g4) {
            const int c0 = 4 * g4, jlo = c0 - 8 < 0 ? 0 : c0 - 8, NT = c0 + 4 - jlo, cw = c0 + (F.wave >> 1), wt1 = cw - jlo, wt0 = cw - 8 - jlo < 0 ? 0 : cw - 8 - jlo, qi0 = 32 * (F.wave & 1);
            const size_t row0 = (size_t)b * SEQ + 64 * cw + qi0, krow0 = (size_t)b * SEQ + 64 * jlo;
            attn3::attn_unit<ODD_IN, D, 8>(PROJ + row0 * ODD_IN + h * 64, PROJ + krow0 * ODD_IN + 1024 + h * 64, PROJ + krow0 * ODD_IN + 2048 + h * 64, OB + row0 * D + h * 64, NT, wt0, wt1, qi0, F.ldsg + RING_OFF);
        }
    }
}
__device__ __forceinline__ void p_attn0(Frame& F, const bf16* PROJ, bf16* OB, int first, int stride) {
#pragma unroll 1
    for (int u = first; u < BATCH * 2 * 32; u += stride) {
        const int c = u & 31, hk = (u >> 5) & 1, b = u >> 6, qh = 4 * hk + (F.wave >> 1), qpos0 = 64 * c + 32 * (F.wave & 1), jlo = c - 2 < 0 ? 0 : c - 2;
        const size_t row0 = (size_t)b * SEQ + qpos0, seq0 = (size_t)b * SEQ;
        attn2::band_unit<EVEN_IN, EVEN_IN, D, false, true>(PROJ + row0 * EVEN_IN + qh * 64, PROJ + seq0 * EVEN_IN + 512 + hk * 64, PROJ + seq0 * EVEN_IN + 640 + hk * 64,
                                                           OB + row0 * D + qh * 64, jlo, c, jlo, c, qpos0, F.even_sinks[qh] * LOG2E, F.ldsg + RING_OFF);
    }
}

__device__ __forceinline__ void p_hgrn(Frame& F, const bf16* PROJ, bf16* OB, const float* lb, int nhw) {
#pragma unroll 1
    for (int pair = blockIdx.x; pair < BATCH * 4; pair += nhw)
        hgrn2::hgrn_pair<EVEN_IN, QB_OFF, FB_OFF, IB_OFF, GB_OFF, D, 512, SEQ>(PROJ, OB, lb, F.hgrn_norm_w, pair >> 2, pair & 3, F.lds + RING_OFF, EPS);
}
constexpr int NPH = 17;
struct Args { const float* in[14]; float* out; unsigned char* ws; int ph_lo, ph_hi; };
__global__ void __launch_bounds__(NWAVES * 64, 2) mk_fwd(Args args) {
    extern __shared__ __attribute__((aligned(16))) unsigned char lds[];
    Frame F;
    F.lds = (LAS unsigned char*)lds; F.ldsg = (char*)lds;
    F.MISC = (volatile LAS unsigned*)(F.lds + MISC_OFF);
    F.tid = threadIdx.x; F.lane = F.tid & 63; F.wave = __builtin_amdgcn_readfirstlane(F.tid >> 6);
    F.G = gridDim.x;
    unsigned char* ws = args.ws; F.ws = ws;
    F.ctl = (gu32*)(ws + WS_CTL);
    F.x = args.in[0]; F.even_w_in = args.in[1]; F.even_w_out = args.in[2]; F.even_sinks = args.in[3]; F.lb_logits = args.in[4]; F.hgrn_norm_w = args.in[5];
    F.odd_w_in = args.in[6]; F.odd_w_out = args.in[7]; F.odd_rel = args.in[8]; F.w_up = args.in[9]; F.conv_w = args.in[10]; F.conv_b = args.in[11]; F.w_down = args.in[12]; F.norm_w = args.in[13];
    F.out = args.out;
    for (int u = F.tid; u < (LDS_BYTES - LDSCTL_OFF) / 4; u += NWAVES * 64) ((LAS unsigned*)(F.lds + LDSCTL_OFF))[u] = 0u;
    __syncthreads();
    const int lo = args.ph_lo, hi = args.ph_hi;
    XcdBarrier bar; bar.bar = (unsigned*)(F.ctl + CW_BAR); bar.x = 0; bar.st = nullptr;
    if (hi - lo > 1) {
        bar.x = xb_xcc_id(); bar.st = F.MISC + 8;
        if (F.tid == 0) F.MISC[10] = xb_add(&bar.bar[XB_XCNT(bar.x)], 1u);
    }
    int vcu = (int)blockIdx.x;
#define IN(k) (lo <= (k) && (k) < hi)
#define SEAM(k) do { if (IN(k) && IN((k) + 1)) xcd_barrier(bar); } while (0)
    bf16* const XN = (bf16*)(ws + WS_XN); bf16* const PROJ = (bf16*)(ws + WS_PROJ); bf16* const OB = (bf16*)(ws + WS_O); bf16* const YB = (bf16*)(ws + WS_Y);
    bf16* const UL = (bf16*)(ws + WS_SIDE); bf16* const UF = (bf16*)(ws + WS_SIDE + SIDE_STRIDE); bf16* const VF = (bf16*)(ws + WS_SIDE + 2 * SIDE_STRIDE);
    float* const SCB = (float*)(ws + WS_SC); const float* const tab = (const float*)(ws + WS_TAB); const float* const lbv = (const float*)(ws + WS_LB);

    if (IN(0)) { p_prologue(F); } SEAM(0);
    if (hi - lo > 1 && lo == 0) {
        if (F.tid == 0) { unsigned dense = 0u, nx = 0u; bool ok = (F.G % 8) == 0;
            for (unsigned j = 0; j < 16; ++j) { const unsigned cnt = xb_ld(&bar.bar[XB_XCNT(j)]); if (cnt) { ++nx; if (cnt != (unsigned)F.G / 8u) ok = false; } if (j < bar.x && cnt) ++dense; }
            const unsigned rank = F.MISC[10];
            F.MISC[11] = (ok && nx == 8u && rank < (unsigned)F.G / 8u) ? (8u * rank + dense) : 0xffffffffu; }
        __syncthreads();
        const unsigned v = F.MISC[11]; if (v != 0xffffffffu) vcu = (int)v;
    }

    if (IN(1)) { pg8::Gemm g{XN, (const bf16*)(ws + WS_WIN0), M, EVEN_IN, D}; pg8::StaticOrder S; S.init(M, EVEN_IN, F.G, vcu);
        typedef pg8::EpiIn<EVEN_IN, 640, 512, FB_OFF, FB_OFF + 512, GB_OFF, GB_OFF + 512> EpiIn0; EpiIn0 E{PROJ, C2, tab, lbv};
        pg8::gemm_phase<EpiIn0, pg8::StaticOrder, true, true>(F.lds + RING_OFF, g, S, E); } SEAM(1);
    if (IN(2)) { const int nhw = F.G >= 192 ? 128 : 0;
        if (nhw == 0) { p_attn0(F, PROJ, OB, (int)blockIdx.x, F.G); __syncthreads(); p_hgrn(F, PROJ, OB, lbv, F.G); }
        else if ((int)blockIdx.x < nhw) p_hgrn(F, PROJ, OB, lbv, nhw);
        else p_attn0(F, PROJ, OB, (int)blockIdx.x - nhw, F.G - nhw); } SEAM(2);
    if (IN(3)) { pg8::Gemm g{OB, (const bf16*)(ws + WS_WOUT0), M, D, D}; pg8::StaticOrder S; S.init(M, D, F.G, vcu);
        pg8::EpiBf16<0> E{YB, D, nullptr, 0, 0, 1.f};
        pg8::gemm_phase<pg8::EpiBf16<0>, pg8::StaticOrder, true, true>(F.lds + RING_OFF, g, S, E); } SEAM(3);
    if (IN(4)) { p_norm(F, XN, SCB, YB, F.norm_w + 1 * D, nullptr); } SEAM(4);
    if (IN(5)) { pg8::Gemm g{XN, (const bf16*)(ws + WS_WUP), M, UPN, D}; pg8::StaticOrder S; S.init(M, UPN, F.G, vcu);
        pg8::EpiConvGate E{PROJ, UL, UF, VF, F.conv_w, F.conv_b, DFF};
        pg8::gemm_phase<pg8::EpiConvGate, pg8::StaticOrder, true, true>(F.lds + RING_OFF, g, S, E); } SEAM(5);
    if (IN(6)) { p_fixup(F, PROJ, UL, UF, VF, F.conv_w, F.conv_b); } SEAM(6);
    if (IN(7)) { pg8::Gemm g{PROJ, (const bf16*)(ws + WS_WDN), M, D, DFF}; pg8::StaticOrder S; S.init(M, D, F.G, vcu);
        pg8::EpiBf16<0> E{YB, D, nullptr, 0, 0, 1.f};
        pg8::gemm_phase<pg8::EpiBf16<0>, pg8::StaticOrder, true, true>(F.lds + RING_OFF, g, S, E); } SEAM(7);
    if (IN(8)) { p_norm(F, XN, SCB, YB, F.norm_w + 3 * D, nullptr); } SEAM(8);
    if (IN(9)) { pg8::Gemm g{XN, (const bf16*)(ws + WS_WIN1), M, ODD_IN, D}; pg8::StaticOrder S; S.init(M, ODD_IN, F.G, vcu);
        typedef pg8::EpiIn<ODD_IN, 0, 1024, 0, 0, 0, 0> EpiIn1; EpiIn1 E{PROJ, C2, tab, lbv};
        pg8::gemm_phase<EpiIn1, pg8::StaticOrder, true, true>(F.lds + RING_OFF, g, S, E); } SEAM(9);
    if (IN(10)) { p_attn1(F, PROJ, OB); } SEAM(10);
    if (IN(11)) { pg8::Gemm g{OB, (const bf16*)(ws + WS_WOUT1), M, D, D}; pg8::StaticOrder S; S.init(M, D, F.G, vcu);
        pg8::EpiBf16<0> E{YB, D, nullptr, 0, 0, 1.f};
        pg8::gemm_phase<pg8::EpiBf16<0>, pg8::StaticOrder, true, true>(F.lds + RING_OFF, g, S, E); } SEAM(11);
    if (IN(12)) { p_norm(F, XN, SCB, YB, F.norm_w + 5 * D, nullptr); } SEAM(12);
    if (IN(13)) { pg8::Gemm g{XN, (const bf16*)(ws + WS_WUP + 11 * MiB), M, UPN, D}; pg8::StaticOrder S; S.init(M, UPN, F.G, vcu);
        pg8::EpiConvGate E{PROJ, UL, UF, VF, F.conv_w + 3 * DFF, F.conv_b + DFF, DFF};
        pg8::gemm_phase<pg8::EpiConvGate, pg8::StaticOrder, true, true>(F.lds + RING_OFF, g, S, E); } SEAM(13);
    if (IN(14)) { p_fixup(F, PROJ, UL, UF, VF, F.conv_w + 3 * DFF, F.conv_b + DFF); } SEAM(14);
    if (IN(15)) { pg8::Gemm g{PROJ, (const bf16*)(ws + WS_WDN + (size_t)5632 * 1024), M, D, DFF}; pg8::StaticOrder S; S.init(M, D, F.G, vcu);
        pg8::EpiBf16<0> E{YB, D, nullptr, 0, 0, 1.f};
        pg8::gemm_phase<pg8::EpiBf16<0>, pg8::StaticOrder, true, true>(F.lds + RING_OFF, g, S, E); } SEAM(15);
    if (IN(16)) { p_norm(F, XN, SCB, YB, F.norm_w + 7 * D, F.out); }
#undef IN
#undef SEAM
}

#ifndef MK_ONE_LAUNCH
#define MK_ONE_LAUNCH 1
#endif
extern "C" void kernel_launch(void* const* d_in, const int* in_sizes, int n_in, void* d_out, int out_size, void* d_ws, size_t ws_size, hipStream_t stream) {
    static int grid = 0;
    if (grid == 0) {
        if (n_in != 14 || in_sizes[0] != M * D || out_size != M * D || ws_size < WS_END) { fprintf(stderr, "kernel_launch: unexpected shapes (n_in %d, in0 %d, out %d, ws %zu); nothing launched\n", n_in, n_in > 0 ? in_sizes[0] : -1, out_size, ws_size); grid = -1; return; }
        int dev = 0, cus = 0, per_cu = 0;
        if (hipGetDevice(&dev) != hipSuccess || hipDeviceGetAttribute(&cus, hipDeviceAttributeMultiprocessorCount, dev) != hipSuccess) { grid = -1; return; }
        if (hipFuncSetAttribute((const void*)mk_fwd, hipFuncAttributeMaxDynamicSharedMemorySize, LDS_BYTES) != hipSuccess) { fprintf(stderr, "kernel_launch: hipFuncSetAttribute failed\n"); grid = -1; return; }
        if (hipOccupancyMaxActiveBlocksPerMultiprocessor(&per_cu, (const void*)mk_fwd, NWAVES * 64, LDS_BYTES) != hipSuccess || per_cu < 1) { fprintf(stderr, "kernel_launch: occupancy query says %d\n", per_cu); }
        (void)hipGetLastError();
        grid = cus;
    }
    if (grid < 0) return;
    if (hipMemsetAsync((char*)d_ws + WS_CTL, 0, CTL_ZERO_BYTES, stream) != hipSuccess) return;
    Args a{};
    for (int i = 0; i < 14; ++i) a.in[i] = (const float*)d_in[i];
    a.out = (float*)d_out; a.ws = (unsigned char*)d_ws;
#if MK_ONE_LAUNCH
    a.ph_lo = 0; a.ph_hi = NPH;
    hipLaunchKernelGGL(mk_fwd, dim3(grid), dim3(NWAVES * 64), LDS_BYTES, stream, a);
#else
    for (int k = 0; k < NPH; ++k) { a.ph_lo = k; a.ph_hi = k + 1; hipLaunchKernelGGL(mk_fwd, dim3(grid), dim3(NWAVES * 64), LDS_BYTES, stream, a); }
#endif
}
```

```cpp
#include <hip/hip_runtime.h>
#include <cstdio>
#include <cstdint>
#include <cmath>
namespace pg8 {
#define PG8_LAS __attribute__((address_space(3)))
typedef unsigned short bf16_t;
typedef short bf16x8 __attribute__((ext_vector_type(8)));
typedef float f32x4 __attribute__((ext_vector_type(4)));
typedef unsigned u32x4 __attribute__((ext_vector_type(4)));
constexpr int BM = 256, BK = 64, HALF = 128, HTB = HALF * BK * 2  , STAGE_BYTES = 8 * HTB, NXCD = 8, WGM = 8;

__host__ __device__ __forceinline__ int lds_byte(int r, int c) { const int st = (r >> 4) * 2 + (c >> 5), rr = r & 15, cc = c & 31, ob = rr * 64 + cc * 2; return st * 1024 + (ob ^ (((ob >> 9) & 1) << 5)); }
__host__ __device__ __forceinline__ void stage_rc(int b, int& R, int& C) { const int st = b / 1024, sb = b % 1024, swz = sb ^ (((sb >> 9) & 1) << 5); R = (st >> 1) * 16 + swz / 64; C = (st & 1) * 32 + (swz % 64) / 2; }
__host__ __device__ __forceinline__ int perm32(int rho) { const int n = rho >> 4, i = rho & 15; return 8 * (i >> 2) + 4 * n + (i & 3); }

struct Unit { int pm, pn; };
struct Gemm { const bf16_t* A; const bf16_t* Bt; int M, N, K; };

struct StaticOrder {
    int nM, nN, nwg, G, c;
    __host__ __device__ void init(int M, int N, int G_, int c_) { nM = M / BM; nN = N / BM; nwg = nM * nN; G = G_; c = c_; }
    __host__ __device__ bool next(int i, Unit& u) const {
        const long L = (long)i * G + c; if (L >= nwg) return false;
        int wgid = (int)L; { const int q = nwg / NXCD, r = nwg % NXCD, xcd = wgid % NXCD, off = wgid / NXCD; wgid = (xcd < r ? xcd * (q + 1) : r * (q + 1) + (xcd - r) * q) + off; }
        const int nig = WGM * nN, gid = wgid / nig, fm = gid * WGM, gsz = (nM - fm) < WGM ? (nM - fm) : WGM;
        u.pm = fm + ((wgid % nig) % gsz); u.pn = (wgid % nig) / gsz; return true;
    }
    __device__ __forceinline__ void a_ready(const Unit&) const {}
    __device__ __forceinline__ void done(const Unit&) const {}
};

__device__ __forceinline__ unsigned cvt_pk_bf16(float lo, float hi) { unsigned r; asm volatile("v_cvt_pk_bf16_f32 %0, %1, %2" : "=v"(r) : "v"(lo), "v"(hi)); return r; }
typedef float f32x2 __attribute__((ext_vector_type(2)));
__device__ __forceinline__ f32x2 gelu_pk(f32x2 v) {
    const f32x2 av = __builtin_elementwise_abs(v), d = av * 0.2316418882f + 1.0f;
    f32x2 t; t.x = __builtin_amdgcn_rcpf(d.x); t.y = __builtin_amdgcn_rcpf(d.y);
    f32x2 q = t * 0.5307027145f + (-0.7265760135f); q = q * t + 0.7107068705f; q = q * t + (-0.142248368f); q = q * t + 0.127414796f; q = q * t;
    const f32x2 s = (v * v) * (-0.72134752044f);
    f32x2 e; e.x = __builtin_amdgcn_exp2f(s.x); e.y = __builtin_amdgcn_exp2f(s.y);
    const f32x2 m = v * (q * e), r = v - m;
    f32x2 o; o.x = v.x < 0.f ? m.x : r.x; o.y = v.y < 0.f ? m.y : r.y; return o;
}

template <int ACT  > struct EpiBf16 {
    static constexpr bool PERM = true, AFTER_DRAIN = false; static_assert(ACT == 0 || ACT == 1, "EpiBf16: ACT is 0 (none) or 1 (gelu_pk)");
    bf16_t* O; int ldc; const float* bias; int split_cols; size_t split_stride; float scale0;
    __device__ __forceinline__ void operator()(const f32x4 (&acc)[2][2][4][2], const Unit& u, int wr, int wc, int fr, int fq) const {
        const int row0 = u.pm * BM + wr * 64 + fr; int colt = u.pn * BM; bf16_t* base = O;
        float sc = 1.f; if (split_cols) { const int t = colt / split_cols; base += (size_t)t * split_stride; colt -= t * split_cols; if (t == 0) sc = scale0; }
        const int col0 = colt + wc * 32 + 8 * fq, bcol0 = u.pn * BM + wc * 32 + 8 * fq;
        f32x4 bv[2][2];
#pragma unroll
        for (int bj = 0; bj < 2; ++bj)
#pragma unroll
            for (int n = 0; n < 2; ++n) bv[bj][n] = bias ? *(const f32x4*)(bias + bcol0 + bj * HALF + 4 * n) : (f32x4){0.f, 0.f, 0.f, 0.f};
#pragma unroll
        for (int ai = 0; ai < 2; ++ai)
#pragma unroll
            for (int m = 0; m < 4; ++m) { bf16_t* rowp = base + (size_t)(row0 + ai * HALF + m * 16) * ldc + col0;
#pragma unroll
                for (int bj = 0; bj < 2; ++bj) { f32x4 v0 = acc[ai][bj][m][0] + bv[bj][0], v1 = acc[ai][bj][m][1] + bv[bj][1];
                    if (ACT == 1) { f32x2 a = gelu_pk((f32x2){v0[0], v0[1]}), b = gelu_pk((f32x2){v0[2], v0[3]}), c = gelu_pk((f32x2){v1[0], v1[1]}), d = gelu_pk((f32x2){v1[2], v1[3]});
                        v0 = (f32x4){a.x, a.y, b.x, b.y}; v1 = (f32x4){c.x, c.y, d.x, d.y}; }
                    v0 = v0 * sc; v1 = v1 * sc; u32x4 w; w.x = cvt_pk_bf16(v0[0], v0[1]); w.y = cvt_pk_bf16(v0[2], v0[3]); w.z = cvt_pk_bf16(v1[0], v1[1]); w.w = cvt_pk_bf16(v1[2], v1[3]);
                    *(u32x4*)(rowp + bj * HALF) = w; } }
    }
};
template <int LDC, int ROPE_COLS, int SCALE_COLS, int GATE_LO, int GATE_HI, int SILU_LO, int SILU_HI> struct EpiIn {
    static constexpr bool PERM = true, AFTER_DRAIN = false;
    static constexpr int ldc = LDC, rope_cols = ROPE_COLS, scale_cols = SCALE_COLS, gate_lo = GATE_LO, gate_hi = GATE_HI;
    bf16_t* O; float scale; const float* tab; const float* lb;
    __device__ __forceinline__ void operator()(const f32x4 (&acc)[2][2][4][2], const Unit& u, int wr, int wc, int fr, int fq) const {
        const int row0 = u.pm * BM + wr * 64 + fr; const int colt = u.pn * BM;
        const int col0 = colt + wc * 32 + 8 * fq; const int i0 = 16 * (wc & 1) + 4 * fq;
#pragma unroll
        for (int ai = 0; ai < 2; ++ai)
#pragma unroll
            for (int m = 0; m < 4; ++m) { const int row = row0 + ai * HALF + m * 16; const int t = row & 2047; bf16_t* rowp = O + (size_t)row * ldc + col0;
#pragma unroll
                for (int bj = 0; bj < 2; ++bj) { f32x4 v0 = acc[ai][bj][m][0], v1 = acc[ai][bj][m][1]; const int cb = colt + bj * HALF;
                    if (cb < rope_cols) { const f32x4 c0 = *(const f32x4*)(tab + (size_t)(t * 32 + i0) * 2), c1 = *(const f32x4*)(tab + (size_t)(t * 32 + i0) * 2 + 4);
                        f32x4 r0, r1;
                        r0[0] = v0[0] * c0[0] - v0[1] * c0[1]; r0[1] = v0[1] * c0[0] + v0[0] * c0[1]; r0[2] = v0[2] * c0[2] - v0[3] * c0[3]; r0[3] = v0[3] * c0[2] + v0[2] * c0[3];
                        r1[0] = v1[0] * c1[0] - v1[1] * c1[1]; r1[1] = v1[1] * c1[0] + v1[0] * c1[1]; r1[2] = v1[2] * c1[2] - v1[3] * c1[3]; r1[3] = v1[3] * c1[2] + v1[2] * c1[3];
                        v0 = r0; v1 = r1; }
                    if (cb < scale_cols) { v0 = v0 * scale; v1 = v1 * scale; }
                    if (cb >= SILU_LO && cb < SILU_HI) {
#pragma unroll
                        for (int e_ = 0; e_ < 4; ++e_) { v0[e_] = v0[e_] * __builtin_amdgcn_rcpf(1.f + __expf(-v0[e_])); v1[e_] = v1[e_] * __builtin_amdgcn_rcpf(1.f + __expf(-v1[e_])); } }
                    if (cb >= gate_lo && cb < gate_hi) { const f32x4 l0 = *(const f32x4*)(lb + (col0 + bj * HALF - gate_lo)), l1 = *(const f32x4*)(lb + (col0 + bj * HALF - gate_lo) + 4);
                        f32x4 fa, fb;
#pragma unroll
                        for (int e_ = 0; e_ < 4; ++e_) { fa[e_] = __builtin_fminf((l0[e_] + (1.f - l0[e_]) * __builtin_amdgcn_rcpf(1.f + __expf(-v0[e_]))) * 65536.f + 0.5f, 65535.f);
                            fb[e_] = __builtin_fminf((l1[e_] + (1.f - l1[e_]) * __builtin_amdgcn_rcpf(1.f + __expf(-v1[e_]))) * 65536.f + 0.5f, 65535.f); }
                        u32x4 wq; wq.x = (unsigned)fa[0] | ((unsigned)fa[1] << 16); wq.y = (unsigned)fa[2] | ((unsigned)fa[3] << 16); wq.z = (unsigned)fb[0] | ((unsigned)fb[1] << 16); wq.w = (unsigned)fb[2] | ((unsigned)fb[3] << 16);
                        *(u32x4*)(rowp + bj * HALF) = wq; }
                    else {
                    u32x4 w; w.x = cvt_pk_bf16(v0[0], v0[1]); w.y = cvt_pk_bf16(v0[2], v0[3]); w.z = cvt_pk_bf16(v1[0], v1[1]); w.w = cvt_pk_bf16(v1[2], v1[3]);
                    *(u32x4*)(rowp + bj * HALF) = w; } } }
    }
};
struct EpiConvGate {
    static constexpr bool PERM = true, AFTER_DRAIN = false;
    bf16_t* H; bf16_t* UL; bf16_t* UF; bf16_t* VF; const float* cw; const float* cb; int ff; PG8_LAS float* xch;
    __device__ __forceinline__ void operator()(const f32x4 (&acc)[2][2][4][2], const Unit& u, int wr, int wc, int fr, int fq) const {
        const int j0 = u.pn * HALF + wc * 32 + 8 * fq;
        float k0[8], k1[8], k2[8], kb[8];
#pragma unroll
        for (int q = 0; q < 2; ++q) { const f32x4 a = *(const f32x4*)(cw + j0 + 4 * q), b = *(const f32x4*)(cw + ff + j0 + 4 * q), c = *(const f32x4*)(cw + 2 * ff + j0 + 4 * q), d = *(const f32x4*)(cb + j0 + 4 * q);
#pragma unroll
            for (int e = 0; e < 4; ++e) { k0[4 * q + e] = a[e]; k1[4 * q + e] = b[e]; k2[4 * q + e] = c[e]; kb[4 * q + e] = d[e]; } }
        if (fr >= 14) {
#pragma unroll
            for (int ai = 0; ai < 2; ++ai) { PG8_LAS float* xp = xch + ((2 * ai + wr) * 2 + (fr - 14)) * 128 + wc * 32 + 8 * fq;
                *(PG8_LAS f32x4*)xp = acc[ai][0][3][0]; *(PG8_LAS f32x4*)(xp + 4) = acc[ai][0][3][1]; } }
        asm volatile("s_waitcnt lgkmcnt(0)" ::: "memory"); __builtin_amdgcn_s_barrier(); asm volatile("" ::: "memory");
#pragma unroll
        for (int ai = 0; ai < 2; ++ai) {
            float pr1[8], pr2[8];
            const int sprev = 2 * ai + wr - 1;
            if (sprev >= 0) { const PG8_LAS float* x14 = xch + (sprev * 2 + 0) * 128 + wc * 32 + 8 * fq; const PG8_LAS float* x15 = x14 + 128;
                const f32x4 a0 = *(const PG8_LAS f32x4*)x14, a1 = *(const PG8_LAS f32x4*)(x14 + 4), b0 = *(const PG8_LAS f32x4*)x15, b1 = *(const PG8_LAS f32x4*)(x15 + 4);
#pragma unroll
                for (int e = 0; e < 4; ++e) { pr1[e] = b0[e]; pr1[4 + e] = b1[e]; pr2[e] = fr == 0 ? a0[e] : b0[e]; pr2[4 + e] = fr == 0 ? a1[e] : b1[e]; } }
            else {
#pragma unroll
                for (int e = 0; e < 8; ++e) { pr1[e] = 0.f; pr2[e] = 0.f; } }
#pragma unroll
            for (int m = 0; m < 4; ++m) { const int row = u.pm * BM + ai * HALF + wr * 64 + m * 16 + fr;
                float uu[8], vv[8], hh[8];
#pragma unroll
                for (int e = 0; e < 4; ++e) { uu[e] = acc[ai][0][m][0][e]; uu[4 + e] = acc[ai][0][m][1][e]; vv[e] = acc[ai][1][m][0][e]; vv[4 + e] = acc[ai][1][m][1][e]; }
#pragma unroll
                for (int e = 0; e < 8; ++e) { const float r1 = __builtin_bit_cast(float, __builtin_amdgcn_update_dpp(0, __builtin_bit_cast(int, uu[e]), 0x121  , 0xF, 0xF, false)),
                                                          r2 = __builtin_bit_cast(float, __builtin_amdgcn_update_dpp(0, __builtin_bit_cast(int, uu[e]), 0x122  , 0xF, 0xF, false));
                    const float p1 = fr >= 1 ? r1 : pr1[e], p2 = fr >= 2 ? r2 : pr2[e]; pr1[e] = r1; pr2[e] = r2;
                    hh[e] = kb[e] + k0[e] * p2 + k1[e] * p1 + k2[e] * uu[e]; }
#pragma unroll
                for (int e = 0; e < 8; e += 2) { const f32x2 g = gelu_pk((f32x2){hh[e], hh[e + 1]}); hh[e] = g.x * vv[e]; hh[e + 1] = g.y * vv[e + 1]; }
                u32x4 w; w.x = cvt_pk_bf16(hh[0], hh[1]); w.y = cvt_pk_bf16(hh[2], hh[3]); w.z = cvt_pk_bf16(hh[4], hh[5]); w.w = cvt_pk_bf16(hh[6], hh[7]);
                *(u32x4*)(H + (size_t)row * ff + j0) = w;
                if (ai == 1 && wr == 1 && m == 3 && fr >= 14) { u32x4 s; s.x = cvt_pk_bf16(uu[0], uu[1]); s.y = cvt_pk_bf16(uu[2], uu[3]); s.z = cvt_pk_bf16(uu[4], uu[5]); s.w = cvt_pk_bf16(uu[6], uu[7]);
                    *(u32x4*)(UL + ((size_t)u.pm * 2 + (fr - 14)) * ff + j0) = s; }
                if (ai == 0 && wr == 0 && m == 0 && fr < 2) { u32x4 s; s.x = cvt_pk_bf16(uu[0], uu[1]); s.y = cvt_pk_bf16(uu[2], uu[3]); s.z = cvt_pk_bf16(uu[4], uu[5]); s.w = cvt_pk_bf16(uu[6], uu[7]);
                    *(u32x4*)(UF + ((size_t)u.pm * 2 + fr) * ff + j0) = s;
                    u32x4 z; z.x = cvt_pk_bf16(vv[0], vv[1]); z.y = cvt_pk_bf16(vv[2], vv[3]); z.z = cvt_pk_bf16(vv[4], vv[5]); z.w = cvt_pk_bf16(vv[6], vv[7]);
                    *(u32x4*)(VF + ((size_t)u.pm * 2 + fr) * ff + j0) = z; }
            }
        }
    }
};
template <class Epi, class Sched, bool ALIGN_EPI = false, bool SP2 = false>
__device__ __forceinline__ void gemm_phase(PG8_LAS unsigned char* lds, const Gemm g, const Sched& S, const Epi& E) {
    const int tid = threadIdx.x, wid = __builtin_amdgcn_readfirstlane(tid >> 6), lane = tid & 63, wr = wid >> 2, wc = wid & 3, fr = lane & 15, fq = lane >> 4;
    const int K = g.K, nt = K / BK;
    unsigned voffA[2], voffB[2];
#pragma unroll
    for (int i = 0; i < 2; ++i) { int R, C; stage_rc(tid * 16 + i * 8192, R, C); const int Rb = Epi::PERM ? ((R & ~31) + perm32(R & 31)) : R;
        voffA[i] = (unsigned)(R * K + C) * 2u; voffB[i] = (unsigned)(Rb * K + C) * 2u; }
    const size_t kstep = (size_t)(BK * 2);
    const size_t hstep = (size_t)HALF * K * 2;
    const size_t tstep = 2 * hstep;
    const unsigned ldsw = (unsigned)wid * 1024u;
    const int aoff = lds_byte(wr * 64 + fr, fq * 8), boff = lds_byte(wc * 32 + fr, fq * 8);
#define PG8_SA(b, h) (((b) * 2 + (h)) * HTB)
#define PG8_SB(b, h) ((4 + (b) * 2 + (h)) * HTB)
#define PG8_STAGE(bufoff, gbase, voff) do { _Pragma("unroll") for (int _i = 0; _i < 2; ++_i) \
        __builtin_amdgcn_global_load_lds((const unsigned*)((const char*)(gbase) + (voff)[_i]), (PG8_LAS unsigned*)(lds + (bufoff) + ldsw + _i * 8192), 16, 0, 0); } while (0)
#define PG8_LDA(dst, b, h) do { __builtin_amdgcn_s_setprio(2); _Pragma("unroll") for (int m = 0; m < 4; ++m) _Pragma("unroll") for (int k = 0; k < 2; ++k) dst[m][k] = *(const PG8_LAS bf16x8*)(lds + PG8_SA(b, h) + aoff + m * 2048 + k * 1024); } while (0)
#define PG8_LDB(dst, b, h) do { __builtin_amdgcn_s_setprio(2); _Pragma("unroll") for (int n = 0; n < 2; ++n) _Pragma("unroll") for (int k = 0; k < 2; ++k) dst[n][k] = *(const PG8_LAS bf16x8*)(lds + PG8_SB(b, h) + boff + n * 2048 + k * 1024); } while (0)
#define PG8_MMA(ai, bj, At, Bt) do { __builtin_amdgcn_s_setprio(1); _Pragma("unroll") for (int m = 0; m < 4; ++m) _Pragma("unroll") for (int n = 0; n < 2; ++n) _Pragma("unroll") for (int k = 0; k < 2; ++k) \
        acc[ai][bj][m][n] = __builtin_amdgcn_mfma_f32_16x16x32_bf16(Bt[n][k], At[m][k], acc[ai][bj][m][n], 0, 0, 0); __builtin_amdgcn_s_setprio(0); } while (0)
#define PG8_WAIT_V(n) asm volatile("s_setprio 0\n\ts_waitcnt vmcnt(" #n ")" ::: "memory")
#define PG8_WAIT_L(n) asm volatile("s_waitcnt lgkmcnt(" #n ")" ::: "memory")
#define PG8_BAR __builtin_amdgcn_s_barrier()
#define PG8_SCHED __builtin_amdgcn_sched_barrier(0)
    Unit cur, nxt; int ui = 0;
    if (!S.next(0, cur)) return;
    f32x4 acc[2][2][4][2];
#pragma unroll
    for (int a = 0; a < 2; ++a)
#pragma unroll
        for (int b = 0; b < 2; ++b)
#pragma unroll
            for (int m = 0; m < 4; ++m)
#pragma unroll
                for (int n = 0; n < 2; ++n) acc[a][b][m][n] = (f32x4){0.f, 0.f, 0.f, 0.f};
    bf16x8 At[4][2], B0[2][2], B1[2][2];
    const char* cA = (const char*)g.A + (size_t)cur.pm * tstep; const char* cB = (const char*)g.Bt + (size_t)cur.pn * tstep;
    S.a_ready(cur);
    if constexpr (SP2) {
        PG8_STAGE(PG8_SB(0, 0), cB, voffB); PG8_STAGE(PG8_SB(0, 1), cB + hstep, voffB); PG8_STAGE(PG8_SA(0, 0), cA, voffA); PG8_STAGE(PG8_SA(0, 1), cA + hstep, voffA);
        if (wr == 1) PG8_BAR;
        PG8_WAIT_V(2); PG8_BAR;
        PG8_STAGE(PG8_SB(1, 0), cB + kstep, voffB); PG8_STAGE(PG8_SA(1, 0), cA + kstep, voffA); PG8_STAGE(PG8_SB(1, 1), cB + hstep + kstep, voffB);
        PG8_WAIT_V(6); PG8_BAR;
    } else {
        PG8_STAGE(PG8_SB(0, 0), cB, voffB); PG8_STAGE(PG8_SA(0, 0), cA, voffA); PG8_STAGE(PG8_SB(0, 1), cB + hstep, voffB); PG8_STAGE(PG8_SA(0, 1), cA + hstep, voffA);
        if (wr == 1) PG8_BAR;
        PG8_WAIT_V(4); PG8_BAR;
        PG8_STAGE(PG8_SB(1, 0), cB + kstep, voffB); PG8_STAGE(PG8_SA(1, 0), cA + kstep, voffA); PG8_STAGE(PG8_SB(1, 1), cB + hstep + kstep, voffB);
        PG8_WAIT_V(6); PG8_BAR;
    }
    for (;;) {
        const bool has_next = S.next(ui + 1, nxt);
        const char* nA = has_next ? (const char*)g.A + (size_t)nxt.pm * tstep : cA; const char* nB = has_next ? (const char*)g.Bt + (size_t)nxt.pn * tstep : cB;
        for (int t = 0; t < nt; t += 2) {
            const bool last = (t == nt - 2);
            const char* a1 = cA + (size_t)(t + 1) * kstep;
            const char* a2 = last ? nA : cA + (size_t)(t + 2) * kstep; const char* b2 = last ? nB : cB + (size_t)(t + 2) * kstep;
            const char* a3 = a2 + kstep; const char* b3 = b2 + kstep;
            if (last && has_next) S.a_ready(nxt);
            if constexpr (SP2) {
            PG8_LDB(B0, 0, 0); PG8_LDB(B1, 0, 1); PG8_SCHED; PG8_LDA(At, 0, 0); PG8_STAGE(PG8_SA(1, 1), a1 + hstep, voffA);
            PG8_WAIT_V(8); PG8_WAIT_L(0); PG8_BAR; PG8_MMA(0, 0, At, B0); PG8_MMA(0, 1, At, B1); PG8_BAR; PG8_SCHED;
            PG8_LDA(At, 0, 1); PG8_STAGE(PG8_SB(0, 0), b2, voffB); PG8_STAGE(PG8_SB(0, 1), b2 + hstep, voffB); PG8_STAGE(PG8_SA(0, 0), a2, voffA);
            PG8_WAIT_V(8); PG8_WAIT_L(0); PG8_BAR; PG8_MMA(1, 0, At, B0); PG8_MMA(1, 1, At, B1); PG8_BAR; PG8_SCHED;
            PG8_LDB(B0, 1, 0); PG8_LDB(B1, 1, 1); PG8_SCHED; PG8_LDA(At, 1, 0); PG8_STAGE(PG8_SA(0, 1), a2 + hstep, voffA);
            PG8_WAIT_V(8); PG8_WAIT_L(0); PG8_BAR; PG8_MMA(0, 0, At, B0); PG8_MMA(0, 1, At, B1); PG8_BAR; PG8_SCHED;
            PG8_LDA(At, 1, 1); PG8_STAGE(PG8_SB(1, 0), b3, voffB); PG8_STAGE(PG8_SB(1, 1), b3 + hstep, voffB); PG8_STAGE(PG8_SA(1, 0), a3, voffA);
            PG8_WAIT_V(8); PG8_WAIT_L(0); PG8_BAR; PG8_MMA(1, 0, At, B0); PG8_MMA(1, 1, At, B1); PG8_BAR; PG8_SCHED;
            } else {
            PG8_LDB(B0, 0, 0); PG8_SCHED; PG8_LDA(At, 0, 0); PG8_STAGE(PG8_SA(1, 1), a1 + hstep, voffA);
            PG8_WAIT_L(8); PG8_BAR; PG8_WAIT_L(0); PG8_MMA(0, 0, At, B0); PG8_BAR; PG8_SCHED;
            PG8_LDB(B1, 0, 1); PG8_STAGE(PG8_SB(0, 0), b2, voffB);
            PG8_BAR; PG8_WAIT_L(0); PG8_MMA(0, 1, At, B1); PG8_BAR;
            PG8_LDA(At, 0, 1); PG8_STAGE(PG8_SA(0, 0), a2, voffA);
            PG8_BAR; PG8_WAIT_L(0); PG8_MMA(1, 0, At, B0); PG8_BAR; PG8_SCHED;
            PG8_STAGE(PG8_SB(0, 1), b2 + hstep, voffB);
            PG8_WAIT_V(6); PG8_BAR; PG8_MMA(1, 1, At, B1); PG8_BAR;
            PG8_LDB(B0, 1, 0); PG8_SCHED; PG8_LDA(At, 1, 0); PG8_STAGE(PG8_SA(0, 1), a2 + hstep, voffA);
            PG8_WAIT_L(8); PG8_BAR; PG8_WAIT_L(0); PG8_MMA(0, 0, At, B0); PG8_BAR; PG8_SCHED;
            PG8_LDB(B1, 1, 1); PG8_STAGE(PG8_SB(1, 0), b3, voffB);
            PG8_BAR; PG8_WAIT_L(0); PG8_MMA(0, 1, At, B1); PG8_BAR;
            PG8_LDA(At, 1, 1); PG8_STAGE(PG8_SA(1, 0), a3, voffA);
            PG8_BAR; PG8_WAIT_L(0); PG8_MMA(1, 0, At, B0); PG8_BAR; PG8_SCHED;
            PG8_STAGE(PG8_SB(1, 1), b3 + hstep, voffB);
            PG8_WAIT_V(6); PG8_BAR; PG8_MMA(1, 1, At, B1); PG8_BAR;
            }
        }
        if constexpr (ALIGN_EPI) { if (wr == 0) PG8_BAR; }
        if constexpr (!Epi::AFTER_DRAIN) { E(acc, cur, wr, wc, fr, fq); S.done(cur); }
        if (!has_next) break;
#pragma unroll
        for (int a = 0; a < 2; ++a)
#pragma unroll
            for (int b = 0; b < 2; ++b)
#pragma unroll
                for (int m = 0; m < 4; ++m)
#pragma unroll
                    for (int n = 0; n < 2; ++n) acc[a][b][m][n] = (f32x4){0.f, 0.f, 0.f, 0.f};
        cur = nxt; cA = nA; cB = nB; ++ui;
        if constexpr (ALIGN_EPI) { if (wr == 1) PG8_BAR; }
    }
    PG8_WAIT_V(0);
    if constexpr (!ALIGN_EPI) { if (wr == 0) PG8_BAR; }
    PG8_BAR;
    if constexpr (Epi::AFTER_DRAIN) { E.fused(acc, cur, wr, wc, fr, fq, lds, wid, lane); S.done(cur); }
#undef PG8_SA
#undef PG8_SB
#undef PG8_STAGE
#undef PG8_LDA
#undef PG8_LDB
#undef PG8_MMA
#undef PG8_WAIT_V
#undef PG8_WAIT_L
#undef PG8_BAR
#undef PG8_SCHED
}
}
constexpr int NWAVES = 8;
constexpr int BATCH = 32, SEQ = 2048, D = 1024, M = BATCH * SEQ;
constexpr int EVEN_IN = 2816, ODD_IN = 3072, DFF = 2816, UPN = 2 * DFF;
constexpr int QB_OFF = 768, FB_OFF = 1280, IB_OFF = 1792, GB_OFF = 2304;
constexpr float EPS = 1e-6f;
constexpr float LOG2E = 1.4426950408889634f;
constexpr float C2 = 0.125f * LOG2E;

constexpr size_t MiB = 1u << 20;
constexpr size_t WS_CTL = 0, CTL_ZERO_BYTES = 64 * 1024;
constexpr size_t WS_TAB = 1 * MiB;
constexpr size_t WS_LB = WS_TAB + 768 * 1024;
constexpr size_t WS_WIN0 = 2 * MiB, WS_WOUT0 = 8 * MiB, WS_WIN1 = 10 * MiB, WS_WOUT1 = 16 * MiB, WS_WUP = 18 * MiB  , WS_WDN = 40 * MiB  ;
constexpr size_t WS_SIDE = 52 * MiB, SIDE_STRIDE = 12 * MiB;
constexpr size_t WS_SC = 90 * MiB;
constexpr size_t WS_XN = 96 * MiB;
constexpr size_t WS_PROJ = 224 * MiB;
constexpr size_t WS_O = 608 * MiB;
constexpr size_t WS_Y = 736 * MiB;
constexpr size_t WS_END = 864 * MiB;
constexpr int CW_BAR = 4096;

constexpr int RING_OFF = 0, RING_BYTES = 131072;
constexpr int LDSCTL_OFF = RING_BYTES, MISC_OFF = LDSCTL_OFF + 320, XCH_OFF = LDSCTL_OFF + 1024;
constexpr int LDS_BYTES = 147456;

namespace attn2 {
using bf16x8 = __attribute__((ext_vector_type(8))) short;
using s16x4 = __attribute__((ext_vector_type(4))) short;
using f32x16 = __attribute__((ext_vector_type(16))) float;
using u32x4 = __attribute__((ext_vector_type(4))) unsigned;
typedef unsigned short bf16;
constexpr int NSLOT = 3, SLOTB = 8192;
constexpr int LDS_K = 0, LDS_V = NSLOT * SLOTB, LDS_WS = 2 * NSLOT * SLOTB, LDS_OST = LDS_WS + 8 * 64 * 4, LDS_TB = LDS_OST + 8 * 4096, LDS_BYTES = LDS_TB + 1088;
constexpr float THR = 8.f;
__device__ __forceinline__ int crow(int r, int hi) { return (r & 3) + 8 * (r >> 2) + 4 * hi; }
__device__ __forceinline__ void glds16(const void* gsrc, unsigned lds_dst) { unsigned keep;
    asm volatile("s_mov_b32 %0, m0\n\ts_mov_b32 m0, %2\n\ts_nop 0\n\tglobal_load_lds_dwordx4 %1, off\n\ts_mov_b32 m0, %0" : "=&s"(keep) : "v"(gsrc), "s"(lds_dst) : "memory"); }
typedef float f32x2_t __attribute__((ext_vector_type(2))); typedef __bf16 bf16x2_t __attribute__((ext_vector_type(2)));
__device__ __forceinline__ unsigned cvtpk_s(float lo, float hi) { f32x2_t v = {lo, hi}; bf16x2_t b = __builtin_convertvector(v, bf16x2_t); return __builtin_bit_cast(unsigned, b); }
__device__ __forceinline__ void qkt(f32x16& p0, f32x16& p1, const char* Kslot, const bf16x8* qr, const f32x16& cin, int r32, int hi) {
    const char* kb = Kslot + hi * 1024 + r32 * 16;
#pragma unroll
    for (int d0 = 0; d0 < 4; ++d0) {
        const bf16x8 b0 = *reinterpret_cast<const bf16x8*>(kb + d0 * 2048);
        const bf16x8 b1 = *reinterpret_cast<const bf16x8*>(kb + d0 * 2048 + 512);
        if (d0 == 0) { p0 = __builtin_amdgcn_mfma_f32_32x32x16_bf16(b0, qr[0], cin, 0, 0, 0); p1 = __builtin_amdgcn_mfma_f32_32x32x16_bf16(b1, qr[0], cin, 0, 0, 0); }
        else { p0 = __builtin_amdgcn_mfma_f32_32x32x16_bf16(b0, qr[d0], p0, 0, 0, 0); p1 = __builtin_amdgcn_mfma_f32_32x32x16_bf16(b1, qr[d0], p1, 0, 0, 0); } }
}
__device__ __forceinline__ void pv(f32x16* o, int vb, bf16x8 pa0, bf16x8 pa1, bf16x8 pa2, bf16x8 pa3) {
#pragma unroll
    for (int d0 = 0; d0 < 2; ++d0) { s16x4 lo[4], hi[4];
#pragma unroll
        for (int ks = 0; ks < 4; ++ks) {
            asm volatile("ds_read_b64_tr_b16 %0,%1 offset:%c2" : "=&v"(lo[ks]) : "v"(vb), "i"(d0 * 4096 + ks * 1024) : "memory");
            asm volatile("ds_read_b64_tr_b16 %0,%1 offset:%c2" : "=&v"(hi[ks]) : "v"(vb), "i"(d0 * 4096 + ks * 1024 + 512) : "memory"); }
        asm volatile("s_waitcnt lgkmcnt(0)" ::: "memory"); __builtin_amdgcn_sched_barrier(0);
#define ATT_PK(k) (bf16x8){lo[k][0], lo[k][1], lo[k][2], lo[k][3], hi[k][0], hi[k][1], hi[k][2], hi[k][3]}
        o[d0] = __builtin_amdgcn_mfma_f32_32x32x16_bf16(pa0, ATT_PK(0), o[d0], 0, 0, 0);
        o[d0] = __builtin_amdgcn_mfma_f32_32x32x16_bf16(pa1, ATT_PK(1), o[d0], 0, 0, 0);
        o[d0] = __builtin_amdgcn_mfma_f32_32x32x16_bf16(pa2, ATT_PK(2), o[d0], 0, 0, 0);
        o[d0] = __builtin_amdgcn_mfma_f32_32x32x16_bf16(pa3, ATT_PK(3), o[d0], 0, 0, 0);
#undef ATT_PK
    }
}
template <int LDQ, int LDKV, int LDO, bool BIAS, bool SINK>
__device__ __forceinline__ void band_unit(const bf16* Qw, const bf16* Kt, const bf16* Vt, bf16* Ow, int jlo, int jhi, int wlo, int whi, int qpos0, float sink2, char* shm) {
    const int tid = threadIdx.x, lane = tid & 63, r32 = lane & 31, hi = lane >> 5; const int wid = __builtin_amdgcn_readfirstlane(tid >> 6);
    const unsigned lds0 = (unsigned)(uintptr_t)shm;
    float* wsf = (float*)(shm + LDS_WS) + wid * 64;
    const float* tb = (const float*)(shm + LDS_TB);
    const bf16* ksrc = Kt + (long)lane * LDKV + wid * 8;
    const bf16* vsrc = Vt + (long)(16 * (wid & 3) + (lane >> 2)) * LDKV + (wid >> 2) * 32 + (lane & 3) * 8;
    const unsigned kdst = lds0 + LDS_K + wid * 1024, vdst = lds0 + LDS_V + wid * 1024;
#define ATT_DMAK(t, slot) glds16(ksrc + (long)(t) * 64 * LDKV, (unsigned)__builtin_amdgcn_readfirstlane(kdst + (slot)))
#define ATT_DMAV(t, slot) glds16(vsrc + (long)(t) * 64 * LDKV, (unsigned)__builtin_amdgcn_readfirstlane(vdst + (slot)))
#define ATT_SLOT(t) ((((t) - jlo) % 3) * SLOTB)
    const int vb0 = (int)(lds0 + LDS_V) + ((lane >> 4) & 1) * 32 + (lane & 3) * 8 + (4 * hi + ((lane & 15) >> 2)) * 64;
    bf16x8 qr[4];
#pragma unroll
    for (int d0 = 0; d0 < 4; ++d0) qr[d0] = *reinterpret_cast<const bf16x8*>(&Qw[(long)r32 * LDQ + d0 * 16 + hi * 8]);
    ATT_DMAK(jlo, 0);
    if (jlo + 1 <= jhi) ATT_DMAK(jlo + 1, SLOTB);
    ATT_DMAV(jlo, 0);
    if (jlo + 2 <= jhi) ATT_DMAK(jlo + 2, 2 * SLOTB);
    if (jlo + 1 <= jhi) ATT_DMAV(jlo + 1, SLOTB);
    float mhat = SINK ? sink2 : 0.f, l_reg = (SINK && hi == 0) ? 1.f : 0.f; bool first = !SINK;
    f32x16 o[2]; o[0] = f32x16{}; o[1] = f32x16{};
    f32x16 negm;
#pragma unroll
    for (int r = 0; r < 16; ++r) negm[r] = -mhat;
    asm volatile("s_waitcnt vmcnt(0) lgkmcnt(0)\n\ts_barrier" ::: "memory");
    asm volatile("" :: "v"(qr[0]), "v"(qr[1]), "v"(qr[2]), "v"(qr[3]));
    f32x16 pc0 = f32x16{}, pc1 = f32x16{}, pn0 = f32x16{}, pn1 = f32x16{};
    if (jlo >= wlo && jlo <= whi) qkt(pc0, pc1, shm + LDS_K, qr, negm, r32, hi);
    for (int j = jlo; j <= jhi; ++j) {
        if (j + 2 <= jhi) asm volatile("s_waitcnt vmcnt(2) lgkmcnt(0)\n\ts_barrier" ::: "memory");
        else if (j + 1 <= jhi) asm volatile("s_waitcnt vmcnt(1) lgkmcnt(0)\n\ts_barrier" ::: "memory");
        else asm volatile("s_waitcnt vmcnt(0) lgkmcnt(0)\n\ts_barrier" ::: "memory");
        if (j + 3 <= jhi) ATT_DMAK(j + 3, ATT_SLOT(j + 3));
        if (j + 2 <= jhi) ATT_DMAV(j + 2, ATT_SLOT(j + 2));
        const bool actn = (j + 1 <= jhi) && (j + 1 >= wlo) && (j + 1 <= whi);
        if (actn) qkt(pn0, pn1, shm + LDS_K + ATT_SLOT(j + 1), qr, negm, r32, hi);
        __builtin_amdgcn_sched_barrier(0);
        if (j >= wlo && j <= whi) {
            if (BIAS) {
                const int dq = qpos0 + r32 - 64 * j;
                if ((qpos0 & ~63) - 64 * j >= 192) { const float c = tb[256];
#pragma unroll
                    for (int r = 0; r < 16; ++r) { pc0[r] += c; pc1[r] += c; } }
                else {
#pragma unroll
                    for (int r = 0; r < 16; ++r) { const int a = dq - crow(r, hi) + 128; const int i0 = a > 256 ? 256 : a, i1 = a - 32 > 256 ? 256 : a - 32; pc0[r] += tb[i0]; pc1[r] += tb[i1]; } }
            }
            float ra = fmaxf(fmaxf(pc0[0], pc0[1]), pc1[0]), rb = fmaxf(fmaxf(pc0[2], pc0[3]), pc1[1]); ra = fmaxf(fmaxf(ra, pc1[2]), pc1[3]);
#pragma unroll
            for (int r = 4; r < 16; r += 4) { ra = fmaxf(fmaxf(ra, pc0[r]), pc0[r + 1]); rb = fmaxf(fmaxf(rb, pc0[r + 2]), pc0[r + 3]); ra = fmaxf(fmaxf(ra, pc1[r]), pc1[r + 1]); rb = fmaxf(fmaxf(rb, pc1[r + 2]), pc1[r + 3]); }
            float rm = fmaxf(ra, rb);
            { auto rr = __builtin_amdgcn_permlane32_swap(__float_as_uint(rm), __float_as_uint(rm), false, false); rm = fmaxf(__uint_as_float(rr[0]), __uint_as_float(rr[1])); }
            bool resc = false;
            if (first) { const float dl = rm; mhat = dl;
#pragma unroll
                for (int r = 0; r < 16; ++r) { pc0[r] -= dl; pc1[r] -= dl; pn0[r] -= dl; pn1[r] -= dl; negm[r] = -mhat; }
                first = false; }
            else if (__any(rm > THR)) { const float dl = fmaxf(rm, 0.f); mhat += dl;
#pragma unroll
                for (int r = 0; r < 16; ++r) { pc0[r] -= dl; pc1[r] -= dl; pn0[r] -= dl; pn1[r] -= dl; negm[r] = -mhat; }
                const float f = __builtin_amdgcn_exp2f(-dl); l_reg *= f; if (hi == 0) wsf[r32] = f; resc = true; }
            f32x2_t sacc = {0.f, 0.f};
#pragma unroll
            for (int r = 0; r < 16; ++r) { pc0[r] = __builtin_amdgcn_exp2f(pc0[r]); pc1[r] = __builtin_amdgcn_exp2f(pc1[r]); }
#pragma unroll
            for (int r = 0; r < 16; r += 2) { sacc += (f32x2_t){pc0[r], pc0[r + 1]}; sacc += (f32x2_t){pc1[r], pc1[r + 1]}; }
            l_reg += sacc[0] + sacc[1];
            u32x4 pw0, pw1, pw2, pw3;
            pw0 = (u32x4){cvtpk_s(pc0[0], pc0[1]), cvtpk_s(pc0[2], pc0[3]), cvtpk_s(pc0[4], pc0[5]), cvtpk_s(pc0[6], pc0[7])};
            pw1 = (u32x4){cvtpk_s(pc0[8], pc0[9]), cvtpk_s(pc0[10], pc0[11]), cvtpk_s(pc0[12], pc0[13]), cvtpk_s(pc0[14], pc0[15])};
            pw2 = (u32x4){cvtpk_s(pc1[0], pc1[1]), cvtpk_s(pc1[2], pc1[3]), cvtpk_s(pc1[4], pc1[5]), cvtpk_s(pc1[6], pc1[7])};
            pw3 = (u32x4){cvtpk_s(pc1[8], pc1[9]), cvtpk_s(pc1[10], pc1[11]), cvtpk_s(pc1[12], pc1[13]), cvtpk_s(pc1[14], pc1[15])};
            if (resc) { asm volatile("s_waitcnt lgkmcnt(0)" ::: "memory");
#pragma unroll
                for (int d_ = 0; d_ < 2; ++d_)
#pragma unroll
                    for (int r = 0; r < 16; ++r) o[d_][r] *= wsf[crow(r, hi)]; }
            pv(o, vb0 + ATT_SLOT(j), __builtin_bit_cast(bf16x8, pw0), __builtin_bit_cast(bf16x8, pw1), __builtin_bit_cast(bf16x8, pw2), __builtin_bit_cast(bf16x8, pw3));
        }
        pc0 = pn0; pc1 = pn1;
    }
    { auto rr = __builtin_amdgcn_permlane32_swap(__float_as_uint(l_reg), __float_as_uint(l_reg), false, false); l_reg = __uint_as_float(rr[0]) + __uint_as_float(rr[1]); }
    if (hi == 0) wsf[32 + r32] = l_reg; asm volatile("s_waitcnt lgkmcnt(0)" ::: "memory");
    float rli[16];
#pragma unroll
    for (int r = 0; r < 16; ++r) rli[r] = __builtin_amdgcn_rcpf(wsf[32 + crow(r, hi)]);
    { bf16* stg = (bf16*)(shm + LDS_OST) + wid * 2048;
#pragma unroll
      for (int r = 0; r < 16; ++r) { const int orow = crow(r, hi);
#pragma unroll
          for (int d0 = 0; d0 < 2; ++d0) { const float v = o[d0][r] * rli[r]; const unsigned u = __builtin_bit_cast(unsigned, v); stg[orow * 64 + d0 * 32 + r32] = (bf16)((u + 0x7fffu + ((u >> 16) & 1u)) >> 16); } }
      asm volatile("s_waitcnt lgkmcnt(0)" ::: "memory");
#pragma unroll
      for (int i = 0; i < 4; ++i) { const int row = i * 8 + (lane >> 3), ch = lane & 7; const u32x4 v = *(const u32x4*)(stg + row * 64 + ch * 8); *(u32x4*)(Ow + (long)row * LDO + ch * 8) = v; } }
    asm volatile("s_waitcnt lgkmcnt(0)\n\ts_barrier" ::: "memory");
#undef ATT_DMAK
#undef ATT_DMAV
#undef ATT_SLOT
}
}
namespace attn3 {
typedef unsigned short bf16;
using bf16x8=__attribute__((ext_vector_type(8)))short;
using s16x4=__attribute__((ext_vector_type(4)))short;
using f32x16=__attribute__((ext_vector_type(16)))float;
using u32x4=__attribute__((ext_vector_type(4)))unsigned;
constexpr int NW=8,QBLK=32,KVBLK=64;
__device__ __forceinline__ int crow(int r,int hi){return (r&3)+8*(r>>2)+4*hi;}
#define SBAR() __builtin_amdgcn_sched_barrier(0)
constexpr int NSLOT=3, SLOTB=8192;
constexpr int LDS_K=0, LDS_V=NSLOT*SLOTB, LDS_WS=2*NSLOT*SLOTB, LDS_OST=LDS_WS+NW*64*4, LDS_TB=LDS_OST+NW*4096,LDS_BYTES=LDS_TB+1280;
constexpr float MASKV=-4096.f;
__device__ __forceinline__ void glds16(const void*gbase,unsigned voff,unsigned lds_dst){unsigned keep;
  asm volatile("s_mov_b32 %0, m0\n\ts_mov_b32 m0, %3\n\ts_nop 0\n\tglobal_load_lds_dwordx4 %1, %2\n\ts_mov_b32 m0, %0":"=&s"(keep):"v"(voff),"s"(gbase),"s"(lds_dst):"memory");}
__device__ __forceinline__ float max3f(float a,float b,float c){float r;asm("v_max3_f32 %0, %1, %2, %3":"=v"(r):"v"(a),"v"(b),"v"(c));return r;}
__device__ __forceinline__ float max2f(float a,float b){float r;asm("v_max_f32_e32 %0, %1, %2":"=v"(r):"v"(a),"v"(b));return r;}
__device__ __forceinline__ float fadd_s(float a,float b){float r;asm("v_add_f32_e32 %0, %1, %2":"=v"(r):"v"(a),"v"(b));return r;}
__device__ __forceinline__ float fsub_s(float a,float b){float r;asm("v_sub_f32_e32 %0, %1, %2":"=v"(r):"v"(a),"v"(b));return r;}
typedef float f32x2_t __attribute__((ext_vector_type(2))); typedef __bf16 bf16x2_t __attribute__((ext_vector_type(2)));
__device__ __forceinline__ unsigned cvtpk_s(float lo,float hi){f32x2_t v={lo,hi};bf16x2_t b=__builtin_convertvector(v,bf16x2_t);return __builtin_bit_cast(unsigned,b);}
#define WAIT_BAR(N) asm volatile("s_waitcnt vmcnt(" #N ") lgkmcnt(0)\n\ts_barrier":::"memory")

__device__ __forceinline__ void qkt(f32x16&p0,f32x16&p1,const char*Kslot,const bf16x8*qr,int r32,int hi){ const f32x16 zz=f32x16{};
  const char*kb=Kslot+hi*1024+r32*16;
  #pragma unroll
  for(int d0=0;d0<4;++d0){
    const bf16x8 b0=*reinterpret_cast<const bf16x8*>(kb+d0*2048);
    const bf16x8 b1=*reinterpret_cast<const bf16x8*>(kb+d0*2048+512);
    if(d0==0){p0=__builtin_amdgcn_mfma_f32_32x32x16_bf16(b0,qr[0],zz,0,0,0);p1=__builtin_amdgcn_mfma_f32_32x32x16_bf16(b1,qr[0],zz,0,0,0);}
    else{p0=__builtin_amdgcn_mfma_f32_32x32x16_bf16(b0,qr[d0],p0,0,0,0);p1=__builtin_amdgcn_mfma_f32_32x32x16_bf16(b1,qr[d0],p1,0,0,0);}}
}
typedef __attribute__((address_space(3))) const char* lds_cptr;
typedef short v4i16_t __attribute__((ext_vector_type(4)));
__device__ __forceinline__ void kload8(bf16x8*kf,lds_cptr kp){
  kf[0]=*(const __attribute__((address_space(3))) bf16x8*)(kp);      kf[1]=*(const __attribute__((address_space(3))) bf16x8*)(kp+512);
  kf[2]=*(const __attribute__((address_space(3))) bf16x8*)(kp+2048); kf[3]=*(const __attribute__((address_space(3))) bf16x8*)(kp+2560);
  kf[4]=*(const __attribute__((address_space(3))) bf16x8*)(kp+4096); kf[5]=*(const __attribute__((address_space(3))) bf16x8*)(kp+4608);
  kf[6]=*(const __attribute__((address_space(3))) bf16x8*)(kp+6144); kf[7]=*(const __attribute__((address_space(3))) bf16x8*)(kp+6656);
}
__device__ __forceinline__ void kload2(bf16x8*kf,lds_cptr kp,int j){ kf[2*j]=*(const __attribute__((address_space(3))) bf16x8*)(kp+j*2048); kf[2*j+1]=*(const __attribute__((address_space(3))) bf16x8*)(kp+j*2048+512); }
__device__ __forceinline__ s16x4 vtr(lds_cptr p){ return __builtin_bit_cast(s16x4,__builtin_amdgcn_ds_read_tr16_b64_v4i16((__attribute__((address_space(3))) v4i16_t*)p)); }
__device__ __forceinline__ float rowmax(const f32x16&p0,const f32x16&p1){
  float a=max3f(p0[0],p0[1],p1[0]),b=max3f(p0[2],p0[3],p1[1]);a=max3f(a,p1[2],p1[3]);
  #pragma unroll
  for(int r=4;r<16;r+=4){a=max3f(a,p0[r],p0[r+1]);b=max3f(b,p0[r+2],p0[r+3]);a=max3f(a,p1[r],p1[r+1]);b=max3f(b,p1[r+2],p1[r+3]);}
  const float m=max2f(a,b);
  auto rr=__builtin_amdgcn_permlane32_swap(__float_as_uint(m),__float_as_uint(m),false,false);
  return max2f(__uint_as_float(rr[0]),__uint_as_float(rr[1]));
}
__device__ __forceinline__ void pv(f32x16*o,int vb,bf16x8 pa0,bf16x8 pa1,bf16x8 pa2,bf16x8 pa3){
  #pragma unroll
  for(int d0=0;d0<2;++d0){s16x4 lo[4],hi[4];
    #pragma unroll
    for(int ks=0;ks<4;++ks){
      asm volatile("ds_read_b64_tr_b16 %0,%1 offset:%c2":"=&v"(lo[ks]):"v"(vb),"i"(d0*4096+ks*1024):"memory");
      asm volatile("ds_read_b64_tr_b16 %0,%1 offset:%c2":"=&v"(hi[ks]):"v"(vb),"i"(d0*4096+ks*1024+512):"memory");}
    asm volatile("s_waitcnt lgkmcnt(0)":::"memory");SBAR();
    #define PK(k) (bf16x8){lo[k][0],lo[k][1],lo[k][2],lo[k][3],hi[k][0],hi[k][1],hi[k][2],hi[k][3]}
    o[d0]=__builtin_amdgcn_mfma_f32_32x32x16_bf16(pa0,PK(0),o[d0],0,0,0);
    o[d0]=__builtin_amdgcn_mfma_f32_32x32x16_bf16(pa1,PK(1),o[d0],0,0,0);
    o[d0]=__builtin_amdgcn_mfma_f32_32x32x16_bf16(pa2,PK(2),o[d0],0,0,0);
    o[d0]=__builtin_amdgcn_mfma_f32_32x32x16_bf16(pa3,PK(3),o[d0],0,0,0);
    #undef PK
  }
}

#ifndef ATTN_STORE16
#define ATTN_STORE16(p,v) (*(u32x4*)(p)=(v))
#endif
template<int DM,int LDO,int THRL> __device__ __forceinline__ void attn_unit(const bf16*Qw,const bf16*__restrict__ Kh,const bf16*__restrict__ Vh,bf16*Ow,int NT,int wt0,int wt1,int qi0,char*shm){
  const int tid=threadIdx.x,lane=tid&63,r32=lane&31,hi=lane>>5; const int wid=__builtin_amdgcn_readfirstlane(tid>>6);
  const unsigned lds0=(unsigned)(uintptr_t)shm;
  float*wsf=(float*)(shm+LDS_WS)+wid*64;
  const unsigned koff=(unsigned)(lane*DM+wid*8)*2u, voff=(unsigned)((16*(wid&3)+(lane>>2))*DM+(wid>>2)*32+(lane&3)*8)*2u;
  const unsigned kdst=lds0+LDS_K+wid*1024, vdst=lds0+LDS_V+wid*1024;
  #define DMA_K(t,slot) glds16(Kh+(long)(t)*KVBLK*DM,koff,(unsigned)__builtin_amdgcn_readfirstlane(kdst+(slot)))
  #define DMA_V(t,slot) glds16(Vh+(long)(t)*KVBLK*DM,voff,(unsigned)__builtin_amdgcn_readfirstlane(vdst+(slot)))
  const char*Kbase=shm+LDS_K; bf16x8 kf[8];
  const lds_cptr shm3=(lds_cptr)shm; const lds_cptr kp0=shm3+LDS_K+hi*1024+r32*16; const lds_cptr vp0=shm3+LDS_V+((lane>>4)&1)*32+(lane&3)*8+(4*hi+((lane&15)>>2))*64;
  DMA_K(0,0);DMA_V(0,0);DMA_K(1,SLOTB);
  bf16x8 qr[4];
  #pragma unroll
  for(int d0=0;d0<4;++d0)qr[d0]=*reinterpret_cast<const bf16x8*>(&Qw[(long)r32*DM+d0*16+hi*8]);
  float mhat=0.f,l_reg=0.f;f32x16 o[2];o[0]=f32x16{};o[1]=f32x16{};const f32x16 zz=f32x16{};
  const __attribute__((address_space(3))) float*tbr=(const __attribute__((address_space(3))) float*)((lds_cptr)shm+LDS_TB); const float cfar=__uint_as_float(__builtin_amdgcn_readfirstlane(__float_as_uint(tbr[0])));
  #define CMASK(P0,P1,t) do{ const int dc_=wt1-(t); \
    if(dc_<0||(t)<wt0){ const float mv_=MASKV-mhat; _Pragma("unroll") for(int r=0;r<16;++r){P0[r]=mv_;P1[r]=mv_;} } \
    else if(dc_>=3){ const float c_=cfar-mhat; _Pragma("unroll") for(int r=0;r<16;++r){P0[r]+=c_;P1[r]+=c_;} } \
    else{ const __attribute__((address_space(3))) float*tp_=tbr+(191-64*dc_-qi0-(int)(threadIdx.x&31u)+4*(int)((threadIdx.x>>5)&1u)); \
      _Pragma("unroll") for(int r=0;r<16;++r){ P0[r]+=tp_[(r&3)+8*(r>>2)]-mhat; P1[r]+=tp_[(r&3)+8*(r>>2)+32]-mhat; } } }while(0)
  bool resc=false;
  #define START(P0,P1) do{ const float rm=rowmax(P0,P1); resc=false; \
    { const float dl=rm; mhat=fadd_s(mhat,dl); \
      _Pragma("unroll") for(int r=0;r<16;++r){P0[r]=fsub_s(P0[r],dl);P1[r]=fsub_s(P1[r],dl);} \
      } \
    _Pragma("unroll") for(int r=0;r<16;++r)P0[r]=__builtin_amdgcn_exp2f(P0[r]); }while(0)
  #define RESC() do{ if(resc){ asm volatile("s_waitcnt lgkmcnt(0)":::"memory"); \
      _Pragma("unroll") for(int d_=0;d_<2;++d_) _Pragma("unroll") for(int r=0;r<16;++r)o[d_][r]*=wsf[crow(r,hi)]; } }while(0)
  f32x16 pA0,pA1,pB0,pB1;
  int sl_prev=0,sl_cur=0,sl_next=SLOTB;
  #define ROT() do{sl_prev=sl_cur;sl_cur=sl_next;sl_next=(sl_next==(NSLOT-1)*SLOTB)?0:sl_next+SLOTB;}while(0)
  DMA_K(2,2*SLOTB);
  WAIT_BAR(3);
  qkt(pA0,pA1,Kbase,qr,r32,hi);asm volatile("s_nop 15\n\ts_nop 7":"+v"(pA0),"+v"(pA1));CMASK(pA0,pA1,0);
  START(pA0,pA1);
  _Pragma("unroll") for(int r=0;r<16;++r)pA1[r]=__builtin_amdgcn_exp2f(pA1[r]);
  WAIT_BAR(0);
  DMA_K(3,0);DMA_V(1,SLOTB);
  ROT();
  kload8(kf,kp0+sl_cur);
  WAIT_BAR(2);
  s16x4 vlo[8],vhi[8]; u32x4 pw0,pw1,pw2,pw3;
  #define PKW(P,B) cvtpk_s(P[B],P[B+1])
  #define PAF(k) __builtin_bit_cast(bf16x8,pw##k)
  #define VFR(i) (bf16x8){vlo[i][0],vlo[i][1],vlo[i][2],vlo[i][3],vhi[i][0],vhi[i][1],vhi[i][2],vhi[i][3]}
  #define PIN(x) asm volatile("":"+v"(x))
  #define MX3(a,b,c) __builtin_fmaxf(__builtin_fmaxf((a),(b)),(c))
  #define GAPA(MF,A0,A1,A2,A3,W0,W1,PW) do{ MF; sacc+=A0; sacc+=A1; sacc+=A2; sacc+=A3; PIN(sacc); W0; W1; PIN(PW); SBAR(); }while(0)
  #define EX(v) __builtin_amdgcn_exp2f(v)
  #define GAPB(MF,X,B) do{ MF; X[B]=EX(X[B]); X[B+1]=EX(X[B+1]); X[B+2]=EX(X[B+2]); X[B+3]=EX(X[B+3]); PIN(X); SBAR(); }while(0)
  #define VRD(i) do{ vlo[i]=vtr(vp_+(((i)>>2)*4096+((i)&3)*1024)); vhi[i]=vtr(vp_+(((i)>>2)*4096+((i)&3)*1024+512)); }while(0)
  #define KRD(G,j) do{ if(G){ kload2(kf,kp0+sl_next,j); SBAR(); } }while(0)
  #define STEP(C0,C1,P0,P1,t,GK,GV,GL) do{ SBAR(); \
    const lds_cptr vp_=vp0+sl_prev; \
    VRD(0); SBAR(); float sacc=(P0[0]+P0[1]); \
    GAPA(C0=__builtin_amdgcn_mfma_f32_32x32x16_bf16(kf[0],qr[0],zz,0,0,0), P0[2],P0[3],P0[4],P0[5],     pw0[0]=PKW(P0,0), pw0[1]=PKW(P0,2), pw0); \
    VRD(4); SBAR(); GAPA(C1=__builtin_amdgcn_mfma_f32_32x32x16_bf16(kf[1],qr[0],zz,0,0,0), P0[6],P0[7],P0[8],P0[9],     pw0[2]=PKW(P0,4), pw0[3]=PKW(P0,6), pw0); \
    VRD(1); SBAR(); GAPA(C0=__builtin_amdgcn_mfma_f32_32x32x16_bf16(kf[2],qr[1],C0,0,0,0),   P0[10],P0[11],P0[12],P0[13], pw1[0]=PKW(P0,8), pw1[1]=PKW(P0,10), pw1); \
    VRD(5); SBAR(); GAPA(C1=__builtin_amdgcn_mfma_f32_32x32x16_bf16(kf[3],qr[1],C1,0,0,0),   P0[14],P0[15],P1[0],P1[1],   pw1[2]=PKW(P0,12),pw1[3]=PKW(P0,14), pw1); \
    VRD(2); SBAR(); GAPA(C0=__builtin_amdgcn_mfma_f32_32x32x16_bf16(kf[4],qr[2],C0,0,0,0),   P1[2],P1[3],P1[4],P1[5],     pw2[0]=PKW(P1,0), pw2[1]=PKW(P1,2), pw2); \
    VRD(6); SBAR(); GAPA(C1=__builtin_amdgcn_mfma_f32_32x32x16_bf16(kf[5],qr[2],C1,0,0,0),   P1[6],P1[7],P1[8],P1[9],     pw2[2]=PKW(P1,4), pw2[3]=PKW(P1,6), pw2); \
    VRD(3); SBAR(); GAPA(C0=__builtin_amdgcn_mfma_f32_32x32x16_bf16(kf[6],qr[3],C0,0,0,0),   P1[10],P1[11],P1[12],P1[13], pw3[0]=PKW(P1,8), pw3[1]=PKW(P1,10), pw3); \
    VRD(7); SBAR(); GAPA(C1=__builtin_amdgcn_mfma_f32_32x32x16_bf16(kf[7],qr[3],C1,0,0,0),   P1[14],P1[15],0.f,0.f,       pw3[2]=PKW(P1,12),pw3[3]=PKW(P1,14), pw3); \
    l_reg+=sacc; \
    if(GK){DMA_K((t)+3,sl_cur);} if(GV){DMA_V((t)+1,sl_next);} \
    CMASK(C0,C1,t); \
    { float a=MX3(C0[0],C0[1],C1[0]),b=MX3(C0[2],C0[3],C1[1]); a=MX3(a,C1[2],C1[3]); \
      _Pragma("unroll") for(int r=4;r<16;r+=4){a=MX3(a,C0[r],C0[r+1]);b=MX3(b,C0[r+2],C0[r+3]);a=MX3(a,C1[r],C1[r+1]);b=MX3(b,C1[r+2],C1[r+3]);} \
      float rm=__builtin_fmaxf(a,b); { auto rr=__builtin_amdgcn_permlane32_swap(__float_as_uint(rm),__float_as_uint(rm),false,false); rm=__builtin_fmaxf(__uint_as_float(rr[0]),__uint_as_float(rr[1])); } \
      resc=false; \
      if(__builtin_expect(__any(rm>(float)THRL),0)){ const float dl=__builtin_fmaxf(rm,0.f); mhat+=dl; \
        _Pragma("unroll") for(int r=0;r<16;++r){C0[r]-=dl;C1[r]-=dl;} \
        const float f=__builtin_amdgcn_exp2f(-dl); l_reg*=f; if(hi==0)wsf[r32]=f; resc=true; } } \
    SBAR(); \
    GAPB(o[0]=__builtin_amdgcn_mfma_f32_32x32x16_bf16(PAF(0),VFR(0),o[0],0,0,0), C0,0); \
    GAPB(o[1]=__builtin_amdgcn_mfma_f32_32x32x16_bf16(PAF(0),VFR(4),o[1],0,0,0), C0,4); \
    KRD(GL,0); GAPB(o[0]=__builtin_amdgcn_mfma_f32_32x32x16_bf16(PAF(1),VFR(1),o[0],0,0,0), C0,8); \
    KRD(GL,1); GAPB(o[1]=__builtin_amdgcn_mfma_f32_32x32x16_bf16(PAF(1),VFR(5),o[1],0,0,0), C0,12); \
    KRD(GL,2); GAPB(o[0]=__builtin_amdgcn_mfma_f32_32x32x16_bf16(PAF(2),VFR(2),o[0],0,0,0), C1,0); \
    KRD(GL,3); GAPB(o[1]=__builtin_amdgcn_mfma_f32_32x32x16_bf16(PAF(2),VFR(6),o[1],0,0,0), C1,4); \
    GAPB(o[0]=__builtin_amdgcn_mfma_f32_32x32x16_bf16(PAF(3),VFR(3),o[0],0,0,0), C1,8); \
    GAPB(o[1]=__builtin_amdgcn_mfma_f32_32x32x16_bf16(PAF(3),VFR(7),o[1],0,0,0), C1,12); \
    }while(0)
  int t=1;
  for(;t+5<NT;t+=2){
    STEP(pB0,pB1,pA0,pA1,t,true,true,true);     WAIT_BAR(2); RESC(); ROT();
    STEP(pA0,pA1,pB0,pB1,t+1,true,true,true);   WAIT_BAR(2); RESC(); ROT();
  }
  #define ENDW(tt) do{ if((tt)+3<NT){WAIT_BAR(2);} else if((tt)+2<NT){WAIT_BAR(1);} else {WAIT_BAR(0);} }while(0)
  for(;t+1<NT;t+=2){
    STEP(pB0,pB1,pA0,pA1,t,(t+3<NT),(t+1<NT),(t+1<NT));       ENDW(t);   RESC(); ROT();
    STEP(pA0,pA1,pB0,pB1,t+1,(t+4<NT),(t+2<NT),(t+2<NT));     ENDW(t+1); RESC(); ROT();
  }
  STEP(pB0,pB1,pA0,pA1,NT-1,false,false,false); RESC();
  { float sacc=pB0[0]+pB0[1]; _Pragma("unroll") for(int r=2;r<16;++r)sacc+=pB0[r]; _Pragma("unroll") for(int r=0;r<16;++r)sacc+=pB1[r]; l_reg+=sacc;
    pw0=(u32x4){PKW(pB0,0),PKW(pB0,2),PKW(pB0,4),PKW(pB0,6)};pw1=(u32x4){PKW(pB0,8),PKW(pB0,10),PKW(pB0,12),PKW(pB0,14)};pw2=(u32x4){PKW(pB1,0),PKW(pB1,2),PKW(pB1,4),PKW(pB1,6)};pw3=(u32x4){PKW(pB1,8),PKW(pB1,10),PKW(pB1,12),PKW(pB1,14)};
    SBAR(); pv(o,(int)(unsigned)(uintptr_t)(vp0+sl_cur),PAF(0),PAF(1),PAF(2),PAF(3)); }
  #undef PKW
  #undef PAF
  #undef VFR
  #undef PIN
  #undef MX3
  #undef GAPA
  #undef GAPB
  #undef EX
  #undef VRD
  #undef KRD
  #undef STEP
  #undef ENDW
  {auto rr=__builtin_amdgcn_permlane32_swap(__float_as_uint(l_reg),__float_as_uint(l_reg),false,false);l_reg=__uint_as_float(rr[0])+__uint_as_float(rr[1]);}
  if(hi==0)wsf[32+r32]=l_reg;asm volatile("s_waitcnt lgkmcnt(0)":::"memory");
  float rli[16];
  #pragma unroll
  for(int r=0;r<16;++r)rli[r]=__builtin_amdgcn_rcpf(wsf[32+crow(r,hi)]);
  { bf16*stg=(bf16*)(shm+LDS_OST)+wid*2048;
    #pragma unroll
    for(int r=0;r<16;++r){const int orow=crow(r,hi);
      #pragma unroll
      for(int d0=0;d0<2;++d0){ const float v_=o[d0][r]*rli[r]; const unsigned u_=__builtin_bit_cast(unsigned,v_); stg[orow*64+d0*32+r32]=(bf16)((u_+0x7fffu+((u_>>16)&1u))>>16); } }
    asm volatile("s_waitcnt lgkmcnt(0)":::"memory");
    #pragma unroll
    for(int i=0;i<4;++i){const int row=i*8+(lane>>3),ch=lane&7; const u32x4 v=*(const u32x4*)(stg+row*64+ch*8); *(u32x4*)(Ow+(long)row*LDO+ch*8)=v;} }
  asm volatile("s_waitcnt lgkmcnt(0)\n\ts_barrier":::"memory");
  #undef DMA_K
  #undef DMA_V
  #undef CMASK
  #undef START
  #undef RESC
  #undef ROT
}
#undef SBAR
#undef WAIT_BAR
}
namespace hgrn2 {
using bf16x8 = __attribute__((ext_vector_type(8))) short;
using f32x16 = __attribute__((ext_vector_type(16))) float;
using f32x4 = __attribute__((ext_vector_type(4))) float;
using u32x4 = __attribute__((ext_vector_type(4))) unsigned;
using u32x2 = __attribute__((ext_vector_type(2))) unsigned;
typedef unsigned short bf16;
#define HG_LAS __attribute__((address_space(3)))
constexpr int QS = 136, KS = 40, OS = 33;
constexpr int QD = 0, KD = QD + 32 * QS * 2, KET = KD + 32 * QS * 2, VT = KET + 128 * KS * 2, DEC = VT + 128 * KS * 2, PBSZ = DEC + 512;
constexpr int OT = 2 * PBSZ, SSP = OT + 4 * 32 * OS * 4, WG_BYTES = SSP + 2 * 512;
static_assert(WG_BYTES <= 131072 && PBSZ % 16 == 0 && OT % 16 == 0, "hgrn LDS map");
__device__ __forceinline__ int crow(int r, int hi) { return (r & 3) + 8 * (r >> 2) + 4 * hi; }
typedef float f32x2_t __attribute__((ext_vector_type(2))); typedef __bf16 bf16x2_t __attribute__((ext_vector_type(2)));
__device__ __forceinline__ unsigned cvtpk(float lo, float hi) { f32x2_t v = {lo, hi}; bf16x2_t b = __builtin_convertvector(v, bf16x2_t); return __builtin_bit_cast(unsigned, b); }
__device__ __forceinline__ float bf2f(unsigned short b) { return __builtin_bit_cast(float, (unsigned)b << 16); }
__device__ __forceinline__ bf16x8 packacc(const f32x16& x, int s) {
    u32x4 p; p[0] = cvtpk(x[8 * s], x[8 * s + 1]); p[1] = cvtpk(x[8 * s + 2], x[8 * s + 3]); p[2] = cvtpk(x[8 * s + 4], x[8 * s + 5]); p[3] = cvtpk(x[8 * s + 6], x[8 * s + 7]);
    return __builtin_bit_cast(bf16x8, p); }
__device__ __forceinline__ bf16x8 ldperm(const HG_LAS bf16* rowp, int k0, int hi) {
    const u32x2 a = *(const HG_LAS u32x2*)(rowp + k0 + 4 * hi), b = *(const HG_LAS u32x2*)(rowp + k0 + 8 + 4 * hi);
    u32x4 p; p[0] = a[0]; p[1] = a[1]; p[2] = b[0]; p[3] = b[1]; return __builtin_bit_cast(bf16x8, p); }
#define HG_MFMA(a, b, c) __builtin_amdgcn_mfma_f32_32x32x16_bf16((a), (b), (c), 0, 0, 0)

template <int LDP, int QOFF, int FOFF, int IOFF, int GOFF, int LDO, int OOFF, int SEQ_>
__device__ __forceinline__ void hgrn_pair(const bf16* P, bf16* O, const float* lb, const float* gw, int b, int h, HG_LAS unsigned char* lds, float eps) {
    constexpr int NB = SEQ_ / 32;
    const int tid = threadIdx.x, tid4 = tid & 255, lane = tid & 63, r32 = lane & 31, hi = lane >> 5; const int wave = __builtin_amdgcn_readfirstlane(tid >> 6); const int w4 = wave & 3;
    const size_t seq0 = (size_t)b * SEQ_;
    if (wave >= 4) {
        const int plane = tid4 & 63, rp = plane & 15, d0 = 8 * (4 * (tid4 >> 6) + (plane >> 4));
        const bf16* src0 = P + (seq0 + 2 * rp) * LDP + h * 128 + d0;
        u32x4 aF[2], aQ[2], aV[2], bF[2], bQ[2], bV[2];
#define HG_LOAD(F_, Q_, V_, n) do { const bf16* s_ = src0 + (size_t)(n) * 32 * LDP; _Pragma("unroll") for (int j = 0; j < 2; ++j) { F_[j] = *(const u32x4*)(s_ + (size_t)j * LDP + FOFF); Q_[j] = *(const u32x4*)(s_ + (size_t)j * LDP + QOFF); V_[j] = *(const u32x4*)(s_ + (size_t)j * LDP + IOFF); } } while (0)
#define HG_SHR(x, ctrl) __builtin_bit_cast(float, __builtin_amdgcn_update_dpp(0x3f800000, __builtin_bit_cast(int, (x)), (ctrl), 0xF, 0xF, false))
#define HG_PREP(F_, Q_, V_, pbo) do { \
        HG_LAS bf16* qd = (HG_LAS bf16*)(lds + (pbo) + QD); HG_LAS bf16* kd = (HG_LAS bf16*)(lds + (pbo) + KD); HG_LAS bf16* ket = (HG_LAS bf16*)(lds + (pbo) + KET); HG_LAS bf16* vt = (HG_LAS bf16*)(lds + (pbo) + VT); \
        HG_LAS float* dec = (HG_LAS float*)(lds + (pbo) + DEC); \
        float fa[8], fb[8], inc[8], exc[8]; \
        _Pragma("unroll") for (int e = 0; e < 8; ++e) { const unsigned wa = F_[0][e >> 1], wb = F_[1][e >> 1]; \
            fa[e] = (float)((e & 1) ? (wa >> 16) : (wa & 0xffffu)) * (1.f / 65536.f); fb[e] = (float)((e & 1) ? (wb >> 16) : (wb & 0xffffu)) * (1.f / 65536.f); inc[e] = fa[e] * fb[e]; } \
        _Pragma("unroll") for (int e = 0; e < 8; ++e) { inc[e] *= HG_SHR(inc[e], 0x111); inc[e] *= HG_SHR(inc[e], 0x112); inc[e] *= HG_SHR(inc[e], 0x114); inc[e] *= HG_SHR(inc[e], 0x118); exc[e] = HG_SHR(inc[e], 0x111); } \
        unsigned qwa[4], qwb[4], kwa[4], kwb[4]; float dtot[8], kea[8], keb[8]; \
        _Pragma("unroll") for (int e = 0; e < 8; ++e) dtot[e] = __shfl(inc[e], plane | 15); \
        _Pragma("unroll") for (int e = 0; e < 8; e += 2) { \
            const unsigned qa_ = Q_[0][e >> 1], qb_ = Q_[1][e >> 1]; \
            const float pa0 = exc[e] * fa[e], pa1 = exc[e + 1] * fa[e + 1], pb0 = inc[e], pb1 = inc[e + 1]; \
            qwa[e >> 1] = cvtpk(__builtin_bit_cast(float, qa_ << 16) * pa0, __builtin_bit_cast(float, qa_ & 0xffff0000u) * pa1); \
            qwb[e >> 1] = cvtpk(__builtin_bit_cast(float, qb_ << 16) * pb0, __builtin_bit_cast(float, qb_ & 0xffff0000u) * pb1); \
            const float ka0 = (1.f - fa[e]) * __builtin_amdgcn_rcpf(pa0), ka1 = (1.f - fa[e + 1]) * __builtin_amdgcn_rcpf(pa1), kb0 = (1.f - fb[e]) * __builtin_amdgcn_rcpf(pb0), kb1 = (1.f - fb[e + 1]) * __builtin_amdgcn_rcpf(pb1); \
            kwa[e >> 1] = cvtpk(ka0, ka1); kwb[e >> 1] = cvtpk(kb0, kb1); \
            kea[e] = ka0 * dtot[e]; kea[e + 1] = ka1 * dtot[e + 1]; keb[e] = kb0 * dtot[e]; keb[e + 1] = kb1 * dtot[e + 1]; } \
        *(HG_LAS u32x4*)(qd + (2 * rp) * QS + d0) = (u32x4){qwa[0], qwa[1], qwa[2], qwa[3]}; *(HG_LAS u32x4*)(qd + (2 * rp + 1) * QS + d0) = (u32x4){qwb[0], qwb[1], qwb[2], qwb[3]}; \
        *(HG_LAS u32x4*)(kd + (2 * rp) * QS + d0) = (u32x4){kwa[0], kwa[1], kwa[2], kwa[3]}; *(HG_LAS u32x4*)(kd + (2 * rp + 1) * QS + d0) = (u32x4){kwb[0], kwb[1], kwb[2], kwb[3]}; \
        _Pragma("unroll") for (int e = 0; e < 8; ++e) { const unsigned va_ = V_[0][e >> 1], vb_ = V_[1][e >> 1]; \
            *(HG_LAS unsigned*)(ket + (d0 + e) * KS + 2 * rp) = cvtpk(kea[e], keb[e]); \
            *(HG_LAS unsigned*)(vt + (d0 + e) * KS + 2 * rp) = (e & 1) ? ((va_ >> 16) | (vb_ & 0xffff0000u)) : ((va_ & 0xffffu) | (vb_ << 16)); } \
        if (rp == 15) { *(HG_LAS f32x4*)(dec + d0) = (f32x4){inc[0], inc[1], inc[2], inc[3]}; *(HG_LAS f32x4*)(dec + d0 + 4) = (f32x4){inc[4], inc[5], inc[6], inc[7]}; } } while (0)
        HG_LOAD(aF, aQ, aV, 0);
#pragma unroll 1
        for (int n = 0; n < NB + 2; n += 2) {
            if (n + 1 < NB) HG_LOAD(bF, bQ, bV, n + 1);
            if (n < NB) HG_PREP(aF, aQ, aV, 0);
            __syncthreads();
            if (n + 2 < NB) HG_LOAD(aF, aQ, aV, n + 2);
            if (n + 1 < NB) HG_PREP(bF, bQ, bV, PBSZ);
            __syncthreads();
        }
#undef HG_LOAD
#undef HG_PREP
#undef HG_SHR
    } else {
        __builtin_amdgcn_s_setprio(3);
        HG_LAS float* ot = (HG_LAS float*)(lds + OT) + w4 * 32 * OS;
        const int fl_ = lane & 31, eh = lane >> 5, ecol = 32 * w4 + 16 * eh;
        float gwv[16];
#pragma unroll
        for (int k = 0; k < 16; ++k) gwv[k] = gw[h * 128 + ecol + k];
        f32x16 S[4];
#pragma unroll
        for (int k = 0; k < 4; ++k) S[k] = f32x16{};
        float ov[16]; u32x4 g0 = {0u, 0u, 0u, 0u}, g1 = {0u, 0u, 0u, 0u};
#pragma unroll
        for (int k = 0; k < 16; ++k) ov[k] = 0.f;
#define HG_MMA(nb, pbo, sso) do { \
        const HG_LAS bf16* qd = (const HG_LAS bf16*)(lds + (pbo) + QD); const HG_LAS bf16* kd = (const HG_LAS bf16*)(lds + (pbo) + KD); const HG_LAS bf16* ket = (const HG_LAS bf16*)(lds + (pbo) + KET); \
        const HG_LAS bf16* vt = (const HG_LAS bf16*)(lds + (pbo) + VT); const HG_LAS float* dec = (const HG_LAS float*)(lds + (pbo) + DEC); HG_LAS float* ssp = (HG_LAS float*)(lds + SSP + (sso)); \
        { const bf16* gsrc = P + (seq0 + (size_t)(nb) * 32 + fl_) * LDP + GOFF + h * 128 + ecol; g0 = *(const u32x4*)(gsrc); g1 = *(const u32x4*)(gsrc + 8); } \
        f32x16 X = f32x16{}, X2 = f32x16{};                                       \
        _Pragma("unroll") for (int s = 0; s < 8; s += 2) { const bf16x8 a = *(const HG_LAS bf16x8*)(kd + r32 * QS + 16 * s + 8 * hi), bq_ = *(const HG_LAS bf16x8*)(qd + r32 * QS + 16 * s + 8 * hi); X = HG_MFMA(a, bq_, X); \
            const bf16x8 a2 = *(const HG_LAS bf16x8*)(kd + r32 * QS + 16 * (s + 1) + 8 * hi), bq2 = *(const HG_LAS bf16x8*)(qd + r32 * QS + 16 * (s + 1) + 8 * hi); X2 = HG_MFMA(a2, bq2, X2); } \
        _Pragma("unroll") for (int r = 0; r < 16; ++r) X[r] = crow(r, hi) <= r32 ? X[r] + X2[r] : 0.f; \
        const bf16x8 vf0 = ldperm(vt + (32 * w4 + r32) * KS, 0, hi), vf1 = ldperm(vt + (32 * w4 + r32) * KS, 16, hi); \
        f32x16 Oa = f32x16{}, Ob = f32x16{}, Oc = f32x16{}; \
        _Pragma("unroll") for (int blk = 0; blk < 2; ++blk) _Pragma("unroll") for (int s = 0; s < 2; ++s) { Ob = HG_MFMA(ldperm(qd + r32 * QS, 32 * blk + 16 * s, hi), packacc(S[blk], s), Ob); \
            Oc = HG_MFMA(ldperm(qd + r32 * QS, 32 * (blk + 2) + 16 * s, hi), packacc(S[blk + 2], s), Oc); } \
        Oa = HG_MFMA(packacc(X, 0), vf0, Oa); Oa = HG_MFMA(packacc(X, 1), vf1, Oa); \
        _Pragma("unroll") for (int r = 0; r < 16; ++r) Oa[r] += Ob[r] + Oc[r]; \
        _Pragma("unroll") for (int blk = 0; blk < 4; ++blk) { \
            _Pragma("unroll") for (int q4 = 0; q4 < 4; ++q4) { const f32x4 dv = *(const HG_LAS f32x4*)(dec + 32 * blk + 8 * q4 + 4 * hi); \
                _Pragma("unroll") for (int e = 0; e < 4; ++e) S[blk][4 * q4 + e] *= dv[e]; } \
            S[blk] = HG_MFMA(ldperm(ket + (32 * blk + r32) * KS, 0, hi), vf0, S[blk]); \
            S[blk] = HG_MFMA(ldperm(ket + (32 * blk + r32) * KS, 16, hi), vf1, S[blk]); } \
        _Pragma("unroll") for (int r = 0; r < 16; ++r) ot[crow(r, hi) * OS + r32] = Oa[r]; \
        asm volatile("s_waitcnt lgkmcnt(0)" ::: "memory"); \
        float ss = 0.f; \
        _Pragma("unroll") for (int k = 0; k < 16; ++k) { ov[k] = ot[fl_ * OS + 16 * eh + k]; ss += ov[k] * ov[k]; } \
        ss += __shfl_xor(ss, 32); \
        if (lane < 32) ssp[w4 * 32 + fl_] = ss; } while (0)
#define HG_FIN(nb, sso) do { \
        const HG_LAS float* ssp = (const HG_LAS float*)(lds + SSP + (sso)); \
        const float tot = (ssp[fl_] + ssp[32 + fl_]) + (ssp[64 + fl_] + ssp[96 + fl_]); const float rstd = 1.f / sqrtf(tot * (1.f / 128.f) + eps); \
        unsigned ow[8]; \
        _Pragma("unroll") for (int k = 0; k < 16; k += 2) { const unsigned gwd = k < 8 ? g0[k >> 1] : g1[(k - 8) >> 1]; \
            const float ga = bf2f((unsigned short)(gwd & 0xffffu)), gb = bf2f((unsigned short)(gwd >> 16)); \
            const float ra = ov[k] * rstd * gwv[k] * ga, rb = ov[k + 1] * rstd * gwv[k + 1] * gb;     \
            ow[k >> 1] = cvtpk(ra, rb); } \
        bf16* dst = O + (seq0 + (size_t)(nb) * 32 + fl_) * LDO + OOFF + h * 128 + ecol; \
        *(u32x4*)(dst) = (u32x4){ow[0], ow[1], ow[2], ow[3]}; *(u32x4*)(dst + 8) = (u32x4){ow[4], ow[5], ow[6], ow[7]}; } while (0)
#pragma unroll 1
        for (int n = 0; n < NB + 2; n += 2) {
            if (n >= 2) HG_FIN(n - 2, 0);
            if (n >= 1 && n <= NB) HG_MMA(n - 1, PBSZ, 512);
            __syncthreads();
            if (n >= 1 && n <= NB) HG_FIN(n - 1, 512);
            if (n < NB) HG_MMA(n, 0, 0);
            __syncthreads();
        }
#undef HG_MMA
#undef HG_FIN
        __builtin_amdgcn_s_setprio(0);
    }
    __syncthreads();
}
#undef HG_MFMA
}
#define GAS __attribute__((address_space(1)))
#define LAS __attribute__((address_space(3)))
typedef unsigned short bf16;
typedef unsigned v4u __attribute__((ext_vector_type(4)));
typedef float f32x4 __attribute__((ext_vector_type(4)));
typedef short bf16x8 __attribute__((ext_vector_type(8)));
typedef GAS unsigned gu32;
typedef GAS unsigned long long gu64;
#define RLX_AGENT __ATOMIC_RELAXED, __HIP_MEMORY_SCOPE_AGENT
#define LDS_WAIT() asm volatile("s_waitcnt lgkmcnt(0)" ::: "memory")
#define VM_WAIT() asm volatile("s_waitcnt vmcnt(0)" ::: "memory")
__device__ __forceinline__ unsigned long long rt() { return __builtin_amdgcn_s_memrealtime(); }
__device__ __forceinline__ unsigned f2bf(float f) { unsigned u = __builtin_bit_cast(unsigned, f); return (u + 0x7fffu + ((u >> 16) & 1u)) >> 16; }
__device__ __forceinline__ unsigned pk2(float lo, float hi) { return f2bf(lo) | (f2bf(hi) << 16); }

#define XB_TMO      128
#define XB_XCNT(j)  (256  + 64 * (j))
#define XB_XSUB(j)  (1280 + 64 * (j))
#define XB_XGEN(j)  (2304 + 64 * (j))
#define XB_TOP      3328
#define XB_TOPGEN   3392
#define XCD_BAR_WORDS 3456
#define XB_SPIN_CAP (1u << 18)

__device__ __forceinline__ unsigned xb_ld(unsigned* p)              { return __hip_atomic_load(p, __ATOMIC_RELAXED, __HIP_MEMORY_SCOPE_AGENT); }
__device__ __forceinline__ unsigned xb_add(unsigned* p, unsigned v) { return __hip_atomic_fetch_add(p, v, __ATOMIC_RELAXED, __HIP_MEMORY_SCOPE_AGENT); }
__device__ __forceinline__ unsigned xb_xcc_id() { return (unsigned)__builtin_amdgcn_s_getreg((3 << 11) | 20) & 0xFu; }
#define XB_SPIN(cond, bar) do { unsigned _sp = 0; while (cond) { __builtin_amdgcn_s_sleep(1); \
    if ((++_sp & 255u) == 0u) { if (xb_ld(&(bar)[XB_TMO])) break; if (_sp > XB_SPIN_CAP) { atomicAdd(&(bar)[XB_TMO], 1u); break; } } } } while (0)

struct XcdBarrier {
    unsigned* bar; unsigned x;
    volatile LAS unsigned* st;
};

__device__ __forceinline__ XcdBarrier xcd_barrier_post(unsigned* bar, volatile LAS unsigned* st) {
    XcdBarrier b; b.bar = bar; b.x = xb_xcc_id(); b.st = st;
    if (threadIdx.x == 0) (void)xb_add(&bar[XB_XCNT(b.x)], 1u);
    return b;
}
__device__ __forceinline__ void xcd_barrier_complete(unsigned* bar, unsigned x, unsigned& nloc, unsigned& nx) {
    const unsigned G = gridDim.x * gridDim.y * gridDim.z;
    unsigned sum, cnt, mine, sp = 0u;
    for (;;) {
        sum = 0u; cnt = 0u; mine = 0u;
#pragma unroll
        for (unsigned j = 0; j < 16; ++j) { const unsigned c = xb_ld(&bar[XB_XCNT(j)]); sum += c; cnt += (c > 0u) ? 1u : 0u; mine = (j == x) ? c : mine; }
        if (sum == G) break;
        __builtin_amdgcn_s_sleep(1);
        if ((++sp & 255u) == 0u) { if (xb_ld(&bar[XB_TMO])) break; if (sp > XB_SPIN_CAP) { atomicAdd(&bar[XB_TMO], 1u); break; } }
    }
    nloc = mine > 0u ? mine : 1u; nx = cnt > 0u ? cnt : 1u;
}

__device__ __forceinline__ void xcd_barrier(const XcdBarrier& b) {
    asm volatile("s_waitcnt vmcnt(0)" ::: "memory");
    __syncthreads();
    if (threadIdx.x == 0) {
        unsigned* bar = b.bar;
        __builtin_amdgcn_s_waitcnt(0);
        unsigned nloc = b.st[0], nx = b.st[1];
        if (nloc == 0u) { xcd_barrier_complete(bar, b.x, nloc, nx); b.st[0] = nloc; b.st[1] = nx; }
        const unsigned old = xb_add(&bar[XB_XSUB(b.x)], 1u);
        const unsigned gen = old / nloc;
        if (old + 1u == (gen + 1u) * nloc) {
            __builtin_amdgcn_fence(__ATOMIC_RELEASE, "agent");
            asm volatile("s_waitcnt vmcnt(0)" ::: "memory");
            const unsigned og = xb_add(&bar[XB_TOP], 1u);
            const unsigned tg = og / nx;
            if (og + 1u == (tg + 1u) * nx) xb_add(&bar[XB_TOPGEN], 1u);
            else XB_SPIN(xb_ld(&bar[XB_TOPGEN]) == tg, bar);
            __builtin_amdgcn_fence(__ATOMIC_ACQUIRE, "agent");
            xb_add(&bar[XB_XGEN(b.x)], 1u);
            asm volatile("s_waitcnt vmcnt(0)" ::: "memory");
        } else {
            XB_SPIN(xb_ld(&bar[XB_XGEN(b.x)]) == gen, bar);
            __builtin_amdgcn_fence(__ATOMIC_ACQUIRE, "agent");
            asm volatile("s_waitcnt vmcnt(0)" ::: "memory");
        }
    }
    __syncthreads();
}
struct Frame {
    LAS unsigned char* lds; char* ldsg;
    volatile LAS unsigned* MISC;
    gu32* ctl;
    int tid, lane, wave, G;
    unsigned char* ws;
    const float *x, *even_w_in, *even_w_out, *even_sinks, *lb_logits, *hgrn_norm_w, *odd_w_in, *odd_w_out, *odd_rel, *w_up, *conv_w, *conv_b, *w_down, *norm_w;
    float* out;
};
__device__ __forceinline__ float bf2f(bf16 b) { return __builtin_bit_cast(float, (unsigned)b << 16); }
__device__ __forceinline__ float wave_sum(float v) {
#pragma unroll
    for (int o = 1; o < 64; o <<= 1) v += __shfl_xor(v, o);
    return v;
}
__device__ __forceinline__ int colmap(int cmode, int n) {
    if (cmode == 1) { if (n >= 640) return n; const int p = n & 63; return (n - p) + (p >> 1) + 32 * (p & 1); }
    if (cmode == 2) { const int pn = n >> 8, r = n & 255; return r < 128 ? pn * 128 + r : DFF + pn * 128 + (r - 128); }
    return n;
}
__device__ __forceinline__ void transpose_item(const float* W, int K, int Nsrc, int Nout, bf16* WT, const float* kscale, int cmode, LAS float* scr, int item, int lane) {
    const int nblk = Nout / 32, kb = item / nblk, nb = item % nblk, k0 = 64 * kb, n0 = 32 * nb;
    const int nsrc = colmap(cmode, n0 + (lane & 31));
    float wv[32];
#pragma unroll
    for (int i = 0; i < 32; ++i) wv[i] = W[(size_t)(k0 + 2 * i + (lane >> 5)) * Nsrc + nsrc];
#pragma unroll
    for (int i = 0; i < 32; ++i) scr[(2 * i + (lane >> 5)) * 33 + (lane & 31)] = wv[i];
    LDS_WAIT(); asm volatile("" ::: "memory");
    const int c = lane & 7;
    f32x4 ksa = {1.f, 1.f, 1.f, 1.f}, ksb = {1.f, 1.f, 1.f, 1.f};
    if (kscale) { ksa = *(const GAS f32x4*)(kscale + k0 + 8 * c); ksb = *(const GAS f32x4*)(kscale + k0 + 8 * c + 4); }
#pragma unroll
    for (int j = 0; j < 4; ++j) { const int n = (lane >> 3) + 8 * j; const LAS float* s = scr + (8 * c) * 33 + n;
        v4u o; o.x = pk2(s[0 * 33] * ksa[0], s[1 * 33] * ksa[1]); o.y = pk2(s[2 * 33] * ksa[2], s[3 * 33] * ksa[3]); o.z = pk2(s[4 * 33] * ksb[0], s[5 * 33] * ksb[1]); o.w = pk2(s[6 * 33] * ksb[2], s[7 * 33] * ksb[3]);
        *(GAS v4u*)(WT + (size_t)(n0 + n) * K + k0 + 8 * c) = o; }
    LDS_WAIT(); asm volatile("" ::: "memory");
}
__device__ __forceinline__ void rms_row_to_bf16(int lane, const float* xrow, bf16* orow, float* scp) {
    const GAS f32x4* xr = (const GAS f32x4*)xrow + lane;
    f32x4 v[4]; float s = 0.f;
#pragma unroll
    for (int j = 0; j < 4; ++j) { v[j] = xr[64 * j]; s += (v[j].x * v[j].x + v[j].y * v[j].y) + (v[j].z * v[j].z + v[j].w * v[j].w); }
    const float rms = sqrtf(wave_sum(s) * (1.f / D) + EPS), rstd = 1.f / rms;
    if (lane == 0) *scp = rms;
    GAS unsigned long long* o8 = (GAS unsigned long long*)orow + lane;
#pragma unroll
    for (int j = 0; j < 4; ++j) o8[64 * j] = (unsigned long long)pk2(v[j].x * rstd, v[j].y * rstd) | ((unsigned long long)pk2(v[j].z * rstd, v[j].w * rstd) << 32);
}
__device__ __forceinline__ void p_prologue(Frame& F) {
    LAS float* scr = (LAS float*)(F.lds + RING_OFF + F.wave * 16384);
    const int gw = blockIdx.x * NWAVES + F.wave, NGW = F.G * NWAVES;
    constexpr int C0 = 1408, C1 = C0 + 512, C2_ = C1 + 1536, C3 = C2_ + 512, C4 = C3 + 2816, C5 = C4 + 2816, C6 = C5 + 1408, C7 = C6 + 1408;
#pragma unroll 1
    for (int git = gw; git < C7; git += NGW) {
        const int mat = git < C0 ? 0 : git < C1 ? 1 : git < C2_ ? 2 : git < C3 ? 3 : git < C4 ? 4 : git < C5 ? 5 : git < C6 ? 6 : 7;
        const int it = git - (mat == 0 ? 0 : mat == 1 ? C0 : mat == 2 ? C1 : mat == 3 ? C2_ : mat == 4 ? C3 : mat == 5 ? C4 : mat == 6 ? C5 : C6);
        const float* W; int K, Nsrc, Nout, cmode = 0; const float* ks = nullptr; size_t dst;
        if (mat == 0)      { W = F.even_w_in;  K = D; Nsrc = EVEN_IN; Nout = EVEN_IN; cmode = 1; ks = F.norm_w + 0 * D; dst = WS_WIN0; }
        else if (mat == 1) { W = F.even_w_out; K = D; Nsrc = D; Nout = D; dst = WS_WOUT0; }
        else if (mat == 2) { W = F.odd_w_in;   K = D; Nsrc = ODD_IN; Nout = ODD_IN; ks = F.norm_w + 4 * D; dst = WS_WIN1; }
        else if (mat == 3) { W = F.odd_w_out;  K = D; Nsrc = D; Nout = D; dst = WS_WOUT1; }
        else if (mat < 6)  { const int l = mat - 4; W = F.w_up + (size_t)l * D * UPN; K = D; Nsrc = UPN; Nout = UPN; cmode = 2; ks = F.norm_w + (size_t)(l * 4 + 2) * D; dst = WS_WUP + (size_t)l * 11 * MiB; }
        else               { const int l = mat - 6; W = F.w_down + (size_t)l * DFF * D; K = DFF; Nsrc = D; Nout = D; dst = WS_WDN + (size_t)l * 5632 * 1024; }
        transpose_item(W, K, Nsrc, Nout, (bf16*)(F.ws + dst), ks, cmode, scr, it, F.lane);
    }
    { float* tab = (float*)(F.ws + WS_TAB); const int gt = blockIdx.x * (NWAVES * 64) + F.tid, NT = F.G * NWAVES * 64;
      for (int e = gt; e < SEQ * 32; e += NT) { const int t = e >> 5, i = e & 31; const float inv = powf(10000.f, -(float)(2 * i) / 64.f); const float ang = (float)t * inv;
          tab[2 * e] = (float)cos((double)ang); tab[2 * e + 1] = (float)sin((double)ang); }
      float* lb = (float*)(F.ws + WS_LB);
      for (int e = gt; e < 512; e += NT) { const float a = F.lb_logits[e], b = F.lb_logits[512 + e]; const float mx = fmaxf(a, b); const float ea = expf(a - mx), eb = expf(b - mx); lb[e] = ea / (ea + eb); } }
    for (int m0 = gw; m0 < M; m0 += 2 * NGW) {
        const int m1 = m0 + NGW < M ? m0 + NGW : m0;
        const GAS f32x4* xa = (const GAS f32x4*)(F.x + (size_t)m0 * D); const GAS f32x4* xb = (const GAS f32x4*)(F.x + (size_t)m1 * D);
        f32x4 va[2][2], vb[2][2]; float sa = 0.f, sb = 0.f;
#pragma unroll
        for (int j = 0; j < 2; ++j) { va[j][0] = xa[2 * (F.lane + 64 * j)]; va[j][1] = xa[2 * (F.lane + 64 * j) + 1]; vb[j][0] = xb[2 * (F.lane + 64 * j)]; vb[j][1] = xb[2 * (F.lane + 64 * j) + 1]; }
#pragma unroll
        for (int j = 0; j < 2; ++j)
#pragma unroll
            for (int q = 0; q < 2; ++q) { sa += (va[j][q][0] * va[j][q][0] + va[j][q][1] * va[j][q][1]) + (va[j][q][2] * va[j][q][2] + va[j][q][3] * va[j][q][3]); sb += (vb[j][q][0] * vb[j][q][0] + vb[j][q][1] * vb[j][q][1]) + (vb[j][q][2] * vb[j][q][2] + vb[j][q][3] * vb[j][q][3]); }
        const float rmsa = sqrtf(wave_sum(sa) * (1.f / D) + EPS), rmsb = sqrtf(wave_sum(sb) * (1.f / D) + EPS), ra = 1.f / rmsa, rb = 1.f / rmsb;
        float* scp = (float*)(F.ws + WS_SC);
        GAS v4u* oa = (GAS v4u*)((bf16*)(F.ws + WS_XN) + (size_t)m0 * D) + F.lane; GAS v4u* ob = (GAS v4u*)((bf16*)(F.ws + WS_XN) + (size_t)m1 * D) + F.lane;
        if (F.lane == 0) { scp[m0] = rmsa; if (m1 != m0) scp[m1] = rmsb; }
#pragma unroll
        for (int j = 0; j < 2; ++j) { v4u o; o.x = pk2(va[j][0][0] * ra, va[j][0][1] * ra); o.y = pk2(va[j][0][2] * ra, va[j][0][3] * ra); o.z = pk2(va[j][1][0] * ra, va[j][1][1] * ra); o.w = pk2(va[j][1][2] * ra, va[j][1][3] * ra); oa[64 * j] = o; }
        if (m1 != m0) {
#pragma unroll
            for (int j = 0; j < 2; ++j) { v4u o; o.x = pk2(vb[j][0][0] * rb, vb[j][0][1] * rb); o.y = pk2(vb[j][0][2] * rb, vb[j][0][3] * rb); o.z = pk2(vb[j][1][0] * rb, vb[j][1][1] * rb); o.w = pk2(vb[j][1][2] * rb, vb[j][1][3] * rb); ob[64 * j] = o; } }
    }
}
__device__ __forceinline__ void p_norm(Frame& F, bf16* XNp, float* sc, const bf16* Y, const float* g, float* outf) {
    const int gw = blockIdx.x * NWAVES + F.wave, NGW = F.G * NWAVES;
    f32x4 gv[2][2];
#pragma unroll
    for (int j = 0; j < 2; ++j) { gv[j][0] = ((const GAS f32x4*)g)[2 * (F.lane + 64 * j)]; gv[j][1] = ((const GAS f32x4*)g)[2 * (F.lane + 64 * j) + 1]; }
    constexpr int R = 2;
    for (int m0 = gw; m0 < M; m0 += R * NGW) {
        v4u wx[R][2], wy[R][2]; float scm[R];
#pragma unroll
        for (int r = 0; r < R; ++r) { const int m = m0 + r * NGW; const int mm = m < M ? m : m0;
            const GAS v4u* xr = (const GAS v4u*)(XNp + (size_t)mm * D) + F.lane; const GAS v4u* yr = (const GAS v4u*)(Y + (size_t)mm * D) + F.lane;
            scm[r] = sc[mm];
#pragma unroll
            for (int j = 0; j < 2; ++j) { wx[r][j] = xr[64 * j]; wy[r][j] = yr[64 * j]; } }
#pragma unroll
        for (int r = 0; r < R; ++r) { const int m = m0 + r * NGW; if (m >= M) break;
            f32x4 h[2][2], y[2][2]; float s = 0.f;
#pragma unroll
            for (int j = 0; j < 2; ++j) { const v4u a = wx[r][j], w = wy[r][j];
                h[j][0][0] = __builtin_bit_cast(float, a.x << 16); h[j][0][1] = __builtin_bit_cast(float, a.x & 0xffff0000u); h[j][0][2] = __builtin_bit_cast(float, a.y << 16); h[j][0][3] = __builtin_bit_cast(float, a.y & 0xffff0000u);
                h[j][1][0] = __builtin_bit_cast(float, a.z << 16); h[j][1][1] = __builtin_bit_cast(float, a.z & 0xffff0000u); h[j][1][2] = __builtin_bit_cast(float, a.w << 16); h[j][1][3] = __builtin_bit_cast(float, a.w & 0xffff0000u);
                y[j][0][0] = __builtin_bit_cast(float, w.x << 16); y[j][0][1] = __builtin_bit_cast(float, w.x & 0xffff0000u); y[j][0][2] = __builtin_bit_cast(float, w.y << 16); y[j][0][3] = __builtin_bit_cast(float, w.y & 0xffff0000u);
                y[j][1][0] = __builtin_bit_cast(float, w.z << 16); y[j][1][1] = __builtin_bit_cast(float, w.z & 0xffff0000u); y[j][1][2] = __builtin_bit_cast(float, w.w << 16); y[j][1][3] = __builtin_bit_cast(float, w.w & 0xffff0000u);
#pragma unroll
                for (int q = 0; q < 2; ++q) s += (y[j][q][0] * y[j][q][0] + y[j][q][1] * y[j][q][1]) + (y[j][q][2] * y[j][q][2] + y[j][q][3] * y[j][q][3]); }
            const float r1 = 1.f / sqrtf(wave_sum(s) * (1.f / D) + EPS); float s2 = 0.f;
#pragma unroll
            for (int j = 0; j < 2; ++j)
#pragma unroll
                for (int q = 0; q < 2; ++q) { h[j][q] = h[j][q] * scm[r] + y[j][q] * r1 * gv[j][q]; s2 += (h[j][q][0] * h[j][q][0] + h[j][q][1] * h[j][q][1]) + (h[j][q][2] * h[j][q][2] + h[j][q][3] * h[j][q][3]); }
            if (outf) { GAS f32x4* ho = (GAS f32x4*)(outf + (size_t)m * D);
#pragma unroll
                for (int j = 0; j < 2; ++j) { ho[2 * (F.lane + 64 * j)] = h[j][0]; ho[2 * (F.lane + 64 * j) + 1] = h[j][1]; } }
            else { const float rms = sqrtf(wave_sum(s2) * (1.f / D) + EPS), r2 = 1.f / rms;
                if (F.lane == 0) sc[m] = rms;
                GAS v4u* xo = (GAS v4u*)(XNp + (size_t)m * D) + F.lane;
#pragma unroll
                for (int j = 0; j < 2; ++j) { v4u o; o.x = pk2(h[j][0][0] * r2, h[j][0][1] * r2); o.y = pk2(h[j][0][2] * r2, h[j][0][3] * r2); o.z = pk2(h[j][1][0] * r2, h[j][1][1] * r2); o.w = pk2(h[j][1][2] * r2, h[j][1][3] * r2); xo[64 * j] = o; } }
        }
    }
}
template <class Sched> __device__ __forceinline__ void p_fixup_mine(Frame& F, const Sched& S, bf16* H, const bf16* UL, const bf16* UF, const bf16* VF, const float* cw, const float* cb) {
    if (F.tid < DFF / 8) { const int j0 = F.tid * 8;
        f32x4 kc[8];
        kc[0] = *(const GAS f32x4*)(cb + j0); kc[1] = *(const GAS f32x4*)(cb + j0 + 4); kc[2] = *(const GAS f32x4*)(cw + j0); kc[3] = *(const GAS f32x4*)(cw + j0 + 4);
        kc[4] = *(const GAS f32x4*)(cw + DFF + j0); kc[5] = *(const GAS f32x4*)(cw + DFF + j0 + 4); kc[6] = *(const GAS f32x4*)(cw + 2 * DFF + j0); kc[7] = *(const GAS f32x4*)(cw + 2 * DFF + j0 + 4);
#pragma unroll 1
        for (int i0 = 0; ; i0 += 4) {
            int pms[4]; int n = 0; pg8::Unit u;
#pragma unroll
            for (int q = 0; q < 4; ++q) { pms[q] = 0; if (S.next(i0 + q, u)) { pms[q] = u.pm; n = q + 1; } }
            if (n == 0) break;
            v4u uf[4][2], vf[4][2], ul[4][2];
#pragma unroll
            for (int q = 0; q < 4; ++q) { const int pm = pms[q]; const bool has_prev = (pm & 7) != 0; const v4u z4 = {0u, 0u, 0u, 0u};
                uf[q][0] = *(const GAS v4u*)(UF + ((size_t)pm * 2 + 0) * DFF + j0); uf[q][1] = *(const GAS v4u*)(UF + ((size_t)pm * 2 + 1) * DFF + j0);
                vf[q][0] = *(const GAS v4u*)(VF + ((size_t)pm * 2 + 0) * DFF + j0); vf[q][1] = *(const GAS v4u*)(VF + ((size_t)pm * 2 + 1) * DFF + j0);
                ul[q][0] = has_prev ? *(const GAS v4u*)(UL + ((size_t)(pm - 1) * 2 + 0) * DFF + j0) : z4; ul[q][1] = has_prev ? *(const GAS v4u*)(UL + ((size_t)(pm - 1) * 2 + 1) * DFF + j0) : z4; }
#pragma unroll
            for (int q = 0; q < 4; ++q) { if (q < n) {
#pragma unroll
                for (int r = 0; r < 2; ++r) { const v4u u0 = uf[q][r], vv = vf[q][r], um1 = r ? uf[q][0] : ul[q][1], um2 = r ? ul[q][1] : ul[q][0];
                    float hh[8];
#pragma unroll
                    for (int e = 0; e < 8; ++e) { const int sh = (e & 1) * 16; const unsigned wa = u0[e >> 1], wb = um1[e >> 1], wc_ = um2[e >> 1], wv = vv[e >> 1];
                        const float a = bf2f((bf16)(wa >> sh)), b_ = bf2f((bf16)(wb >> sh)), c = bf2f((bf16)(wc_ >> sh)), v = bf2f((bf16)(wv >> sh));
                        const float pre = kc[(e >> 2)][e & 3] + kc[2 + (e >> 2)][e & 3] * c + kc[4 + (e >> 2)][e & 3] * b_ + kc[6 + (e >> 2)][e & 3] * a;
                        const pg8::f32x2 gg = pg8::gelu_pk((pg8::f32x2){pre, pre}); hh[e] = gg.x * v; }
                    v4u o; o.x = pk2(hh[0], hh[1]); o.y = pk2(hh[2], hh[3]); o.z = pk2(hh[4], hh[5]); o.w = pk2(hh[6], hh[7]);
                    *(GAS v4u*)(H + ((size_t)pms[q] * 256 + r) * DFF + j0) = o; } } }
            if (n < 4) break;
        } }
    asm volatile("s_waitcnt vmcnt(0)" ::: "memory"); __syncthreads();
}
__device__ __forceinline__ void p_attn1(Frame& F, const bf16* PROJ, bf16* OB) {
    LAS float* tbw = (LAS float*)(F.lds + RING_OFF + attn3::LDS_TB);
    for (int pair = blockIdx.x; pair < BATCH * 16; pair += F.G) {
        const int b = pair >> 4, h = pair & 15;
        if (F.tid < 320) { const int a = 319 - F.tid; tbw[F.tid] = F.odd_rel[h * 257 + (a > 256 ? 256 : a)] * LOG2E; }
        __syncthreads();
#pragma unroll 1
        for (int g4 = 0; g4 < 8; ++g4) {
            const int c0 = 4 * g4, jlo = c0 - 8 < 0 ? 0 : c0 - 8, NT = c0 + 4 - jlo, cw = c0 + (F.wave >> 1), wt1 = cw - jlo, wt0 = cw - 8 - jlo < 0 ? 0 : cw - 8 - jlo, qi0 = 32 * (F.wave & 1);
            const size_t row0 = (size_t)b * SEQ + 64 * cw + qi0, krow0 = (size_t)b * SEQ + 64 * jlo;
            attn3::attn_unit<ODD_IN, D, 8>(PROJ + row0 * ODD_IN + h * 64, PROJ + krow0 * ODD_IN + 1024 + h * 64, PROJ + krow0 * ODD_IN + 2048 + h * 64, OB + row0 * D + h * 64, NT, wt0, wt1, qi0, F.ldsg + RING_OFF);
        }
    }
}
__device__ __forceinline__ void p_attn0(Frame& F, const bf16* PROJ, bf16* OB, int first, int stride) {
#pragma unroll 1
    for (int u = first; u < BATCH * 2 * 32; u += stride) {
        const int c = u & 31, hk = (u >> 5) & 1, b = u >> 6, qh = 4 * hk + (F.wave >> 1), qpos0 = 64 * c + 32 * (F.wave & 1), jlo = c - 2 < 0 ? 0 : c - 2;
        const size_t row0 = (size_t)b * SEQ + qpos0, seq0 = (size_t)b * SEQ;
        attn2::band_unit<EVEN_IN, EVEN_IN, D, false, true>(PROJ + row0 * EVEN_IN + qh * 64, PROJ + seq0 * EVEN_IN + 512 + hk * 64, PROJ + seq0 * EVEN_IN + 640 + hk * 64,
                                                           OB + row0 * D + qh * 64, jlo, c, jlo, c, qpos0, F.even_sinks[qh] * LOG2E, F.ldsg + RING_OFF);
    }
}

__device__ __forceinline__ void p_hgrn(Frame& F, const bf16* PROJ, bf16* OB, const float* lb, int nhw) {
#pragma unroll 1
    for (int pair = blockIdx.x; pair < BATCH * 4; pair += nhw)
        hgrn2::hgrn_pair<EVEN_IN, QB_OFF, FB_OFF, IB_OFF, GB_OFF, D, 512, SEQ>(PROJ, OB, lb, F.hgrn_norm_w, pair >> 2, pair & 3, F.lds + RING_OFF, EPS);
}
constexpr int NPH = 17;
struct Args { const float* in[14]; float* out; unsigned char* ws; int ph_lo, ph_hi; };
__global__ void __launch_bounds__(NWAVES * 64, 2) mk_fwd(Args args) {
    extern __shared__ __attribute__((aligned(16))) unsigned char lds[];
    Frame F;
    F.lds = (LAS unsigned char*)lds; F.ldsg = (char*)lds;
    F.MISC = (volatile LAS unsigned*)(F.lds + MISC_OFF);
    F.tid = threadIdx.x; F.lane = F.tid & 63; F.wave = __builtin_amdgcn_readfirstlane(F.tid >> 6);
    F.G = gridDim.x;
    unsigned char* ws = args.ws; F.ws = ws;
    F.ctl = (gu32*)(ws + WS_CTL);
    F.x = args.in[0]; F.even_w_in = args.in[1]; F.even_w_out = args.in[2]; F.even_sinks = args.in[3]; F.lb_logits = args.in[4]; F.hgrn_norm_w = args.in[5];
    F.odd_w_in = args.in[6]; F.odd_w_out = args.in[7]; F.odd_rel = args.in[8]; F.w_up = args.in[9]; F.conv_w = args.in[10]; F.conv_b = args.in[11]; F.w_down = args.in[12]; F.norm_w = args.in[13];
    F.out = args.out;
    for (int u = F.tid; u < (LDS_BYTES - LDSCTL_OFF) / 4; u += NWAVES * 64) ((LAS unsigned*)(F.lds + LDSCTL_OFF))[u] = 0u;
    __syncthreads();
    const int lo = args.ph_lo, hi = args.ph_hi;
    XcdBarrier bar; bar.bar = (unsigned*)(F.ctl + CW_BAR); bar.x = 0; bar.st = nullptr;
    if (hi - lo > 1) {
        bar.x = xb_xcc_id(); bar.st = F.MISC + 8;
        if (F.tid == 0) F.MISC[10] = xb_add(&bar.bar[XB_XCNT(bar.x)], 1u);
    }
    int vcu = (int)blockIdx.x;
#define IN(k) (lo <= (k) && (k) < hi)
#define SEAM(k) do { if (IN(k) && IN((k) + 1)) xcd_barrier(bar); } while (0)
    bf16* const XN = (bf16*)(ws + WS_XN); bf16* const PROJ = (bf16*)(ws + WS_PROJ); bf16* const OB = (bf16*)(ws + WS_O); bf16* const YB = (bf16*)(ws + WS_Y);
    bf16* const UL = (bf16*)(ws + WS_SIDE); bf16* const UF = (bf16*)(ws + WS_SIDE + SIDE_STRIDE); bf16* const VF = (bf16*)(ws + WS_SIDE + 2 * SIDE_STRIDE);
    float* const SCB = (float*)(ws + WS_SC); const float* const tab = (const float*)(ws + WS_TAB); const float* const lbv = (const float*)(ws + WS_LB);

    if (IN(0)) { p_prologue(F); } SEAM(0);
    if (hi - lo > 1 && lo == 0) {
        if (F.tid == 0) { unsigned dense = 0u, nx = 0u; bool ok = (F.G % 8) == 0;
            for (unsigned j = 0; j < 16; ++j) { const unsigned cnt = xb_ld(&bar.bar[XB_XCNT(j)]); if (cnt) { ++nx; if (cnt != (unsigned)F.G / 8u) ok = false; } if (j < bar.x && cnt) ++dense; }
            const unsigned rank = F.MISC[10];
            F.MISC[11] = (ok && nx == 8u && rank < (unsigned)F.G / 8u) ? (8u * rank + dense) : 0xffffffffu; }
        __syncthreads();
        const unsigned v = F.MISC[11]; if (v != 0xffffffffu) vcu = (int)v;
    }

    if (IN(1)) { pg8::Gemm g{XN, (const bf16*)(ws + WS_WIN0), M, EVEN_IN, D}; pg8::StaticOrder S; S.init(M, EVEN_IN, F.G, vcu);
        typedef pg8::EpiIn<EVEN_IN, 640, 512, FB_OFF, FB_OFF + 512, GB_OFF, GB_OFF + 512> EpiIn0; EpiIn0 E{PROJ, C2, tab, lbv};
        pg8::gemm_phase<EpiIn0, pg8::StaticOrder, true, true>(F.lds + RING_OFF, g, S, E); } SEAM(1);
    if (IN(2)) { const int nhw = F.G >= 192 ? 128 : 0;
        if (nhw == 0) { p_attn0(F, PROJ, OB, (int)blockIdx.x, F.G); __syncthreads(); p_hgrn(F, PROJ, OB, lbv, F.G); }
        else if ((int)blockIdx.x < nhw) p_hgrn(F, PROJ, OB, lbv, nhw);
        else p_attn0(F, PROJ, OB, (int)blockIdx.x - nhw, F.G - nhw); } SEAM(2);
    if (IN(3)) { pg8::Gemm g{OB, (const bf16*)(ws + WS_WOUT0), M, D, D}; pg8::StaticOrder S; S.init(M, D, F.G, vcu);
        pg8::EpiBf16<0> E{YB, D, nullptr, 0, 0, 1.f};
        pg8::gemm_phase<pg8::EpiBf16<0>, pg8::StaticOrder, true, true>(F.lds + RING_OFF, g, S, E); } SEAM(3);
    if (IN(4)) { p_norm(F, XN, SCB, YB, F.norm_w + 1 * D, nullptr); } SEAM(4);
    if (IN(5)) { pg8::Gemm g{XN, (const bf16*)(ws + WS_WUP), M, UPN, D}; pg8::StaticOrder S; S.init(M, UPN, F.G, vcu);
        pg8::EpiConvGate E{PROJ, UL, UF, VF, F.conv_w, F.conv_b, DFF, (LAS float*)(F.lds + XCH_OFF)};
        pg8::gemm_phase<pg8::EpiConvGate, pg8::StaticOrder, true, true>(F.lds + RING_OFF, g, S, E); } SEAM(5);
    if (IN(7)) { pg8::Gemm g{PROJ, (const bf16*)(ws + WS_WDN), M, D, DFF}; pg8::StaticOrder S; S.init(M, D, F.G, vcu);
        p_fixup_mine(F, S, PROJ, UL, UF, VF, F.conv_w, F.conv_b);
        pg8::EpiBf16<0> E{YB, D, nullptr, 0, 0, 1.f};
        pg8::gemm_phase<pg8::EpiBf16<0>, pg8::StaticOrder, true, true>(F.lds + RING_OFF, g, S, E); } SEAM(7);
    if (IN(8)) { p_norm(F, XN, SCB, YB, F.norm_w + 3 * D, nullptr); } SEAM(8);
    if (IN(9)) { pg8::Gemm g{XN, (const bf16*)(ws + WS_WIN1), M, ODD_IN, D}; pg8::StaticOrder S; S.init(M, ODD_IN, F.G, vcu);
        typedef pg8::EpiIn<ODD_IN, 0, 1024, 0, 0, 0, 0> EpiIn1; EpiIn1 E{PROJ, C2, tab, lbv};
        pg8::gemm_phase<EpiIn1, pg8::StaticOrder, true, true>(F.lds + RING_OFF, g, S, E); } SEAM(9);
    if (IN(10)) { p_attn1(F, PROJ, OB); } SEAM(10);
    if (IN(11)) { pg8::Gemm g{OB, (const bf16*)(ws + WS_WOUT1), M, D, D}; pg8::StaticOrder S; S.init(M, D, F.G, vcu);
        pg8::EpiBf16<0> E{YB, D, nullptr, 0, 0, 1.f};
        pg8::gemm_phase<pg8::EpiBf16<0>, pg8::StaticOrder, true, true>(F.lds + RING_OFF, g, S, E); } SEAM(11);
    if (IN(12)) { p_norm(F, XN, SCB, YB, F.norm_w + 5 * D, nullptr); } SEAM(12);
    if (IN(13)) { pg8::Gemm g{XN, (const bf16*)(ws + WS_WUP + 11 * MiB), M, UPN, D}; pg8::StaticOrder S; S.init(M, UPN, F.G, vcu);
        pg8::EpiConvGate E{PROJ, UL, UF, VF, F.conv_w + 3 * DFF, F.conv_b + DFF, DFF, (LAS float*)(F.lds + XCH_OFF)};
        pg8::gemm_phase<pg8::EpiConvGate, pg8::StaticOrder, true, true>(F.lds + RING_OFF, g, S, E); } SEAM(13);
    if (IN(15)) { pg8::Gemm g{PROJ, (const bf16*)(ws + WS_WDN + (size_t)5632 * 1024), M, D, DFF}; pg8::StaticOrder S; S.init(M, D, F.G, vcu);
        p_fixup_mine(F, S, PROJ, UL, UF, VF, F.conv_w + 3 * DFF, F.conv_b + DFF);
        pg8::EpiBf16<0> E{YB, D, nullptr, 0, 0, 1.f};
        pg8::gemm_phase<pg8::EpiBf16<0>, pg8::StaticOrder, true, true>(F.lds + RING_OFF, g, S, E); } SEAM(15);
    if (IN(16)) { p_norm(F, XN, SCB, YB, F.norm_w + 7 * D, F.out); }
#undef IN
#undef SEAM
}

#ifndef MK_ONE_LAUNCH
#define MK_ONE_LAUNCH 1
#endif
extern "C" void kernel_launch(void* const* d_in, const int* in_sizes, int n_in, void* d_out, int out_size, void* d_ws, size_t ws_size, hipStream_t stream) {
    static int grid = 0;
    if (grid == 0) {
        if (n_in != 14 || in_sizes[0] != M * D || out_size != M * D || ws_size < WS_END) { fprintf(stderr, "kernel_launch: unexpected shapes (n_in %d, in0 %d, out %d, ws %zu); nothing launched\n", n_in, n_in > 0 ? in_sizes[0] : -1, out_size, ws_size); grid = -1; return; }
        int dev = 0, cus = 0, per_cu = 0;
        if (hipGetDevice(&dev) != hipSuccess || hipDeviceGetAttribute(&cus, hipDeviceAttributeMultiprocessorCount, dev) != hipSuccess) { grid = -1; return; }
        if (hipFuncSetAttribute((const void*)mk_fwd, hipFuncAttributeMaxDynamicSharedMemorySize, LDS_BYTES) != hipSuccess) { fprintf(stderr, "kernel_launch: hipFuncSetAttribute failed\n"); grid = -1; return; }
        if (hipOccupancyMaxActiveBlocksPerMultiprocessor(&per_cu, (const void*)mk_fwd, NWAVES * 64, LDS_BYTES) != hipSuccess || per_cu < 1) { fprintf(stderr, "kernel_launch: occupancy query says %d\n", per_cu); }
        (void)hipGetLastError();
        grid = cus;
    }
    if (grid < 0) return;
    if (hipMemsetAsync((char*)d_ws + WS_CTL, 0, CTL_ZERO_BYTES, stream) != hipSuccess) return;
    Args a{};
    for (int i = 0; i < 14; ++i) a.in[i] = (const float*)d_in[i];
    a.out = (float*)d_out; a.ws = (unsigned char*)d_ws;
#if MK_ONE_LAUNCH
    a.ph_lo = 0; a.ph_hi = NPH;
    hipLaunchKernelGGL(mk_fwd, dim3(grid), dim3(NWAVES * 64), LDS_BYTES, stream, a);
#else
    for (int k = 0; k < NPH; ++k) { a.ph_lo = k; a.ph_hi = k + 1; hipLaunchKernelGGL(mk_fwd, dim3(grid), dim3(NWAVES * 64), LDS_BYTES, stream, a); }
#endif
}
```
